# Optimizing an MI355X kernel written in HIP

```python
import jax, jax.numpy as jnp
from jax import lax
import numpy as np

D_MODEL = 1024
BATCH = 4
SEQ = 4096
DEPTH = 2
DEC_BATCH = 8
DEC_SEQ = 32
PAST_LEN = 1024

CHUNK = 64
D_A = D_MODEL
CONV_A_W = 3
D_B = D_MODEL
CONV_B_W = 4
LRU_BLOCKS = 8
LRU_BW = D_B // LRU_BLOCKS
LRU_C = 8.0
D_C = D_MODEL
C_HEADS = 8
C_HD = D_C // C_HEADS
PEER_HEADS = 8
PEER_DQ = 256
PEER_DH = PEER_DQ // 2
N_KEYS = 128
N_EXPERTS = N_KEYS * N_KEYS
PEER_TOPK = 16
PEER_BLOCK = 128
ALPHA = (2.0 * DEPTH) ** 0.25
BETA = (8.0 * DEPTH) ** -0.25
LN_EPS = 1e-5
RMS_EPS = 1e-6
IN_SPLITS = (D_A, D_A, D_A, D_B, D_B, D_C, D_C, D_C, D_C, D_MODEL, D_MODEL, D_MODEL)
IN_COLS = sum(IN_SPLITS)

kernel_name = 'hybrid_conv_rglru_hgrn2_peer_stream_step'


def layer_norm(x, g, b):
    xf = x.astype(jnp.float32)
    mu = jnp.mean(xf, axis=-1, keepdims=True)
    var = jnp.mean(jnp.square(xf - mu), axis=-1, keepdims=True)
    return ((xf - mu) * lax.rsqrt(var + LN_EPS) * g + b).astype(x.dtype)


def causal_dwconv(u, past, w):
    width = w.shape[0]
    t_len = u.shape[1]
    full = jnp.concatenate([past.astype(u.dtype), u], axis=1)
    y = sum(full[:, k:k + t_len] * w[k] for k in range(width))
    return y, full[:, full.shape[1] - (width - 1):]


def rg_lru(x, w_a, b_a, w_x, b_x, lam, h0):
    bsz, t_len, _ = x.shape
    xf = x.astype(jnp.float32)
    xb = xf.reshape(bsz, t_len, LRU_BLOCKS, LRU_BW)
    r = jax.nn.sigmoid(jnp.einsum('btni,nij->btnj', xb, w_a).reshape(bsz, t_len, D_B) + b_a)
    gi = jax.nn.sigmoid(jnp.einsum('btni,nij->btnj', xb, w_x).reshape(bsz, t_len, D_B) + b_x)
    log_a = -LRU_C * r * jax.nn.softplus(-lam.astype(jnp.float32))
    a = jnp.exp(log_a)
    u = jnp.sqrt(-jnp.expm1(2.0 * log_a)) * (gi * xf)
    u = u.at[:, 0].add(a[:, 0] * h0.astype(jnp.float32))

    def combine(left, right):
        a1, b1 = left
        a2, b2 = right
        return a1 * a2, a2 * b1 + b2

    _, h = lax.associative_scan(combine, (a, u), axis=1)
    return h.astype(x.dtype), h[:, -1].astype(x.dtype)


def hgrn2_chunk(s0, blk):
    q, k, v, logf = blk
    l_len = q.shape[1]
    b = jnp.cumsum(logf, axis=1)
    mask = jnp.tril(jnp.ones((l_len, l_len), dtype=bool))
    diff = b[:, :, None] - b[:, None, :]
    decay = jnp.exp(jnp.where(mask[None, :, :, None, None], diff, -jnp.inf))
    att = jnp.einsum('bthd,bshd,btshd->bhts', q, k, decay)
    o = (jnp.einsum('bthd,bhde->bthe', q * jnp.exp(b), s0)
         + jnp.einsum('bhts,bshe->bthe', att, v))
    b_last = b[:, -1]
    s_new = (jnp.exp(b_last)[..., None] * s0
             + jnp.einsum('bshd,bshe->bhde', k * jnp.exp(b_last[:, None] - b), v))
    return s_new, o


def hgrn2(q, k, v, logf, s0):
    bsz, t_len, nh, _ = q.shape
    l_len = min(CHUNK, t_len)
    n_chunks = t_len // l_len

    def to_chunks(t):
        return t.reshape(bsz, n_chunks, l_len, nh, t.shape[-1]).swapaxes(0, 1)

    s_t, o = lax.scan(hgrn2_chunk, s0, (to_chunks(q), to_chunks(k), to_chunks(v), to_chunks(logf)))
    o = o.swapaxes(0, 1).reshape(bsz, t_len, nh, o.shape[-1])
    return o, s_t


def peer_block(xt, wq, keys, u_tab, v_tab):
    n = xt.shape[0]
    q = (xt @ wq).reshape(n, PEER_HEADS, 2, PEER_DH)
    s = jnp.einsum('nhpd,hpkd->nhpk', q, keys).astype(jnp.float32)
    sv, si = lax.top_k(s, PEER_TOPK)
    cand = (sv[:, :, 0, :, None] + sv[:, :, 1, None, :]).reshape(n, PEER_HEADS, PEER_TOPK * PEER_TOPK)
    cid = (si[:, :, 0, :, None] * N_KEYS + si[:, :, 1, None, :]).reshape(n, PEER_HEADS, PEER_TOPK * PEER_TOPK)
    top_s, top_p = lax.top_k(cand, PEER_TOPK)
    expert = jnp.take_along_axis(cid, top_p, axis=-1)
    g = jax.nn.softmax(top_s, axis=-1)
    h = jax.nn.gelu(jnp.einsum('nd,nhkd->nhk', xt, u_tab[expert]), approximate=False)
    return jnp.einsum('nhk,nhkd->nd', (g * h).astype(xt.dtype), v_tab[expert])


def peer(x, wq, keys, u_tab, v_tab):
    bsz, t_len, d = x.shape
    n = bsz * t_len
    blk = PEER_BLOCK if n % PEER_BLOCK == 0 else n
    xt = x.reshape(n // blk, blk, d)
    out = lax.map(lambda t: peer_block(t, wq, keys, u_tab, v_tab), xt)
    return out.reshape(bsz, t_len, d)


def trunk_layer(x, past_a, past_b, h0, s0, lb, w_in, b_in, conv_a_w, conv_b_w, conv_b_b,
                lru_wa, lru_ba, lru_wx, lru_bx, lru_lambda, hgrn_norm_g, w_out_a, w_out_b,
                w_out_c, w_o, ln1_g, ln1_b, peer_wq, peer_keys, peer_u, peer_v, ln2_g, ln2_b):
    bsz, t_len, _ = x.shape
    z = x @ w_in + b_in
    split_points = np.cumsum(IN_SPLITS)[:-1].tolist()
    a_b, a_c, a_x, b_x, b_g, c_q, c_f, c_i, c_g, g_a, g_b, g_c = jnp.split(z, split_points, axis=-1)

    conv_a, new_a = causal_dwconv(a_c * a_x, past_a, conv_a_w)
    y_a = (a_b * conv_a) @ w_out_a

    conv_b, new_b = causal_dwconv(b_x, past_b, conv_b_w)
    lru_out, h_t = rg_lru(conv_b + conv_b_b, lru_wa, lru_ba, lru_wx, lru_bx, lru_lambda, h0)
    y_b = (jax.nn.gelu(b_g, approximate=False) * lru_out) @ w_out_b

    def heads(t):
        return t.astype(jnp.float32).reshape(bsz, t_len, C_HEADS, C_HD)

    lb_h = lb.reshape(C_HEADS, C_HD)
    f = lb_h + (1.0 - lb_h) * jax.nn.sigmoid(heads(c_f))
    o, s_t = hgrn2(jax.nn.silu(heads(c_q)), 1.0 - f, heads(c_i), jnp.log(f), s0.astype(jnp.float32))
    o = o * lax.rsqrt(jnp.mean(jnp.square(o), axis=-1, keepdims=True) + RMS_EPS) * hgrn_norm_g
    o = o * jax.nn.silu(heads(c_g))
    y_c = o.reshape(bsz, t_len, D_C).astype(x.dtype) @ w_out_c

    merged = jax.nn.sigmoid(g_a) * y_a + jax.nn.sigmoid(g_b) * y_b + jax.nn.sigmoid(g_c) * y_c
    x = layer_norm(ALPHA * x + merged @ w_o, ln1_g, ln1_b)
    x = layer_norm(ALPHA * x + peer(x, peer_wq, peer_keys, peer_u, peer_v), ln2_g, ln2_b)
    return x, new_a, new_b, h_t, s_t.astype(x.dtype)


def setup_inputs(seed: int = 0) -> dict:
    key = jax.random.key(seed)
    ks = jax.random.split(key, 32)
    nrm = jax.random.normal
    f32 = jnp.float32
    a0 = jax.random.uniform(ks[15], (DEPTH, D_B), f32, 0.9, 0.999)
    a_root = a0 ** (1.0 / LRU_C)
    lru_lambda = jnp.log(a_root) - jnp.log1p(-a_root)
    return {
        'x_prompt': nrm(ks[0], (BATCH, SEQ, D_MODEL), f32),
        'x_sample': nrm(ks[1], (DEC_BATCH, DEC_SEQ, D_MODEL), f32),
        'state_conv_a': nrm(ks[2], (DEPTH, DEC_BATCH, CONV_A_W - 1, D_A), f32),
        'state_conv_b': nrm(ks[3], (DEPTH, DEC_BATCH, CONV_B_W - 1, D_B), f32),
        'state_lru': 0.5 * nrm(ks[4], (DEPTH, DEC_BATCH, D_B), f32),
        'state_hgrn': 0.5 * nrm(ks[5], (DEPTH, DEC_BATCH, C_HEADS, C_HD, C_HD), f32),
        'w_in': nrm(ks[6], (DEPTH, D_MODEL, IN_COLS), f32) * D_MODEL ** -0.5,
        'b_in': 0.02 * nrm(ks[7], (DEPTH, IN_COLS), f32),
        'conv_a_w': nrm(ks[8], (DEPTH, CONV_A_W, D_A), f32) * CONV_A_W ** -0.5,
        'conv_b_w': nrm(ks[9], (DEPTH, CONV_B_W, D_B), f32) * CONV_B_W ** -0.5,
        'conv_b_b': 0.02 * nrm(ks[10], (DEPTH, D_B), f32),
        'lru_wa': nrm(ks[11], (DEPTH, LRU_BLOCKS, LRU_BW, LRU_BW), f32) * LRU_BW ** -0.5,
        'lru_ba': 0.02 * nrm(ks[12], (DEPTH, D_B), f32),
        'lru_wx': nrm(ks[13], (DEPTH, LRU_BLOCKS, LRU_BW, LRU_BW), f32) * LRU_BW ** -0.5,
        'lru_bx': 0.02 * nrm(ks[14], (DEPTH, D_B), f32),
        'lru_lambda': lru_lambda,
        'hgrn_lb_logits': 0.5 * nrm(ks[16], (DEPTH, D_C), f32),
        'hgrn_norm_g': 1.0 + 0.05 * nrm(ks[17], (DEPTH, C_HD), f32),
        'w_out_a': nrm(ks[18], (DEPTH, D_A, D_MODEL), f32) * D_A ** -0.5,
        'w_out_b': nrm(ks[19], (DEPTH, D_B, D_MODEL), f32) * D_B ** -0.5,
        'w_out_c': nrm(ks[20], (DEPTH, D_C, D_MODEL), f32) * D_C ** -0.5,
        'w_o': nrm(ks[21], (DEPTH, D_MODEL, D_MODEL), f32) * (BETA * D_MODEL ** -0.5),
        'ln1_g': 1.0 + 0.05 * nrm(ks[22], (DEPTH, D_MODEL), f32),
        'ln1_b': 0.02 * nrm(ks[23], (DEPTH, D_MODEL), f32),
        'peer_wq': nrm(ks[24], (DEPTH, D_MODEL, PEER_HEADS * PEER_DQ), f32) * D_MODEL ** -0.5,
        'peer_keys': nrm(ks[25], (DEPTH, PEER_HEADS, 2, N_KEYS, PEER_DH), f32) * PEER_DH ** -0.5,
        'peer_u': nrm(ks[26], (DEPTH, N_EXPERTS, D_MODEL), f32) * D_MODEL ** -0.5,
        'peer_v': nrm(ks[27], (DEPTH, N_EXPERTS, D_MODEL), f32) * (BETA * PEER_HEADS ** -0.5),
        'ln2_g': 1.0 + 0.05 * nrm(ks[28], (DEPTH, D_MODEL), f32),
        'ln2_b': 0.02 * nrm(ks[29], (DEPTH, D_MODEL), f32),
    }


def reference(x_prompt, x_sample, state_conv_a, state_conv_b, state_lru, state_hgrn,
              w_in, b_in, conv_a_w, conv_b_w, conv_b_b, lru_wa, lru_ba, lru_wx, lru_bx,
              lru_lambda, hgrn_lb_logits, hgrn_norm_g, w_out_a, w_out_b, w_out_c, w_o,
              ln1_g, ln1_b, peer_wq, peer_keys, peer_u, peer_v, ln2_g, ln2_b):
    p = jax.nn.softmax(hgrn_lb_logits.astype(jnp.float32), axis=0)
    lbs = jnp.cumsum(p, axis=0) - p[0]
    xp, xs = x_prompt, x_sample
    bp = xp.shape[0]
    pa_l, pb_l, ph_l, ps_l = [], [], [], []
    sa_l, sb_l, sh_l, ss_l = [], [], [], []
    for l in range(DEPTH):
        lp = (w_in[l], b_in[l], conv_a_w[l], conv_b_w[l], conv_b_b[l], lru_wa[l], lru_ba[l],
              lru_wx[l], lru_bx[l], lru_lambda[l], hgrn_norm_g[l], w_out_a[l], w_out_b[l],
              w_out_c[l], w_o[l], ln1_g[l], ln1_b[l], peer_wq[l], peer_keys[l], peer_u[l],
              peer_v[l], ln2_g[l], ln2_b[l])
        xp, pa, pb, ph, ps = trunk_layer(
            xp,
            jnp.zeros((bp, CONV_A_W - 1, D_A), xp.dtype),
            jnp.zeros((bp, CONV_B_W - 1, D_B), xp.dtype),
            jnp.zeros((bp, D_B), xp.dtype),
            jnp.zeros((bp, C_HEADS, C_HD, C_HD), xp.dtype),
            lbs[l], *lp)
        xs, sa, sb, sh, ss = trunk_layer(
            xs, state_conv_a[l], state_conv_b[l], state_lru[l], state_hgrn[l], lbs[l], *lp)
        pa_l.append(pa); pb_l.append(pb); ph_l.append(ph); ps_l.append(ps)
        sa_l.append(sa); sb_l.append(sb); sh_l.append(sh); ss_l.append(ss)
    return (xp, xs,
            jnp.stack(pa_l), jnp.stack(pb_l), jnp.stack(ph_l), jnp.stack(ps_l),
            jnp.stack(sa_l), jnp.stack(sb_l), jnp.stack(sh_l), jnp.stack(ss_l))
```

```cpp
#include <hip/hip_runtime.h>
#include <hip/hip_bf16.h>
#include <hip/hip_cooperative_groups.h>
#include <cstdio>
namespace cg = cooperative_groups;

typedef unsigned short bfu;
using bf16x8 = __attribute__((ext_vector_type(8))) short;
using f32x4 = __attribute__((ext_vector_type(4))) float;
#define DEVI __device__ __forceinline__

constexpr float ALPHA = 1.41421356237f;
constexpr int NCOL = 12288;

constexpr size_t O_WIN = 0;
constexpr size_t O_WOA = O_WIN + 25165824;
constexpr size_t O_WOB = O_WOA + 2097152;
constexpr size_t O_WOC = O_WOB + 2097152;
constexpr size_t O_WO = O_WOC + 2097152;
constexpr size_t O_WQ = O_WO + 2097152;
constexpr size_t O_KEYS = O_WQ + 4194304;
constexpr size_t O_LRU = O_KEYS + 524288;
constexpr size_t O_UTB = O_LRU + 524288;
constexpr size_t O_VTB = O_UTB + 33554432;
constexpr size_t O_LBS = O_VTB + 33554432;
constexpr size_t O_XB = O_LBS + 8192;
constexpr size_t O_Z = O_XB + 34078720;
constexpr size_t O_UA = O_Z + 207618048;
constexpr size_t O_UB = O_UA + 17301504;
constexpr size_t O_UC = O_UB + 17301504;
constexpr size_t O_CB = O_UC + 17301504;
constexpr size_t O_AU = O_CB + 17301504;
constexpr size_t O_LSUM = O_AU + 69206016;
constexpr size_t O_US = O_LSUM + 540672;
constexpr size_t O_DEC = O_US + 33554432;
constexpr size_t O_END = O_DEC + 524288;
constexpr size_t O_PRE = O_Z;
constexpr size_t O_QP = O_Z + 34603008;
constexpr size_t O_SC = O_QP + 34603008;

constexpr long OUT_YS = 16777216;
constexpr long OUT_CAP = 17039360;
constexpr long OUT_CBP = 17055744;
constexpr long OUT_LRP = 17080320;
constexpr long OUT_HGP = 17088512;
constexpr long OUT_CAS = 18137088;
constexpr long OUT_CBS = 18169856;
constexpr long OUT_LRS = 18219008;
constexpr long OUT_HGS = 18235392;

struct Params {
  const float* in[30];
  float* out;
  char* ws;
};

DEVI bfu f2b(float f) {
  unsigned u = __float_as_uint(f);
  u += 0x7FFFu + ((u >> 16) & 1u);
  return (bfu)(u >> 16);
}
DEVI float b2f(bfu b) { return __uint_as_float(((unsigned)b) << 16); }
DEVI float sigmoidf_(float x) { return 1.f / (1.f + __expf(-x)); }
DEVI float siluf_(float x) { return x / (1.f + __expf(-x)); }
DEVI float geluf_(float x) { return 0.5f * x * (1.f + erff(x * 0.70710678118f)); }
DEVI float wave_sum(float v) {
#pragma unroll
  for (int o = 32; o; o >>= 1) v += __shfl_xor(v, o);
  return v;
}

DEVI int ltid() { int t = threadIdx.x; asm volatile("" : "+v"(t)); return t; }
struct TokInfo { int sample, seq, t; };
DEVI TokInfo tokinfo(int it) {
  TokInfo r;
  if (it < 8192) { r.sample = 0; r.seq = it >> 12; r.t = it & 4095; }
  else if (it < 8448) { int q = it - 8192; r.sample = 1; r.seq = q >> 5; r.t = q & 31; }
  else { int q = it - 8448; r.sample = 0; r.seq = 2 + (q >> 12); r.t = q & 4095; }
  return r;
}
DEVI float* xrow(const Params& P, int it) {
  TokInfo ti = tokinfo(it);
  return ti.sample ? P.out + OUT_YS + (long)(ti.seq * 32 + ti.t) * 1024
                   : P.out + (long)(ti.seq * 4096 + ti.t) * 1024;
}

DEVI void stage_tile(const bfu* __restrict__ g, int ld, int k0, char* lds, int tid) {
#pragma unroll
  for (int i = 0; i < 4; ++i) {
    int b = tid * 16 + i * 4096;
    int r = b >> 7, cp = (b >> 4) & 7, gc = cp ^ (r & 7);
    __builtin_amdgcn_global_load_lds((const unsigned*)(g + (long)r * ld + k0 + gc * 8),
                                     (unsigned*)(lds + b), 16, 0, 0);
  }
}
DEVI bf16x8 ldfrag(const char* tile, int r, int kc) {
  return *reinterpret_cast<const bf16x8*>(tile + r * 128 + ((kc ^ (r & 7)) << 4));
}
DEVI void gemm_core(f32x4 (&acc)[4][4], const bfu* __restrict__ A, int lda,
                    const bfu* __restrict__ B, int ldb, int K, char* smem, int tid) {
  const int wid = tid >> 6, lane = tid & 63;
  const int wr = wid >> 1, wc = wid & 1, fr = lane & 15, fq = lane >> 4;
  const int nt = K >> 6;
  __syncthreads();
  stage_tile(A, lda, 0, smem, tid);
  stage_tile(B, ldb, 0, smem + 16384, tid);
  for (int t = 0; t < nt; ++t) {
    asm volatile("s_waitcnt vmcnt(0)" ::: "memory");
    __syncthreads();
    char* cur = smem + (t & 1) * 32768;
    if (t + 1 < nt) {
      char* nx = smem + ((t + 1) & 1) * 32768;
      stage_tile(A, lda, (t + 1) * 64, nx, tid);
      stage_tile(B, ldb, (t + 1) * 64, nx + 16384, tid);
    }
#pragma unroll
    for (int kk = 0; kk < 2; ++kk) {
      bf16x8 af[4], bfr[4];
#pragma unroll
      for (int m = 0; m < 4; ++m) af[m] = ldfrag(cur, wr * 64 + m * 16 + fr, kk * 4 + fq);
#pragma unroll
      for (int n = 0; n < 4; ++n) bfr[n] = ldfrag(cur + 16384, wc * 64 + n * 16 + fr, kk * 4 + fq);
#pragma unroll
      for (int m = 0; m < 4; ++m)
#pragma unroll
        for (int n = 0; n < 4; ++n)
          acc[m][n] = __builtin_amdgcn_mfma_f32_16x16x32_bf16(af[m], bfr[n], acc[m][n], 0, 0, 0);
    }
  }
}
DEVI void tile_rc(int id, int nM, int nN, int& pm, int& pn) {
  const int WGM = 8;
  int nig = WGM * nN, gid = id / nig, fm = gid * WGM;
  int gsz = min(nM - fm, WGM);
  pm = fm + ((id % nig) % gsz);
  pn = (id % nig) / gsz;
}
#define ZERO_ACC(a) _Pragma("unroll") for (int m_ = 0; m_ < 4; ++m_) _Pragma("unroll") for (int n_ = 0; n_ < 4; ++n_) a[m_][n_] = f32x4{0.f, 0.f, 0.f, 0.f}
#define EPI_LOOP \
  const int wid_ = tid >> 6, lane_ = tid & 63; \
  const int wr_ = wid_ >> 1, wc_ = wid_ & 1, fr_ = lane_ & 15, fq_ = lane_ >> 4; \
  _Pragma("unroll") for (int m = 0; m < 4; ++m) for (int sb_ = (__builtin_amdgcn_sched_barrier(0), 0); sb_ < 1; ++sb_) _Pragma("unroll") for (int n = 0; n < 4; ++n) _Pragma("unroll") for (int j = 0; j < 4; ++j)
#define EPI_ROW (wr_ * 64 + m * 16 + fq_ * 4 + j)
#define EPI_COL (wc_ * 64 + n * 16 + fr_)

DEVI void transpose_tile(const float* __restrict__ src, bfu* __restrict__ dst, int R, int C, int r0, int c0, float* tile, int tid) {
  __syncthreads();
  {
    int tx = tid & 15, ty = tid >> 4;
#pragma unroll
    for (int i = 0; i < 4; ++i) {
      int r = ty + i * 16;
      float4 v = *reinterpret_cast<const float4*>(src + (long)(r0 + r) * C + c0 + tx * 4);
      float* tp = tile + r * 65 + tx * 4;
      tp[0] = v.x; tp[1] = v.y; tp[2] = v.z; tp[3] = v.w;
    }
  }
  __syncthreads();
  {
    int c = tid >> 2, rs = (tid & 3) * 16;
    unsigned pk[8];
#pragma unroll
    for (int i = 0; i < 8; ++i) {
      unsigned lo = f2b(tile[(rs + 2 * i) * 65 + c]);
      unsigned hi = f2b(tile[(rs + 2 * i + 1) * 65 + c]);
      pk[i] = lo | (hi << 16);
    }
    uint4* dp = reinterpret_cast<uint4*>(dst + (long)(c0 + c) * R + r0 + rs);
    dp[0] = make_uint4(pk[0], pk[1], pk[2], pk[3]);
    dp[1] = make_uint4(pk[4], pk[5], pk[6], pk[7]);
  }
}
DEVI void convert_chunk(const float* __restrict__ src, bfu* __restrict__ dst, int tid) {
  int o = tid * 8;
  float4 a = *reinterpret_cast<const float4*>(src + o);
  float4 b = *reinterpret_cast<const float4*>(src + o + 4);
  uint4 r;
  r.x = f2b(a.x) | ((unsigned)f2b(a.y) << 16);
  r.y = f2b(a.z) | ((unsigned)f2b(a.w) << 16);
  r.z = f2b(b.x) | ((unsigned)f2b(b.y) << 16);
  r.w = f2b(b.z) | ((unsigned)f2b(b.w) << 16);
  *reinterpret_cast<uint4*>(dst + o) = r;
}

DEVI void phase_prep(const Params& P, int l, char* smem) {
  const int tid = ltid();
  char* ws = P.ws;
  float* tile = reinterpret_cast<float*>(smem);
  const int NT_WIN = 3072, NT_SQ = 256, NT_WQ = 512, NT_LRU = 64;
  const int T0 = NT_WIN, T1 = T0 + 4 * NT_SQ, T2 = T1 + NT_WQ, T3 = T2 + NT_LRU;
  const int C0 = T3 + 128, C1 = C0 + 8192, C2 = C1 + 8192;
  const int X0 = C2;
  const int L0 = X0 + (l == 0 ? 8 : 0);
  for (int id = blockIdx.x; id < L0; id += gridDim.x) {
    if (id < T0) {
      int tr = id / 192, tc = id % 192;
      transpose_tile(P.in[6] + (long)l * 1024 * 12288, (bfu*)(ws + O_WIN), 1024, 12288, tr * 64, tc * 64, tile, tid);
    } else if (id < T1) {
      int q = id - T0, w = q >> 8, t = q & 255;
      const float* src = P.in[18 + w] + (long)l * 1048576;
      bfu* dst = (bfu*)(ws + (w == 0 ? O_WOA : w == 1 ? O_WOB : w == 2 ? O_WOC : O_WO));
      transpose_tile(src, dst, 1024, 1024, (t >> 4) * 64, (t & 15) * 64, tile, tid);
    } else if (id < T2) {
      int q = id - T1;
      transpose_tile(P.in[24] + (long)l * 2097152, (bfu*)(ws + O_WQ), 1024, 2048, (q >> 5) * 64, (q & 31) * 64, tile, tid);
    } else if (id < T3) {
      int q = id - T2, mtx = q >> 2, t = q & 3, g = mtx >> 3, nb = mtx & 7;
      const float* src = P.in[g == 0 ? 11 : 13] + (long)l * 131072 + nb * 16384;
      transpose_tile(src, (bfu*)(ws + O_LRU) + mtx * 16384, 128, 128, (t >> 1) * 64, (t & 1) * 64, tile, tid);
    } else if (id < C0) {
      int q = id - T3;
      convert_chunk(P.in[25] + (long)l * 262144 + (long)q * 2048, (bfu*)(ws + O_KEYS) + (long)q * 2048, tid);
    } else if (id < C1) {
      int q = id - C0;
      convert_chunk(P.in[26] + (long)l * 16777216 + (long)q * 2048, (bfu*)(ws + O_UTB) + (long)q * 2048, tid);
    } else if (id < C2) {
      int q = id - C1;
      convert_chunk(P.in[27] + (long)l * 16777216 + (long)q * 2048, (bfu*)(ws + O_VTB) + (long)q * 2048, tid);
    } else {
      int q = id - X0;
      int c = (q & 3) * 256 + tid, ll = q >> 2;
      float a0 = P.in[16][c], a1 = P.in[16][1024 + c];
      float mx = fmaxf(a0, a1);
      float e0 = __expf(a0 - mx), e1 = __expf(a1 - mx);
      float p1 = e1 / (e0 + e1);
      float* lbs = (float*)(ws + O_LBS);
      lbs[ll * 1024 + c] = (ll == 0) ? 0.f : p1;
    }
  }
}

DEVI void phase_xcopy(const Params& P) {
  const int tid = ltid();
  bfu* xb = (bfu*)(P.ws + O_XB);
  for (int it = blockIdx.x; it < 16640; it += gridDim.x) {
    TokInfo ti = tokinfo(it);
    const float* src = ti.sample ? P.in[1] + (long)(ti.seq * 32 + ti.t) * 1024 : P.in[0] + (long)(ti.seq * 4096 + ti.t) * 1024;
    float* dst = xrow(P, it);
    int c = tid * 4;
    float4 v = *reinterpret_cast<const float4*>(src + c);
    *reinterpret_cast<float4*>(dst + c) = v;
    uint2 r;
    r.x = f2b(v.x) | ((unsigned)f2b(v.y) << 16);
    r.y = f2b(v.z) | ((unsigned)f2b(v.w) << 16);
    *reinterpret_cast<uint2*>(xb + (long)it * 1024 + c) = r;
  }
}

DEVI void phase_inproj(const Params& P, int l, int pass, char* smem) {
  const int tid = ltid();
  const int ntok = pass ? 8192 : 8448, base = pass ? 8448 : 0;
  const int nM = ntok / 128, nN = 96;
  const bfu* xb = (const bfu*)(P.ws + O_XB) + (long)base * 1024;
  const bfu* wT = (const bfu*)(P.ws + O_WIN);
  bfu* z = (bfu*)(P.ws + O_Z);
  const float* bin = P.in[7] + l * NCOL;
  for (int id = blockIdx.x; id < nM * nN; id += gridDim.x) {
    int pm, pn; tile_rc(id, nM, nN, pm, pn);
    f32x4 acc[4][4]; ZERO_ACC(acc);
    gemm_core(acc, xb + (long)pm * 128 * 1024, 1024, wT + (long)pn * 128 * 1024, 1024, 1024, smem, tid);
    EPI_LOOP {
      int row = pm * 128 + EPI_ROW, col = pn * 128 + EPI_COL;
      z[(long)row * NCOL + col] = f2b(acc[m][n][j] + bin[col]);
    }
  }
}

DEVI void load4bf(const bfu* p, float (&o)[4]) {
  uint2 v = *reinterpret_cast<const uint2*>(p);
  o[0] = __uint_as_float(v.x << 16); o[1] = __uint_as_float(v.x & 0xFFFF0000u);
  o[2] = __uint_as_float(v.y << 16); o[3] = __uint_as_float(v.y & 0xFFFF0000u);
}
DEVI void store4bf(bfu* p, const float (&v)[4]) {
  uint2 r;
  r.x = f2b(v[0]) | ((unsigned)f2b(v[1]) << 16);
  r.y = f2b(v[2]) | ((unsigned)f2b(v[3]) << 16);
  *reinterpret_cast<uint2*>(p) = r;
}
DEVI void mixab_row(const Params& P, int l, int base, int lt, int tid) {
  const int it = base + lt;
  const TokInfo ti = tokinfo(it);
  const int T = ti.sample ? 32 : 4096;
  const bfu* z = (const bfu*)(P.ws + O_Z);
  const int c = tid * 4;
  float pk[3][4];
#pragma unroll
  for (int k = 0; k < 3; ++k) {
    int tt = ti.t - 2 + k;
    if (tt >= 0) {
      const bfu* zr = z + (long)(lt - 2 + k) * NCOL;
      float ac[4], ax[4];
      load4bf(zr + 1024 + c, ac); load4bf(zr + 2048 + c, ax);
#pragma unroll
      for (int i = 0; i < 4; ++i) pk[k][i] = ac[i] * ax[i];
    } else if (ti.sample) {
      float4 v = *reinterpret_cast<const float4*>(P.in[2] + ((long)(l * 8 + ti.seq) * 2 + (tt + 2)) * 1024 + c);
      pk[k][0] = v.x; pk[k][1] = v.y; pk[k][2] = v.z; pk[k][3] = v.w;
    } else {
#pragma unroll
      for (int i = 0; i < 4; ++i) pk[k][i] = 0.f;
    }
  }
  {
    float ab[4], o[4];
    load4bf(z + (long)lt * NCOL + c, ab);
    const float* w = P.in[8] + (long)l * 3 * 1024 + c;
#pragma unroll
    for (int i = 0; i < 4; ++i) o[i] = ab[i] * (w[i] * pk[0][i] + w[1024 + i] * pk[1][i] + w[2048 + i] * pk[2][i]);
    store4bf((bfu*)(P.ws + O_UA) + (long)lt * 1024 + c, o);
    if (ti.t >= T - 2) {
      int r = ti.t - (T - 2);
      float* dst = ti.sample ? P.out + OUT_CAS + ((long)(l * 8 + ti.seq) * 2 + r) * 1024 + c
                             : P.out + OUT_CAP + ((long)(l * 4 + ti.seq) * 2 + r) * 1024 + c;
      *reinterpret_cast<float4*>(dst) = make_float4(pk[2][0], pk[2][1], pk[2][2], pk[2][3]);
    }
  }
  float xk[4][4];
#pragma unroll
  for (int k = 0; k < 4; ++k) {
    int tt = ti.t - 3 + k;
    if (tt >= 0) {
      load4bf(z + (long)(lt - 3 + k) * NCOL + 3072 + c, xk[k]);
    } else if (ti.sample) {
      float4 v = *reinterpret_cast<const float4*>(P.in[3] + ((long)(l * 8 + ti.seq) * 3 + (tt + 3)) * 1024 + c);
      xk[k][0] = v.x; xk[k][1] = v.y; xk[k][2] = v.z; xk[k][3] = v.w;
    } else {
#pragma unroll
      for (int i = 0; i < 4; ++i) xk[k][i] = 0.f;
    }
  }
  {
    const float* w = P.in[9] + (long)l * 4 * 1024 + c;
    const float* bb = P.in[10] + (long)l * 1024 + c;
    float o[4];
#pragma unroll
    for (int i = 0; i < 4; ++i)
      o[i] = w[i] * xk[0][i] + w[1024 + i] * xk[1][i] + w[2048 + i] * xk[2][i] + w[3072 + i] * xk[3][i] + bb[i];
    store4bf((bfu*)(P.ws + O_CB) + (long)lt * 1024 + c, o);
    if (ti.t >= T - 3) {
      int r = ti.t - (T - 3);
      float* dst = ti.sample ? P.out + OUT_CBS + ((long)(l * 8 + ti.seq) * 3 + r) * 1024 + c
                             : P.out + OUT_CBP + ((long)(l * 4 + ti.seq) * 3 + r) * 1024 + c;
      *reinterpret_cast<float4*>(dst) = make_float4(xk[3][0], xk[3][1], xk[3][2], xk[3][3]);
    }
  }
}

struct ChunkInfo { int lt0, L, sample, seqi, c; };
DEVI ChunkInfo chunkinfo(int ck) {
  ChunkInfo r;
  if (ck < 128) { r.seqi = ck >> 6; r.c = ck & 63; r.lt0 = r.seqi * 4096 + r.c * 64; r.L = 64; r.sample = 0; }
  else { r.seqi = ck - 128; r.c = 0; r.lt0 = 8192 + r.seqi * 32; r.L = 32; r.sample = 1; }
  return r;
}

DEVI void h1_item(const Params& P, int l, int ck, int h, char* smem, int tid) {
  const ChunkInfo ci = chunkinfo(ck);
  const int lane = tid & 63, w = tid >> 6, fr = lane & 15, fq = lane >> 4;
  bfu* VT = (bfu*)smem;
  bfu* KT = VT + 128 * 72;
  float* tots = (float*)(smem + 36864);
  float* decl = tots + 256;
  const int d = tid & 127, hf = tid >> 7, L = ci.L, Lh = L >> 1;
  const float lb = ((const float*)(P.ws + O_LBS))[l * 1024 + h * 128 + d];
  const bfu* Z = (const bfu*)(P.ws + O_Z);
  const bfu* zf = Z + (long)ci.lt0 * NCOL + 6 * 1024 + h * 128 + d;
  const bfu* zi = Z + (long)ci.lt0 * NCOL + 7 * 1024 + h * 128 + d;
  __syncthreads();
  float tot = 0.f;
  for (int s = hf * Lh; s < hf * Lh + Lh; ++s) {
    float f = lb + (1.f - lb) * sigmoidf_(b2f(zf[(long)s * NCOL]));
    tot += __logf(f);
  }
  tots[hf * 128 + d] = tot;
  __syncthreads();
  float run = hf ? 0.f : tots[128 + d];
  for (int s = hf * Lh + Lh - 1; s >= hf * Lh; --s) {
    float f = lb + (1.f - lb) * sigmoidf_(b2f(zf[(long)s * NCOL]));
    KT[d * 72 + s] = f2b((1.f - f) * __expf(run));
    VT[d * 72 + s] = zi[(long)s * NCOL];
    run += __logf(f);
  }
  if (L == 32) {
    for (int s = 32 + hf * 16; s < 48 + hf * 16; ++s) { KT[d * 72 + s] = 0; VT[d * 72 + s] = 0; }
  }
  if (hf == 0) {
    float dc = __expf(tots[d] + tots[128 + d]);
    decl[d] = dc;
    if (!ci.sample) ((float*)(P.ws + O_DEC))[((ci.seqi * 8 + h) * 64 + ci.c) * 128 + d] = dc;
  }
  __syncthreads();
  f32x4 acc[2][8];
#pragma unroll
  for (int mi = 0; mi < 2; ++mi)
#pragma unroll
    for (int n = 0; n < 8; ++n) acc[mi][n] = f32x4{0.f, 0.f, 0.f, 0.f};
#pragma unroll
  for (int kk = 0; kk < 2; ++kk) {
    bf16x8 a[2];
#pragma unroll
    for (int mi = 0; mi < 2; ++mi) a[mi] = *reinterpret_cast<const bf16x8*>(VT + ((2 * w + mi) * 16 + fr) * 72 + kk * 32 + fq * 8);
#pragma unroll
    for (int n = 0; n < 8; ++n) {
      bf16x8 b = *reinterpret_cast<const bf16x8*>(KT + (n * 16 + fr) * 72 + kk * 32 + fq * 8);
#pragma unroll
      for (int mi = 0; mi < 2; ++mi) acc[mi][n] = __builtin_amdgcn_mfma_f32_16x16x32_bf16(a[mi], b, acc[mi][n], 0, 0, 0);
    }
  }
  if (!ci.sample) {
    bfu* US = (bfu*)(P.ws + O_US) + ((long)((ci.seqi * 8 + h) * 64 + ci.c) << 14);
#pragma unroll
    for (int mi = 0; mi < 2; ++mi) {
      __builtin_amdgcn_sched_barrier(0);
      bfu* bp = US + ((2 * w + mi) * 16 + fq * 4) * 128 + fr;
#pragma unroll
      for (int n = 0; n < 8; ++n)
#pragma unroll
        for (int j = 0; j < 4; ++j) bp[j * 128 + n * 16] = f2b(acc[mi][n][j]);
    }
  } else {
    long sb = ((long)((l * 8 + ci.seqi) * 8 + h)) << 14;
    const float* S0 = P.in[5] + sb;
    float* So = P.out + OUT_HGS + sb;
#pragma unroll
    for (int mi = 0; mi < 2; ++mi)
#pragma unroll
      for (int n = 0; n < 8; ++n) {
        __builtin_amdgcn_sched_barrier(0);
        int e0 = (2 * w + mi) * 16 + fq * 4, dd = n * 16 + fr;
        float4 s0 = *reinterpret_cast<const float4*>(S0 + dd * 128 + e0);
        float dcl = decl[dd];
        float4 r;
        r.x = dcl * s0.x + acc[mi][n][0]; r.y = dcl * s0.y + acc[mi][n][1];
        r.z = dcl * s0.z + acc[mi][n][2]; r.w = dcl * s0.w + acc[mi][n][3];
        *reinterpret_cast<float4*>(So + dd * 128 + e0) = r;
      }
  }
}

DEVI void phase2(const Params& P, int l, int pass, char* smem) {
  const int tid = ltid();
  const int ntok = pass ? 8192 : 8448, base = pass ? 8448 : 0;
  const int nck = pass ? 128 : 136;
  const int nH = nck * 8;
  const int total = nH + ntok;
  for (int id = blockIdx.x; id < total; id += gridDim.x) {
    if (id < nH) h1_item(P, l, id >> 3, id & 7, smem, tid);
    else mixab_row(P, l, base, id - nH, tid);
  }
}

DEVI void gate_tile(const Params& P, int l, int pm, int nb, char* smem, int tid) {
  const bfu* cb = (const bfu*)(P.ws + O_CB);
  const bfu* A = cb + (long)pm * 128 * 1024 + nb * 128;
  const bfu* B1 = (const bfu*)(P.ws + O_LRU) + nb * 16384;
  const bfu* B2 = B1 + 8 * 16384;
  float* au0 = (float*)(P.ws + O_AU);
  float* au1 = au0 + (long)8448 * 1024;
  const float* ba = P.in[12] + l * 1024;
  const float* bx = P.in[14] + l * 1024;
  const float* lam = P.in[15] + l * 1024;
  {
    f32x4 acc[4][4]; ZERO_ACC(acc);
    gemm_core(acc, A, 1024, B1, 128, 128, smem, tid);
    EPI_LOOP {
      int row = pm * 128 + EPI_ROW, col = nb * 128 + EPI_COL;
      float r = sigmoidf_(acc[m][n][j] + ba[col]);
      float sp = log1pf(__expf(-lam[col]));
      au0[(long)row * 1024 + col] = -8.f * r * sp;
    }
  }
  asm volatile("" : "+s"(pm), "+s"(nb));
  {
    f32x4 acc[4][4]; ZERO_ACC(acc);
    gemm_core(acc, A, 1024, B2, 128, 128, smem, tid);
    EPI_LOOP {
      int row = pm * 128 + EPI_ROW, col = nb * 128 + EPI_COL;
      float gi = sigmoidf_(acc[m][n][j] + bx[col]);
      float la = au0[(long)row * 1024 + col];
      float a = __expf(la);
      float mult = sqrtf(fmaxf(-expm1f(2.f * la), 0.f));
      float xv = b2f(cb[(long)row * 1024 + col]);
      au0[(long)row * 1024 + col] = a;
      au1[(long)row * 1024 + col] = mult * gi * xv;
    }
  }
}
DEVI void h2_item(const Params& P, int l, int pass, int item, int tid) {
  const int sh = item >> 6, blk = item & 63;
  const int idx = blk * 256 + tid, e = idx >> 7, d = idx & 127;
  bfu* US = (bfu*)(P.ws + O_US) + ((long)sh * 64 << 14) + idx;
  const float* dec = (const float*)(P.ws + O_DEC) + (long)sh * 64 * 128 + d;
  float S = 0.f;
  for (int c0 = 0; c0 < 64; c0 += 8) {
    float u[8], dc[8];
#pragma unroll
    for (int i = 0; i < 8; ++i) { u[i] = b2f(US[(long)(c0 + i) << 14]); dc[i] = dec[(c0 + i) * 128]; }
#pragma unroll
    for (int i = 0; i < 8; ++i) { US[(long)(c0 + i) << 14] = f2b(S); S = dc[i] * S + u[i]; }
  }
  const int sl = sh >> 3, h = sh & 7, b = pass * 2 + sl;
  P.out[OUT_HGP + (((long)((l * 4 + b) * 8 + h)) << 14) + d * 128 + e] = S;
}
DEVI void phase3(const Params& P, int l, int pass, char* smem) {
  const int tid = ltid();
  const int ntok = pass ? 8192 : 8448;
  const int nG = (ntok / 128) * 8, nH2 = 1024;
  for (int id = blockIdx.x; id < nG + nH2; id += gridDim.x) {
    if (id < nG) gate_tile(P, l, id >> 3, id & 7, smem, tid);
    else h2_item(P, l, pass, id - nG, tid);
  }
}

DEVI void lsum_item(const Params& P, int tile, int cg4, int tid) {
  const int w = tid >> 6, lane = tid & 63;
  const int ch = (cg4 * 4 + w) * 64 + lane;
  const float* a0 = (const float*)(P.ws + O_AU) + (long)tile * 128 * 1024 + ch;
  const float* u0 = a0 + (long)8448 * 1024;
  float A = 1.f, H = 0.f;
  for (int r0 = 0; r0 < 128; r0 += 16) {
    float av[16], uv[16];
#pragma unroll
    for (int i = 0; i < 16; ++i) { av[i] = a0[(long)(r0 + i) * 1024]; uv[i] = u0[(long)(r0 + i) * 1024]; }
#pragma unroll
    for (int i = 0; i < 16; ++i) { H = av[i] * H + uv[i]; A *= av[i]; }
  }
  float* ls = (float*)(P.ws + O_LSUM) + (long)tile * 2048;
  ls[ch] = A; ls[1024 + ch] = H;
}

DEVI void h3_item(const Params& P, int l, int ck, int h, char* smem, int tid) {
  const ChunkInfo ci = chunkinfo(ck);
  const int lane = tid & 63, w = tid >> 6, fr = lane & 15, fq = lane >> 4;
  bfu* QT = (bfu*)smem;
  bfu* KT = QT + 64 * 136;
  bfu* AT = KT + 64 * 136;
  bfu* BS = AT + 64 * 72;
  float* bmid = (float*)(BS + 128 * 72);
  const int d = tid & 127, hf = tid >> 7, L = ci.L, Lh = L >> 1;
  const float lb = ((const float*)(P.ws + O_LBS))[l * 1024 + h * 128 + d];
  const bfu* Z = (const bfu*)(P.ws + O_Z);
  const bfu* zq = Z + (long)ci.lt0 * NCOL + 5 * 1024 + h * 128 + d;
  const bfu* zf = zq + 1024;
  const bfu* zi = zq + 2048;
  __syncthreads();
  if (hf == 0) {
    float rel = 0.f;
    for (int t = Lh - 1; t >= 0; --t) {
      float f = lb + (1.f - lb) * sigmoidf_(b2f(zf[(long)t * NCOL]));
      float q = siluf_(b2f(zq[(long)t * NCOL]));
      QT[t * 136 + d] = f2b(q * __expf(fminf(rel, 80.f)));
      KT[t * 136 + d] = f2b((1.f - f) * __expf(-rel));
      rel -= __logf(f);
    }
    bmid[d] = -rel;
  } else {
    float rel = 0.f;
    for (int t = Lh; t < L; ++t) {
      float f = lb + (1.f - lb) * sigmoidf_(b2f(zf[(long)t * NCOL]));
      float q = siluf_(b2f(zq[(long)t * NCOL]));
      rel += __logf(f);
      QT[t * 136 + d] = f2b(q * __expf(rel));
      KT[t * 136 + d] = f2b((1.f - f) * __expf(fminf(-rel, 80.f)));
    }
  }
  if (L == 32) {
    for (int t = 32 + hf * 16; t < 48 + hf * 16; ++t) { QT[t * 136 + d] = 0; KT[t * 136 + d] = 0; }
  }
#pragma unroll 4
  for (int s = hf * 32; s < hf * 32 + 32; ++s) BS[d * 72 + s] = (s < L) ? zi[(long)s * NCOL] : (bfu)0;
  __syncthreads();
  bf16x8 aq[4];
#pragma unroll
  for (int kk = 0; kk < 4; ++kk) aq[kk] = *reinterpret_cast<const bf16x8*>(QT + (16 * w + fr) * 136 + kk * 32 + fq * 8);
  {
    f32x4 sa[4];
#pragma unroll
    for (int n = 0; n < 4; ++n) sa[n] = f32x4{0.f, 0.f, 0.f, 0.f};
#pragma unroll
    for (int kk = 0; kk < 4; ++kk)
#pragma unroll
      for (int n = 0; n < 4; ++n) {
        bf16x8 bk = *reinterpret_cast<const bf16x8*>(KT + (n * 16 + fr) * 136 + kk * 32 + fq * 8);
        sa[n] = __builtin_amdgcn_mfma_f32_16x16x32_bf16(aq[kk], bk, sa[n], 0, 0, 0);
      }
#pragma unroll
    for (int n = 0; n < 4; ++n)
#pragma unroll
      for (int j = 0; j < 4; ++j) {
        int t = 16 * w + fq * 4 + j, s = n * 16 + fr;
        AT[t * 72 + s] = (s <= t) ? f2b(sa[n][j]) : (bfu)0;
      }
  }
  __syncthreads();
  f32x4 o[8];
#pragma unroll
  for (int n = 0; n < 8; ++n) o[n] = f32x4{0.f, 0.f, 0.f, 0.f};
#pragma unroll
  for (int kk = 0; kk < 2; ++kk) {
    bf16x8 a = *reinterpret_cast<const bf16x8*>(AT + (16 * w + fr) * 72 + kk * 32 + fq * 8);
#pragma unroll
    for (int n = 0; n < 8; ++n) {
      bf16x8 b = *reinterpret_cast<const bf16x8*>(BS + (n * 16 + fr) * 72 + kk * 32 + fq * 8);
      o[n] = __builtin_amdgcn_mfma_f32_16x16x32_bf16(a, b, o[n], 0, 0, 0);
    }
  }
#pragma unroll
  for (int sl = 0; sl < 2; ++sl) {
    __syncthreads();
    if (!ci.sample) {
      const bfu* src = (const bfu*)(P.ws + O_US) + ((long)((ci.seqi * 8 + h) * 64 + ci.c) << 14);
      int e2 = tid >> 1, dd0 = (tid & 1) * 32;
#pragma unroll
      for (int q4 = 0; q4 < 4; ++q4) {
        uint4 v = *reinterpret_cast<const uint4*>(src + e2 * 128 + sl * 64 + dd0 + q4 * 8);
        const float* bm = bmid + sl * 64 + dd0 + q4 * 8;
        unsigned vv[4] = {v.x, v.y, v.z, v.w};
        unsigned rr[4];
#pragma unroll
        for (int i = 0; i < 4; ++i) {
          float lo = __uint_as_float(vv[i] << 16) * __expf(bm[2 * i]);
          float hi = __uint_as_float(vv[i] & 0xFFFF0000u) * __expf(bm[2 * i + 1]);
          rr[i] = f2b(lo) | ((unsigned)f2b(hi) << 16);
        }
        *reinterpret_cast<uint4*>(BS + e2 * 72 + dd0 + q4 * 8) = make_uint4(rr[0], rr[1], rr[2], rr[3]);
      }
    } else {
      const float* S0 = P.in[5] + (((long)((l * 8 + ci.seqi) * 8 + h)) << 14);
#pragma unroll 4
      for (int dd = hf * 32; dd < hf * 32 + 32; ++dd)
        BS[d * 72 + dd] = f2b(S0[(sl * 64 + dd) * 128 + d] * __expf(bmid[sl * 64 + dd]));
    }
    __syncthreads();
#pragma unroll
    for (int kk = 0; kk < 2; ++kk) {
#pragma unroll
      for (int n = 0; n < 8; ++n) {
        bf16x8 b = *reinterpret_cast<const bf16x8*>(BS + (n * 16 + fr) * 72 + kk * 32 + fq * 8);
        o[n] = __builtin_amdgcn_mfma_f32_16x16x32_bf16(aq[sl * 2 + kk], b, o[n], 0, 0, 0);
      }
    }
  }
  float rinv[4];
#pragma unroll
  for (int j = 0; j < 4; ++j) {
    float ss = 0.f;
#pragma unroll
    for (int n = 0; n < 8; ++n) ss += o[n][j] * o[n][j];
    ss += __shfl_xor(ss, 1); ss += __shfl_xor(ss, 2); ss += __shfl_xor(ss, 4); ss += __shfl_xor(ss, 8);
    rinv[j] = rsqrtf(ss * (1.f / 128.f) + 1e-6f);
  }
  const float* ng = P.in[17] + l * 128;
  bfu* UC = (bfu*)(P.ws + O_UC);
#pragma unroll
  for (int n = 0; n < 8; ++n)
#pragma unroll
    for (int j = 0; j < 4; ++j) {
      int t = 16 * w + fq * 4 + j, e = n * 16 + fr;
      if (t < L) {
        float g = b2f(Z[(long)(ci.lt0 + t) * NCOL + 8 * 1024 + h * 128 + e]);
        UC[(long)(ci.lt0 + t) * 1024 + h * 128 + e] = f2b(o[n][j] * rinv[j] * ng[e] * siluf_(g));
      }
    }
}
DEVI void phase4(const Params& P, int l, int pass, char* smem) {
  const int tid = ltid();
  const int nck = pass ? 128 : 136;
  const int nH = nck * 8;
  const int nL = 64 * 4;
  for (int id = blockIdx.x; id < nH + nL; id += gridDim.x) {
    if (id < nH) h3_item(P, l, id >> 3, id & 7, smem, tid);
    else { int q = id - nH; lsum_item(P, q >> 2, q & 3, tid); }
  }
}

DEVI void phase5(const Params& P, int l, int pass) {
  const int tid = ltid();
  const int ntok = pass ? 8192 : 8448, base = pass ? 8448 : 0;
  const int nItems = (ntok / 128) * 4;
  const int w = tid >> 6, lane = tid & 63;
  const float* AU0 = (const float*)(P.ws + O_AU);
  const float* AU1 = AU0 + (long)8448 * 1024;
  const float* LS = (const float*)(P.ws + O_LSUM);
  const bfu* Z = (const bfu*)(P.ws + O_Z);
  bfu* UB = (bfu*)(P.ws + O_UB);
  for (int id = blockIdx.x; id < nItems; id += gridDim.x) {
    const int tile = id >> 2, ch = ((id & 3) * 4 + w) * 64 + lane;
    const int lt0 = tile * 128;
    const TokInfo t0 = tokinfo(base + lt0);
    float hcur = 0.f;
    if (!t0.sample) {
      int jf = tile - (t0.t >> 7);
      for (int i = jf; i < tile; ++i) hcur = LS[(long)i * 2048 + ch] * hcur + LS[(long)i * 2048 + 1024 + ch];
    }
    for (int r0 = 0; r0 < 128; r0 += 8) {
      float av[8], uv[8], gv[8];
#pragma unroll
      for (int i = 0; i < 8; ++i) {
        long row = lt0 + r0 + i;
        av[i] = AU0[row * 1024 + ch]; uv[i] = AU1[row * 1024 + ch];
        gv[i] = b2f(Z[row * NCOL + 4 * 1024 + ch]);
      }
#pragma unroll
      for (int i = 0; i < 8; ++i) {
        int r = r0 + i;
        if (t0.sample && (r & 31) == 0) hcur = P.in[4][(long)(l * 8 + t0.seq + (r >> 5)) * 1024 + ch];
        hcur = av[i] * hcur + uv[i];
        UB[(long)(lt0 + r) * 1024 + ch] = f2b(geluf_(gv[i]) * hcur);
        if (t0.sample && (r & 31) == 31) P.out[OUT_LRS + (long)(l * 8 + t0.seq + (r >> 5)) * 1024 + ch] = hcur;
      }
    }
    if (!t0.sample && t0.t + 128 == 4096) P.out[OUT_LRP + (long)(l * 4 + t0.seq) * 1024 + ch] = hcur;
  }
}

template <int BR>
DEVI void p6_branch(const Params& P, int pm, int pn, float* macc, char* smem, int tid) {
  asm volatile("" : "+s"(pm), "+s"(pn));
  const bfu* Z = (const bfu*)(P.ws + O_Z);
  bfu* M = (bfu*)(P.ws + O_CB);
  const bfu* A = (const bfu*)(P.ws + (BR == 0 ? O_UA : BR == 1 ? O_UB : O_UC)) + (long)pm * 128 * 1024;
  const bfu* B = (const bfu*)(P.ws + (BR == 0 ? O_WOA : BR == 1 ? O_WOB : O_WOC)) + (long)pn * 128 * 1024;
  f32x4 acc[4][4]; ZERO_ACC(acc);
  gemm_core(acc, A, 1024, B, 1024, 1024, smem, tid);
  EPI_LOOP {
    int row = pm * 128 + EPI_ROW, col = pn * 128 + EPI_COL;
    float g = sigmoidf_(b2f(Z[(long)row * NCOL + (9 + BR) * 1024 + col]));
    float v = g * acc[m][n][j];
    if (BR > 0) v += macc[(long)row * 1024 + col];
    if (BR < 2) macc[(long)row * 1024 + col] = v;
    else M[(long)row * 1024 + col] = f2b(v);
  }
}
DEVI void phase6(const Params& P, int l, int pass, char* smem) {
  const int tid = ltid();
  const int ntok = pass ? 8192 : 8448;
  const int nM = ntok / 128, nN = 8;
  const bfu* Z = (const bfu*)(P.ws + O_Z);
  bfu* M = (bfu*)(P.ws + O_CB);
  for (int id = blockIdx.x; id < nM * nN; id += gridDim.x) {
    int pm = id >> 3, pn = id & 7;
    float* macc = (float*)(P.ws + O_AU);
    p6_branch<0>(P, pm, pn, macc, smem, tid);
    p6_branch<1>(P, pm, pn, macc, smem, tid);
    p6_branch<2>(P, pm, pn, macc, smem, tid);
  }
}

DEVI void phase7(const Params& P, int l, int pass, char* smem) {
  const int tid = ltid();
  const int ntok = pass ? 8192 : 8448, base = pass ? 8448 : 0;
  const int nM = ntok / 128, nN = 8;
  const bfu* M = (const bfu*)(P.ws + O_CB);
  const bfu* W = (const bfu*)(P.ws + O_WO);
  float* pre = (float*)(P.ws + O_PRE);
  for (int id = blockIdx.x; id < nM * nN; id += gridDim.x) {
    int pm = id >> 3, pn = id & 7;
    f32x4 acc[4][4]; ZERO_ACC(acc);
    gemm_core(acc, M + (long)pm * 128 * 1024, 1024, W + (long)pn * 128 * 1024, 1024, 1024, smem, tid);
    EPI_LOOP {
      int row = pm * 128 + EPI_ROW, col = pn * 128 + EPI_COL;
      const float* xr = xrow(P, base + row);
      pre[(long)row * 1024 + col] = ALPHA * xr[col] + acc[m][n][j];
    }
  }
}

DEVI void phase8(const Params& P, int l, int pass) {
  const int tid = ltid();
  const int ntok = pass ? 8192 : 8448, base = pass ? 8448 : 0;
  const int w = tid >> 6, lane = tid & 63;
  const float* pre = (const float*)(P.ws + O_PRE);
  const float* g = P.in[22] + l * 1024;
  const float* b = P.in[23] + l * 1024;
  bfu* xb = (bfu*)(P.ws + O_XB);
  for (int id = blockIdx.x; id < ntok / 4; id += gridDim.x) {
    int lt = id * 4 + w, it = base + lt;
    const float* src = pre + (long)lt * 1024;
    float v[16];
#pragma unroll
    for (int q = 0; q < 4; ++q) {
      float4 t = *reinterpret_cast<const float4*>(src + q * 256 + lane * 4);
      v[q * 4] = t.x; v[q * 4 + 1] = t.y; v[q * 4 + 2] = t.z; v[q * 4 + 3] = t.w;
    }
    float s = 0.f;
#pragma unroll
    for (int i = 0; i < 16; ++i) s += v[i];
    float mu = wave_sum(s) * (1.f / 1024.f);
    float ss = 0.f;
#pragma unroll
    for (int i = 0; i < 16; ++i) { float dlt = v[i] - mu; ss += dlt * dlt; }
    float rs = rsqrtf(wave_sum(ss) * (1.f / 1024.f) + 1e-5f);
    float* xr = xrow(P, it);
#pragma unroll
    for (int q = 0; q < 4; ++q) {
      int c = q * 256 + lane * 4;
      float o[4];
#pragma unroll
      for (int i = 0; i < 4; ++i) o[i] = (v[q * 4 + i] - mu) * rs * g[c + i] + b[c + i];
      *reinterpret_cast<float4*>(xr + c) = make_float4(o[0], o[1], o[2], o[3]);
      store4bf(xb + (long)it * 1024 + c, o);
    }
  }
}

DEVI void phase9(const Params& P, int l, int pass, char* smem) {
  const int tid = ltid();
  const int ntok = pass ? 8192 : 8448, base = pass ? 8448 : 0;
  const int nM = ntok / 128, nN = 16;
  const bfu* xb = (const bfu*)(P.ws + O_XB) + (long)base * 1024;
  const bfu* W = (const bfu*)(P.ws + O_WQ);
  bfu* qp = (bfu*)(P.ws + O_QP);
  for (int id = blockIdx.x; id < nM * nN; id += gridDim.x) {
    int pm, pn; tile_rc(id, nM, nN, pm, pn);
    f32x4 acc[4][4]; ZERO_ACC(acc);
    gemm_core(acc, xb + (long)pm * 128 * 1024, 1024, W + (long)pn * 128 * 1024, 1024, 1024, smem, tid);
    EPI_LOOP {
      int row = pm * 128 + EPI_ROW, col = pn * 128 + EPI_COL;
      qp[(long)row * 2048 + col] = f2b(acc[m][n][j]);
    }
  }
}
DEVI void phase10(const Params& P, int l, int pass, char* smem) {
  const int tid = ltid();
  const int ntok = pass ? 8192 : 8448;
  const int nM = ntok / 128, nN = 16;
  const bfu* qp = (const bfu*)(P.ws + O_QP);
  const bfu* KB = (const bfu*)(P.ws + O_KEYS);
  float* sc = (float*)(P.ws + O_SC);
  for (int id = blockIdx.x; id < nM * nN; id += gridDim.x) {
    int pm = id >> 4, pn = id & 15;
    f32x4 acc[4][4]; ZERO_ACC(acc);
    gemm_core(acc, qp + (long)pm * 128 * 2048 + pn * 128, 2048, KB + (long)pn * 16384, 128, 128, smem, tid);
    EPI_LOOP {
      int row = pm * 128 + EPI_ROW, col = pn * 128 + EPI_COL;
      sc[(long)row * 2048 + col] = acc[m][n][j];
    }
  }
}

DEVI unsigned fkey(float f) {
  unsigned u = __float_as_uint(f);
  return (u & 0x80000000u) ? ~u : (u | 0x80000000u);
}
DEVI void unpack8(uint4 v, float (&o)[8]) {
  o[0] = __uint_as_float(v.x << 16); o[1] = __uint_as_float(v.x & 0xFFFF0000u);
  o[2] = __uint_as_float(v.y << 16); o[3] = __uint_as_float(v.y & 0xFFFF0000u);
  o[4] = __uint_as_float(v.z << 16); o[5] = __uint_as_float(v.z & 0xFFFF0000u);
  o[6] = __uint_as_float(v.w << 16); o[7] = __uint_as_float(v.w & 0xFFFF0000u);
}
DEVI void phase11(const Params& P, int l, int pass, char* smem) {
  const int ntok = pass ? 8192 : 8448, base = pass ? 8448 : 0;
  const int tid = ltid(); const int w = tid >> 6, lane = tid & 63;
  float* scl = (float*)smem;
  float* sv = scl + 2048;
  int* si = (int*)(sv + 256);
  float* tops = (float*)(si + 256);
  int* tope = (int*)(tops + 128);
  float* wgt = (float*)(tope + 128);
  float* red = wgt + 128;
  float* stat = red + 4096;
  const float* SC = (const float*)(P.ws + O_SC);
  const bfu* UT = (const bfu*)(P.ws + O_UTB);
  const bfu* VTb = (const bfu*)(P.ws + O_VTB);
  const float* g2 = P.in[28] + l * 1024;
  const float* b2 = P.in[29] + l * 1024;
  bfu* xb = (bfu*)(P.ws + O_XB);
  const unsigned long long ltmask = (1ull << lane) - 1ull;
  for (int lt = blockIdx.x; lt < ntok; lt += gridDim.x) {
    const int it = base + lt;
    float* xr = xrow(P, it);
    __syncthreads();
    {
      const float4* s4 = reinterpret_cast<const float4*>(SC + (long)lt * 2048);
      reinterpret_cast<float4*>(scl)[tid] = s4[tid];
      reinterpret_cast<float4*>(scl)[tid + 256] = s4[tid + 256];
    }
    __syncthreads();
#pragma unroll 1
    for (int li = 0; li < 4; ++li) {
      const int Lx = w * 4 + li;
      float v0 = scl[Lx * 128 + lane], v1 = scl[Lx * 128 + 64 + lane];
      unsigned k0 = fkey(v0), k1 = fkey(v1);
      unsigned T = 0;
      for (int b = 31; b >= 0; --b) {
        unsigned cand = T | (1u << b);
        int cnt = __popcll(__ballot(k0 >= cand)) + __popcll(__ballot(k1 >= cand));
        if (cnt >= 16) T = cand;
      }
      bool s0 = k0 >= T, s1 = k1 >= T;
      unsigned long long m0 = __ballot(s0), m1 = __ballot(s1);
      int p0 = __popcll(m0 & ltmask), p1 = __popcll(m0) + __popcll(m1 & ltmask);
      if (s0 && p0 < 16) { sv[Lx * 16 + p0] = v0; si[Lx * 16 + p0] = lane; }
      if (s1 && p1 < 16) { sv[Lx * 16 + p1] = v1; si[Lx * 16 + p1] = lane + 64; }
    }
    __syncthreads();
#pragma unroll 1
    for (int hi = 0; hi < 2; ++hi) {
      const int h = w * 2 + hi;
      float cv[4]; unsigned ck[4];
#pragma unroll
      for (int r = 0; r < 4; ++r) {
        int c = lane + 64 * r;
        cv[r] = sv[(2 * h) * 16 + (c >> 4)] + sv[(2 * h + 1) * 16 + (c & 15)];
        ck[r] = fkey(cv[r]);
      }
      unsigned T = 0;
      for (int b = 31; b >= 0; --b) {
        unsigned cand = T | (1u << b);
        int cnt = 0;
#pragma unroll
        for (int r = 0; r < 4; ++r) cnt += __popcll(__ballot(ck[r] >= cand));
        if (cnt >= 16) T = cand;
      }
      int basec = 0;
#pragma unroll
      for (int r = 0; r < 4; ++r) {
        bool s = ck[r] >= T;
        unsigned long long mm = __ballot(s);
        int p = basec + __popcll(mm & ltmask);
        if (s && p < 16) {
          int c = lane + 64 * r;
          tops[h * 16 + p] = cv[r];
          tope[h * 16 + p] = si[(2 * h) * 16 + (c >> 4)] * 128 + si[(2 * h + 1) * 16 + (c & 15)];
        }
        basec += __popcll(mm);
      }
    }
    __syncthreads();
    if (tid < 128) {
      float s = tops[tid];
      float mx = s;
      mx = fmaxf(mx, __shfl_xor(mx, 1)); mx = fmaxf(mx, __shfl_xor(mx, 2));
      mx = fmaxf(mx, __shfl_xor(mx, 4)); mx = fmaxf(mx, __shfl_xor(mx, 8));
      float e = __expf(s - mx);
      float sm = e;
      sm += __shfl_xor(sm, 1); sm += __shfl_xor(sm, 2); sm += __shfl_xor(sm, 4); sm += __shfl_xor(sm, 8);
      tops[tid] = e / sm;
    }
    __syncthreads();
    float xv[16];
    {
      float4 a = *reinterpret_cast<const float4*>(xr + lane * 8);
      float4 b = *reinterpret_cast<const float4*>(xr + lane * 8 + 4);
      float4 c = *reinterpret_cast<const float4*>(xr + 512 + lane * 8);
      float4 d = *reinterpret_cast<const float4*>(xr + 512 + lane * 8 + 4);
      xv[0] = a.x; xv[1] = a.y; xv[2] = a.z; xv[3] = a.w; xv[4] = b.x; xv[5] = b.y; xv[6] = b.z; xv[7] = b.w;
      xv[8] = c.x; xv[9] = c.y; xv[10] = c.z; xv[11] = c.w; xv[12] = d.x; xv[13] = d.y; xv[14] = d.z; xv[15] = d.w;
    }
#pragma unroll 1
    for (int p0 = 0; p0 < 32; p0 += 4) {
      uint4 ra[4], rb[4];
#pragma unroll
      for (int i = 0; i < 4; ++i) {
        int e = tope[w * 32 + p0 + i];
        const bfu* row = UT + (long)e * 1024;
        ra[i] = *reinterpret_cast<const uint4*>(row + lane * 8);
        rb[i] = *reinterpret_cast<const uint4*>(row + 512 + lane * 8);
      }
#pragma unroll
      for (int i = 0; i < 4; ++i) {
        float fa[8], fb[8];
        unpack8(ra[i], fa); unpack8(rb[i], fb);
        float dsum = 0.f;
#pragma unroll
        for (int q = 0; q < 8; ++q) dsum += fa[q] * xv[q] + fb[q] * xv[8 + q];
        dsum = wave_sum(dsum);
        if (lane == 0) wgt[w * 32 + p0 + i] = tops[w * 32 + p0 + i] * geluf_(dsum);
      }
    }
    __syncthreads();
    float oacc[16];
#pragma unroll
    for (int q = 0; q < 16; ++q) oacc[q] = 0.f;
#pragma unroll 1
    for (int p0 = 0; p0 < 32; p0 += 4) {
      uint4 ra[4], rb[4]; float wg[4];
#pragma unroll
      for (int i = 0; i < 4; ++i) {
        int e = tope[w * 32 + p0 + i];
        wg[i] = wgt[w * 32 + p0 + i];
        const bfu* row = VTb + (long)e * 1024;
        ra[i] = *reinterpret_cast<const uint4*>(row + lane * 8);
        rb[i] = *reinterpret_cast<const uint4*>(row + 512 + lane * 8);
      }
#pragma unroll
      for (int i = 0; i < 4; ++i) {
        float fa[8], fb[8];
        unpack8(ra[i], fa); unpack8(rb[i], fb);
#pragma unroll
        for (int q = 0; q < 8; ++q) { oacc[q] += wg[i] * fa[q]; oacc[8 + q] += wg[i] * fb[q]; }
      }
    }
    {
      float* rw = red + w * 1024;
      *reinterpret_cast<float4*>(rw + lane * 8) = make_float4(oacc[0], oacc[1], oacc[2], oacc[3]);
      *reinterpret_cast<float4*>(rw + lane * 8 + 4) = make_float4(oacc[4], oacc[5], oacc[6], oacc[7]);
      *reinterpret_cast<float4*>(rw + 512 + lane * 8) = make_float4(oacc[8], oacc[9], oacc[10], oacc[11]);
      *reinterpret_cast<float4*>(rw + 512 + lane * 8 + 4) = make_float4(oacc[12], oacc[13], oacc[14], oacc[15]);
    }
    __syncthreads();
    const int c = tid * 4;
    float y[4];
    {
      float4 xx = *reinterpret_cast<const float4*>(xr + c);
      float4 r0 = *reinterpret_cast<const float4*>(red + c);
      float4 r1 = *reinterpret_cast<const float4*>(red + 1024 + c);
      float4 r2 = *reinterpret_cast<const float4*>(red + 2048 + c);
      float4 r3 = *reinterpret_cast<const float4*>(red + 3072 + c);
      y[0] = ALPHA * xx.x + (r0.x + r1.x + r2.x + r3.x);
      y[1] = ALPHA * xx.y + (r0.y + r1.y + r2.y + r3.y);
      y[2] = ALPHA * xx.z + (r0.z + r1.z + r2.z + r3.z);
      y[3] = ALPHA * xx.w + (r0.w + r1.w + r2.w + r3.w);
    }
    float s = wave_sum(y[0] + y[1] + y[2] + y[3]);
    if (lane == 0) stat[w] = s;
    __syncthreads();
    float mu = (stat[0] + stat[1] + stat[2] + stat[3]) * (1.f / 1024.f);
    float ss = 0.f;
#pragma unroll
    for (int i = 0; i < 4; ++i) { float dl = y[i] - mu; ss += dl * dl; }
    ss = wave_sum(ss);
    if (lane == 0) stat[4 + w] = ss;
    __syncthreads();
    float rs = rsqrtf((stat[4] + stat[5] + stat[6] + stat[7]) * (1.f / 1024.f) + 1e-5f);
    float o[4];
#pragma unroll
    for (int i = 0; i < 4; ++i) o[i] = (y[i] - mu) * rs * g2[c + i] + b2[c + i];
    *reinterpret_cast<float4*>(xr + c) = make_float4(o[0], o[1], o[2], o[3]);
    store4bf(xb + (long)it * 1024 + c, o);
  }
}

__global__ void __launch_bounds__(256, 2) fwd_megakernel(Params P) {
  __shared__ __attribute__((aligned(16))) char smem[65536];
  cg::grid_group grid = cg::this_grid();
#define LND asm volatile("" : "+s"(l), "+s"(pass))
#pragma unroll 1
  for (int l = 0; l < 2; ++l) {
    phase_prep(P, l, smem);
    if (l == 0) phase_xcopy(P);
    grid.sync();
#pragma unroll 1
    for (int pass = 0; pass < 2; ++pass) {
      LND; phase_inproj(P, l, pass, smem); grid.sync();
      LND; phase2(P, l, pass, smem); grid.sync();
      LND; phase3(P, l, pass, smem); grid.sync();
      LND; phase4(P, l, pass, smem); grid.sync();
      LND; phase5(P, l, pass); grid.sync();
      LND; phase6(P, l, pass, smem); grid.sync();
      LND; phase7(P, l, pass, smem); grid.sync();
      LND; phase8(P, l, pass); grid.sync();
      LND; phase9(P, l, pass, smem); grid.sync();
      LND; phase10(P, l, pass, smem); grid.sync();
      LND; phase11(P, l, pass, smem); grid.sync();
    }
  }
}

extern "C" void kernel_launch(void* const* d_in, const int* in_sizes, int n_in, void* d_out, int out_size,
                              void* d_ws, size_t ws_size, hipStream_t stream) {
  static int grid_blocks = 0;
  if (!grid_blocks) {
    int dev = 0, cus = 0, per_cu = 0;
    hipGetDevice(&dev);
    hipDeviceGetAttribute(&cus, hipDeviceAttributeMultiprocessorCount, dev);
    hipOccupancyMaxActiveBlocksPerMultiprocessor(&per_cu, fwd_megakernel, 256, 0);
    if (per_cu > 2) per_cu = 2;
    if (per_cu < 1) per_cu = 1;
    grid_blocks = cus * per_cu;
  }
  if (ws_size < O_END) fprintf(stderr, "workspace too small: %zu < %zu\n", ws_size, (size_t)O_END);
  Params p{};
  for (int i = 0; i < 30; ++i) p.in[i] = (const float*)d_in[i];
  p.out = (float*)d_out;
  p.ws = (char*)d_ws;
  void* args[] = {&p};
  hipError_t e = hipLaunchCooperativeKernel((void*)fwd_megakernel, dim3(grid_blocks), dim3(256), args, 0, stream);
  if (e != hipSuccess) fprintf(stderr, "cooperative launch failed: %s (grid %d)\n", hipGetErrorString(e), grid_blocks);
}
```

```cpp
#include <hip/hip_runtime.h>
#include <hip/hip_bf16.h>
#include <hip/hip_cooperative_groups.h>
#include <cstdio>
namespace cg = cooperative_groups;

typedef unsigned short bfu;
using bf16x8 = __attribute__((ext_vector_type(8))) short;
using f32x4 = __attribute__((ext_vector_type(4))) float;
#define DEVI __device__ __forceinline__

constexpr float ALPHA = 1.41421356237f;
constexpr int NCOL = 12288;

constexpr size_t O_WIN = 0;
constexpr size_t O_WOA = O_WIN + 25165824;
constexpr size_t O_WOB = O_WOA + 2097152;
constexpr size_t O_WOC = O_WOB + 2097152;
constexpr size_t O_WO = O_WOC + 2097152;
constexpr size_t O_WQ = O_WO + 2097152;
constexpr size_t O_KEYS = O_WQ + 4194304;
constexpr size_t O_LRU = O_KEYS + 524288;
constexpr size_t O_UTB = O_LRU + 524288;
constexpr size_t O_VTB = O_UTB + 33554432;
constexpr size_t O_LBS = O_VTB + 33554432;
constexpr size_t O_XB = O_LBS + 8192;
constexpr size_t O_Z = O_XB + 34078720;
constexpr size_t O_UA = O_Z + 207618048;
constexpr size_t O_UB = O_UA + 17301504;
constexpr size_t O_UC = O_UB + 17301504;
constexpr size_t O_CB = O_UC + 17301504;
constexpr size_t O_AU = O_CB + 17301504;
constexpr size_t O_LSUM = O_AU + 69206016;
constexpr size_t O_US = O_LSUM + 540672;
constexpr size_t O_DEC = O_US + 33554432;
constexpr size_t O_END = O_DEC + 524288;
constexpr size_t O_PRE = O_Z;
constexpr size_t O_QP = O_Z + 34603008;
constexpr size_t O_SC = O_QP + 34603008;

constexpr long OUT_YS = 16777216;
constexpr long OUT_CAP = 17039360;
constexpr long OUT_CBP = 17055744;
constexpr long OUT_LRP = 17080320;
constexpr long OUT_HGP = 17088512;
constexpr long OUT_CAS = 18137088;
constexpr long OUT_CBS = 18169856;
constexpr long OUT_LRS = 18219008;
constexpr long OUT_HGS = 18235392;

struct Params {
  const float* in[30];
  float* out;
  char* ws;
};

DEVI bfu f2b(float f) {
  unsigned u = __float_as_uint(f);
  u += 0x7FFFu + ((u >> 16) & 1u);
  return (bfu)(u >> 16);
}
DEVI float b2f(bfu b) { return __uint_as_float(((unsigned)b) << 16); }
DEVI float sigmoidf_(float x) { return 1.f / (1.f + __expf(-x)); }
DEVI float siluf_(float x) { return x / (1.f + __expf(-x)); }
DEVI float geluf_(float x) { return 0.5f * x * (1.f + erff(x * 0.70710678118f)); }
DEVI float wave_sum(float v) {
#pragma unroll
  for (int o = 32; o; o >>= 1) v += __shfl_xor(v, o);
  return v;
}

DEVI int ltid() { int t = threadIdx.x; asm volatile("" : "+v"(t)); return t; }
struct TokInfo { int sample, seq, t; };
DEVI TokInfo tokinfo(int it) {
  TokInfo r;
  if (it < 8192) { r.sample = 0; r.seq = it >> 12; r.t = it & 4095; }
  else if (it < 8448) { int q = it - 8192; r.sample = 1; r.seq = q >> 5; r.t = q & 31; }
  else { int q = it - 8448; r.sample = 0; r.seq = 2 + (q >> 12); r.t = q & 4095; }
  return r;
}
DEVI float* xrow(const Params& P, int it) {
  TokInfo ti = tokinfo(it);
  return ti.sample ? P.out + OUT_YS + (long)(ti.seq * 32 + ti.t) * 1024
                   : P.out + (long)(ti.seq * 4096 + ti.t) * 1024;
}

DEVI void stage_tile(const bfu* __restrict__ g, int ld, int k0, char* lds, int tid) {
#pragma unroll
  for (int i = 0; i < 4; ++i) {
    int b = tid * 16 + i * 4096;
    int r = b >> 7, cp = (b >> 4) & 7, gc = cp ^ (r & 7);
    __builtin_amdgcn_global_load_lds((const unsigned*)(g + (long)r * ld + k0 + gc * 8),
                                     (unsigned*)(lds + b), 16, 0, 0);
  }
}
DEVI bf16x8 ldfrag(const char* tile, int r, int kc) {
  return *reinterpret_cast<const bf16x8*>(tile + r * 128 + ((kc ^ (r & 7)) << 4));
}
DEVI void gemm_core(f32x4 (&acc)[4][4], const bfu* __restrict__ A, int lda,
                    const bfu* __restrict__ B, int ldb, int K, char* smem, int tid) {
  const int wid = tid >> 6, lane = tid & 63;
  const int wr = wid >> 1, wc = wid & 1, fr = lane & 15, fq = lane >> 4;
  const int nt = K >> 6;
  __syncthreads();
  stage_tile(A, lda, 0, smem, tid);
  stage_tile(B, ldb, 0, smem + 16384, tid);
  for (int t = 0; t < nt; ++t) {
    asm volatile("s_waitcnt vmcnt(0)" ::: "memory");
    __syncthreads();
    char* cur = smem + (t & 1) * 32768;
    if (t + 1 < nt) {
      char* nx = smem + ((t + 1) & 1) * 32768;
      stage_tile(A, lda, (t + 1) * 64, nx, tid);
      stage_tile(B, ldb, (t + 1) * 64, nx + 16384, tid);
    }
#pragma unroll
    for (int kk = 0; kk < 2; ++kk) {
      bf16x8 af[4], bfr[4];
#pragma unroll
      for (int m = 0; m < 4; ++m) af[m] = ldfrag(cur, wr * 64 + m * 16 + fr, kk * 4 + fq);
#pragma unroll
      for (int n = 0; n < 4; ++n) bfr[n] = ldfrag(cur + 16384, wc * 64 + n * 16 + fr, kk * 4 + fq);
#pragma unroll
      for (int m = 0; m < 4; ++m)
#pragma unroll
        for (int n = 0; n < 4; ++n)
          acc[m][n] = __builtin_amdgcn_mfma_f32_16x16x32_bf16(af[m], bfr[n], acc[m][n], 0, 0, 0);
    }
  }
}
DEVI void tile_rc(int id, int nM, int nN, int& pm, int& pn) {
  const int WGM = 8;
  int nig = WGM * nN, gid = id / nig, fm = gid * WGM;
  int gsz = min(nM - fm, WGM);
  pm = fm + ((id % nig) % gsz);
  pn = (id % nig) / gsz;
}
#define ZERO_ACC(a) _Pragma("unroll") for (int m_ = 0; m_ < 4; ++m_) _Pragma("unroll") for (int n_ = 0; n_ < 4; ++n_) a[m_][n_] = f32x4{0.f, 0.f, 0.f, 0.f}
#define EPI_LOOP \
  const int wid_ = tid >> 6, lane_ = tid & 63; \
  const int wr_ = wid_ >> 1, wc_ = wid_ & 1, fr_ = lane_ & 15, fq_ = lane_ >> 4; \
  _Pragma("unroll") for (int m = 0; m < 4; ++m) for (int sb_ = (__builtin_amdgcn_sched_barrier(0), 0); sb_ < 1; ++sb_) _Pragma("unroll") for (int n = 0; n < 4; ++n) _Pragma("unroll") for (int j = 0; j < 4; ++j)
#define EPI_ROW (wr_ * 64 + m * 16 + fq_ * 4 + j)
#define EPI_COL (wc_ * 64 + n * 16 + fr_)

DEVI void transpose_tile(const float* __restrict__ src, bfu* __restrict__ dst, int R, int C, int r0, int c0, float* tile, int tid) {
  __syncthreads();
  {
    int tx = tid & 15, ty = tid >> 4;
#pragma unroll
    for (int i = 0; i < 4; ++i) {
      int r = ty + i * 16;
      float4 v = *reinterpret_cast<const float4*>(src + (long)(r0 + r) * C + c0 + tx * 4);
      float* tp = tile + r * 65 + tx * 4;
      tp[0] = v.x; tp[1] = v.y; tp[2] = v.z; tp[3] = v.w;
    }
  }
  __syncthreads();
  {
    int c = tid >> 2, rs = (tid & 3) * 16;
    unsigned pk[8];
#pragma unroll
    for (int i = 0; i < 8; ++i) {
      unsigned lo = f2b(tile[(rs + 2 * i) * 65 + c]);
      unsigned hi = f2b(tile[(rs + 2 * i + 1) * 65 + c]);
      pk[i] = lo | (hi << 16);
    }
    uint4* dp = reinterpret_cast<uint4*>(dst + (long)(c0 + c) * R + r0 + rs);
    dp[0] = make_uint4(pk[0], pk[1], pk[2], pk[3]);
    dp[1] = make_uint4(pk[4], pk[5], pk[6], pk[7]);
  }
}
DEVI void convert_chunk(const float* __restrict__ src, bfu* __restrict__ dst, int tid) {
  int o = tid * 8;
  float4 a = *reinterpret_cast<const float4*>(src + o);
  float4 b = *reinterpret_cast<const float4*>(src + o + 4);
  uint4 r;
  r.x = f2b(a.x) | ((unsigned)f2b(a.y) << 16);
  r.y = f2b(a.z) | ((unsigned)f2b(a.w) << 16);
  r.z = f2b(b.x) | ((unsigned)f2b(b.y) << 16);
  r.w = f2b(b.z) | ((unsigned)f2b(b.w) << 16);
  *reinterpret_cast<uint4*>(dst + o) = r;
}

typedef float f32x2 __attribute__((ext_vector_type(2)));
constexpr float U_SCALE = 64.f, V_SCALE = 8.f;
DEVI void convert_chunk_fp8(const float* __restrict__ src, unsigned char* __restrict__ dst, float scale, int tid) {
  int o = tid * 16;
  uint4 r;
  unsigned rr[4];
#pragma unroll
  for (int q = 0; q < 4; ++q) {
    float4 a = *reinterpret_cast<const float4*>(src + o + q * 4);
    int p = __builtin_amdgcn_cvt_pk_fp8_f32(a.x * scale, a.y * scale, 0, false);
    p = __builtin_amdgcn_cvt_pk_fp8_f32(a.z * scale, a.w * scale, p, true);
    rr[q] = (unsigned)p;
  }
  r = make_uint4(rr[0], rr[1], rr[2], rr[3]);
  *reinterpret_cast<uint4*>(dst + o) = r;
}

DEVI void phase_prep(const Params& P, int l, char* smem) {
  const int tid = ltid();
  char* ws = P.ws;
  float* tile = reinterpret_cast<float*>(smem);
  const int NT_WIN = 3072, NT_SQ = 256, NT_WQ = 512, NT_LRU = 64;
  const int T0 = NT_WIN, T1 = T0 + 4 * NT_SQ, T2 = T1 + NT_WQ, T3 = T2 + NT_LRU;
  const int C0 = T3 + 128, C1 = C0 + 4096, C2 = C1 + 4096;
  const int X0 = C2;
  const int L0 = X0 + (l == 0 ? 8 : 0);
  for (int id = blockIdx.x; id < L0; id += gridDim.x) {
    if (id < T0) {
      int tr = id / 192, tc = id % 192;
      transpose_tile(P.in[6] + (long)l * 1024 * 12288, (bfu*)(ws + O_WIN), 1024, 12288, tr * 64, tc * 64, tile, tid);
    } else if (id < T1) {
      int q = id - T0, w = q >> 8, t = q & 255;
      const float* src = P.in[18 + w] + (long)l * 1048576;
      bfu* dst = (bfu*)(ws + (w == 0 ? O_WOA : w == 1 ? O_WOB : w == 2 ? O_WOC : O_WO));
      transpose_tile(src, dst, 1024, 1024, (t >> 4) * 64, (t & 15) * 64, tile, tid);
    } else if (id < T2) {
      int q = id - T1;
      transpose_tile(P.in[24] + (long)l * 2097152, (bfu*)(ws + O_WQ), 1024, 2048, (q >> 5) * 64, (q & 31) * 64, tile, tid);
    } else if (id < T3) {
      int q = id - T2, mtx = q >> 2, t = q & 3, g = mtx >> 3, nb = mtx & 7;
      const float* src = P.in[g == 0 ? 11 : 13] + (long)l * 131072 + nb * 16384;
      transpose_tile(src, (bfu*)(ws + O_LRU) + mtx * 16384, 128, 128, (t >> 1) * 64, (t & 1) * 64, tile, tid);
    } else if (id < C0) {
      int q = id - T3;
      convert_chunk(P.in[25] + (long)l * 262144 + (long)q * 2048, (bfu*)(ws + O_KEYS) + (long)q * 2048, tid);
    } else if (id < C1) {
      int q = id - C0;
      convert_chunk_fp8(P.in[26] + (long)l * 16777216 + (long)q * 4096, (unsigned char*)(ws + O_UTB) + (long)q * 4096, U_SCALE, tid);
    } else if (id < C2) {
      int q = id - C1;
      convert_chunk_fp8(P.in[27] + (long)l * 16777216 + (long)q * 4096, (unsigned char*)(ws + O_VTB) + (long)q * 4096, V_SCALE, tid);
    } else {
      int q = id - X0;
      int c = (q & 3) * 256 + tid, ll = q >> 2;
      float a0 = P.in[16][c], a1 = P.in[16][1024 + c];
      float mx = fmaxf(a0, a1);
      float e0 = __expf(a0 - mx), e1 = __expf(a1 - mx);
      float p1 = e1 / (e0 + e1);
      float* lbs = (float*)(ws + O_LBS);
      lbs[ll * 1024 + c] = (ll == 0) ? 0.f : p1;
    }
  }
}

DEVI void phase_xcopy(const Params& P) {
  const int tid = ltid();
  bfu* xb = (bfu*)(P.ws + O_XB);
  for (int it = blockIdx.x; it < 16640; it += gridDim.x) {
    TokInfo ti = tokinfo(it);
    const float* src = ti.sample ? P.in[1] + (long)(ti.seq * 32 + ti.t) * 1024 : P.in[0] + (long)(ti.seq * 4096 + ti.t) * 1024;
    float* dst = xrow(P, it);
    int c = tid * 4;
    float4 v = *reinterpret_cast<const float4*>(src + c);
    *reinterpret_cast<float4*>(dst + c) = v;
    uint2 r;
    r.x = f2b(v.x) | ((unsigned)f2b(v.y) << 16);
    r.y = f2b(v.z) | ((unsigned)f2b(v.w) << 16);
    *reinterpret_cast<uint2*>(xb + (long)it * 1024 + c) = r;
  }
}

DEVI void phase_inproj(const Params& P, int l, int pass, char* smem) {
  const int tid = ltid();
  const int ntok = pass ? 8192 : 8448, base = pass ? 8448 : 0;
  const int nM = ntok / 128, nN = 96;
  const bfu* xb = (const bfu*)(P.ws + O_XB) + (long)base * 1024;
  const bfu* wT = (const bfu*)(P.ws + O_WIN);
  bfu* z = (bfu*)(P.ws + O_Z);
  const float* bin = P.in[7] + l * NCOL;
  for (int id = blockIdx.x; id < nM * nN; id += gridDim.x) {
    int pm, pn; tile_rc(id, nM, nN, pm, pn);
    f32x4 acc[4][4]; ZERO_ACC(acc);
    gemm_core(acc, xb + (long)pm * 128 * 1024, 1024, wT + (long)pn * 128 * 1024, 1024, 1024, smem, tid);
    EPI_LOOP {
      int row = pm * 128 + EPI_ROW, col = pn * 128 + EPI_COL;
      z[(long)row * NCOL + col] = f2b(acc[m][n][j] + bin[col]);
    }
  }
}

DEVI void load4bf(const bfu* p, float (&o)[4]) {
  uint2 v = *reinterpret_cast<const uint2*>(p);
  o[0] = __uint_as_float(v.x << 16); o[1] = __uint_as_float(v.x & 0xFFFF0000u);
  o[2] = __uint_as_float(v.y << 16); o[3] = __uint_as_float(v.y & 0xFFFF0000u);
}
DEVI void store4bf(bfu* p, const float (&v)[4]) {
  uint2 r;
  r.x = f2b(v[0]) | ((unsigned)f2b(v[1]) << 16);
  r.y = f2b(v[2]) | ((unsigned)f2b(v[3]) << 16);
  *reinterpret_cast<uint2*>(p) = r;
}
DEVI void mixab_row(const Params& P, int l, int base, int lt, int tid) {
  const int it = base + lt;
  const TokInfo ti = tokinfo(it);
  const int T = ti.sample ? 32 : 4096;
  const bfu* z = (const bfu*)(P.ws + O_Z);
  const int c = tid * 4;
  float pk[3][4];
#pragma unroll
  for (int k = 0; k < 3; ++k) {
    int tt = ti.t - 2 + k;
    if (tt >= 0) {
      const bfu* zr = z + (long)(lt - 2 + k) * NCOL;
      float ac[4], ax[4];
      load4bf(zr + 1024 + c, ac); load4bf(zr + 2048 + c, ax);
#pragma unroll
      for (int i = 0; i < 4; ++i) pk[k][i] = ac[i] * ax[i];
    } else if (ti.sample) {
      float4 v = *reinterpret_cast<const float4*>(P.in[2] + ((long)(l * 8 + ti.seq) * 2 + (tt + 2)) * 1024 + c);
      pk[k][0] = v.x; pk[k][1] = v.y; pk[k][2] = v.z; pk[k][3] = v.w;
    } else {
#pragma unroll
      for (int i = 0; i < 4; ++i) pk[k][i] = 0.f;
    }
  }
  {
    float ab[4], o[4];
    load4bf(z + (long)lt * NCOL + c, ab);
    const float* w = P.in[8] + (long)l * 3 * 1024 + c;
#pragma unroll
    for (int i = 0; i < 4; ++i) o[i] = ab[i] * (w[i] * pk[0][i] + w[1024 + i] * pk[1][i] + w[2048 + i] * pk[2][i]);
    store4bf((bfu*)(P.ws + O_UA) + (long)lt * 1024 + c, o);
    if (ti.t >= T - 2) {
      int r = ti.t - (T - 2);
      float* dst = ti.sample ? P.out + OUT_CAS + ((long)(l * 8 + ti.seq) * 2 + r) * 1024 + c
                             : P.out + OUT_CAP + ((long)(l * 4 + ti.seq) * 2 + r) * 1024 + c;
      *reinterpret_cast<float4*>(dst) = make_float4(pk[2][0], pk[2][1], pk[2][2], pk[2][3]);
    }
  }
  float xk[4][4];
#pragma unroll
  for (int k = 0; k < 4; ++k) {
    int tt = ti.t - 3 + k;
    if (tt >= 0) {
      load4bf(z + (long)(lt - 3 + k) * NCOL + 3072 + c, xk[k]);
    } else if (ti.sample) {
      float4 v = *reinterpret_cast<const float4*>(P.in[3] + ((long)(l * 8 + ti.seq) * 3 + (tt + 3)) * 1024 + c);
      xk[k][0] = v.x; xk[k][1] = v.y; xk[k][2] = v.z; xk[k][3] = v.w;
    } else {
#pragma unroll
      for (int i = 0; i < 4; ++i) xk[k][i] = 0.f;
    }
  }
  {
    const float* w = P.in[9] + (long)l * 4 * 1024 + c;
    const float* bb = P.in[10] + (long)l * 1024 + c;
    float o[4];
#pragma unroll
    for (int i = 0; i < 4; ++i)
      o[i] = w[i] * xk[0][i] + w[1024 + i] * xk[1][i] + w[2048 + i] * xk[2][i] + w[3072 + i] * xk[3][i] + bb[i];
    store4bf((bfu*)(P.ws + O_CB) + (long)lt * 1024 + c, o);
    if (ti.t >= T - 3) {
      int r = ti.t - (T - 3);
      float* dst = ti.sample ? P.out + OUT_CBS + ((long)(l * 8 + ti.seq) * 3 + r) * 1024 + c
                             : P.out + OUT_CBP + ((long)(l * 4 + ti.seq) * 3 + r) * 1024 + c;
      *reinterpret_cast<float4*>(dst) = make_float4(xk[3][0], xk[3][1], xk[3][2], xk[3][3]);
    }
  }
}

struct ChunkInfo { int lt0, L, sample, seqi, c; };
DEVI ChunkInfo chunkinfo(int ck) {
  ChunkInfo r;
  if (ck < 128) { r.seqi = ck >> 6; r.c = ck & 63; r.lt0 = r.seqi * 4096 + r.c * 64; r.L = 64; r.sample = 0; }
  else { r.seqi = ck - 128; r.c = 0; r.lt0 = 8192 + r.seqi * 32; r.L = 32; r.sample = 1; }
  return r;
}

DEVI void h1_item(const Params& P, int l, int ck, int h, char* smem, int tid) {
  const ChunkInfo ci = chunkinfo(ck);
  const int lane = tid & 63, w = tid >> 6, fr = lane & 15, fq = lane >> 4;
  bfu* VT = (bfu*)smem;
  bfu* KT = VT + 128 * 72;
  float* tots = (float*)(smem + 36864);
  float* decl = tots + 256;
  const int d = tid & 127, hf = tid >> 7, L = ci.L, Lh = L >> 1;
  const float lb = ((const float*)(P.ws + O_LBS))[l * 1024 + h * 128 + d];
  const bfu* Z = (const bfu*)(P.ws + O_Z);
  const bfu* zf = Z + (long)ci.lt0 * NCOL + 6 * 1024 + h * 128 + d;
  const bfu* zi = Z + (long)ci.lt0 * NCOL + 7 * 1024 + h * 128 + d;
  __syncthreads();
  float tot = 0.f;
  for (int s = hf * Lh; s < hf * Lh + Lh; ++s) {
    float f = lb + (1.f - lb) * sigmoidf_(b2f(zf[(long)s * NCOL]));
    tot += __logf(f);
  }
  tots[hf * 128 + d] = tot;
  __syncthreads();
  float run = hf ? 0.f : tots[128 + d];
  for (int s = hf * Lh + Lh - 1; s >= hf * Lh; --s) {
    float f = lb + (1.f - lb) * sigmoidf_(b2f(zf[(long)s * NCOL]));
    KT[d * 72 + s] = f2b((1.f - f) * __expf(run));
    VT[d * 72 + s] = zi[(long)s * NCOL];
    run += __logf(f);
  }
  if (L == 32) {
    for (int s = 32 + hf * 16; s < 48 + hf * 16; ++s) { KT[d * 72 + s] = 0; VT[d * 72 + s] = 0; }
  }
  if (hf == 0) {
    float dc = __expf(tots[d] + tots[128 + d]);
    decl[d] = dc;
    if (!ci.sample) ((float*)(P.ws + O_DEC))[((ci.seqi * 8 + h) * 64 + ci.c) * 128 + d] = dc;
  }
  __syncthreads();
  f32x4 acc[2][8];
#pragma unroll
  for (int mi = 0; mi < 2; ++mi)
#pragma unroll
    for (int n = 0; n < 8; ++n) acc[mi][n] = f32x4{0.f, 0.f, 0.f, 0.f};
#pragma unroll
  for (int kk = 0; kk < 2; ++kk) {
    bf16x8 a[2];
#pragma unroll
    for (int mi = 0; mi < 2; ++mi) a[mi] = *reinterpret_cast<const bf16x8*>(VT + ((2 * w + mi) * 16 + fr) * 72 + kk * 32 + fq * 8);
#pragma unroll
    for (int n = 0; n < 8; ++n) {
      bf16x8 b = *reinterpret_cast<const bf16x8*>(KT + (n * 16 + fr) * 72 + kk * 32 + fq * 8);
#pragma unroll
      for (int mi = 0; mi < 2; ++mi) acc[mi][n] = __builtin_amdgcn_mfma_f32_16x16x32_bf16(a[mi], b, acc[mi][n], 0, 0, 0);
    }
  }
  if (!ci.sample) {
    bfu* US = (bfu*)(P.ws + O_US) + ((long)((ci.seqi * 8 + h) * 64 + ci.c) << 14);
#pragma unroll
    for (int mi = 0; mi < 2; ++mi) {
      __builtin_amdgcn_sched_barrier(0);
      bfu* bp = US + ((2 * w + mi) * 16 + fq * 4) * 128 + fr;
#pragma unroll
      for (int n = 0; n < 8; ++n)
#pragma unroll
        for (int j = 0; j < 4; ++j) bp[j * 128 + n * 16] = f2b(acc[mi][n][j]);
    }
  } else {
    long sb = ((long)((l * 8 + ci.seqi) * 8 + h)) << 14;
    const float* S0 = P.in[5] + sb;
    float* So = P.out + OUT_HGS + sb;
#pragma unroll
    for (int mi = 0; mi < 2; ++mi)
#pragma unroll
      for (int n = 0; n < 8; ++n) {
        __builtin_amdgcn_sched_barrier(0);
        int e0 = (2 * w + mi) * 16 + fq * 4, dd = n * 16 + fr;
        float4 s0 = *reinterpret_cast<const float4*>(S0 + dd * 128 + e0);
        float dcl = decl[dd];
        float4 r;
        r.x = dcl * s0.x + acc[mi][n][0]; r.y = dcl * s0.y + acc[mi][n][1];
        r.z = dcl * s0.z + acc[mi][n][2]; r.w = dcl * s0.w + acc[mi][n][3];
        *reinterpret_cast<float4*>(So + dd * 128 + e0) = r;
      }
  }
}

DEVI void phase2(const Params& P, int l, int pass, char* smem) {
  const int tid = ltid();
  const int ntok = pass ? 8192 : 8448, base = pass ? 8448 : 0;
  const int nck = pass ? 128 : 136;
  const int nH = nck * 8;
  const int total = nH + ntok;
  for (int id = blockIdx.x; id < total; id += gridDim.x) {
    if (id < nH) h1_item(P, l, id >> 3, id & 7, smem, tid);
    else mixab_row(P, l, base, id - nH, tid);
  }
}

DEVI void gate_tile(const Params& P, int l, int pm, int nb, char* smem, int tid) {
  const bfu* cb = (const bfu*)(P.ws + O_CB);
  const bfu* A = cb + (long)pm * 128 * 1024 + nb * 128;
  const bfu* B1 = (const bfu*)(P.ws + O_LRU) + nb * 16384;
  const bfu* B2 = B1 + 8 * 16384;
  float* au0 = (float*)(P.ws + O_AU);
  float* au1 = au0 + (long)8448 * 1024;
  const float* ba = P.in[12] + l * 1024;
  const float* bx = P.in[14] + l * 1024;
  const float* lam = P.in[15] + l * 1024;
  {
    f32x4 acc[4][4]; ZERO_ACC(acc);
    gemm_core(acc, A, 1024, B1, 128, 128, smem, tid);
    EPI_LOOP {
      int row = pm * 128 + EPI_ROW, col = nb * 128 + EPI_COL;
      float r = sigmoidf_(acc[m][n][j] + ba[col]);
      float sp = log1pf(__expf(-lam[col]));
      au0[(long)row * 1024 + col] = -8.f * r * sp;
    }
  }
  asm volatile("" : "+s"(pm), "+s"(nb));
  {
    f32x4 acc[4][4]; ZERO_ACC(acc);
    gemm_core(acc, A, 1024, B2, 128, 128, smem, tid);
    EPI_LOOP {
      int row = pm * 128 + EPI_ROW, col = nb * 128 + EPI_COL;
      float gi = sigmoidf_(acc[m][n][j] + bx[col]);
      float la = au0[(long)row * 1024 + col];
      float a = __expf(la);
      float mult = sqrtf(fmaxf(-expm1f(2.f * la), 0.f));
      float xv = b2f(cb[(long)row * 1024 + col]);
      au0[(long)row * 1024 + col] = a;
      au1[(long)row * 1024 + col] = mult * gi * xv;
    }
  }
}
DEVI void h2_item(const Params& P, int l, int pass, int item, int tid) {
  const int sh = item >> 6, blk = item & 63;
  const int idx = blk * 256 + tid, e = idx >> 7, d = idx & 127;
  bfu* US = (bfu*)(P.ws + O_US) + ((long)sh * 64 << 14) + idx;
  const float* dec = (const float*)(P.ws + O_DEC) + (long)sh * 64 * 128 + d;
  float S = 0.f;
  for (int c0 = 0; c0 < 64; c0 += 8) {
    float u[8], dc[8];
#pragma unroll
    for (int i = 0; i < 8; ++i) { u[i] = b2f(US[(long)(c0 + i) << 14]); dc[i] = dec[(c0 + i) * 128]; }
#pragma unroll
    for (int i = 0; i < 8; ++i) { US[(long)(c0 + i) << 14] = f2b(S); S = dc[i] * S + u[i]; }
  }
  const int sl = sh >> 3, h = sh & 7, b = pass * 2 + sl;
  P.out[OUT_HGP + (((long)((l * 4 + b) * 8 + h)) << 14) + d * 128 + e] = S;
}
DEVI void phase3(const Params& P, int l, int pass, char* smem) {
  const int tid = ltid();
  const int ntok = pass ? 8192 : 8448;
  const int nG = (ntok / 128) * 8, nH2 = 1024;
  for (int id = blockIdx.x; id < nG + nH2; id += gridDim.x) {
    if (id < nG) gate_tile(P, l, id >> 3, id & 7, smem, tid);
    else h2_item(P, l, pass, id - nG, tid);
  }
}

DEVI void lsum_item(const Params& P, int tile, int cg4, int tid) {
  const int w = tid >> 6, lane = tid & 63;
  const int ch = (cg4 * 4 + w) * 64 + lane;
  const float* a0 = (const float*)(P.ws + O_AU) + (long)tile * 128 * 1024 + ch;
  const float* u0 = a0 + (long)8448 * 1024;
  float A = 1.f, H = 0.f;
  for (int r0 = 0; r0 < 128; r0 += 16) {
    float av[16], uv[16];
#pragma unroll
    for (int i = 0; i < 16; ++i) { av[i] = a0[(long)(r0 + i) * 1024]; uv[i] = u0[(long)(r0 + i) * 1024]; }
#pragma unroll
    for (int i = 0; i < 16; ++i) { H = av[i] * H + uv[i]; A *= av[i]; }
  }
  float* ls = (float*)(P.ws + O_LSUM) + (long)tile * 2048;
  ls[ch] = A; ls[1024 + ch] = H;
}

DEVI void h3_item(const Params& P, int l, int ck, int h, char* smem, int tid) {
  const ChunkInfo ci = chunkinfo(ck);
  const int lane = tid & 63, w = tid >> 6, fr = lane & 15, fq = lane >> 4;
  bfu* QT = (bfu*)smem;
  bfu* KT = QT + 64 * 136;
  bfu* AT = KT + 64 * 136;
  bfu* BS = AT + 64 * 72;
  float* bmid = (float*)(BS + 128 * 72);
  const int d = tid & 127, hf = tid >> 7, L = ci.L, Lh = L >> 1;
  const float lb = ((const float*)(P.ws + O_LBS))[l * 1024 + h * 128 + d];
  const bfu* Z = (const bfu*)(P.ws + O_Z);
  const bfu* zq = Z + (long)ci.lt0 * NCOL + 5 * 1024 + h * 128 + d;
  const bfu* zf = zq + 1024;
  const bfu* zi = zq + 2048;
  __syncthreads();
  if (hf == 0) {
    float rel = 0.f;
    for (int t = Lh - 1; t >= 0; --t) {
      float f = lb + (1.f - lb) * sigmoidf_(b2f(zf[(long)t * NCOL]));
      float q = siluf_(b2f(zq[(long)t * NCOL]));
      QT[t * 136 + d] = f2b(q * __expf(fminf(rel, 80.f)));
      KT[t * 136 + d] = f2b((1.f - f) * __expf(-rel));
      rel -= __logf(f);
    }
    bmid[d] = -rel;
  } else {
    float rel = 0.f;
    for (int t = Lh; t < L; ++t) {
      float f = lb + (1.f - lb) * sigmoidf_(b2f(zf[(long)t * NCOL]));
      float q = siluf_(b2f(zq[(long)t * NCOL]));
      rel += __logf(f);
      QT[t * 136 + d] = f2b(q * __expf(rel));
      KT[t * 136 + d] = f2b((1.f - f) * __expf(fminf(-rel, 80.f)));
    }
  }
  if (L == 32) {
    for (int t = 32 + hf * 16; t < 48 + hf * 16; ++t) { QT[t * 136 + d] = 0; KT[t * 136 + d] = 0; }
  }
#pragma unroll 4
  for (int s = hf * 32; s < hf * 32 + 32; ++s) BS[d * 72 + s] = (s < L) ? zi[(long)s * NCOL] : (bfu)0;
  __syncthreads();
  bf16x8 aq[4];
#pragma unroll
  for (int kk = 0; kk < 4; ++kk) aq[kk] = *reinterpret_cast<const bf16x8*>(QT + (16 * w + fr) * 136 + kk * 32 + fq * 8);
  {
    f32x4 sa[4];
#pragma unroll
    for (int n = 0; n < 4; ++n) sa[n] = f32x4{0.f, 0.f, 0.f, 0.f};
#pragma unroll
    for (int kk = 0; kk < 4; ++kk)
#pragma unroll
      for (int n = 0; n < 4; ++n) {
        bf16x8 bk = *reinterpret_cast<const bf16x8*>(KT + (n * 16 + fr) * 136 + kk * 32 + fq * 8);
        sa[n] = __builtin_amdgcn_mfma_f32_16x16x32_bf16(aq[kk], bk, sa[n], 0, 0, 0);
      }
#pragma unroll
    for (int n = 0; n < 4; ++n)
#pragma unroll
      for (int j = 0; j < 4; ++j) {
        int t = 16 * w + fq * 4 + j, s = n * 16 + fr;
        AT[t * 72 + s] = (s <= t) ? f2b(sa[n][j]) : (bfu)0;
      }
  }
  __syncthreads();
  f32x4 o[8];
#pragma unroll
  for (int n = 0; n < 8; ++n) o[n] = f32x4{0.f, 0.f, 0.f, 0.f};
#pragma unroll
  for (int kk = 0; kk < 2; ++kk) {
    bf16x8 a = *reinterpret_cast<const bf16x8*>(AT + (16 * w + fr) * 72 + kk * 32 + fq * 8);
#pragma unroll
    for (int n = 0; n < 8; ++n) {
      bf16x8 b = *reinterpret_cast<const bf16x8*>(BS + (n * 16 + fr) * 72 + kk * 32 + fq * 8);
      o[n] = __builtin_amdgcn_mfma_f32_16x16x32_bf16(a, b, o[n], 0, 0, 0);
    }
  }
#pragma unroll
  for (int sl = 0; sl < 2; ++sl) {
    __syncthreads();
    if (!ci.sample) {
      const bfu* src = (const bfu*)(P.ws + O_US) + ((long)((ci.seqi * 8 + h) * 64 + ci.c) << 14);
      int e2 = tid >> 1, dd0 = (tid & 1) * 32;
#pragma unroll
      for (int q4 = 0; q4 < 4; ++q4) {
        uint4 v = *reinterpret_cast<const uint4*>(src + e2 * 128 + sl * 64 + dd0 + q4 * 8);
        const float* bm = bmid + sl * 64 + dd0 + q4 * 8;
        unsigned vv[4] = {v.x, v.y, v.z, v.w};
        unsigned rr[4];
#pragma unroll
        for (int i = 0; i < 4; ++i) {
          float lo = __uint_as_float(vv[i] << 16) * __expf(bm[2 * i]);
          float hi = __uint_as_float(vv[i] & 0xFFFF0000u) * __expf(bm[2 * i + 1]);
          rr[i] = f2b(lo) | ((unsigned)f2b(hi) << 16);
        }
        *reinterpret_cast<uint4*>(BS + e2 * 72 + dd0 + q4 * 8) = make_uint4(rr[0], rr[1], rr[2], rr[3]);
      }
    } else {
      const float* S0 = P.in[5] + (((long)((l * 8 + ci.seqi) * 8 + h)) << 14);
#pragma unroll 4
      for (int dd = hf * 32; dd < hf * 32 + 32; ++dd)
        BS[d * 72 + dd] = f2b(S0[(sl * 64 + dd) * 128 + d] * __expf(bmid[sl * 64 + dd]));
    }
    __syncthreads();
#pragma unroll
    for (int kk = 0; kk < 2; ++kk) {
#pragma unroll
      for (int n = 0; n < 8; ++n) {
        bf16x8 b = *reinterpret_cast<const bf16x8*>(BS + (n * 16 + fr) * 72 + kk * 32 + fq * 8);
        o[n] = __builtin_amdgcn_mfma_f32_16x16x32_bf16(aq[sl * 2 + kk], b, o[n], 0, 0, 0);
      }
    }
  }
  float rinv[4];
#pragma unroll
  for (int j = 0; j < 4; ++j) {
    float ss = 0.f;
#pragma unroll
    for (int n = 0; n < 8; ++n) ss += o[n][j] * o[n][j];
    ss += __shfl_xor(ss, 1); ss += __shfl_xor(ss, 2); ss += __shfl_xor(ss, 4); ss += __shfl_xor(ss, 8);
    rinv[j] = rsqrtf(ss * (1.f / 128.f) + 1e-6f);
  }
  const float* ng = P.in[17] + l * 128;
  bfu* UC = (bfu*)(P.ws + O_UC);
#pragma unroll
  for (int n = 0; n < 8; ++n)
#pragma unroll
    for (int j = 0; j < 4; ++j) {
      int t = 16 * w + fq * 4 + j, e = n * 16 + fr;
      if (t < L) {
        float g = b2f(Z[(long)(ci.lt0 + t) * NCOL + 8 * 1024 + h * 128 + e]);
        UC[(long)(ci.lt0 + t) * 1024 + h * 128 + e] = f2b(o[n][j] * rinv[j] * ng[e] * siluf_(g));
      }
    }
}
DEVI void phase4(const Params& P, int l, int pass, char* smem) {
  const int tid = ltid();
  const int nck = pass ? 128 : 136;
  const int nH = nck * 8;
  const int nL = 64 * 4;
  for (int id = blockIdx.x; id < nH + nL; id += gridDim.x) {
    if (id < nH) h3_item(P, l, id >> 3, id & 7, smem, tid);
    else { int q = id - nH; lsum_item(P, q >> 2, q & 3, tid); }
  }
}

DEVI void phase5(const Params& P, int l, int pass) {
  const int tid = ltid();
  const int ntok = pass ? 8192 : 8448, base = pass ? 8448 : 0;
  const int nItems = (ntok / 128) * 4;
  const int w = tid >> 6, lane = tid & 63;
  const float* AU0 = (const float*)(P.ws + O_AU);
  const float* AU1 = AU0 + (long)8448 * 1024;
  const float* LS = (const float*)(P.ws + O_LSUM);
  const bfu* Z = (const bfu*)(P.ws + O_Z);
  bfu* UB = (bfu*)(P.ws + O_UB);
  for (int id = blockIdx.x; id < nItems; id += gridDim.x) {
    const int tile = id >> 2, ch = ((id & 3) * 4 + w) * 64 + lane;
    const int lt0 = tile * 128;
    const TokInfo t0 = tokinfo(base + lt0);
    float hcur = 0.f;
    if (!t0.sample) {
      int jf = tile - (t0.t >> 7);
      for (int i = jf; i < tile; ++i) hcur = LS[(long)i * 2048 + ch] * hcur + LS[(long)i * 2048 + 1024 + ch];
    }
    for (int r0 = 0; r0 < 128; r0 += 8) {
      float av[8], uv[8], gv[8];
#pragma unroll
      for (int i = 0; i < 8; ++i) {
        long row = lt0 + r0 + i;
        av[i] = AU0[row * 1024 + ch]; uv[i] = AU1[row * 1024 + ch];
        gv[i] = b2f(Z[row * NCOL + 4 * 1024 + ch]);
      }
#pragma unroll
      for (int i = 0; i < 8; ++i) {
        int r = r0 + i;
        if (t0.sample && (r & 31) == 0) hcur = P.in[4][(long)(l * 8 + t0.seq + (r >> 5)) * 1024 + ch];
        hcur = av[i] * hcur + uv[i];
        UB[(long)(lt0 + r) * 1024 + ch] = f2b(geluf_(gv[i]) * hcur);
        if (t0.sample && (r & 31) == 31) P.out[OUT_LRS + (long)(l * 8 + t0.seq + (r >> 5)) * 1024 + ch] = hcur;
      }
    }
    if (!t0.sample && t0.t + 128 == 4096) P.out[OUT_LRP + (long)(l * 4 + t0.seq) * 1024 + ch] = hcur;
  }
}

template <int BR>
DEVI void p6_branch(const Params& P, int pm, int pn, float* macc, char* smem, int tid) {
  asm volatile("" : "+s"(pm), "+s"(pn));
  const bfu* Z = (const bfu*)(P.ws + O_Z);
  bfu* M = (bfu*)(P.ws + O_CB);
  const bfu* A = (const bfu*)(P.ws + (BR == 0 ? O_UA : BR == 1 ? O_UB : O_UC)) + (long)pm * 128 * 1024;
  const bfu* B = (const bfu*)(P.ws + (BR == 0 ? O_WOA : BR == 1 ? O_WOB : O_WOC)) + (long)pn * 128 * 1024;
  f32x4 acc[4][4]; ZERO_ACC(acc);
  gemm_core(acc, A, 1024, B, 1024, 1024, smem, tid);
  EPI_LOOP {
    int row = pm * 128 + EPI_ROW, col = pn * 128 + EPI_COL;
    float g = sigmoidf_(b2f(Z[(long)row * NCOL + (9 + BR) * 1024 + col]));
    float v = g * acc[m][n][j];
    if (BR > 0) v += macc[(long)row * 1024 + col];
    if (BR < 2) macc[(long)row * 1024 + col] = v;
    else M[(long)row * 1024 + col] = f2b(v);
  }
}
DEVI void phase6(const Params& P, int l, int pass, char* smem) {
  const int tid = ltid();
  const int ntok = pass ? 8192 : 8448;
  const int nM = ntok / 128, nN = 8;
  const bfu* Z = (const bfu*)(P.ws + O_Z);
  bfu* M = (bfu*)(P.ws + O_CB);
  for (int id = blockIdx.x; id < nM * nN; id += gridDim.x) {
    int pm = id >> 3, pn = id & 7;
    float* macc = (float*)(P.ws + O_AU);
    p6_branch<0>(P, pm, pn, macc, smem, tid);
    p6_branch<1>(P, pm, pn, macc, smem, tid);
    p6_branch<2>(P, pm, pn, macc, smem, tid);
  }
}

DEVI void phase7(const Params& P, int l, int pass, char* smem) {
  const int tid = ltid();
  const int ntok = pass ? 8192 : 8448, base = pass ? 8448 : 0;
  const int nM = ntok / 128, nN = 8;
  const bfu* M = (const bfu*)(P.ws + O_CB);
  const bfu* W = (const bfu*)(P.ws + O_WO);
  float* pre = (float*)(P.ws + O_PRE);
  for (int id = blockIdx.x; id < nM * nN; id += gridDim.x) {
    int pm = id >> 3, pn = id & 7;
    f32x4 acc[4][4]; ZERO_ACC(acc);
    gemm_core(acc, M + (long)pm * 128 * 1024, 1024, W + (long)pn * 128 * 1024, 1024, 1024, smem, tid);
    EPI_LOOP {
      int row = pm * 128 + EPI_ROW, col = pn * 128 + EPI_COL;
      const float* xr = xrow(P, base + row);
      pre[(long)row * 1024 + col] = ALPHA * xr[col] + acc[m][n][j];
    }
  }
}

DEVI void phase8(const Params& P, int l, int pass) {
  const int tid = ltid();
  const int ntok = pass ? 8192 : 8448, base = pass ? 8448 : 0;
  const int w = tid >> 6, lane = tid & 63;
  const float* pre = (const float*)(P.ws + O_PRE);
  const float* g = P.in[22] + l * 1024;
  const float* b = P.in[23] + l * 1024;
  bfu* xb = (bfu*)(P.ws + O_XB);
  for (int id = blockIdx.x; id < ntok / 4; id += gridDim.x) {
    int lt = id * 4 + w, it = base + lt;
    const float* src = pre + (long)lt * 1024;
    float v[16];
#pragma unroll
    for (int q = 0; q < 4; ++q) {
      float4 t = *reinterpret_cast<const float4*>(src + q * 256 + lane * 4);
      v[q * 4] = t.x; v[q * 4 + 1] = t.y; v[q * 4 + 2] = t.z; v[q * 4 + 3] = t.w;
    }
    float s = 0.f;
#pragma unroll
    for (int i = 0; i < 16; ++i) s += v[i];
    float mu = wave_sum(s) * (1.f / 1024.f);
    float ss = 0.f;
#pragma unroll
    for (int i = 0; i < 16; ++i) { float dlt = v[i] - mu; ss += dlt * dlt; }
    float rs = rsqrtf(wave_sum(ss) * (1.f / 1024.f) + 1e-5f);
    float* xr = xrow(P, it);
#pragma unroll
    for (int q = 0; q < 4; ++q) {
      int c = q * 256 + lane * 4;
      float o[4];
#pragma unroll
      for (int i = 0; i < 4; ++i) o[i] = (v[q * 4 + i] - mu) * rs * g[c + i] + b[c + i];
      *reinterpret_cast<float4*>(xr + c) = make_float4(o[0], o[1], o[2], o[3]);
      store4bf(xb + (long)it * 1024 + c, o);
    }
  }
}

DEVI void phase9(const Params& P, int l, int pass, char* smem) {
  const int tid = ltid();
  const int ntok = pass ? 8192 : 8448, base = pass ? 8448 : 0;
  const int nM = ntok / 128, nN = 16;
  const bfu* xb = (const bfu*)(P.ws + O_XB) + (long)base * 1024;
  const bfu* W = (const bfu*)(P.ws + O_WQ);
  bfu* qp = (bfu*)(P.ws + O_QP);
  for (int id = blockIdx.x; id < nM * nN; id += gridDim.x) {
    int pm, pn; tile_rc(id, nM, nN, pm, pn);
    f32x4 acc[4][4]; ZERO_ACC(acc);
    gemm_core(acc, xb + (long)pm * 128 * 1024, 1024, W + (long)pn * 128 * 1024, 1024, 1024, smem, tid);
    EPI_LOOP {
      int row = pm * 128 + EPI_ROW, col = pn * 128 + EPI_COL;
      qp[(long)row * 2048 + col] = f2b(acc[m][n][j]);
    }
  }
}
DEVI void phase10(const Params& P, int l, int pass, char* smem) {
  const int tid = ltid();
  const int ntok = pass ? 8192 : 8448;
  const int nM = ntok / 128, nN = 16;
  const bfu* qp = (const bfu*)(P.ws + O_QP);
  const bfu* KB = (const bfu*)(P.ws + O_KEYS);
  float* sc = (float*)(P.ws + O_SC);
  for (int id = blockIdx.x; id < nM * nN; id += gridDim.x) {
    int pm = id >> 4, pn = id & 15;
    f32x4 acc[4][4]; ZERO_ACC(acc);
    gemm_core(acc, qp + (long)pm * 128 * 2048 + pn * 128, 2048, KB + (long)pn * 16384, 128, 128, smem, tid);
    EPI_LOOP {
      int row = pm * 128 + EPI_ROW, col = pn * 128 + EPI_COL;
      sc[(long)row * 2048 + col] = acc[m][n][j];
    }
  }
}

DEVI unsigned fkey(float f) {
  unsigned u = __float_as_uint(f);
  return (u & 0x80000000u) ? ~u : (u | 0x80000000u);
}
DEVI void dec16(uint4 v, f32x2 (&o)[8]) {
  o[0] = __builtin_amdgcn_cvt_pk_f32_fp8((int)v.x, false); o[1] = __builtin_amdgcn_cvt_pk_f32_fp8((int)v.x, true);
  o[2] = __builtin_amdgcn_cvt_pk_f32_fp8((int)v.y, false); o[3] = __builtin_amdgcn_cvt_pk_f32_fp8((int)v.y, true);
  o[4] = __builtin_amdgcn_cvt_pk_f32_fp8((int)v.z, false); o[5] = __builtin_amdgcn_cvt_pk_f32_fp8((int)v.z, true);
  o[6] = __builtin_amdgcn_cvt_pk_f32_fp8((int)v.w, false); o[7] = __builtin_amdgcn_cvt_pk_f32_fp8((int)v.w, true);
}
DEVI void phase11(const Params& P, int l, int pass, char* smem) {
  const int ntok = pass ? 8192 : 8448, base = pass ? 8448 : 0;
  const int tid = ltid(); const int w = tid >> 6, lane = tid & 63;
  float* scl = (float*)smem;
  float* sv = scl + 2048;
  int* si = (int*)(sv + 256);
  float* tops = (float*)(si + 256);
  int* tope = (int*)(tops + 128);
  float* wgt = (float*)(tope + 128);
  float* dotv = wgt + 128;
  float* red = dotv + 128;
  float* stat = red + 4096;
  const float* SC = (const float*)(P.ws + O_SC);
  const unsigned char* UT = (const unsigned char*)(P.ws + O_UTB);
  const unsigned char* VTb = (const unsigned char*)(P.ws + O_VTB);
  const float* g2 = P.in[28] + l * 1024;
  const float* b2 = P.in[29] + l * 1024;
  bfu* xb = (bfu*)(P.ws + O_XB);
  const unsigned long long ltmask = (1ull << lane) - 1ull;
  for (int lt = blockIdx.x; lt < ntok; lt += gridDim.x) {
    const int it = base + lt;
    float* xr = xrow(P, it);
    __syncthreads();
    {
      const float4* s4 = reinterpret_cast<const float4*>(SC + (long)lt * 2048);
      reinterpret_cast<float4*>(scl)[tid] = s4[tid];
      reinterpret_cast<float4*>(scl)[tid + 256] = s4[tid + 256];
    }
    __syncthreads();
    {
      float v0[4], v1[4]; unsigned k0[4], k1[4], T[4];
#pragma unroll
      for (int li = 0; li < 4; ++li) {
        const int Lx = w * 4 + li;
        v0[li] = scl[Lx * 128 + lane]; v1[li] = scl[Lx * 128 + 64 + lane];
        k0[li] = fkey(v0[li]); k1[li] = fkey(v1[li]); T[li] = 0;
      }
      for (int b = 31; b >= 0; --b) {
#pragma unroll
        for (int li = 0; li < 4; ++li) {
          unsigned cand = T[li] | (1u << b);
          int cnt = __popcll(__ballot(k0[li] >= cand)) + __popcll(__ballot(k1[li] >= cand));
          if (cnt >= 16) T[li] = cand;
        }
      }
#pragma unroll
      for (int li = 0; li < 4; ++li) {
        const int Lx = w * 4 + li;
        bool s0 = k0[li] >= T[li], s1 = k1[li] >= T[li];
        unsigned long long m0 = __ballot(s0), m1 = __ballot(s1);
        int p0 = __popcll(m0 & ltmask), p1 = __popcll(m0) + __popcll(m1 & ltmask);
        if (s0 && p0 < 16) { sv[Lx * 16 + p0] = v0[li]; si[Lx * 16 + p0] = lane; }
        if (s1 && p1 < 16) { sv[Lx * 16 + p1] = v1[li]; si[Lx * 16 + p1] = lane + 64; }
      }
    }
    __syncthreads();
    {
      float cv[2][4]; unsigned ck[2][4], T[2];
#pragma unroll
      for (int hi = 0; hi < 2; ++hi) {
        const int h = w * 2 + hi;
        T[hi] = 0;
#pragma unroll
        for (int r = 0; r < 4; ++r) {
          int c = lane + 64 * r;
          cv[hi][r] = sv[(2 * h) * 16 + (c >> 4)] + sv[(2 * h + 1) * 16 + (c & 15)];
          ck[hi][r] = fkey(cv[hi][r]);
        }
      }
      for (int b = 31; b >= 0; --b) {
#pragma unroll
        for (int hi = 0; hi < 2; ++hi) {
          unsigned cand = T[hi] | (1u << b);
          int cnt = 0;
#pragma unroll
          for (int r = 0; r < 4; ++r) cnt += __popcll(__ballot(ck[hi][r] >= cand));
          if (cnt >= 16) T[hi] = cand;
        }
      }
#pragma unroll
      for (int hi = 0; hi < 2; ++hi) {
        const int h = w * 2 + hi;
        int basec = 0;
#pragma unroll
        for (int r = 0; r < 4; ++r) {
          bool s = ck[hi][r] >= T[hi];
          unsigned long long mm = __ballot(s);
          int p = basec + __popcll(mm & ltmask);
          if (s && p < 16) {
            int c = lane + 64 * r;
            tops[h * 16 + p] = cv[hi][r];
            tope[h * 16 + p] = si[(2 * h) * 16 + (c >> 4)] * 128 + si[(2 * h + 1) * 16 + (c & 15)];
          }
          basec += __popcll(mm);
        }
      }
    }
    __syncthreads();
    if (tid < 128) {
      float s = tops[tid];
      float mx = s;
      mx = fmaxf(mx, __shfl_xor(mx, 1)); mx = fmaxf(mx, __shfl_xor(mx, 2));
      mx = fmaxf(mx, __shfl_xor(mx, 4)); mx = fmaxf(mx, __shfl_xor(mx, 8));
      float e = __expf(s - mx);
      float sm = e;
      sm += __shfl_xor(sm, 1); sm += __shfl_xor(sm, 2); sm += __shfl_xor(sm, 4); sm += __shfl_xor(sm, 8);
      tops[tid] = e / sm;
    }
    f32x2 xv[8];
    {
      const float4* xp = reinterpret_cast<const float4*>(xr + lane * 16);
#pragma unroll
      for (int q = 0; q < 4; ++q) {
        float4 a = xp[q];
        xv[2 * q] = f32x2{a.x, a.y}; xv[2 * q + 1] = f32x2{a.z, a.w};
      }
    }
#pragma unroll 1
    for (int p0 = 0; p0 < 32; p0 += 8) {
      uint4 rw[8];
#pragma unroll
      for (int i = 0; i < 8; ++i) {
        int e = tope[w * 32 + p0 + i];
        rw[i] = *reinterpret_cast<const uint4*>(UT + (long)e * 1024 + lane * 16);
      }
      float dsum[8];
#pragma unroll
      for (int i = 0; i < 8; ++i) {
        f32x2 f[8];
        dec16(rw[i], f);
        f32x2 acc = f[0] * xv[0];
#pragma unroll
        for (int q = 1; q < 8; ++q) acc = __builtin_elementwise_fma(f[q], xv[q], acc);
        dsum[i] = acc.x + acc.y;
      }
      float e4[4], e2[2], e1;
      {
        const bool hi = (lane & 32) != 0;
#pragma unroll
        for (int i = 0; i < 4; ++i) {
          float snd = hi ? dsum[i] : dsum[i + 4];
          float kp = hi ? dsum[i + 4] : dsum[i];
          e4[i] = kp + __shfl_xor(snd, 32);
        }
        const bool hi2 = (lane & 16) != 0;
#pragma unroll
        for (int i = 0; i < 2; ++i) {
          float snd = hi2 ? e4[i] : e4[i + 2];
          float kp = hi2 ? e4[i + 2] : e4[i];
          e2[i] = kp + __shfl_xor(snd, 16);
        }
        const bool hi3 = (lane & 8) != 0;
        {
          float snd = hi3 ? e2[0] : e2[1];
          float kp = hi3 ? e2[1] : e2[0];
          e1 = kp + __shfl_xor(snd, 8);
        }
        e1 += __shfl_xor(e1, 4); e1 += __shfl_xor(e1, 2); e1 += __shfl_xor(e1, 1);
      }
      if ((lane & 7) == 0) {
        int r = ((lane >> 5) & 1) * 4 + ((lane >> 4) & 1) * 2 + ((lane >> 3) & 1);
        dotv[w * 32 + p0 + r] = e1;
      }
    }
    __syncthreads();
    if (tid < 128) wgt[tid] = tops[tid] * geluf_(dotv[tid] * (1.f / U_SCALE)) * (1.f / V_SCALE);
    __syncthreads();
    f32x2 oacc[8];
#pragma unroll
    for (int q = 0; q < 8; ++q) oacc[q] = f32x2{0.f, 0.f};
#pragma unroll 1
    for (int p0 = 0; p0 < 32; p0 += 8) {
      uint4 rw[8]; float wg[8];
#pragma unroll
      for (int i = 0; i < 8; ++i) {
        int e = tope[w * 32 + p0 + i];
        wg[i] = wgt[w * 32 + p0 + i];
        rw[i] = *reinterpret_cast<const uint4*>(VTb + (long)e * 1024 + lane * 16);
      }
#pragma unroll
      for (int i = 0; i < 8; ++i) {
        f32x2 f[8];
        dec16(rw[i], f);
        f32x2 wv = f32x2{wg[i], wg[i]};
#pragma unroll
        for (int q = 0; q < 8; ++q) oacc[q] = __builtin_elementwise_fma(f[q], wv, oacc[q]);
      }
    }
    {
      float4* rwp = reinterpret_cast<float4*>(red + w * 1024 + lane * 16);
#pragma unroll
      for (int q = 0; q < 4; ++q) rwp[q] = make_float4(oacc[2 * q].x, oacc[2 * q].y, oacc[2 * q + 1].x, oacc[2 * q + 1].y);
    }
    __syncthreads();
    const int c = tid * 4;
    float y[4];
    {
      float4 xx = *reinterpret_cast<const float4*>(xr + c);
      float4 r0 = *reinterpret_cast<const float4*>(red + c);
      float4 r1 = *reinterpret_cast<const float4*>(red + 1024 + c);
      float4 r2 = *reinterpret_cast<const float4*>(red + 2048 + c);
      float4 r3 = *reinterpret_cast<const float4*>(red + 3072 + c);
      y[0] = ALPHA * xx.x + (r0.x + r1.x + r2.x + r3.x);
      y[1] = ALPHA * xx.y + (r0.y + r1.y + r2.y + r3.y);
      y[2] = ALPHA * xx.z + (r0.z + r1.z + r2.z + r3.z);
      y[3] = ALPHA * xx.w + (r0.w + r1.w + r2.w + r3.w);
    }
    float s = wave_sum(y[0] + y[1] + y[2] + y[3]);
    if (lane == 0) stat[w] = s;
    __syncthreads();
    float mu = (stat[0] + stat[1] + stat[2] + stat[3]) * (1.f / 1024.f);
    float ss = 0.f;
#pragma unroll
    for (int i = 0; i < 4; ++i) { float dl = y[i] - mu; ss += dl * dl; }
    ss = wave_sum(ss);
    if (lane == 0) stat[4 + w] = ss;
    __syncthreads();
    float rs = rsqrtf((stat[4] + stat[5] + stat[6] + stat[7]) * (1.f / 1024.f) + 1e-5f);
    float o[4];
#pragma unroll
    for (int i = 0; i < 4; ++i) o[i] = (y[i] - mu) * rs * g2[c + i] + b2[c + i];
    *reinterpret_cast<float4*>(xr + c) = make_float4(o[0], o[1], o[2], o[3]);
    store4bf(xb + (long)it * 1024 + c, o);
  }
}

__global__ void __launch_bounds__(256, 2) fwd_megakernel(Params P) {
  __shared__ __attribute__((aligned(16))) char smem[65536];
  cg::grid_group grid = cg::this_grid();
#define LND asm volatile("" : "+s"(l), "+s"(pass))
#pragma unroll 1
  for (int l = 0; l < 2; ++l) {
    phase_prep(P, l, smem);
    if (l == 0) phase_xcopy(P);
    grid.sync();
#pragma unroll 1
    for (int pass = 0; pass < 2; ++pass) {
      LND; phase_inproj(P, l, pass, smem); grid.sync();
      LND; phase2(P, l, pass, smem); grid.sync();
      LND; phase3(P, l, pass, smem); grid.sync();
      LND; phase4(P, l, pass, smem); grid.sync();
      LND; phase5(P, l, pass); grid.sync();
      LND; phase6(P, l, pass, smem); grid.sync();
      LND; phase7(P, l, pass, smem); grid.sync();
      LND; phase8(P, l, pass); grid.sync();
      LND; phase9(P, l, pass, smem); grid.sync();
      LND; phase10(P, l, pass, smem); grid.sync();
      LND; phase11(P, l, pass, smem); grid.sync();
    }
  }
}

extern "C" void kernel_launch(void* const* d_in, const int* in_sizes, int n_in, void* d_out, int out_size,
                              void* d_ws, size_t ws_size, hipStream_t stream) {
  static int grid_blocks = 0;
  if (!grid_blocks) {
    int dev = 0, cus = 0, per_cu = 0;
    hipGetDevice(&dev);
    hipDeviceGetAttribute(&cus, hipDeviceAttributeMultiprocessorCount, dev);
    hipOccupancyMaxActiveBlocksPerMultiprocessor(&per_cu, fwd_megakernel, 256, 0);
    if (per_cu > 2) per_cu = 2;
    if (per_cu < 1) per_cu = 1;
    grid_blocks = cus * per_cu;
  }
  if (ws_size < O_END) fprintf(stderr, "workspace too small: %zu < %zu\n", ws_size, (size_t)O_END);
  Params p{};
  for (int i = 0; i < 30; ++i) p.in[i] = (const float*)d_in[i];
  p.out = (float*)d_out;
  p.ws = (char*)d_ws;
  void* args[] = {&p};
  hipError_t e = hipLaunchCooperativeKernel((void*)fwd_megakernel, dim3(grid_blocks), dim3(256), args, 0, stream);
  if (e != hipSuccess) fprintf(stderr, "cooperative launch failed: %s (grid %d)\n", hipGetErrorString(e), grid_blocks);
}
```

```cpp
#include <hip/hip_runtime.h>
#include <hip/hip_bf16.h>
#include <hip/hip_cooperative_groups.h>
#include <cstdio>
namespace cg = cooperative_groups;

typedef unsigned short bfu;
using bf16x8 = __attribute__((ext_vector_type(8))) short;
using f32x4 = __attribute__((ext_vector_type(4))) float;
#define DEVI __device__ __forceinline__

constexpr float ALPHA = 1.41421356237f;
constexpr int NCOL = 12288;

constexpr size_t O_WIN = 0;
constexpr size_t O_WOA = O_WIN + 25165824;
constexpr size_t O_WOB = O_WOA + 2097152;
constexpr size_t O_WOC = O_WOB + 2097152;
constexpr size_t O_WO = O_WOC + 2097152;
constexpr size_t O_WQ = O_WO + 2097152;
constexpr size_t O_KEYS = O_WQ + 4194304;
constexpr size_t O_LRU = O_KEYS + 524288;
constexpr size_t O_UTB = O_LRU + 524288;
constexpr size_t O_VTB = O_UTB + 33554432;
constexpr size_t O_LBS = O_VTB + 33554432;
constexpr size_t O_XB = O_LBS + 8192;
constexpr size_t O_Z = O_XB + 34078720;
constexpr size_t O_UA = O_Z + 207618048;
constexpr size_t O_UB = O_UA + 17301504;
constexpr size_t O_UC = O_UB + 17301504;
constexpr size_t O_CB = O_UC + 17301504;
constexpr size_t O_AU = O_CB + 17301504;
constexpr size_t O_LSUM = O_AU + 69206016;
constexpr size_t O_US = O_LSUM + 540672;
constexpr size_t O_DEC = O_US + 33554432;
constexpr size_t O_BAR = O_DEC + 524288;
constexpr size_t O_END = O_BAR + 16384;
constexpr size_t O_PRE = O_Z;
constexpr size_t O_QP = O_Z + 34603008;
constexpr size_t O_SC = O_QP + 34603008;

constexpr long OUT_YS = 16777216;
constexpr long OUT_CAP = 17039360;
constexpr long OUT_CBP = 17055744;
constexpr long OUT_LRP = 17080320;
constexpr long OUT_HGP = 17088512;
constexpr long OUT_CAS = 18137088;
constexpr long OUT_CBS = 18169856;
constexpr long OUT_LRS = 18219008;
constexpr long OUT_HGS = 18235392;

struct Params {
  const float* in[30];
  float* out;
  char* ws;
};

DEVI bfu f2b(float f) {
  unsigned u = __float_as_uint(f);
  u += 0x7FFFu + ((u >> 16) & 1u);
  return (bfu)(u >> 16);
}
DEVI float b2f(bfu b) { return __uint_as_float(((unsigned)b) << 16); }
DEVI float sigmoidf_(float x) { return 1.f / (1.f + __expf(-x)); }
DEVI float siluf_(float x) { return x / (1.f + __expf(-x)); }
DEVI float geluf_(float x) { return 0.5f * x * (1.f + erff(x * 0.70710678118f)); }
DEVI float wave_sum(float v) {
#pragma unroll
  for (int o = 32; o; o >>= 1) v += __shfl_xor(v, o);
  return v;
}

DEVI int ltid() { int t = threadIdx.x; asm volatile("" : "+v"(t)); return t; }
struct TokInfo { int sample, seq, t; };
DEVI TokInfo tokinfo(int it) {
  TokInfo r;
  if (it < 8192) { r.sample = 0; r.seq = it >> 12; r.t = it & 4095; }
  else if (it < 8448) { int q = it - 8192; r.sample = 1; r.seq = q >> 5; r.t = q & 31; }
  else { int q = it - 8448; r.sample = 0; r.seq = 2 + (q >> 12); r.t = q & 4095; }
  return r;
}
DEVI float* xrow(const Params& P, int it) {
  TokInfo ti = tokinfo(it);
  return ti.sample ? P.out + OUT_YS + (long)(ti.seq * 32 + ti.t) * 1024
                   : P.out + (long)(ti.seq * 4096 + ti.t) * 1024;
}

DEVI void stage_tile(const bfu* __restrict__ g, int ld, int k0, char* lds, int tid) {
#pragma unroll
  for (int i = 0; i < 4; ++i) {
    int b = tid * 16 + i * 4096;
    int r = b >> 7, cp = (b >> 4) & 7, gc = cp ^ (r & 7);
    __builtin_amdgcn_global_load_lds((const unsigned*)(g + (long)r * ld + k0 + gc * 8),
                                     (unsigned*)(lds + b), 16, 0, 0);
  }
}
DEVI bf16x8 ldfrag(const char* tile, int r, int kc) {
  return *reinterpret_cast<const bf16x8*>(tile + r * 128 + ((kc ^ (r & 7)) << 4));
}
DEVI void gemm_core(f32x4 (&acc)[4][4], const bfu* __restrict__ A, int lda,
                    const bfu* __restrict__ B, int ldb, int K, char* smem, int tid) {
  const int wid = tid >> 6, lane = tid & 63;
  const int wr = wid >> 1, wc = wid & 1, fr = lane & 15, fq = lane >> 4;
  const int nt = K >> 6;
  __syncthreads();
  stage_tile(A, lda, 0, smem, tid);
  stage_tile(B, ldb, 0, smem + 16384, tid);
  for (int t = 0; t < nt; ++t) {
    asm volatile("s_waitcnt vmcnt(0)" ::: "memory");
    __syncthreads();
    char* cur = smem + (t & 1) * 32768;
    if (t + 1 < nt) {
      char* nx = smem + ((t + 1) & 1) * 32768;
      stage_tile(A, lda, (t + 1) * 64, nx, tid);
      stage_tile(B, ldb, (t + 1) * 64, nx + 16384, tid);
    }
#pragma unroll
    for (int kk = 0; kk < 2; ++kk) {
      bf16x8 af[4], bfr[4];
#pragma unroll
      for (int m = 0; m < 4; ++m) af[m] = ldfrag(cur, wr * 64 + m * 16 + fr, kk * 4 + fq);
#pragma unroll
      for (int n = 0; n < 4; ++n) bfr[n] = ldfrag(cur + 16384, wc * 64 + n * 16 + fr, kk * 4 + fq);
#pragma unroll
      for (int m = 0; m < 4; ++m)
#pragma unroll
        for (int n = 0; n < 4; ++n)
          acc[m][n] = __builtin_amdgcn_mfma_f32_16x16x32_bf16(af[m], bfr[n], acc[m][n], 0, 0, 0);
    }
  }
}
DEVI void tile_rc(int id, int nM, int nN, int& pm, int& pn) {
  const int WGM = 8;
  int nig = WGM * nN, gid = id / nig, fm = gid * WGM;
  int gsz = min(nM - fm, WGM);
  pm = fm + ((id % nig) % gsz);
  pn = (id % nig) / gsz;
}
#define ZERO_ACC(a) _Pragma("unroll") for (int m_ = 0; m_ < 4; ++m_) _Pragma("unroll") for (int n_ = 0; n_ < 4; ++n_) a[m_][n_] = f32x4{0.f, 0.f, 0.f, 0.f}
#define EPI_LOOP \
  const int wid_ = tid >> 6, lane_ = tid & 63; \
  const int wr_ = wid_ >> 1, wc_ = wid_ & 1, fr_ = lane_ & 15, fq_ = lane_ >> 4; \
  _Pragma("unroll") for (int m = 0; m < 4; ++m) for (int sb_ = (__builtin_amdgcn_sched_barrier(0), 0); sb_ < 1; ++sb_) _Pragma("unroll") for (int n = 0; n < 4; ++n) _Pragma("unroll") for (int j = 0; j < 4; ++j)
#define EPI_ROW (wr_ * 64 + m * 16 + fq_ * 4 + j)
#define EPI_COL (wc_ * 64 + n * 16 + fr_)

DEVI void transpose_tile(const float* __restrict__ src, bfu* __restrict__ dst, int R, int C, int r0, int c0, float* tile, int tid) {
  __syncthreads();
  {
    int tx = tid & 15, ty = tid >> 4;
#pragma unroll
    for (int i = 0; i < 4; ++i) {
      int r = ty + i * 16;
      float4 v = *reinterpret_cast<const float4*>(src + (long)(r0 + r) * C + c0 + tx * 4);
      float* tp = tile + r * 65 + tx * 4;
      tp[0] = v.x; tp[1] = v.y; tp[2] = v.z; tp[3] = v.w;
    }
  }
  __syncthreads();
  {
    int c = tid >> 2, rs = (tid & 3) * 16;
    unsigned pk[8];
#pragma unroll
    for (int i = 0; i < 8; ++i) {
      unsigned lo = f2b(tile[(rs + 2 * i) * 65 + c]);
      unsigned hi = f2b(tile[(rs + 2 * i + 1) * 65 + c]);
      pk[i] = lo | (hi << 16);
    }
    uint4* dp = reinterpret_cast<uint4*>(dst + (long)(c0 + c) * R + r0 + rs);
    dp[0] = make_uint4(pk[0], pk[1], pk[2], pk[3]);
    dp[1] = make_uint4(pk[4], pk[5], pk[6], pk[7]);
  }
}
DEVI void convert_chunk(const float* __restrict__ src, bfu* __restrict__ dst, int tid) {
  int o = tid * 8;
  float4 a = *reinterpret_cast<const float4*>(src + o);
  float4 b = *reinterpret_cast<const float4*>(src + o + 4);
  uint4 r;
  r.x = f2b(a.x) | ((unsigned)f2b(a.y) << 16);
  r.y = f2b(a.z) | ((unsigned)f2b(a.w) << 16);
  r.z = f2b(b.x) | ((unsigned)f2b(b.y) << 16);
  r.w = f2b(b.z) | ((unsigned)f2b(b.w) << 16);
  *reinterpret_cast<uint4*>(dst + o) = r;
}

typedef float f32x2 __attribute__((ext_vector_type(2)));
constexpr float U_SCALE = 64.f, V_SCALE = 8.f;
DEVI void convert_chunk_fp8(const float* __restrict__ src, unsigned char* __restrict__ dst, float scale, int tid) {
  int o = tid * 16;
  uint4 r;
  unsigned rr[4];
#pragma unroll
  for (int q = 0; q < 4; ++q) {
    float4 a = *reinterpret_cast<const float4*>(src + o + q * 4);
    int p = __builtin_amdgcn_cvt_pk_fp8_f32(a.x * scale, a.y * scale, 0, false);
    p = __builtin_amdgcn_cvt_pk_fp8_f32(a.z * scale, a.w * scale, p, true);
    rr[q] = (unsigned)p;
  }
  r = make_uint4(rr[0], rr[1], rr[2], rr[3]);
  *reinterpret_cast<uint4*>(dst + o) = r;
}

DEVI void phase_prep(const Params& P, int l, char* smem) {
  const int tid = ltid();
  char* ws = P.ws;
  float* tile = reinterpret_cast<float*>(smem);
  const int NT_WIN = 3072, NT_SQ = 256, NT_WQ = 512, NT_LRU = 64;
  const int T0 = NT_WIN, T1 = T0 + 4 * NT_SQ, T2 = T1 + NT_WQ, T3 = T2 + NT_LRU;
  const int C0 = T3 + 128, C1 = C0 + 4096, C2 = C1 + 4096;
  const int X0 = C2;
  const int L0 = X0 + (l == 0 ? 8 : 0);
  for (int id = blockIdx.x; id < L0; id += gridDim.x) {
    if (id < T0) {
      int tr = id / 192, tc = id % 192;
      transpose_tile(P.in[6] + (long)l * 1024 * 12288, (bfu*)(ws + O_WIN), 1024, 12288, tr * 64, tc * 64, tile, tid);
    } else if (id < T1) {
      int q = id - T0, w = q >> 8, t = q & 255;
      const float* src = P.in[18 + w] + (long)l * 1048576;
      bfu* dst = (bfu*)(ws + (w == 0 ? O_WOA : w == 1 ? O_WOB : w == 2 ? O_WOC : O_WO));
      transpose_tile(src, dst, 1024, 1024, (t >> 4) * 64, (t & 15) * 64, tile, tid);
    } else if (id < T2) {
      int q = id - T1;
      transpose_tile(P.in[24] + (long)l * 2097152, (bfu*)(ws + O_WQ), 1024, 2048, (q >> 5) * 64, (q & 31) * 64, tile, tid);
    } else if (id < T3) {
      int q = id - T2, mtx = q >> 2, t = q & 3, g = mtx >> 3, nb = mtx & 7;
      const float* src = P.in[g == 0 ? 11 : 13] + (long)l * 131072 + nb * 16384;
      transpose_tile(src, (bfu*)(ws + O_LRU) + mtx * 16384, 128, 128, (t >> 1) * 64, (t & 1) * 64, tile, tid);
    } else if (id < C0) {
      int q = id - T3;
      convert_chunk(P.in[25] + (long)l * 262144 + (long)q * 2048, (bfu*)(ws + O_KEYS) + (long)q * 2048, tid);
    } else if (id < C1) {
      int q = id - C0;
      convert_chunk_fp8(P.in[26] + (long)l * 16777216 + (long)q * 4096, (unsigned char*)(ws + O_UTB) + (long)q * 4096, U_SCALE, tid);
    } else if (id < C2) {
      int q = id - C1;
      convert_chunk_fp8(P.in[27] + (long)l * 16777216 + (long)q * 4096, (unsigned char*)(ws + O_VTB) + (long)q * 4096, V_SCALE, tid);
    } else {
      int q = id - X0;
      int c = (q & 3) * 256 + tid, ll = q >> 2;
      float a0 = P.in[16][c], a1 = P.in[16][1024 + c];
      float mx = fmaxf(a0, a1);
      float e0 = __expf(a0 - mx), e1 = __expf(a1 - mx);
      float p1 = e1 / (e0 + e1);
      float* lbs = (float*)(ws + O_LBS);
      lbs[ll * 1024 + c] = (ll == 0) ? 0.f : p1;
    }
  }
}

DEVI void phase_xcopy(const Params& P) {
  const int tid = ltid();
  bfu* xb = (bfu*)(P.ws + O_XB);
  for (int it = blockIdx.x; it < 16640; it += gridDim.x) {
    TokInfo ti = tokinfo(it);
    const float* src = ti.sample ? P.in[1] + (long)(ti.seq * 32 + ti.t) * 1024 : P.in[0] + (long)(ti.seq * 4096 + ti.t) * 1024;
    float* dst = xrow(P, it);
    int c = tid * 4;
    float4 v = *reinterpret_cast<const float4*>(src + c);
    *reinterpret_cast<float4*>(dst + c) = v;
    uint2 r;
    r.x = f2b(v.x) | ((unsigned)f2b(v.y) << 16);
    r.y = f2b(v.z) | ((unsigned)f2b(v.w) << 16);
    *reinterpret_cast<uint2*>(xb + (long)it * 1024 + c) = r;
  }
}

DEVI void phase_inproj(const Params& P, int l, int pass, char* smem) {
  const int tid = ltid();
  const int ntok = pass ? 8192 : 8448, base = pass ? 8448 : 0;
  const int nM = ntok / 128, nN = 96;
  const bfu* xb = (const bfu*)(P.ws + O_XB) + (long)base * 1024;
  const bfu* wT = (const bfu*)(P.ws + O_WIN);
  bfu* z = (bfu*)(P.ws + O_Z);
  const float* bin = P.in[7] + l * NCOL;
  for (int id = blockIdx.x; id < nM * nN; id += gridDim.x) {
    int pm, pn; tile_rc(id, nM, nN, pm, pn);
    f32x4 acc[4][4]; ZERO_ACC(acc);
    gemm_core(acc, xb + (long)pm * 128 * 1024, 1024, wT + (long)pn * 128 * 1024, 1024, 1024, smem, tid);
    EPI_LOOP {
      int row = pm * 128 + EPI_ROW, col = pn * 128 + EPI_COL;
      z[(long)row * NCOL + col] = f2b(acc[m][n][j] + bin[col]);
    }
  }
}

DEVI void load4bf(const bfu* p, float (&o)[4]) {
  uint2 v = *reinterpret_cast<const uint2*>(p);
  o[0] = __uint_as_float(v.x << 16); o[1] = __uint_as_float(v.x & 0xFFFF0000u);
  o[2] = __uint_as_float(v.y << 16); o[3] = __uint_as_float(v.y & 0xFFFF0000u);
}
DEVI void store4bf(bfu* p, const float (&v)[4]) {
  uint2 r;
  r.x = f2b(v[0]) | ((unsigned)f2b(v[1]) << 16);
  r.y = f2b(v[2]) | ((unsigned)f2b(v[3]) << 16);
  *reinterpret_cast<uint2*>(p) = r;
}
DEVI void mixab_row(const Params& P, int l, int base, int lt, int tid) {
  const int it = base + lt;
  const TokInfo ti = tokinfo(it);
  const int T = ti.sample ? 32 : 4096;
  const bfu* z = (const bfu*)(P.ws + O_Z);
  const int c = tid * 4;
  float pk[3][4];
#pragma unroll
  for (int k = 0; k < 3; ++k) {
    int tt = ti.t - 2 + k;
    if (tt >= 0) {
      const bfu* zr = z + (long)(lt - 2 + k) * NCOL;
      float ac[4], ax[4];
      load4bf(zr + 1024 + c, ac); load4bf(zr + 2048 + c, ax);
#pragma unroll
      for (int i = 0; i < 4; ++i) pk[k][i] = ac[i] * ax[i];
    } else if (ti.sample) {
      float4 v = *reinterpret_cast<const float4*>(P.in[2] + ((long)(l * 8 + ti.seq) * 2 + (tt + 2)) * 1024 + c);
      pk[k][0] = v.x; pk[k][1] = v.y; pk[k][2] = v.z; pk[k][3] = v.w;
    } else {
#pragma unroll
      for (int i = 0; i < 4; ++i) pk[k][i] = 0.f;
    }
  }
  {
    float ab[4], o[4];
    load4bf(z + (long)lt * NCOL + c, ab);
    const float* w = P.in[8] + (long)l * 3 * 1024 + c;
#pragma unroll
    for (int i = 0; i < 4; ++i) o[i] = ab[i] * (w[i] * pk[0][i] + w[1024 + i] * pk[1][i] + w[2048 + i] * pk[2][i]);
    store4bf((bfu*)(P.ws + O_UA) + (long)lt * 1024 + c, o);
    if (ti.t >= T - 2) {
      int r = ti.t - (T - 2);
      float* dst = ti.sample ? P.out + OUT_CAS + ((long)(l * 8 + ti.seq) * 2 + r) * 1024 + c
                             : P.out + OUT_CAP + ((long)(l * 4 + ti.seq) * 2 + r) * 1024 + c;
      *reinterpret_cast<float4*>(dst) = make_float4(pk[2][0], pk[2][1], pk[2][2], pk[2][3]);
    }
  }
  float xk[4][4];
#pragma unroll
  for (int k = 0; k < 4; ++k) {
    int tt = ti.t - 3 + k;
    if (tt >= 0) {
      load4bf(z + (long)(lt - 3 + k) * NCOL + 3072 + c, xk[k]);
    } else if (ti.sample) {
      float4 v = *reinterpret_cast<const float4*>(P.in[3] + ((long)(l * 8 + ti.seq) * 3 + (tt + 3)) * 1024 + c);
      xk[k][0] = v.x; xk[k][1] = v.y; xk[k][2] = v.z; xk[k][3] = v.w;
    } else {
#pragma unroll
      for (int i = 0; i < 4; ++i) xk[k][i] = 0.f;
    }
  }
  {
    const float* w = P.in[9] + (long)l * 4 * 1024 + c;
    const float* bb = P.in[10] + (long)l * 1024 + c;
    float o[4];
#pragma unroll
    for (int i = 0; i < 4; ++i)
      o[i] = w[i] * xk[0][i] + w[1024 + i] * xk[1][i] + w[2048 + i] * xk[2][i] + w[3072 + i] * xk[3][i] + bb[i];
    store4bf((bfu*)(P.ws + O_CB) + (long)lt * 1024 + c, o);
    if (ti.t >= T - 3) {
      int r = ti.t - (T - 3);
      float* dst = ti.sample ? P.out + OUT_CBS + ((long)(l * 8 + ti.seq) * 3 + r) * 1024 + c
                             : P.out + OUT_CBP + ((long)(l * 4 + ti.seq) * 3 + r) * 1024 + c;
      *reinterpret_cast<float4*>(dst) = make_float4(xk[3][0], xk[3][1], xk[3][2], xk[3][3]);
    }
  }
}

struct ChunkInfo { int lt0, L, sample, seqi, c; };
DEVI ChunkInfo chunkinfo(int ck) {
  ChunkInfo r;
  if (ck < 128) { r.seqi = ck >> 6; r.c = ck & 63; r.lt0 = r.seqi * 4096 + r.c * 64; r.L = 64; r.sample = 0; }
  else { r.seqi = ck - 128; r.c = 0; r.lt0 = 8192 + r.seqi * 32; r.L = 32; r.sample = 1; }
  return r;
}

DEVI void h1_item(const Params& P, int l, int ck, int h, char* smem, int tid) {
  const ChunkInfo ci = chunkinfo(ck);
  const int lane = tid & 63, w = tid >> 6, fr = lane & 15, fq = lane >> 4;
  bfu* VT = (bfu*)smem;
  bfu* KT = VT + 128 * 72;
  float* tots = (float*)(smem + 36864);
  float* decl = tots + 256;
  const int d = tid & 127, hf = tid >> 7, L = ci.L, Lh = L >> 1;
  const float lb = ((const float*)(P.ws + O_LBS))[l * 1024 + h * 128 + d];
  const bfu* Z = (const bfu*)(P.ws + O_Z);
  const bfu* zf = Z + (long)ci.lt0 * NCOL + 6 * 1024 + h * 128 + d;
  const bfu* zi = Z + (long)ci.lt0 * NCOL + 7 * 1024 + h * 128 + d;
  __syncthreads();
  float tot = 0.f;
  for (int s = hf * Lh; s < hf * Lh + Lh; ++s) {
    float f = lb + (1.f - lb) * sigmoidf_(b2f(zf[(long)s * NCOL]));
    tot += __logf(f);
  }
  tots[hf * 128 + d] = tot;
  __syncthreads();
  float run = hf ? 0.f : tots[128 + d];
  for (int s = hf * Lh + Lh - 1; s >= hf * Lh; --s) {
    float f = lb + (1.f - lb) * sigmoidf_(b2f(zf[(long)s * NCOL]));
    KT[d * 72 + s] = f2b((1.f - f) * __expf(run));
    VT[d * 72 + s] = zi[(long)s * NCOL];
    run += __logf(f);
  }
  if (L == 32) {
    for (int s = 32 + hf * 16; s < 48 + hf * 16; ++s) { KT[d * 72 + s] = 0; VT[d * 72 + s] = 0; }
  }
  if (hf == 0) {
    float dc = __expf(tots[d] + tots[128 + d]);
    decl[d] = dc;
    if (!ci.sample) ((float*)(P.ws + O_DEC))[((ci.seqi * 8 + h) * 64 + ci.c) * 128 + d] = dc;
  }
  __syncthreads();
  f32x4 acc[2][8];
#pragma unroll
  for (int mi = 0; mi < 2; ++mi)
#pragma unroll
    for (int n = 0; n < 8; ++n) acc[mi][n] = f32x4{0.f, 0.f, 0.f, 0.f};
#pragma unroll
  for (int kk = 0; kk < 2; ++kk) {
    bf16x8 a[2];
#pragma unroll
    for (int mi = 0; mi < 2; ++mi) a[mi] = *reinterpret_cast<const bf16x8*>(VT + ((2 * w + mi) * 16 + fr) * 72 + kk * 32 + fq * 8);
#pragma unroll
    for (int n = 0; n < 8; ++n) {
      bf16x8 b = *reinterpret_cast<const bf16x8*>(KT + (n * 16 + fr) * 72 + kk * 32 + fq * 8);
#pragma unroll
      for (int mi = 0; mi < 2; ++mi) acc[mi][n] = __builtin_amdgcn_mfma_f32_16x16x32_bf16(a[mi], b, acc[mi][n], 0, 0, 0);
    }
  }
  if (!ci.sample) {
    bfu* US = (bfu*)(P.ws + O_US) + ((long)((ci.seqi * 8 + h) * 64 + ci.c) << 14);
#pragma unroll
    for (int mi = 0; mi < 2; ++mi) {
      __builtin_amdgcn_sched_barrier(0);
      bfu* bp = US + ((2 * w + mi) * 16 + fq * 4) * 128 + fr;
#pragma unroll
      for (int n = 0; n < 8; ++n)
#pragma unroll
        for (int j = 0; j < 4; ++j) bp[j * 128 + n * 16] = f2b(acc[mi][n][j]);
    }
  } else {
    long sb = ((long)((l * 8 + ci.seqi) * 8 + h)) << 14;
    const float* S0 = P.in[5] + sb;
    float* So = P.out + OUT_HGS + sb;
#pragma unroll
    for (int mi = 0; mi < 2; ++mi)
#pragma unroll
      for (int n = 0; n < 8; ++n) {
        __builtin_amdgcn_sched_barrier(0);
        int e0 = (2 * w + mi) * 16 + fq * 4, dd = n * 16 + fr;
        float4 s0 = *reinterpret_cast<const float4*>(S0 + dd * 128 + e0);
        float dcl = decl[dd];
        float4 r;
        r.x = dcl * s0.x + acc[mi][n][0]; r.y = dcl * s0.y + acc[mi][n][1];
        r.z = dcl * s0.z + acc[mi][n][2]; r.w = dcl * s0.w + acc[mi][n][3];
        *reinterpret_cast<float4*>(So + dd * 128 + e0) = r;
      }
  }
}

DEVI void phase2(const Params& P, int l, int pass, char* smem) {
  const int tid = ltid();
  const int ntok = pass ? 8192 : 8448, base = pass ? 8448 : 0;
  const int nck = pass ? 128 : 136;
  const int nH = nck * 8;
  const int total = nH + ntok;
  for (int id = blockIdx.x; id < total; id += gridDim.x) {
    if (id < nH) h1_item(P, l, id >> 3, id & 7, smem, tid);
    else mixab_row(P, l, base, id - nH, tid);
  }
}

DEVI void gate_tile(const Params& P, int l, int pm, int nb, char* smem, int tid) {
  const bfu* cb = (const bfu*)(P.ws + O_CB);
  const bfu* A = cb + (long)pm * 128 * 1024 + nb * 128;
  const bfu* B1 = (const bfu*)(P.ws + O_LRU) + nb * 16384;
  const bfu* B2 = B1 + 8 * 16384;
  float* au0 = (float*)(P.ws + O_AU);
  float* au1 = au0 + (long)8448 * 1024;
  const float* ba = P.in[12] + l * 1024;
  const float* bx = P.in[14] + l * 1024;
  const float* lam = P.in[15] + l * 1024;
  {
    f32x4 acc[4][4]; ZERO_ACC(acc);
    gemm_core(acc, A, 1024, B1, 128, 128, smem, tid);
    EPI_LOOP {
      int row = pm * 128 + EPI_ROW, col = nb * 128 + EPI_COL;
      float r = sigmoidf_(acc[m][n][j] + ba[col]);
      float sp = log1pf(__expf(-lam[col]));
      au0[(long)row * 1024 + col] = -8.f * r * sp;
    }
  }
  asm volatile("" : "+s"(pm), "+s"(nb));
  {
    f32x4 acc[4][4]; ZERO_ACC(acc);
    gemm_core(acc, A, 1024, B2, 128, 128, smem, tid);
    EPI_LOOP {
      int row = pm * 128 + EPI_ROW, col = nb * 128 + EPI_COL;
      float gi = sigmoidf_(acc[m][n][j] + bx[col]);
      float la = au0[(long)row * 1024 + col];
      float a = __expf(la);
      float mult = sqrtf(fmaxf(-expm1f(2.f * la), 0.f));
      float xv = b2f(cb[(long)row * 1024 + col]);
      au0[(long)row * 1024 + col] = a;
      au1[(long)row * 1024 + col] = mult * gi * xv;
    }
  }
}
DEVI void h2_item(const Params& P, int l, int pass, int item, int tid) {
  const int sh = item >> 6, blk = item & 63;
  const int idx = blk * 256 + tid, e = idx >> 7, d = idx & 127;
  bfu* US = (bfu*)(P.ws + O_US) + ((long)sh * 64 << 14) + idx;
  const float* dec = (const float*)(P.ws + O_DEC) + (long)sh * 64 * 128 + d;
  float S = 0.f;
  for (int c0 = 0; c0 < 64; c0 += 8) {
    float u[8], dc[8];
#pragma unroll
    for (int i = 0; i < 8; ++i) { u[i] = b2f(US[(long)(c0 + i) << 14]); dc[i] = dec[(c0 + i) * 128]; }
#pragma unroll
    for (int i = 0; i < 8; ++i) { US[(long)(c0 + i) << 14] = f2b(S); S = dc[i] * S + u[i]; }
  }
  const int sl = sh >> 3, h = sh & 7, b = pass * 2 + sl;
  P.out[OUT_HGP + (((long)((l * 4 + b) * 8 + h)) << 14) + d * 128 + e] = S;
}
DEVI void phase3(const Params& P, int l, int pass, char* smem) {
  const int tid = ltid();
  const int ntok = pass ? 8192 : 8448;
  const int nG = (ntok / 128) * 8, nH2 = 1024;
  for (int id = blockIdx.x; id < nG + nH2; id += gridDim.x) {
    if (id < nG) gate_tile(P, l, id >> 3, id & 7, smem, tid);
    else h2_item(P, l, pass, id - nG, tid);
  }
}

DEVI void lsum_item(const Params& P, int tile, int cg4, int tid) {
  const int w = tid >> 6, lane = tid & 63;
  const int ch = (cg4 * 4 + w) * 64 + lane;
  const float* a0 = (const float*)(P.ws + O_AU) + (long)tile * 128 * 1024 + ch;
  const float* u0 = a0 + (long)8448 * 1024;
  float A = 1.f, H = 0.f;
  for (int r0 = 0; r0 < 128; r0 += 16) {
    float av[16], uv[16];
#pragma unroll
    for (int i = 0; i < 16; ++i) { av[i] = a0[(long)(r0 + i) * 1024]; uv[i] = u0[(long)(r0 + i) * 1024]; }
#pragma unroll
    for (int i = 0; i < 16; ++i) { H = av[i] * H + uv[i]; A *= av[i]; }
  }
  float* ls = (float*)(P.ws + O_LSUM) + (long)tile * 2048;
  ls[ch] = A; ls[1024 + ch] = H;
}

DEVI void h3_item(const Params& P, int l, int ck, int h, char* smem, int tid) {
  const ChunkInfo ci = chunkinfo(ck);
  const int lane = tid & 63, w = tid >> 6, fr = lane & 15, fq = lane >> 4;
  bfu* QT = (bfu*)smem;
  bfu* KT = QT + 64 * 136;
  bfu* AT = KT + 64 * 136;
  bfu* BS = AT + 64 * 72;
  float* bmid = (float*)(BS + 128 * 72);
  const int d = tid & 127, hf = tid >> 7, L = ci.L, Lh = L >> 1;
  const float lb = ((const float*)(P.ws + O_LBS))[l * 1024 + h * 128 + d];
  const bfu* Z = (const bfu*)(P.ws + O_Z);
  const bfu* zq = Z + (long)ci.lt0 * NCOL + 5 * 1024 + h * 128 + d;
  const bfu* zf = zq + 1024;
  const bfu* zi = zq + 2048;
  __syncthreads();
  if (hf == 0) {
    float rel = 0.f;
    for (int t = Lh - 1; t >= 0; --t) {
      float f = lb + (1.f - lb) * sigmoidf_(b2f(zf[(long)t * NCOL]));
      float q = siluf_(b2f(zq[(long)t * NCOL]));
      QT[t * 136 + d] = f2b(q * __expf(fminf(rel, 80.f)));
      KT[t * 136 + d] = f2b((1.f - f) * __expf(-rel));
      rel -= __logf(f);
    }
    bmid[d] = -rel;
  } else {
    float rel = 0.f;
    for (int t = Lh; t < L; ++t) {
      float f = lb + (1.f - lb) * sigmoidf_(b2f(zf[(long)t * NCOL]));
      float q = siluf_(b2f(zq[(long)t * NCOL]));
      rel += __logf(f);
      QT[t * 136 + d] = f2b(q * __expf(rel));
      KT[t * 136 + d] = f2b((1.f - f) * __expf(fminf(-rel, 80.f)));
    }
  }
  if (L == 32) {
    for (int t = 32 + hf * 16; t < 48 + hf * 16; ++t) { QT[t * 136 + d] = 0; KT[t * 136 + d] = 0; }
  }
#pragma unroll 4
  for (int s = hf * 32; s < hf * 32 + 32; ++s) BS[d * 72 + s] = (s < L) ? zi[(long)s * NCOL] : (bfu)0;
  __syncthreads();
  bf16x8 aq[4];
#pragma unroll
  for (int kk = 0; kk < 4; ++kk) aq[kk] = *reinterpret_cast<const bf16x8*>(QT + (16 * w + fr) * 136 + kk * 32 + fq * 8);
  {
    f32x4 sa[4];
#pragma unroll
    for (int n = 0; n < 4; ++n) sa[n] = f32x4{0.f, 0.f, 0.f, 0.f};
#pragma unroll
    for (int kk = 0; kk < 4; ++kk)
#pragma unroll
      for (int n = 0; n < 4; ++n) {
        bf16x8 bk = *reinterpret_cast<const bf16x8*>(KT + (n * 16 + fr) * 136 + kk * 32 + fq * 8);
        sa[n] = __builtin_amdgcn_mfma_f32_16x16x32_bf16(aq[kk], bk, sa[n], 0, 0, 0);
      }
#pragma unroll
    for (int n = 0; n < 4; ++n)
#pragma unroll
      for (int j = 0; j < 4; ++j) {
        int t = 16 * w + fq * 4 + j, s = n * 16 + fr;
        AT[t * 72 + s] = (s <= t) ? f2b(sa[n][j]) : (bfu)0;
      }
  }
  __syncthreads();
  f32x4 o[8];
#pragma unroll
  for (int n = 0; n < 8; ++n) o[n] = f32x4{0.f, 0.f, 0.f, 0.f};
#pragma unroll
  for (int kk = 0; kk < 2; ++kk) {
    bf16x8 a = *reinterpret_cast<const bf16x8*>(AT + (16 * w + fr) * 72 + kk * 32 + fq * 8);
#pragma unroll
    for (int n = 0; n < 8; ++n) {
      bf16x8 b = *reinterpret_cast<const bf16x8*>(BS + (n * 16 + fr) * 72 + kk * 32 + fq * 8);
      o[n] = __builtin_amdgcn_mfma_f32_16x16x32_bf16(a, b, o[n], 0, 0, 0);
    }
  }
#pragma unroll
  for (int sl = 0; sl < 2; ++sl) {
    __syncthreads();
    if (!ci.sample) {
      const bfu* src = (const bfu*)(P.ws + O_US) + ((long)((ci.seqi * 8 + h) * 64 + ci.c) << 14);
      int e2 = tid >> 1, dd0 = (tid & 1) * 32;
#pragma unroll
      for (int q4 = 0; q4 < 4; ++q4) {
        uint4 v = *reinterpret_cast<const uint4*>(src + e2 * 128 + sl * 64 + dd0 + q4 * 8);
        const float* bm = bmid + sl * 64 + dd0 + q4 * 8;
        unsigned vv[4] = {v.x, v.y, v.z, v.w};
        unsigned rr[4];
#pragma unroll
        for (int i = 0; i < 4; ++i) {
          float lo = __uint_as_float(vv[i] << 16) * __expf(bm[2 * i]);
          float hi = __uint_as_float(vv[i] & 0xFFFF0000u) * __expf(bm[2 * i + 1]);
          rr[i] = f2b(lo) | ((unsigned)f2b(hi) << 16);
        }
        *reinterpret_cast<uint4*>(BS + e2 * 72 + dd0 + q4 * 8) = make_uint4(rr[0], rr[1], rr[2], rr[3]);
      }
    } else {
      const float* S0 = P.in[5] + (((long)((l * 8 + ci.seqi) * 8 + h)) << 14);
#pragma unroll 4
      for (int dd = hf * 32; dd < hf * 32 + 32; ++dd)
        BS[d * 72 + dd] = f2b(S0[(sl * 64 + dd) * 128 + d] * __expf(bmid[sl * 64 + dd]));
    }
    __syncthreads();
#pragma unroll
    for (int kk = 0; kk < 2; ++kk) {
#pragma unroll
      for (int n = 0; n < 8; ++n) {
        bf16x8 b = *reinterpret_cast<const bf16x8*>(BS + (n * 16 + fr) * 72 + kk * 32 + fq * 8);
        o[n] = __builtin_amdgcn_mfma_f32_16x16x32_bf16(aq[sl * 2 + kk], b, o[n], 0, 0, 0);
      }
    }
  }
  float rinv[4];
#pragma unroll
  for (int j = 0; j < 4; ++j) {
    float ss = 0.f;
#pragma unroll
    for (int n = 0; n < 8; ++n) ss += o[n][j] * o[n][j];
    ss += __shfl_xor(ss, 1); ss += __shfl_xor(ss, 2); ss += __shfl_xor(ss, 4); ss += __shfl_xor(ss, 8);
    rinv[j] = rsqrtf(ss * (1.f / 128.f) + 1e-6f);
  }
  const float* ng = P.in[17] + l * 128;
  bfu* UC = (bfu*)(P.ws + O_UC);
#pragma unroll
  for (int n = 0; n < 8; ++n)
#pragma unroll
    for (int j = 0; j < 4; ++j) {
      int t = 16 * w + fq * 4 + j, e = n * 16 + fr;
      if (t < L) {
        float g = b2f(Z[(long)(ci.lt0 + t) * NCOL + 8 * 1024 + h * 128 + e]);
        UC[(long)(ci.lt0 + t) * 1024 + h * 128 + e] = f2b(o[n][j] * rinv[j] * ng[e] * siluf_(g));
      }
    }
}
DEVI void phase4(const Params& P, int l, int pass, char* smem) {
  const int tid = ltid();
  const int nck = pass ? 128 : 136;
  const int nH = nck * 8;
  const int nL = 64 * 4;
  for (int id = blockIdx.x; id < nH + nL; id += gridDim.x) {
    if (id < nH) h3_item(P, l, id >> 3, id & 7, smem, tid);
    else { int q = id - nH; lsum_item(P, q >> 2, q & 3, tid); }
  }
}

DEVI void phase5(const Params& P, int l, int pass) {
  const int tid = ltid();
  const int ntok = pass ? 8192 : 8448, base = pass ? 8448 : 0;
  const int nItems = (ntok / 128) * 4;
  const int w = tid >> 6, lane = tid & 63;
  const float* AU0 = (const float*)(P.ws + O_AU);
  const float* AU1 = AU0 + (long)8448 * 1024;
  const float* LS = (const float*)(P.ws + O_LSUM);
  const bfu* Z = (const bfu*)(P.ws + O_Z);
  bfu* UB = (bfu*)(P.ws + O_UB);
  for (int id = blockIdx.x; id < nItems; id += gridDim.x) {
    const int tile = id >> 2, ch = ((id & 3) * 4 + w) * 64 + lane;
    const int lt0 = tile * 128;
    const TokInfo t0 = tokinfo(base + lt0);
    float hcur = 0.f;
    if (!t0.sample) {
      int jf = tile - (t0.t >> 7);
      for (int i = jf; i < tile; ++i) hcur = LS[(long)i * 2048 + ch] * hcur + LS[(long)i * 2048 + 1024 + ch];
    }
    for (int r0 = 0; r0 < 128; r0 += 8) {
      float av[8], uv[8], gv[8];
#pragma unroll
      for (int i = 0; i < 8; ++i) {
        long row = lt0 + r0 + i;
        av[i] = AU0[row * 1024 + ch]; uv[i] = AU1[row * 1024 + ch];
        gv[i] = b2f(Z[row * NCOL + 4 * 1024 + ch]);
      }
#pragma unroll
      for (int i = 0; i < 8; ++i) {
        int r = r0 + i;
        if (t0.sample && (r & 31) == 0) hcur = P.in[4][(long)(l * 8 + t0.seq + (r >> 5)) * 1024 + ch];
        hcur = av[i] * hcur + uv[i];
        UB[(long)(lt0 + r) * 1024 + ch] = f2b(geluf_(gv[i]) * hcur);
        if (t0.sample && (r & 31) == 31) P.out[OUT_LRS + (long)(l * 8 + t0.seq + (r >> 5)) * 1024 + ch] = hcur;
      }
    }
    if (!t0.sample && t0.t + 128 == 4096) P.out[OUT_LRP + (long)(l * 4 + t0.seq) * 1024 + ch] = hcur;
  }
}

template <int BR>
DEVI void p6_branch(const Params& P, int pm, int pn, float* macc, char* smem, int tid) {
  asm volatile("" : "+s"(pm), "+s"(pn));
  const bfu* Z = (const bfu*)(P.ws + O_Z);
  bfu* M = (bfu*)(P.ws + O_CB);
  const bfu* A = (const bfu*)(P.ws + (BR == 0 ? O_UA : BR == 1 ? O_UB : O_UC)) + (long)pm * 128 * 1024;
  const bfu* B = (const bfu*)(P.ws + (BR == 0 ? O_WOA : BR == 1 ? O_WOB : O_WOC)) + (long)pn * 128 * 1024;
  f32x4 acc[4][4]; ZERO_ACC(acc);
  gemm_core(acc, A, 1024, B, 1024, 1024, smem, tid);
  EPI_LOOP {
    int row = pm * 128 + EPI_ROW, col = pn * 128 + EPI_COL;
    float g = sigmoidf_(b2f(Z[(long)row * NCOL + (9 + BR) * 1024 + col]));
    float v = g * acc[m][n][j];
    if (BR > 0) v += macc[(long)row * 1024 + col];
    if (BR < 2) macc[(long)row * 1024 + col] = v;
    else M[(long)row * 1024 + col] = f2b(v);
  }
}
DEVI void phase6(const Params& P, int l, int pass, char* smem) {
  const int tid = ltid();
  const int ntok = pass ? 8192 : 8448;
  const int nM = ntok / 128, nN = 8;
  const bfu* Z = (const bfu*)(P.ws + O_Z);
  bfu* M = (bfu*)(P.ws + O_CB);
  for (int id = blockIdx.x; id < nM * nN; id += gridDim.x) {
    int pm = id >> 3, pn = id & 7;
    float* macc = (float*)(P.ws + O_AU);
    p6_branch<0>(P, pm, pn, macc, smem, tid);
    p6_branch<1>(P, pm, pn, macc, smem, tid);
    p6_branch<2>(P, pm, pn, macc, smem, tid);
  }
}

DEVI void phase7(const Params& P, int l, int pass, char* smem) {
  const int tid = ltid();
  const int ntok = pass ? 8192 : 8448, base = pass ? 8448 : 0;
  const int nM = ntok / 128, nN = 8;
  const bfu* M = (const bfu*)(P.ws + O_CB);
  const bfu* W = (const bfu*)(P.ws + O_WO);
  float* pre = (float*)(P.ws + O_PRE);
  for (int id = blockIdx.x; id < nM * nN; id += gridDim.x) {
    int pm = id >> 3, pn = id & 7;
    f32x4 acc[4][4]; ZERO_ACC(acc);
    gemm_core(acc, M + (long)pm * 128 * 1024, 1024, W + (long)pn * 128 * 1024, 1024, 1024, smem, tid);
    EPI_LOOP {
      int row = pm * 128 + EPI_ROW, col = pn * 128 + EPI_COL;
      const float* xr = xrow(P, base + row);
      pre[(long)row * 1024 + col] = ALPHA * xr[col] + acc[m][n][j];
    }
  }
}

DEVI void phase8(const Params& P, int l, int pass) {
  const int tid = ltid();
  const int ntok = pass ? 8192 : 8448, base = pass ? 8448 : 0;
  const int w = tid >> 6, lane = tid & 63;
  const float* pre = (const float*)(P.ws + O_PRE);
  const float* g = P.in[22] + l * 1024;
  const float* b = P.in[23] + l * 1024;
  bfu* xb = (bfu*)(P.ws + O_XB);
  for (int id = blockIdx.x; id < ntok / 4; id += gridDim.x) {
    int lt = id * 4 + w, it = base + lt;
    const float* src = pre + (long)lt * 1024;
    float v[16];
#pragma unroll
    for (int q = 0; q < 4; ++q) {
      float4 t = *reinterpret_cast<const float4*>(src + q * 256 + lane * 4);
      v[q * 4] = t.x; v[q * 4 + 1] = t.y; v[q * 4 + 2] = t.z; v[q * 4 + 3] = t.w;
    }
    float s = 0.f;
#pragma unroll
    for (int i = 0; i < 16; ++i) s += v[i];
    float mu = wave_sum(s) * (1.f / 1024.f);
    float ss = 0.f;
#pragma unroll
    for (int i = 0; i < 16; ++i) { float dlt = v[i] - mu; ss += dlt * dlt; }
    float rs = rsqrtf(wave_sum(ss) * (1.f / 1024.f) + 1e-5f);
    float* xr = xrow(P, it);
#pragma unroll
    for (int q = 0; q < 4; ++q) {
      int c = q * 256 + lane * 4;
      float o[4];
#pragma unroll
      for (int i = 0; i < 4; ++i) o[i] = (v[q * 4 + i] - mu) * rs * g[c + i] + b[c + i];
      *reinterpret_cast<float4*>(xr + c) = make_float4(o[0], o[1], o[2], o[3]);
      store4bf(xb + (long)it * 1024 + c, o);
    }
  }
}

DEVI void phase9(const Params& P, int l, int pass, char* smem) {
  const int tid = ltid();
  const int ntok = pass ? 8192 : 8448, base = pass ? 8448 : 0;
  const int nM = ntok / 128, nN = 16;
  const bfu* xb = (const bfu*)(P.ws + O_XB) + (long)base * 1024;
  const bfu* W = (const bfu*)(P.ws + O_WQ);
  bfu* qp = (bfu*)(P.ws + O_QP);
  for (int id = blockIdx.x; id < nM * nN; id += gridDim.x) {
    int pm, pn; tile_rc(id, nM, nN, pm, pn);
    f32x4 acc[4][4]; ZERO_ACC(acc);
    gemm_core(acc, xb + (long)pm * 128 * 1024, 1024, W + (long)pn * 128 * 1024, 1024, 1024, smem, tid);
    EPI_LOOP {
      int row = pm * 128 + EPI_ROW, col = pn * 128 + EPI_COL;
      qp[(long)row * 2048 + col] = f2b(acc[m][n][j]);
    }
  }
}
DEVI void phase10(const Params& P, int l, int pass, char* smem) {
  const int tid = ltid();
  const int ntok = pass ? 8192 : 8448;
  const int nM = ntok / 128, nN = 16;
  const bfu* qp = (const bfu*)(P.ws + O_QP);
  const bfu* KB = (const bfu*)(P.ws + O_KEYS);
  float* sc = (float*)(P.ws + O_SC);
  for (int id = blockIdx.x; id < nM * nN; id += gridDim.x) {
    int pm = id >> 4, pn = id & 15;
    f32x4 acc[4][4]; ZERO_ACC(acc);
    gemm_core(acc, qp + (long)pm * 128 * 2048 + pn * 128, 2048, KB + (long)pn * 16384, 128, 128, smem, tid);
    EPI_LOOP {
      int row = pm * 128 + EPI_ROW, col = pn * 128 + EPI_COL;
      sc[(long)row * 2048 + col] = acc[m][n][j];
    }
  }
}

DEVI unsigned fkey(float f) {
  unsigned u = __float_as_uint(f);
  return (u & 0x80000000u) ? ~u : (u | 0x80000000u);
}
DEVI void dec16(uint4 v, f32x2 (&o)[8]) {
  o[0] = __builtin_amdgcn_cvt_pk_f32_fp8((int)v.x, false); o[1] = __builtin_amdgcn_cvt_pk_f32_fp8((int)v.x, true);
  o[2] = __builtin_amdgcn_cvt_pk_f32_fp8((int)v.y, false); o[3] = __builtin_amdgcn_cvt_pk_f32_fp8((int)v.y, true);
  o[4] = __builtin_amdgcn_cvt_pk_f32_fp8((int)v.z, false); o[5] = __builtin_amdgcn_cvt_pk_f32_fp8((int)v.z, true);
  o[6] = __builtin_amdgcn_cvt_pk_f32_fp8((int)v.w, false); o[7] = __builtin_amdgcn_cvt_pk_f32_fp8((int)v.w, true);
}
DEVI void phase11(const Params& P, int l, int pass, char* smem) {
  const int ntok = pass ? 8192 : 8448, base = pass ? 8448 : 0;
  const int tid = ltid(); const int w = tid >> 6, lane = tid & 63;
  float* scl = (float*)smem;
  float* sv = scl + 2048;
  int* si = (int*)(sv + 256);
  float* tops = (float*)(si + 256);
  int* tope = (int*)(tops + 128);
  float* wgt = (float*)(tope + 128);
  float* dotv = wgt + 128;
  float* red = dotv + 128;
  float* stat = red + 4096;
  const float* SC = (const float*)(P.ws + O_SC);
  const unsigned char* UT = (const unsigned char*)(P.ws + O_UTB);
  const unsigned char* VTb = (const unsigned char*)(P.ws + O_VTB);
  const float* g2 = P.in[28] + l * 1024;
  const float* b2 = P.in[29] + l * 1024;
  bfu* xb = (bfu*)(P.ws + O_XB);
  const unsigned long long ltmask = (1ull << lane) - 1ull;
  for (int lt = blockIdx.x; lt < ntok; lt += gridDim.x) {
    const int it = base + lt;
    float* xr = xrow(P, it);
    __syncthreads();
    {
      const float4* s4 = reinterpret_cast<const float4*>(SC + (long)lt * 2048);
      reinterpret_cast<float4*>(scl)[tid] = s4[tid];
      reinterpret_cast<float4*>(scl)[tid + 256] = s4[tid + 256];
    }
    __syncthreads();
    {
      float v0[4], v1[4]; unsigned k0[4], k1[4], T[4];
#pragma unroll
      for (int li = 0; li < 4; ++li) {
        const int Lx = w * 4 + li;
        v0[li] = scl[Lx * 128 + lane]; v1[li] = scl[Lx * 128 + 64 + lane];
        k0[li] = fkey(v0[li]); k1[li] = fkey(v1[li]); T[li] = 0;
      }
      for (int b = 31; b >= 0; --b) {
#pragma unroll
        for (int li = 0; li < 4; ++li) {
          unsigned cand = T[li] | (1u << b);
          int cnt = __popcll(__ballot(k0[li] >= cand)) + __popcll(__ballot(k1[li] >= cand));
          if (cnt >= 16) T[li] = cand;
        }
      }
#pragma unroll
      for (int li = 0; li < 4; ++li) {
        const int Lx = w * 4 + li;
        bool s0 = k0[li] >= T[li], s1 = k1[li] >= T[li];
        unsigned long long m0 = __ballot(s0), m1 = __ballot(s1);
        int p0 = __popcll(m0 & ltmask), p1 = __popcll(m0) + __popcll(m1 & ltmask);
        if (s0 && p0 < 16) { sv[Lx * 16 + p0] = v0[li]; si[Lx * 16 + p0] = lane; }
        if (s1 && p1 < 16) { sv[Lx * 16 + p1] = v1[li]; si[Lx * 16 + p1] = lane + 64; }
      }
    }
    __syncthreads();
    {
      float cv[2][4]; unsigned ck[2][4], T[2];
#pragma unroll
      for (int hi = 0; hi < 2; ++hi) {
        const int h = w * 2 + hi;
        T[hi] = 0;
#pragma unroll
        for (int r = 0; r < 4; ++r) {
          int c = lane + 64 * r;
          cv[hi][r] = sv[(2 * h) * 16 + (c >> 4)] + sv[(2 * h + 1) * 16 + (c & 15)];
          ck[hi][r] = fkey(cv[hi][r]);
        }
      }
      for (int b = 31; b >= 0; --b) {
#pragma unroll
        for (int hi = 0; hi < 2; ++hi) {
          unsigned cand = T[hi] | (1u << b);
          int cnt = 0;
#pragma unroll
          for (int r = 0; r < 4; ++r) cnt += __popcll(__ballot(ck[hi][r] >= cand));
          if (cnt >= 16) T[hi] = cand;
        }
      }
#pragma unroll
      for (int hi = 0; hi < 2; ++hi) {
        const int h = w * 2 + hi;
        int basec = 0;
#pragma unroll
        for (int r = 0; r < 4; ++r) {
          bool s = ck[hi][r] >= T[hi];
          unsigned long long mm = __ballot(s);
          int p = basec + __popcll(mm & ltmask);
          if (s && p < 16) {
            int c = lane + 64 * r;
            tops[h * 16 + p] = cv[hi][r];
            tope[h * 16 + p] = si[(2 * h) * 16 + (c >> 4)] * 128 + si[(2 * h + 1) * 16 + (c & 15)];
          }
          basec += __popcll(mm);
        }
      }
    }
    __syncthreads();
    if (tid < 128) {
      float s = tops[tid];
      float mx = s;
      mx = fmaxf(mx, __shfl_xor(mx, 1)); mx = fmaxf(mx, __shfl_xor(mx, 2));
      mx = fmaxf(mx, __shfl_xor(mx, 4)); mx = fmaxf(mx, __shfl_xor(mx, 8));
      float e = __expf(s - mx);
      float sm = e;
      sm += __shfl_xor(sm, 1); sm += __shfl_xor(sm, 2); sm += __shfl_xor(sm, 4); sm += __shfl_xor(sm, 8);
      tops[tid] = e / sm;
    }
    f32x2 xv[8];
    {
      const float4* xp = reinterpret_cast<const float4*>(xr + lane * 16);
#pragma unroll
      for (int q = 0; q < 4; ++q) {
        float4 a = xp[q];
        xv[2 * q] = f32x2{a.x, a.y}; xv[2 * q + 1] = f32x2{a.z, a.w};
      }
    }
#pragma unroll 1
    for (int p0 = 0; p0 < 32; p0 += 8) {
      uint4 rw[8];
#pragma unroll
      for (int i = 0; i < 8; ++i) {
        int e = tope[w * 32 + p0 + i];
        rw[i] = *reinterpret_cast<const uint4*>(UT + (long)e * 1024 + lane * 16);
      }
      float dsum[8];
#pragma unroll
      for (int i = 0; i < 8; ++i) {
        f32x2 f[8];
        dec16(rw[i], f);
        f32x2 acc = f[0] * xv[0];
#pragma unroll
        for (int q = 1; q < 8; ++q) acc = __builtin_elementwise_fma(f[q], xv[q], acc);
        dsum[i] = acc.x + acc.y;
      }
      float e4[4], e2[2], e1;
      {
        const bool hi = (lane & 32) != 0;
#pragma unroll
        for (int i = 0; i < 4; ++i) {
          float snd = hi ? dsum[i] : dsum[i + 4];
          float kp = hi ? dsum[i + 4] : dsum[i];
          e4[i] = kp + __shfl_xor(snd, 32);
        }
        const bool hi2 = (lane & 16) != 0;
#pragma unroll
        for (int i = 0; i < 2; ++i) {
          float snd = hi2 ? e4[i] : e4[i + 2];
          float kp = hi2 ? e4[i + 2] : e4[i];
          e2[i] = kp + __shfl_xor(snd, 16);
        }
        const bool hi3 = (lane & 8) != 0;
        {
          float snd = hi3 ? e2[0] : e2[1];
          float kp = hi3 ? e2[1] : e2[0];
          e1 = kp + __shfl_xor(snd, 8);
        }
        e1 += __shfl_xor(e1, 4); e1 += __shfl_xor(e1, 2); e1 += __shfl_xor(e1, 1);
      }
      if ((lane & 7) == 0) {
        int r = ((lane >> 5) & 1) * 4 + ((lane >> 4) & 1) * 2 + ((lane >> 3) & 1);
        dotv[w * 32 + p0 + r] = e1;
      }
    }
    __syncthreads();
    if (tid < 128) wgt[tid] = tops[tid] * geluf_(dotv[tid] * (1.f / U_SCALE)) * (1.f / V_SCALE);
    __syncthreads();
    f32x2 oacc[8];
#pragma unroll
    for (int q = 0; q < 8; ++q) oacc[q] = f32x2{0.f, 0.f};
#pragma unroll 1
    for (int p0 = 0; p0 < 32; p0 += 8) {
      uint4 rw[8]; float wg[8];
#pragma unroll
      for (int i = 0; i < 8; ++i) {
        int e = tope[w * 32 + p0 + i];
        wg[i] = wgt[w * 32 + p0 + i];
        rw[i] = *reinterpret_cast<const uint4*>(VTb + (long)e * 1024 + lane * 16);
      }
#pragma unroll
      for (int i = 0; i < 8; ++i) {
        f32x2 f[8];
        dec16(rw[i], f);
        f32x2 wv = f32x2{wg[i], wg[i]};
#pragma unroll
        for (int q = 0; q < 8; ++q) oacc[q] = __builtin_elementwise_fma(f[q], wv, oacc[q]);
      }
    }
    {
      float4* rwp = reinterpret_cast<float4*>(red + w * 1024 + lane * 16);
#pragma unroll
      for (int q = 0; q < 4; ++q) rwp[q] = make_float4(oacc[2 * q].x, oacc[2 * q].y, oacc[2 * q + 1].x, oacc[2 * q + 1].y);
    }
    __syncthreads();
    const int c = tid * 4;
    float y[4];
    {
      float4 xx = *reinterpret_cast<const float4*>(xr + c);
      float4 r0 = *reinterpret_cast<const float4*>(red + c);
      float4 r1 = *reinterpret_cast<const float4*>(red + 1024 + c);
      float4 r2 = *reinterpret_cast<const float4*>(red + 2048 + c);
      float4 r3 = *reinterpret_cast<const float4*>(red + 3072 + c);
      y[0] = ALPHA * xx.x + (r0.x + r1.x + r2.x + r3.x);
      y[1] = ALPHA * xx.y + (r0.y + r1.y + r2.y + r3.y);
      y[2] = ALPHA * xx.z + (r0.z + r1.z + r2.z + r3.z);
      y[3] = ALPHA * xx.w + (r0.w + r1.w + r2.w + r3.w);
    }
    float s = wave_sum(y[0] + y[1] + y[2] + y[3]);
    if (lane == 0) stat[w] = s;
    __syncthreads();
    float mu = (stat[0] + stat[1] + stat[2] + stat[3]) * (1.f / 1024.f);
    float ss = 0.f;
#pragma unroll
    for (int i = 0; i < 4; ++i) { float dl = y[i] - mu; ss += dl * dl; }
    ss = wave_sum(ss);
    if (lane == 0) stat[4 + w] = ss;
    __syncthreads();
    float rs = rsqrtf((stat[4] + stat[5] + stat[6] + stat[7]) * (1.f / 1024.f) + 1e-5f);
    float o[4];
#pragma unroll
    for (int i = 0; i < 4; ++i) o[i] = (y[i] - mu) * rs * g2[c + i] + b2[c + i];
    *reinterpret_cast<float4*>(xr + c) = make_float4(o[0], o[1], o[2], o[3]);
    store4bf(xb + (long)it * 1024 + c, o);
  }
}

#define XB_TMO      128
#define XB_XCNT(j)  (256  + 64 * (j))
#define XB_XSUB(j)  (1280 + 64 * (j))
#define XB_XGEN(j)  (2304 + 64 * (j))
#define XB_TOP      3328
#define XB_TOPGEN   3392
#define XCD_BAR_WORDS 3456
#define XB_SPIN_CAP (1u << 18)
DEVI unsigned xb_ld(unsigned* p) { return __hip_atomic_load(p, __ATOMIC_RELAXED, __HIP_MEMORY_SCOPE_AGENT); }
DEVI unsigned xb_add(unsigned* p, unsigned v) { return __hip_atomic_fetch_add(p, v, __ATOMIC_RELAXED, __HIP_MEMORY_SCOPE_AGENT); }
DEVI unsigned xb_xcc_id() { return (unsigned)__builtin_amdgcn_s_getreg((3 << 11) | 20) & 0xFu; }
#define XB_SPIN(cond, bar) do { unsigned _sp = 0; while (cond) { __builtin_amdgcn_s_sleep(1); \
    if ((++_sp & 255u) == 0u) { if (xb_ld(&(bar)[XB_TMO])) break; if (_sp > XB_SPIN_CAP) { atomicAdd(&(bar)[XB_TMO], 1u); break; } } } } while (0)
DEVI void xcd_census(unsigned* bar, unsigned x, unsigned& nloc, unsigned& nx) {
  const unsigned G = gridDim.x;
  unsigned sum, cnt, mine, sp = 0u;
  for (;;) {
    sum = 0u; cnt = 0u; mine = 0u;
#pragma unroll
    for (unsigned j = 0; j < 16; ++j) { const unsigned c = xb_ld(&bar[XB_XCNT(j)]); sum += c; cnt += (c > 0u) ? 1u : 0u; mine = (j == x) ? c : mine; }
    if (sum == G) break;
    __builtin_amdgcn_s_sleep(1);
    if ((++sp & 255u) == 0u) { if (xb_ld(&bar[XB_TMO])) break; if (sp > XB_SPIN_CAP) { atomicAdd(&bar[XB_TMO], 1u); break; } }
  }
  nloc = mine > 0u ? mine : 1u; nx = cnt > 0u ? cnt : 1u;
}
DEVI void xcd_barrier(unsigned* bar, unsigned x, unsigned nloc, unsigned nx) {
  asm volatile("s_waitcnt vmcnt(0)" ::: "memory");
  __syncthreads();
  if (threadIdx.x == 0) {
    __builtin_amdgcn_s_waitcnt(0);
    const unsigned old = xb_add(&bar[XB_XSUB(x)], 1u);
    const unsigned gen = old / nloc;
    if (old + 1u == (gen + 1u) * nloc) {
      __builtin_amdgcn_fence(__ATOMIC_RELEASE, "agent");
      asm volatile("s_waitcnt vmcnt(0)" ::: "memory");
      const unsigned og = xb_add(&bar[XB_TOP], 1u);
      const unsigned tg = og / nx;
      if (og + 1u == (tg + 1u) * nx) xb_add(&bar[XB_TOPGEN], 1u);
      else XB_SPIN(xb_ld(&bar[XB_TOPGEN]) == tg, bar);
      __builtin_amdgcn_fence(__ATOMIC_ACQUIRE, "agent");
      xb_add(&bar[XB_XGEN(x)], 1u);
      asm volatile("s_waitcnt vmcnt(0)" ::: "memory");
    } else {
      XB_SPIN(xb_ld(&bar[XB_XGEN(x)]) == gen, bar);
      __builtin_amdgcn_fence(__ATOMIC_ACQUIRE, "agent");
      asm volatile("s_waitcnt vmcnt(0)" ::: "memory");
    }
  }
  __syncthreads();
}

__global__ void __launch_bounds__(256, 2) fwd_megakernel(Params P) {
  __shared__ __attribute__((aligned(16))) char smem[65536];
  cg::grid_group grid = cg::this_grid();
  unsigned* bar = (unsigned*)(P.ws + O_BAR);
  const unsigned xcc = xb_xcc_id();
  if (threadIdx.x == 0) (void)xb_add(&bar[XB_XCNT(xcc)], 1u);
  unsigned nloc = 1u, nx = 1u;
#define LND asm volatile("" : "+s"(l), "+s"(pass))
#define GSYNC xcd_barrier(bar, xcc, nloc, nx)
#pragma unroll 1
  for (int l = 0; l < 2; ++l) {
    phase_prep(P, l, smem);
    if (l == 0) {
      phase_xcopy(P);
      grid.sync();
      if (threadIdx.x == 0) xcd_census(bar, xcc, nloc, nx);
    } else {
      GSYNC;
    }
#pragma unroll 1
    for (int pass = 0; pass < 2; ++pass) {
      LND; phase_inproj(P, l, pass, smem); GSYNC;
      LND; phase2(P, l, pass, smem); GSYNC;
      LND; phase3(P, l, pass, smem); GSYNC;
      LND; phase4(P, l, pass, smem); GSYNC;
      LND; phase5(P, l, pass); GSYNC;
      LND; phase6(P, l, pass, smem); GSYNC;
      LND; phase7(P, l, pass, smem); GSYNC;
      LND; phase8(P, l, pass); GSYNC;
      LND; phase9(P, l, pass, smem); GSYNC;
      LND; phase10(P, l, pass, smem); GSYNC;
      LND; phase11(P, l, pass, smem); GSYNC;
    }
  }
}

extern "C" void kernel_launch(void* const* d_in, const int* in_sizes, int n_in, void* d_out, int out_size,
                              void* d_ws, size_t ws_size, hipStream_t stream) {
  static int grid_blocks = 0;
  if (!grid_blocks) {
    int dev = 0, cus = 0, per_cu = 0;
    hipGetDevice(&dev);
    hipDeviceGetAttribute(&cus, hipDeviceAttributeMultiprocessorCount, dev);
    hipOccupancyMaxActiveBlocksPerMultiprocessor(&per_cu, fwd_megakernel, 256, 0);
    if (per_cu > 2) per_cu = 2;
    if (per_cu < 1) per_cu = 1;
    grid_blocks = cus * per_cu;
  }
  if (ws_size < O_END) fprintf(stderr, "workspace too small: %zu < %zu\n", ws_size, (size_t)O_END);
  hipMemsetAsync((char*)d_ws + O_BAR, 0, 16384, stream);
  Params p{};
  for (int i = 0; i < 30; ++i) p.in[i] = (const float*)d_in[i];
  p.out = (float*)d_out;
  p.ws = (char*)d_ws;
  void* args[] = {&p};
  hipError_t e = hipLaunchCooperativeKernel((void*)fwd_megakernel, dim3(grid_blocks), dim3(256), args, 0, stream);
  if (e != hipSuccess) fprintf(stderr, "cooperative launch failed: %s (grid %d)\n", hipGetErrorString(e), grid_blocks);
}
```

```cpp
#include <hip/hip_runtime.h>
#include <hip/hip_bf16.h>
#include <hip/hip_cooperative_groups.h>
#include <cstdio>
namespace cg = cooperative_groups;

typedef unsigned short bfu;
using bf16x8 = __attribute__((ext_vector_type(8))) short;
using f32x4 = __attribute__((ext_vector_type(4))) float;
#define DEVI __device__ __forceinline__

constexpr float ALPHA = 1.41421356237f;
constexpr int NCOL = 12288;

constexpr size_t O_WIN = 0;
constexpr size_t O_WOA = O_WIN + 25165824;
constexpr size_t O_WOB = O_WOA + 2097152;
constexpr size_t O_WOC = O_WOB + 2097152;
constexpr size_t O_WO = O_WOC + 2097152;
constexpr size_t O_WQ = O_WO + 2097152;
constexpr size_t O_KEYS = O_WQ + 4194304;
constexpr size_t O_LRU = O_KEYS + 524288;
constexpr size_t O_UTB = O_LRU + 524288;
constexpr size_t O_VTB = O_UTB + 33554432;
constexpr size_t O_LBS = O_VTB + 33554432;
constexpr size_t O_XB = O_LBS + 8192;
constexpr size_t O_Z = O_XB + 34078720;
constexpr size_t O_UA = O_Z + 207618048;
constexpr size_t O_UB = O_UA + 17301504;
constexpr size_t O_UC = O_UB + 17301504;
constexpr size_t O_CB = O_UC + 17301504;
constexpr size_t O_AU = O_CB + 17301504;
constexpr size_t O_LSUM = O_AU + 69206016;
constexpr size_t O_US = O_LSUM + 540672;
constexpr size_t O_DEC = O_US + 33554432;
constexpr size_t O_BAR = O_DEC + 524288;
constexpr size_t O_END = O_BAR + 16384;
constexpr size_t O_PRE = O_Z;
constexpr size_t O_QP = O_Z + 34603008;
constexpr size_t O_SC = O_QP + 34603008;

constexpr long OUT_YS = 16777216;
constexpr long OUT_CAP = 17039360;
constexpr long OUT_CBP = 17055744;
constexpr long OUT_LRP = 17080320;
constexpr long OUT_HGP = 17088512;
constexpr long OUT_CAS = 18137088;
constexpr long OUT_CBS = 18169856;
constexpr long OUT_LRS = 18219008;
constexpr long OUT_HGS = 18235392;

struct Params {
  const float* in[30];
  float* out;
  char* ws;
};

DEVI bfu f2b(float f) {
  unsigned u = __float_as_uint(f);
  u += 0x7FFFu + ((u >> 16) & 1u);
  return (bfu)(u >> 16);
}
DEVI float b2f(bfu b) { return __uint_as_float(((unsigned)b) << 16); }
DEVI float sigmoidf_(float x) { return 1.f / (1.f + __expf(-x)); }
DEVI float siluf_(float x) { return x / (1.f + __expf(-x)); }
DEVI float geluf_(float x) { return 0.5f * x * (1.f + erff(x * 0.70710678118f)); }
DEVI float wave_sum(float v) {
#pragma unroll
  for (int o = 32; o; o >>= 1) v += __shfl_xor(v, o);
  return v;
}

DEVI int ltid() { int t = threadIdx.x; asm volatile("" : "+v"(t)); return t; }
struct TokInfo { int sample, seq, t; };
DEVI TokInfo tokinfo(int it) {
  TokInfo r;
  if (it < 8192) { r.sample = 0; r.seq = it >> 12; r.t = it & 4095; }
  else if (it < 8448) { int q = it - 8192; r.sample = 1; r.seq = q >> 5; r.t = q & 31; }
  else { int q = it - 8448; r.sample = 0; r.seq = 2 + (q >> 12); r.t = q & 4095; }
  return r;
}
DEVI float* xrow(const Params& P, int it) {
  TokInfo ti = tokinfo(it);
  return ti.sample ? P.out + OUT_YS + (long)(ti.seq * 32 + ti.t) * 1024
                   : P.out + (long)(ti.seq * 4096 + ti.t) * 1024;
}

DEVI void stage_tile(const bfu* __restrict__ g, int ld, int k0, char* lds, int tid) {
#pragma unroll
  for (int i = 0; i < 4; ++i) {
    int b = tid * 16 + i * 4096;
    int r = b >> 7, cp = (b >> 4) & 7, gc = cp ^ (r & 7);
    __builtin_amdgcn_global_load_lds((const unsigned*)(g + (long)r * ld + k0 + gc * 8),
                                     (unsigned*)(lds + b), 16, 0, 0);
  }
}
DEVI bf16x8 ldfrag(const char* tile, int r, int kc) {
  return *reinterpret_cast<const bf16x8*>(tile + r * 128 + ((kc ^ (r & 7)) << 4));
}
DEVI void gemm_core(f32x4 (&acc)[4][4], const bfu* __restrict__ A, int lda,
                    const bfu* __restrict__ B, int ldb, int K, char* smem, int tid) {
  const int wid = tid >> 6, lane = tid & 63;
  const int wr = wid >> 1, wc = wid & 1, fr = lane & 15, fq = lane >> 4;
  const int nt = K >> 6;
  __syncthreads();
  stage_tile(A, lda, 0, smem, tid);
  stage_tile(B, ldb, 0, smem + 16384, tid);
  for (int t = 0; t < nt; ++t) {
    asm volatile("s_waitcnt vmcnt(0)" ::: "memory");
    __syncthreads();
    char* cur = smem + (t & 1) * 32768;
    if (t + 1 < nt) {
      char* nx = smem + ((t + 1) & 1) * 32768;
      stage_tile(A, lda, (t + 1) * 64, nx, tid);
      stage_tile(B, ldb, (t + 1) * 64, nx + 16384, tid);
    }
#pragma unroll
    for (int kk = 0; kk < 2; ++kk) {
      bf16x8 af[4], bfr[4];
#pragma unroll
      for (int m = 0; m < 4; ++m) af[m] = ldfrag(cur, wr * 64 + m * 16 + fr, kk * 4 + fq);
#pragma unroll
      for (int n = 0; n < 4; ++n) bfr[n] = ldfrag(cur + 16384, wc * 64 + n * 16 + fr, kk * 4 + fq);
#pragma unroll
      for (int m = 0; m < 4; ++m)
#pragma unroll
        for (int n = 0; n < 4; ++n)
          acc[m][n] = __builtin_amdgcn_mfma_f32_16x16x32_bf16(af[m], bfr[n], acc[m][n], 0, 0, 0);
    }
  }
}
DEVI void tile_rc(int id, int nM, int nN, int& pm, int& pn) {
  const int x = id & 7, q = id >> 3;
  const int gfull = nM >> 3;
  const int g = q / nN;
  if (g < gfull) {
    int r = q - g * nN;
    pn = (r >> 3) * 8 + x;
    pm = g * 8 + (r & 7);
  } else {
    int gsz = nM - gfull * 8;
    int r = q - gfull * nN;
    pn = (r / gsz) * 8 + x;
    pm = gfull * 8 + (r % gsz);
  }
}
#define ZERO_ACC(a) _Pragma("unroll") for (int m_ = 0; m_ < 4; ++m_) _Pragma("unroll") for (int n_ = 0; n_ < 4; ++n_) a[m_][n_] = f32x4{0.f, 0.f, 0.f, 0.f}
#define EPI_LOOP \
  const int wid_ = tid >> 6, lane_ = tid & 63; \
  const int wr_ = wid_ >> 1, wc_ = wid_ & 1, fr_ = lane_ & 15, fq_ = lane_ >> 4; \
  _Pragma("unroll") for (int m = 0; m < 4; ++m) for (int sb_ = (__builtin_amdgcn_sched_barrier(0), 0); sb_ < 1; ++sb_) _Pragma("unroll") for (int n = 0; n < 4; ++n) _Pragma("unroll") for (int j = 0; j < 4; ++j)
#define EPI_ROW (wr_ * 64 + m * 16 + fq_ * 4 + j)
#define EPI_COL (wc_ * 64 + n * 16 + fr_)

DEVI void transpose_tile(const float* __restrict__ src, bfu* __restrict__ dst, int R, int C, int r0, int c0, float* tile, int tid) {
  __syncthreads();
  {
    int tx = tid & 15, ty = tid >> 4;
#pragma unroll
    for (int i = 0; i < 4; ++i) {
      int r = ty + i * 16;
      float4 v = *reinterpret_cast<const float4*>(src + (long)(r0 + r) * C + c0 + tx * 4);
      float* tp = tile + r * 65 + tx * 4;
      tp[0] = v.x; tp[1] = v.y; tp[2] = v.z; tp[3] = v.w;
    }
  }
  __syncthreads();
  {
    int c = tid >> 2, rs = (tid & 3) * 16;
    unsigned pk[8];
#pragma unroll
    for (int i = 0; i < 8; ++i) {
      unsigned lo = f2b(tile[(rs + 2 * i) * 65 + c]);
      unsigned hi = f2b(tile[(rs + 2 * i + 1) * 65 + c]);
      pk[i] = lo | (hi << 16);
    }
    uint4* dp = reinterpret_cast<uint4*>(dst + (long)(c0 + c) * R + r0 + rs);
    dp[0] = make_uint4(pk[0], pk[1], pk[2], pk[3]);
    dp[1] = make_uint4(pk[4], pk[5], pk[6], pk[7]);
  }
}
DEVI void convert_chunk(const float* __restrict__ src, bfu* __restrict__ dst, int tid) {
  int o = tid * 8;
  float4 a = *reinterpret_cast<const float4*>(src + o);
  float4 b = *reinterpret_cast<const float4*>(src + o + 4);
  uint4 r;
  r.x = f2b(a.x) | ((unsigned)f2b(a.y) << 16);
  r.y = f2b(a.z) | ((unsigned)f2b(a.w) << 16);
  r.z = f2b(b.x) | ((unsigned)f2b(b.y) << 16);
  r.w = f2b(b.z) | ((unsigned)f2b(b.w) << 16);
  *reinterpret_cast<uint4*>(dst + o) = r;
}

typedef float f32x2 __attribute__((ext_vector_type(2)));
constexpr float U_SCALE = 64.f, V_SCALE = 8.f;
DEVI void convert_chunk_fp8(const float* __restrict__ src, unsigned char* __restrict__ dst, float scale, int tid) {
  int o = tid * 16;
  uint4 r;
  unsigned rr[4];
#pragma unroll
  for (int q = 0; q < 4; ++q) {
    float4 a = *reinterpret_cast<const float4*>(src + o + q * 4);
    int p = __builtin_amdgcn_cvt_pk_fp8_f32(a.x * scale, a.y * scale, 0, false);
    p = __builtin_amdgcn_cvt_pk_fp8_f32(a.z * scale, a.w * scale, p, true);
    rr[q] = (unsigned)p;
  }
  r = make_uint4(rr[0], rr[1], rr[2], rr[3]);
  *reinterpret_cast<uint4*>(dst + o) = r;
}

DEVI void phase_prep(const Params& P, int l, char* smem) {
  const int tid = ltid();
  char* ws = P.ws;
  float* tile = reinterpret_cast<float*>(smem);
  const int NT_WIN = 3072, NT_SQ = 256, NT_WQ = 512, NT_LRU = 64;
  const int T0 = NT_WIN, T1 = T0 + 4 * NT_SQ, T2 = T1 + NT_WQ, T3 = T2 + NT_LRU;
  const int C0 = T3 + 128, C1 = C0 + 4096, C2 = C1 + 4096;
  const int X0 = C2;
  const int L0 = X0 + (l == 0 ? 8 : 0);
  for (int id = blockIdx.x; id < L0; id += gridDim.x) {
    if (id < T0) {
      int tr = id / 192, tc = id % 192;
      transpose_tile(P.in[6] + (long)l * 1024 * 12288, (bfu*)(ws + O_WIN), 1024, 12288, tr * 64, tc * 64, tile, tid);
    } else if (id < T1) {
      int q = id - T0, w = q >> 8, t = q & 255;
      const float* src = P.in[18 + w] + (long)l * 1048576;
      bfu* dst = (bfu*)(ws + (w == 0 ? O_WOA : w == 1 ? O_WOB : w == 2 ? O_WOC : O_WO));
      transpose_tile(src, dst, 1024, 1024, (t >> 4) * 64, (t & 15) * 64, tile, tid);
    } else if (id < T2) {
      int q = id - T1;
      transpose_tile(P.in[24] + (long)l * 2097152, (bfu*)(ws + O_WQ), 1024, 2048, (q >> 5) * 64, (q & 31) * 64, tile, tid);
    } else if (id < T3) {
      int q = id - T2, mtx = q >> 2, t = q & 3, g = mtx >> 3, nb = mtx & 7;
      const float* src = P.in[g == 0 ? 11 : 13] + (long)l * 131072 + nb * 16384;
      transpose_tile(src, (bfu*)(ws + O_LRU) + mtx * 16384, 128, 128, (t >> 1) * 64, (t & 1) * 64, tile, tid);
    } else if (id < C0) {
      int q = id - T3;
      convert_chunk(P.in[25] + (long)l * 262144 + (long)q * 2048, (bfu*)(ws + O_KEYS) + (long)q * 2048, tid);
    } else if (id < C1) {
      int q = id - C0;
      convert_chunk_fp8(P.in[26] + (long)l * 16777216 + (long)q * 4096, (unsigned char*)(ws + O_UTB) + (long)q * 4096, U_SCALE, tid);
    } else if (id < C2) {
      int q = id - C1;
      convert_chunk_fp8(P.in[27] + (long)l * 16777216 + (long)q * 4096, (unsigned char*)(ws + O_VTB) + (long)q * 4096, V_SCALE, tid);
    } else {
      int q = id - X0;
      int c = (q & 3) * 256 + tid, ll = q >> 2;
      float a0 = P.in[16][c], a1 = P.in[16][1024 + c];
      float mx = fmaxf(a0, a1);
      float e0 = __expf(a0 - mx), e1 = __expf(a1 - mx);
      float p1 = e1 / (e0 + e1);
      float* lbs = (float*)(ws + O_LBS);
      lbs[ll * 1024 + c] = (ll == 0) ? 0.f : p1;
    }
  }
}

DEVI void phase_xcopy(const Params& P) {
  const int tid = ltid();
  bfu* xb = (bfu*)(P.ws + O_XB);
  for (int it = blockIdx.x; it < 16640; it += gridDim.x) {
    TokInfo ti = tokinfo(it);
    const float* src = ti.sample ? P.in[1] + (long)(ti.seq * 32 + ti.t) * 1024 : P.in[0] + (long)(ti.seq * 4096 + ti.t) * 1024;
    float* dst = xrow(P, it);
    int c = tid * 4;
    float4 v = *reinterpret_cast<const float4*>(src + c);
    *reinterpret_cast<float4*>(dst + c) = v;
    uint2 r;
    r.x = f2b(v.x) | ((unsigned)f2b(v.y) << 16);
    r.y = f2b(v.z) | ((unsigned)f2b(v.w) << 16);
    *reinterpret_cast<uint2*>(xb + (long)it * 1024 + c) = r;
  }
}

DEVI void phase_inproj(const Params& P, int l, int pass, char* smem) {
  const int tid = ltid();
  const int ntok = pass ? 8192 : 8448, base = pass ? 8448 : 0;
  const int nM = ntok / 128, nN = 96;
  const bfu* xb = (const bfu*)(P.ws + O_XB) + (long)base * 1024;
  const bfu* wT = (const bfu*)(P.ws + O_WIN);
  bfu* z = (bfu*)(P.ws + O_Z);
  const float* bin = P.in[7] + l * NCOL;
  for (int id = blockIdx.x; id < nM * nN; id += gridDim.x) {
    int pm, pn; tile_rc(id, nM, nN, pm, pn);
    f32x4 acc[4][4]; ZERO_ACC(acc);
    gemm_core(acc, xb + (long)pm * 128 * 1024, 1024, wT + (long)pn * 128 * 1024, 1024, 1024, smem, tid);
    EPI_LOOP {
      int row = pm * 128 + EPI_ROW, col = pn * 128 + EPI_COL;
      z[(long)row * NCOL + col] = f2b(acc[m][n][j] + bin[col]);
    }
  }
}

DEVI void load4bf(const bfu* p, float (&o)[4]) {
  uint2 v = *reinterpret_cast<const uint2*>(p);
  o[0] = __uint_as_float(v.x << 16); o[1] = __uint_as_float(v.x & 0xFFFF0000u);
  o[2] = __uint_as_float(v.y << 16); o[3] = __uint_as_float(v.y & 0xFFFF0000u);
}
DEVI void store4bf(bfu* p, const float (&v)[4]) {
  uint2 r;
  r.x = f2b(v[0]) | ((unsigned)f2b(v[1]) << 16);
  r.y = f2b(v[2]) | ((unsigned)f2b(v[3]) << 16);
  *reinterpret_cast<uint2*>(p) = r;
}
DEVI void mixab_row(const Params& P, int l, int base, int lt, int tid) {
  const int it = base + lt;
  const TokInfo ti = tokinfo(it);
  const int T = ti.sample ? 32 : 4096;
  const bfu* z = (const bfu*)(P.ws + O_Z);
  const int c = tid * 4;
  float pk[3][4];
#pragma unroll
  for (int k = 0; k < 3; ++k) {
    int tt = ti.t - 2 + k;
    if (tt >= 0) {
      const bfu* zr = z + (long)(lt - 2 + k) * NCOL;
      float ac[4], ax[4];
      load4bf(zr + 1024 + c, ac); load4bf(zr + 2048 + c, ax);
#pragma unroll
      for (int i = 0; i < 4; ++i) pk[k][i] = ac[i] * ax[i];
    } else if (ti.sample) {
      float4 v = *reinterpret_cast<const float4*>(P.in[2] + ((long)(l * 8 + ti.seq) * 2 + (tt + 2)) * 1024 + c);
      pk[k][0] = v.x; pk[k][1] = v.y; pk[k][2] = v.z; pk[k][3] = v.w;
    } else {
#pragma unroll
      for (int i = 0; i < 4; ++i) pk[k][i] = 0.f;
    }
  }
  {
    float ab[4], o[4];
    load4bf(z + (long)lt * NCOL + c, ab);
    const float* w = P.in[8] + (long)l * 3 * 1024 + c;
#pragma unroll
    for (int i = 0; i < 4; ++i) o[i] = ab[i] * (w[i] * pk[0][i] + w[1024 + i] * pk[1][i] + w[2048 + i] * pk[2][i]);
    store4bf((bfu*)(P.ws + O_UA) + (long)lt * 1024 + c, o);
    if (ti.t >= T - 2) {
      int r = ti.t - (T - 2);
      float* dst = ti.sample ? P.out + OUT_CAS + ((long)(l * 8 + ti.seq) * 2 + r) * 1024 + c
                             : P.out + OUT_CAP + ((long)(l * 4 + ti.seq) * 2 + r) * 1024 + c;
      *reinterpret_cast<float4*>(dst) = make_float4(pk[2][0], pk[2][1], pk[2][2], pk[2][3]);
    }
  }
  float xk[4][4];
#pragma unroll
  for (int k = 0; k < 4; ++k) {
    int tt = ti.t - 3 + k;
    if (tt >= 0) {
      load4bf(z + (long)(lt - 3 + k) * NCOL + 3072 + c, xk[k]);
    } else if (ti.sample) {
      float4 v = *reinterpret_cast<const float4*>(P.in[3] + ((long)(l * 8 + ti.seq) * 3 + (tt + 3)) * 1024 + c);
      xk[k][0] = v.x; xk[k][1] = v.y; xk[k][2] = v.z; xk[k][3] = v.w;
    } else {
#pragma unroll
      for (int i = 0; i < 4; ++i) xk[k][i] = 0.f;
    }
  }
  {
    const float* w = P.in[9] + (long)l * 4 * 1024 + c;
    const float* bb = P.in[10] + (long)l * 1024 + c;
    float o[4];
#pragma unroll
    for (int i = 0; i < 4; ++i)
      o[i] = w[i] * xk[0][i] + w[1024 + i] * xk[1][i] + w[2048 + i] * xk[2][i] + w[3072 + i] * xk[3][i] + bb[i];
    store4bf((bfu*)(P.ws + O_CB) + (long)lt * 1024 + c, o);
    if (ti.t >= T - 3) {
      int r = ti.t - (T - 3);
      float* dst = ti.sample ? P.out + OUT_CBS + ((long)(l * 8 + ti.seq) * 3 + r) * 1024 + c
                             : P.out + OUT_CBP + ((long)(l * 4 + ti.seq) * 3 + r) * 1024 + c;
      *reinterpret_cast<float4*>(dst) = make_float4(xk[3][0], xk[3][1], xk[3][2], xk[3][3]);
    }
  }
}

struct ChunkInfo { int lt0, L, sample, seqi, c; };
DEVI ChunkInfo chunkinfo(int ck) {
  ChunkInfo r;
  if (ck < 128) { r.seqi = ck >> 6; r.c = ck & 63; r.lt0 = r.seqi * 4096 + r.c * 64; r.L = 64; r.sample = 0; }
  else { r.seqi = ck - 128; r.c = 0; r.lt0 = 8192 + r.seqi * 32; r.L = 32; r.sample = 1; }
  return r;
}

DEVI void h1_item(const Params& P, int l, int ck, int h, char* smem, int tid) {
  const ChunkInfo ci = chunkinfo(ck);
  const int lane = tid & 63, w = tid >> 6, fr = lane & 15, fq = lane >> 4;
  bfu* VT = (bfu*)smem;
  bfu* KT = VT + 128 * 72;
  float* tots = (float*)(smem + 36864);
  float* decl = tots + 256;
  const int d = tid & 127, hf = tid >> 7, L = ci.L, Lh = L >> 1;
  const float lb = ((const float*)(P.ws + O_LBS))[l * 1024 + h * 128 + d];
  const bfu* Z = (const bfu*)(P.ws + O_Z);
  const bfu* zf = Z + (long)ci.lt0 * NCOL + 6 * 1024 + h * 128 + d;
  const bfu* zi = Z + (long)ci.lt0 * NCOL + 7 * 1024 + h * 128 + d;
  __syncthreads();
  float tot = 0.f;
#pragma unroll 8
  for (int s = hf * Lh; s < hf * Lh + Lh; ++s) {
    float f = lb + (1.f - lb) * sigmoidf_(b2f(zf[(long)s * NCOL]));
    tot += __logf(f);
  }
  tots[hf * 128 + d] = tot;
  __syncthreads();
  float run = hf ? 0.f : tots[128 + d];
#pragma unroll 8
  for (int s = hf * Lh + Lh - 1; s >= hf * Lh; --s) {
    float f = lb + (1.f - lb) * sigmoidf_(b2f(zf[(long)s * NCOL]));
    KT[d * 72 + s] = f2b((1.f - f) * __expf(run));
    VT[d * 72 + s] = zi[(long)s * NCOL];
    run += __logf(f);
  }
  if (L == 32) {
    for (int s = 32 + hf * 16; s < 48 + hf * 16; ++s) { KT[d * 72 + s] = 0; VT[d * 72 + s] = 0; }
  }
  if (hf == 0) {
    float dc = __expf(tots[d] + tots[128 + d]);
    decl[d] = dc;
    if (!ci.sample) ((float*)(P.ws + O_DEC))[((ci.seqi * 8 + h) * 64 + ci.c) * 128 + d] = dc;
  }
  __syncthreads();
  f32x4 acc[2][8];
#pragma unroll
  for (int mi = 0; mi < 2; ++mi)
#pragma unroll
    for (int n = 0; n < 8; ++n) acc[mi][n] = f32x4{0.f, 0.f, 0.f, 0.f};
#pragma unroll
  for (int kk = 0; kk < 2; ++kk) {
    bf16x8 a[2];
#pragma unroll
    for (int mi = 0; mi < 2; ++mi) a[mi] = *reinterpret_cast<const bf16x8*>(VT + ((2 * w + mi) * 16 + fr) * 72 + kk * 32 + fq * 8);
#pragma unroll
    for (int n = 0; n < 8; ++n) {
      bf16x8 b = *reinterpret_cast<const bf16x8*>(KT + (n * 16 + fr) * 72 + kk * 32 + fq * 8);
#pragma unroll
      for (int mi = 0; mi < 2; ++mi) acc[mi][n] = __builtin_amdgcn_mfma_f32_16x16x32_bf16(a[mi], b, acc[mi][n], 0, 0, 0);
    }
  }
  if (!ci.sample) {
    bfu* US = (bfu*)(P.ws + O_US) + ((long)((ci.seqi * 8 + h) * 64 + ci.c) << 14);
#pragma unroll
    for (int mi = 0; mi < 2; ++mi) {
      __builtin_amdgcn_sched_barrier(0);
      bfu* bp = US + ((2 * w + mi) * 16 + fq * 4) * 128 + fr;
#pragma unroll
      for (int n = 0; n < 8; ++n)
#pragma unroll
        for (int j = 0; j < 4; ++j) bp[j * 128 + n * 16] = f2b(acc[mi][n][j]);
    }
  } else {
    long sb = ((long)((l * 8 + ci.seqi) * 8 + h)) << 14;
    const float* S0 = P.in[5] + sb;
    float* So = P.out + OUT_HGS + sb;
#pragma unroll
    for (int mi = 0; mi < 2; ++mi)
#pragma unroll
      for (int n = 0; n < 8; ++n) {
        __builtin_amdgcn_sched_barrier(0);
        int e0 = (2 * w + mi) * 16 + fq * 4, dd = n * 16 + fr;
        float4 s0 = *reinterpret_cast<const float4*>(S0 + dd * 128 + e0);
        float dcl = decl[dd];
        float4 r;
        r.x = dcl * s0.x + acc[mi][n][0]; r.y = dcl * s0.y + acc[mi][n][1];
        r.z = dcl * s0.z + acc[mi][n][2]; r.w = dcl * s0.w + acc[mi][n][3];
        *reinterpret_cast<float4*>(So + dd * 128 + e0) = r;
      }
  }
}

DEVI void phase2(const Params& P, int l, int pass, char* smem) {
  const int tid = ltid();
  const int ntok = pass ? 8192 : 8448, base = pass ? 8448 : 0;
  const int nck = pass ? 128 : 136;
  const int nH = nck * 8;
  const int total = nH + ntok;
  for (int id = blockIdx.x; id < total; id += gridDim.x) {
    if (id < nH) h1_item(P, l, id >> 3, id & 7, smem, tid);
    else mixab_row(P, l, base, id - nH, tid);
  }
}

DEVI void gate_tile(const Params& P, int l, int pm, int nb, char* smem, int tid) {
  const bfu* cb = (const bfu*)(P.ws + O_CB);
  const bfu* A = cb + (long)pm * 128 * 1024 + nb * 128;
  const bfu* B1 = (const bfu*)(P.ws + O_LRU) + nb * 16384;
  const bfu* B2 = B1 + 8 * 16384;
  float* au0 = (float*)(P.ws + O_AU);
  float* au1 = au0 + (long)8448 * 1024;
  const float* ba = P.in[12] + l * 1024;
  const float* bx = P.in[14] + l * 1024;
  const float* lam = P.in[15] + l * 1024;
  {
    f32x4 acc[4][4]; ZERO_ACC(acc);
    gemm_core(acc, A, 1024, B1, 128, 128, smem, tid);
    EPI_LOOP {
      int row = pm * 128 + EPI_ROW, col = nb * 128 + EPI_COL;
      float r = sigmoidf_(acc[m][n][j] + ba[col]);
      float sp = log1pf(__expf(-lam[col]));
      au0[(long)row * 1024 + col] = -8.f * r * sp;
    }
  }
  asm volatile("" : "+s"(pm), "+s"(nb));
  {
    f32x4 acc[4][4]; ZERO_ACC(acc);
    gemm_core(acc, A, 1024, B2, 128, 128, smem, tid);
    EPI_LOOP {
      int row = pm * 128 + EPI_ROW, col = nb * 128 + EPI_COL;
      float gi = sigmoidf_(acc[m][n][j] + bx[col]);
      float la = au0[(long)row * 1024 + col];
      float a = __expf(la);
      float mult = sqrtf(fmaxf(1.f - a * a, 0.f));
      float xv = b2f(cb[(long)row * 1024 + col]);
      au0[(long)row * 1024 + col] = a;
      au1[(long)row * 1024 + col] = mult * gi * xv;
    }
  }
}
DEVI void h2_item(const Params& P, int l, int pass, int item, int tid) {
  const int sh = item >> 6, blk = item & 63;
  const int idx = blk * 256 + tid, e = idx >> 7, d = idx & 127;
  bfu* US = (bfu*)(P.ws + O_US) + ((long)sh * 64 << 14) + idx;
  const float* dec = (const float*)(P.ws + O_DEC) + (long)sh * 64 * 128 + d;
  float S = 0.f;
  for (int c0 = 0; c0 < 64; c0 += 8) {
    float u[8], dc[8];
#pragma unroll
    for (int i = 0; i < 8; ++i) { u[i] = b2f(US[(long)(c0 + i) << 14]); dc[i] = dec[(c0 + i) * 128]; }
#pragma unroll
    for (int i = 0; i < 8; ++i) { US[(long)(c0 + i) << 14] = f2b(S); S = dc[i] * S + u[i]; }
  }
  const int sl = sh >> 3, h = sh & 7, b = pass * 2 + sl;
  P.out[OUT_HGP + (((long)((l * 4 + b) * 8 + h)) << 14) + d * 128 + e] = S;
}
DEVI void phase3(const Params& P, int l, int pass, char* smem) {
  const int tid = ltid();
  const int ntok = pass ? 8192 : 8448;
  const int nG = (ntok / 128) * 8, nH2 = 1024;
  for (int id = blockIdx.x; id < nG + nH2; id += gridDim.x) {
    if (id < nG) gate_tile(P, l, id >> 3, id & 7, smem, tid);
    else h2_item(P, l, pass, id - nG, tid);
  }
}

DEVI void lsum_item(const Params& P, int tile, int cg4, int tid) {
  const int w = tid >> 6, lane = tid & 63;
  const int ch = (cg4 * 4 + w) * 64 + lane;
  const float* a0 = (const float*)(P.ws + O_AU) + (long)tile * 128 * 1024 + ch;
  const float* u0 = a0 + (long)8448 * 1024;
  float A = 1.f, H = 0.f;
  for (int r0 = 0; r0 < 128; r0 += 16) {
    float av[16], uv[16];
#pragma unroll
    for (int i = 0; i < 16; ++i) { av[i] = a0[(long)(r0 + i) * 1024]; uv[i] = u0[(long)(r0 + i) * 1024]; }
#pragma unroll
    for (int i = 0; i < 16; ++i) { H = av[i] * H + uv[i]; A *= av[i]; }
  }
  float* ls = (float*)(P.ws + O_LSUM) + (long)tile * 2048;
  ls[ch] = A; ls[1024 + ch] = H;
}

DEVI void h3_item(const Params& P, int l, int ck, int h, char* smem, int tid) {
  const ChunkInfo ci = chunkinfo(ck);
  const int lane = tid & 63, w = tid >> 6, fr = lane & 15, fq = lane >> 4;
  bfu* QT = (bfu*)smem;
  bfu* KT = QT + 64 * 136;
  bfu* AT = KT + 64 * 136;
  bfu* BS = AT + 64 * 72;
  float* bmid = (float*)(BS + 128 * 72);
  const int d = tid & 127, hf = tid >> 7, L = ci.L, Lh = L >> 1;
  const float lb = ((const float*)(P.ws + O_LBS))[l * 1024 + h * 128 + d];
  const bfu* Z = (const bfu*)(P.ws + O_Z);
  const bfu* zq = Z + (long)ci.lt0 * NCOL + 5 * 1024 + h * 128 + d;
  const bfu* zf = zq + 1024;
  const bfu* zi = zq + 2048;
  __syncthreads();
  if (hf == 0) {
    float rel = 0.f;
#pragma unroll 8
    for (int t = Lh - 1; t >= 0; --t) {
      float f = lb + (1.f - lb) * sigmoidf_(b2f(zf[(long)t * NCOL]));
      float q = siluf_(b2f(zq[(long)t * NCOL]));
      QT[t * 136 + d] = f2b(q * __expf(fminf(rel, 80.f)));
      KT[t * 136 + d] = f2b((1.f - f) * __expf(-rel));
      rel -= __logf(f);
    }
    bmid[d] = -rel;
  } else {
    float rel = 0.f;
#pragma unroll 8
    for (int t = Lh; t < L; ++t) {
      float f = lb + (1.f - lb) * sigmoidf_(b2f(zf[(long)t * NCOL]));
      float q = siluf_(b2f(zq[(long)t * NCOL]));
      rel += __logf(f);
      QT[t * 136 + d] = f2b(q * __expf(rel));
      KT[t * 136 + d] = f2b((1.f - f) * __expf(fminf(-rel, 80.f)));
    }
  }
  if (L == 32) {
    for (int t = 32 + hf * 16; t < 48 + hf * 16; ++t) { QT[t * 136 + d] = 0; KT[t * 136 + d] = 0; }
  }
#pragma unroll 8
  for (int s = hf * 32; s < hf * 32 + 32; ++s) BS[d * 72 + s] = (s < L) ? zi[(long)s * NCOL] : (bfu)0;
  __syncthreads();
  bf16x8 aq[4];
#pragma unroll
  for (int kk = 0; kk < 4; ++kk) aq[kk] = *reinterpret_cast<const bf16x8*>(QT + (16 * w + fr) * 136 + kk * 32 + fq * 8);
  {
    f32x4 sa[4];
#pragma unroll
    for (int n = 0; n < 4; ++n) sa[n] = f32x4{0.f, 0.f, 0.f, 0.f};
#pragma unroll
    for (int kk = 0; kk < 4; ++kk)
#pragma unroll
      for (int n = 0; n < 4; ++n) {
        bf16x8 bk = *reinterpret_cast<const bf16x8*>(KT + (n * 16 + fr) * 136 + kk * 32 + fq * 8);
        sa[n] = __builtin_amdgcn_mfma_f32_16x16x32_bf16(aq[kk], bk, sa[n], 0, 0, 0);
      }
#pragma unroll
    for (int n = 0; n < 4; ++n)
#pragma unroll
      for (int j = 0; j < 4; ++j) {
        int t = 16 * w + fq * 4 + j, s = n * 16 + fr;
        AT[t * 72 + s] = (s <= t) ? f2b(sa[n][j]) : (bfu)0;
      }
  }
  __syncthreads();
  f32x4 o[8];
#pragma unroll
  for (int n = 0; n < 8; ++n) o[n] = f32x4{0.f, 0.f, 0.f, 0.f};
#pragma unroll
  for (int kk = 0; kk < 2; ++kk) {
    bf16x8 a = *reinterpret_cast<const bf16x8*>(AT + (16 * w + fr) * 72 + kk * 32 + fq * 8);
#pragma unroll
    for (int n = 0; n < 8; ++n) {
      bf16x8 b = *reinterpret_cast<const bf16x8*>(BS + (n * 16 + fr) * 72 + kk * 32 + fq * 8);
      o[n] = __builtin_amdgcn_mfma_f32_16x16x32_bf16(a, b, o[n], 0, 0, 0);
    }
  }
#pragma unroll
  for (int sl = 0; sl < 2; ++sl) {
    __syncthreads();
    if (!ci.sample) {
      const bfu* src = (const bfu*)(P.ws + O_US) + ((long)((ci.seqi * 8 + h) * 64 + ci.c) << 14);
      int e2 = tid >> 1, dd0 = (tid & 1) * 32;
#pragma unroll
      for (int q4 = 0; q4 < 4; ++q4) {
        uint4 v = *reinterpret_cast<const uint4*>(src + e2 * 128 + sl * 64 + dd0 + q4 * 8);
        const float* bm = bmid + sl * 64 + dd0 + q4 * 8;
        unsigned vv[4] = {v.x, v.y, v.z, v.w};
        unsigned rr[4];
#pragma unroll
        for (int i = 0; i < 4; ++i) {
          float lo = __uint_as_float(vv[i] << 16) * __expf(bm[2 * i]);
          float hi = __uint_as_float(vv[i] & 0xFFFF0000u) * __expf(bm[2 * i + 1]);
          rr[i] = f2b(lo) | ((unsigned)f2b(hi) << 16);
        }
        *reinterpret_cast<uint4*>(BS + e2 * 72 + dd0 + q4 * 8) = make_uint4(rr[0], rr[1], rr[2], rr[3]);
      }
    } else {
      const float* S0 = P.in[5] + (((long)((l * 8 + ci.seqi) * 8 + h)) << 14);
#pragma unroll 4
      for (int dd = hf * 32; dd < hf * 32 + 32; ++dd)
        BS[d * 72 + dd] = f2b(S0[(sl * 64 + dd) * 128 + d] * __expf(bmid[sl * 64 + dd]));
    }
    __syncthreads();
#pragma unroll
    for (int kk = 0; kk < 2; ++kk) {
#pragma unroll
      for (int n = 0; n < 8; ++n) {
        bf16x8 b = *reinterpret_cast<const bf16x8*>(BS + (n * 16 + fr) * 72 + kk * 32 + fq * 8);
        o[n] = __builtin_amdgcn_mfma_f32_16x16x32_bf16(aq[sl * 2 + kk], b, o[n], 0, 0, 0);
      }
    }
  }
  float rinv[4];
#pragma unroll
  for (int j = 0; j < 4; ++j) {
    float ss = 0.f;
#pragma unroll
    for (int n = 0; n < 8; ++n) ss += o[n][j] * o[n][j];
    ss += __shfl_xor(ss, 1); ss += __shfl_xor(ss, 2); ss += __shfl_xor(ss, 4); ss += __shfl_xor(ss, 8);
    rinv[j] = rsqrtf(ss * (1.f / 128.f) + 1e-6f);
  }
  const float* ng = P.in[17] + l * 128;
  bfu* UC = (bfu*)(P.ws + O_UC);
#pragma unroll
  for (int n = 0; n < 8; ++n)
#pragma unroll
    for (int j = 0; j < 4; ++j) {
      int t = 16 * w + fq * 4 + j, e = n * 16 + fr;
      if (t < L) {
        float g = b2f(Z[(long)(ci.lt0 + t) * NCOL + 8 * 1024 + h * 128 + e]);
        UC[(long)(ci.lt0 + t) * 1024 + h * 128 + e] = f2b(o[n][j] * rinv[j] * ng[e] * siluf_(g));
      }
    }
}
DEVI void phase4(const Params& P, int l, int pass, char* smem) {
  const int tid = ltid();
  const int nck = pass ? 128 : 136;
  const int nH = nck * 8;
  const int nL = 64 * 4;
  for (int id = blockIdx.x; id < nH + nL; id += gridDim.x) {
    if (id < nH) h3_item(P, l, id >> 3, id & 7, smem, tid);
    else { int q = id - nH; lsum_item(P, q >> 2, q & 3, tid); }
  }
}

DEVI void phase5(const Params& P, int l, int pass) {
  const int tid = ltid();
  const int ntok = pass ? 8192 : 8448, base = pass ? 8448 : 0;
  const int nItems = (ntok / 128) * 4;
  const int w = tid >> 6, lane = tid & 63;
  const float* AU0 = (const float*)(P.ws + O_AU);
  const float* AU1 = AU0 + (long)8448 * 1024;
  const float* LS = (const float*)(P.ws + O_LSUM);
  const bfu* Z = (const bfu*)(P.ws + O_Z);
  bfu* UB = (bfu*)(P.ws + O_UB);
  for (int id = blockIdx.x; id < nItems; id += gridDim.x) {
    const int tile = id >> 2, ch = ((id & 3) * 4 + w) * 64 + lane;
    const int lt0 = tile * 128;
    const TokInfo t0 = tokinfo(base + lt0);
    float hcur = 0.f;
    if (!t0.sample) {
      int jf = tile - (t0.t >> 7);
#pragma unroll 4
      for (int i = jf; i < tile; ++i) hcur = LS[(long)i * 2048 + ch] * hcur + LS[(long)i * 2048 + 1024 + ch];
    }
    for (int r0 = 0; r0 < 128; r0 += 8) {
      float av[8], uv[8], gv[8];
#pragma unroll
      for (int i = 0; i < 8; ++i) {
        long row = lt0 + r0 + i;
        av[i] = AU0[row * 1024 + ch]; uv[i] = AU1[row * 1024 + ch];
        gv[i] = b2f(Z[row * NCOL + 4 * 1024 + ch]);
      }
#pragma unroll
      for (int i = 0; i < 8; ++i) {
        int r = r0 + i;
        if (t0.sample && (r & 31) == 0) hcur = P.in[4][(long)(l * 8 + t0.seq + (r >> 5)) * 1024 + ch];
        hcur = av[i] * hcur + uv[i];
        UB[(long)(lt0 + r) * 1024 + ch] = f2b(geluf_(gv[i]) * hcur);
        if (t0.sample && (r & 31) == 31) P.out[OUT_LRS + (long)(l * 8 + t0.seq + (r >> 5)) * 1024 + ch] = hcur;
      }
    }
    if (!t0.sample && t0.t + 128 == 4096) P.out[OUT_LRP + (long)(l * 4 + t0.seq) * 1024 + ch] = hcur;
  }
}

template <int BR>
DEVI void p6_branch(const Params& P, int pm, int pn, float* macc, char* smem, int tid) {
  asm volatile("" : "+s"(pm), "+s"(pn));
  const bfu* Z = (const bfu*)(P.ws + O_Z);
  bfu* M = (bfu*)(P.ws + O_CB);
  const bfu* A = (const bfu*)(P.ws + (BR == 0 ? O_UA : BR == 1 ? O_UB : O_UC)) + (long)pm * 128 * 1024;
  const bfu* B = (const bfu*)(P.ws + (BR == 0 ? O_WOA : BR == 1 ? O_WOB : O_WOC)) + (long)pn * 128 * 1024;
  f32x4 acc[4][4]; ZERO_ACC(acc);
  gemm_core(acc, A, 1024, B, 1024, 1024, smem, tid);
  EPI_LOOP {
    int row = pm * 128 + EPI_ROW, col = pn * 128 + EPI_COL;
    float g = sigmoidf_(b2f(Z[(long)row * NCOL + (9 + BR) * 1024 + col]));
    float v = g * acc[m][n][j];
    if (BR > 0) v += macc[(long)row * 1024 + col];
    if (BR < 2) macc[(long)row * 1024 + col] = v;
    else M[(long)row * 1024 + col] = f2b(v);
  }
}
DEVI void phase6(const Params& P, int l, int pass, char* smem) {
  const int tid = ltid();
  const int ntok = pass ? 8192 : 8448;
  const int nM = ntok / 128, nN = 8;
  const bfu* Z = (const bfu*)(P.ws + O_Z);
  bfu* M = (bfu*)(P.ws + O_CB);
  for (int id = blockIdx.x; id < nM * nN; id += gridDim.x) {
    int pm = id >> 3, pn = id & 7;
    float* macc = (float*)(P.ws + O_AU);
    p6_branch<0>(P, pm, pn, macc, smem, tid);
    p6_branch<1>(P, pm, pn, macc, smem, tid);
    p6_branch<2>(P, pm, pn, macc, smem, tid);
  }
}

DEVI void phase7(const Params& P, int l, int pass, char* smem) {
  const int tid = ltid();
  const int ntok = pass ? 8192 : 8448, base = pass ? 8448 : 0;
  const int nM = ntok / 128, nN = 8;
  const bfu* M = (const bfu*)(P.ws + O_CB);
  const bfu* W = (const bfu*)(P.ws + O_WO);
  float* pre = (float*)(P.ws + O_PRE);
  for (int id = blockIdx.x; id < nM * nN; id += gridDim.x) {
    int pm = id >> 3, pn = id & 7;
    f32x4 acc[4][4]; ZERO_ACC(acc);
    gemm_core(acc, M + (long)pm * 128 * 1024, 1024, W + (long)pn * 128 * 1024, 1024, 1024, smem, tid);
    EPI_LOOP {
      int row = pm * 128 + EPI_ROW, col = pn * 128 + EPI_COL;
      const float* xr = xrow(P, base + row);
      pre[(long)row * 1024 + col] = ALPHA * xr[col] + acc[m][n][j];
    }
  }
}

DEVI void phase8(const Params& P, int l, int pass) {
  const int tid = ltid();
  const int ntok = pass ? 8192 : 8448, base = pass ? 8448 : 0;
  const int w = tid >> 6, lane = tid & 63;
  const float* pre = (const float*)(P.ws + O_PRE);
  const float* g = P.in[22] + l * 1024;
  const float* b = P.in[23] + l * 1024;
  bfu* xb = (bfu*)(P.ws + O_XB);
  for (int id = blockIdx.x; id < ntok / 4; id += gridDim.x) {
    int lt = id * 4 + w, it = base + lt;
    const float* src = pre + (long)lt * 1024;
    float v[16];
#pragma unroll
    for (int q = 0; q < 4; ++q) {
      float4 t = *reinterpret_cast<const float4*>(src + q * 256 + lane * 4);
      v[q * 4] = t.x; v[q * 4 + 1] = t.y; v[q * 4 + 2] = t.z; v[q * 4 + 3] = t.w;
    }
    float s = 0.f;
#pragma unroll
    for (int i = 0; i < 16; ++i) s += v[i];
    float mu = wave_sum(s) * (1.f / 1024.f);
    float ss = 0.f;
#pragma unroll
    for (int i = 0; i < 16; ++i) { float dlt = v[i] - mu; ss += dlt * dlt; }
    float rs = rsqrtf(wave_sum(ss) * (1.f / 1024.f) + 1e-5f);
    float* xr = xrow(P, it);
#pragma unroll
    for (int q = 0; q < 4; ++q) {
      int c = q * 256 + lane * 4;
      float o[4];
#pragma unroll
      for (int i = 0; i < 4; ++i) o[i] = (v[q * 4 + i] - mu) * rs * g[c + i] + b[c + i];
      *reinterpret_cast<float4*>(xr + c) = make_float4(o[0], o[1], o[2], o[3]);
      store4bf(xb + (long)it * 1024 + c, o);
    }
  }
}

DEVI void phase9(const Params& P, int l, int pass, char* smem) {
  const int tid = ltid();
  const int ntok = pass ? 8192 : 8448, base = pass ? 8448 : 0;
  const int nM = ntok / 128, nN = 16;
  const bfu* xb = (const bfu*)(P.ws + O_XB) + (long)base * 1024;
  const bfu* W = (const bfu*)(P.ws + O_WQ);
  bfu* qp = (bfu*)(P.ws + O_QP);
  for (int id = blockIdx.x; id < nM * nN; id += gridDim.x) {
    int pm, pn; tile_rc(id, nM, nN, pm, pn);
    f32x4 acc[4][4]; ZERO_ACC(acc);
    gemm_core(acc, xb + (long)pm * 128 * 1024, 1024, W + (long)pn * 128 * 1024, 1024, 1024, smem, tid);
    EPI_LOOP {
      int row = pm * 128 + EPI_ROW, col = pn * 128 + EPI_COL;
      qp[(long)row * 2048 + col] = f2b(acc[m][n][j]);
    }
  }
}
DEVI void phase10(const Params& P, int l, int pass, char* smem) {
  const int tid = ltid();
  const int ntok = pass ? 8192 : 8448;
  const int nM = ntok / 128, nN = 16;
  const bfu* qp = (const bfu*)(P.ws + O_QP);
  const bfu* KB = (const bfu*)(P.ws + O_KEYS);
  float* sc = (float*)(P.ws + O_SC);
  for (int id = blockIdx.x; id < nM * nN; id += gridDim.x) {
    int pm = id >> 4, pn = id & 15;
    f32x4 acc[4][4]; ZERO_ACC(acc);
    gemm_core(acc, qp + (long)pm * 128 * 2048 + pn * 128, 2048, KB + (long)pn * 16384, 128, 128, smem, tid);
    EPI_LOOP {
      int row = pm * 128 + EPI_ROW, col = pn * 128 + EPI_COL;
      sc[(long)row * 2048 + col] = acc[m][n][j];
    }
  }
}

DEVI unsigned fkey(float f) {
  unsigned u = __float_as_uint(f);
  return (u & 0x80000000u) ? ~u : (u | 0x80000000u);
}
DEVI void dec16(uint4 v, f32x2 (&o)[8]) {
  o[0] = __builtin_amdgcn_cvt_pk_f32_fp8((int)v.x, false); o[1] = __builtin_amdgcn_cvt_pk_f32_fp8((int)v.x, true);
  o[2] = __builtin_amdgcn_cvt_pk_f32_fp8((int)v.y, false); o[3] = __builtin_amdgcn_cvt_pk_f32_fp8((int)v.y, true);
  o[4] = __builtin_amdgcn_cvt_pk_f32_fp8((int)v.z, false); o[5] = __builtin_amdgcn_cvt_pk_f32_fp8((int)v.z, true);
  o[6] = __builtin_amdgcn_cvt_pk_f32_fp8((int)v.w, false); o[7] = __builtin_amdgcn_cvt_pk_f32_fp8((int)v.w, true);
}
DEVI void phase11(const Params& P, int l, int pass, char* smem) {
  const int ntok = pass ? 8192 : 8448, base = pass ? 8448 : 0;
  const int tid = ltid(); const int w = tid >> 6, lane = tid & 63;
  float* scl = (float*)smem;
  float* sv = scl + 2048;
  int* si = (int*)(sv + 256);
  float* tops = (float*)(si + 256);
  int* tope = (int*)(tops + 128);
  float* wgt = (float*)(tope + 128);
  float* dotv = wgt + 128;
  float* red = dotv + 128;
  float* stat = red + 4096;
  const float* SC = (const float*)(P.ws + O_SC);
  const unsigned char* UT = (const unsigned char*)(P.ws + O_UTB);
  const unsigned char* VTb = (const unsigned char*)(P.ws + O_VTB);
  const float* g2 = P.in[28] + l * 1024;
  const float* b2 = P.in[29] + l * 1024;
  bfu* xb = (bfu*)(P.ws + O_XB);
  const unsigned long long ltmask = (1ull << lane) - 1ull;
  for (int lt = blockIdx.x; lt < ntok; lt += gridDim.x) {
    const int it = base + lt;
    float* xr = xrow(P, it);
    __syncthreads();
    {
      const float4* s4 = reinterpret_cast<const float4*>(SC + (long)lt * 2048);
      reinterpret_cast<float4*>(scl)[tid] = s4[tid];
      reinterpret_cast<float4*>(scl)[tid + 256] = s4[tid + 256];
    }
    __syncthreads();
    {
      float v0[4], v1[4]; unsigned k0[4], k1[4], T[4];
#pragma unroll
      for (int li = 0; li < 4; ++li) {
        const int Lx = w * 4 + li;
        v0[li] = scl[Lx * 128 + lane]; v1[li] = scl[Lx * 128 + 64 + lane];
        k0[li] = fkey(v0[li]); k1[li] = fkey(v1[li]); T[li] = 0;
      }
      for (int b = 31; b >= 0; --b) {
#pragma unroll
        for (int li = 0; li < 4; ++li) {
          unsigned cand = T[li] | (1u << b);
          int cnt = __popcll(__ballot(k0[li] >= cand)) + __popcll(__ballot(k1[li] >= cand));
          if (cnt >= 16) T[li] = cand;
        }
      }
#pragma unroll
      for (int li = 0; li < 4; ++li) {
        const int Lx = w * 4 + li;
        bool s0 = k0[li] >= T[li], s1 = k1[li] >= T[li];
        unsigned long long m0 = __ballot(s0), m1 = __ballot(s1);
        int p0 = __popcll(m0 & ltmask), p1 = __popcll(m0) + __popcll(m1 & ltmask);
        if (s0 && p0 < 16) { sv[Lx * 16 + p0] = v0[li]; si[Lx * 16 + p0] = lane; }
        if (s1 && p1 < 16) { sv[Lx * 16 + p1] = v1[li]; si[Lx * 16 + p1] = lane + 64; }
      }
    }
    __syncthreads();
    {
      float cv[2][4]; unsigned ck[2][4], T[2];
#pragma unroll
      for (int hi = 0; hi < 2; ++hi) {
        const int h = w * 2 + hi;
        T[hi] = 0;
#pragma unroll
        for (int r = 0; r < 4; ++r) {
          int c = lane + 64 * r;
          cv[hi][r] = sv[(2 * h) * 16 + (c >> 4)] + sv[(2 * h + 1) * 16 + (c & 15)];
          ck[hi][r] = fkey(cv[hi][r]);
        }
      }
      for (int b = 31; b >= 0; --b) {
#pragma unroll
        for (int hi = 0; hi < 2; ++hi) {
          unsigned cand = T[hi] | (1u << b);
          int cnt = 0;
#pragma unroll
          for (int r = 0; r < 4; ++r) cnt += __popcll(__ballot(ck[hi][r] >= cand));
          if (cnt >= 16) T[hi] = cand;
        }
      }
#pragma unroll
      for (int hi = 0; hi < 2; ++hi) {
        const int h = w * 2 + hi;
        int basec = 0;
#pragma unroll
        for (int r = 0; r < 4; ++r) {
          bool s = ck[hi][r] >= T[hi];
          unsigned long long mm = __ballot(s);
          int p = basec + __popcll(mm & ltmask);
          if (s && p < 16) {
            int c = lane + 64 * r;
            tops[h * 16 + p] = cv[hi][r];
            tope[h * 16 + p] = si[(2 * h) * 16 + (c >> 4)] * 128 + si[(2 * h + 1) * 16 + (c & 15)];
          }
          basec += __popcll(mm);
        }
      }
    }
    __syncthreads();
    if (tid < 128) {
      float s = tops[tid];
      float mx = s;
      mx = fmaxf(mx, __shfl_xor(mx, 1)); mx = fmaxf(mx, __shfl_xor(mx, 2));
      mx = fmaxf(mx, __shfl_xor(mx, 4)); mx = fmaxf(mx, __shfl_xor(mx, 8));
      float e = __expf(s - mx);
      float sm = e;
      sm += __shfl_xor(sm, 1); sm += __shfl_xor(sm, 2); sm += __shfl_xor(sm, 4); sm += __shfl_xor(sm, 8);
      tops[tid] = e / sm;
    }
    __syncthreads();
    f32x2 xv[8];
    {
      const float4* xp = reinterpret_cast<const float4*>(xr + lane * 16);
#pragma unroll
      for (int q = 0; q < 4; ++q) {
        float4 a = xp[q];
        xv[2 * q] = f32x2{a.x, a.y}; xv[2 * q + 1] = f32x2{a.z, a.w};
      }
    }
    f32x2 oacc[8];
#pragma unroll
    for (int q = 0; q < 8; ++q) oacc[q] = f32x2{0.f, 0.f};
#pragma unroll 1
    for (int p0 = 0; p0 < 32; p0 += 8) {
      uint4 ru[8], rv[8];
#pragma unroll
      for (int i = 0; i < 8; ++i) {
        int e = tope[w * 32 + p0 + i];
        ru[i] = *reinterpret_cast<const uint4*>(UT + (long)e * 1024 + lane * 16);
        rv[i] = *reinterpret_cast<const uint4*>(VTb + (long)e * 1024 + lane * 16);
      }
      float dsum[8];
#pragma unroll
      for (int i = 0; i < 8; ++i) {
        f32x2 f[8];
        dec16(ru[i], f);
        f32x2 acc = f[0] * xv[0];
#pragma unroll
        for (int q = 1; q < 8; ++q) acc = __builtin_elementwise_fma(f[q], xv[q], acc);
        dsum[i] = acc.x + acc.y;
      }
      float e4[4], e2[2], e1;
      {
        const bool hi = (lane & 32) != 0;
#pragma unroll
        for (int i = 0; i < 4; ++i) {
          float snd = hi ? dsum[i] : dsum[i + 4];
          float kp = hi ? dsum[i + 4] : dsum[i];
          e4[i] = kp + __shfl_xor(snd, 32);
        }
        const bool hi2 = (lane & 16) != 0;
#pragma unroll
        for (int i = 0; i < 2; ++i) {
          float snd = hi2 ? e4[i] : e4[i + 2];
          float kp = hi2 ? e4[i + 2] : e4[i];
          e2[i] = kp + __shfl_xor(snd, 16);
        }
        const bool hi3 = (lane & 8) != 0;
        {
          float snd = hi3 ? e2[0] : e2[1];
          float kp = hi3 ? e2[1] : e2[0];
          e1 = kp + __shfl_xor(snd, 8);
        }
        e1 += __shfl_xor(e1, 4); e1 += __shfl_xor(e1, 2); e1 += __shfl_xor(e1, 1);
      }
      {
        int r = ((lane >> 5) & 1) * 4 + ((lane >> 4) & 1) * 2 + ((lane >> 3) & 1);
        float wv_ = tops[w * 32 + p0 + r] * geluf_(e1 * (1.f / U_SCALE)) * (1.f / V_SCALE);
        if ((lane & 7) == 0) wgt[w * 32 + p0 + r] = wv_;
      }
      __builtin_amdgcn_wave_barrier();
      float wg[8];
      {
        float4 wa = *reinterpret_cast<const float4*>(wgt + w * 32 + p0);
        float4 wb = *reinterpret_cast<const float4*>(wgt + w * 32 + p0 + 4);
        wg[0] = wa.x; wg[1] = wa.y; wg[2] = wa.z; wg[3] = wa.w; wg[4] = wb.x; wg[5] = wb.y; wg[6] = wb.z; wg[7] = wb.w;
      }
#pragma unroll
      for (int i = 0; i < 8; ++i) {
        f32x2 f[8];
        dec16(rv[i], f);
        f32x2 wv = f32x2{wg[i], wg[i]};
#pragma unroll
        for (int q = 0; q < 8; ++q) oacc[q] = __builtin_elementwise_fma(f[q], wv, oacc[q]);
      }
    }
    {
      float4* rwp = reinterpret_cast<float4*>(red + w * 1024 + lane * 16);
#pragma unroll
      for (int q = 0; q < 4; ++q) rwp[q] = make_float4(oacc[2 * q].x, oacc[2 * q].y, oacc[2 * q + 1].x, oacc[2 * q + 1].y);
    }
    __syncthreads();
    const int c = tid * 4;
    float y[4];
    {
      float4 xx = *reinterpret_cast<const float4*>(xr + c);
      float4 r0 = *reinterpret_cast<const float4*>(red + c);
      float4 r1 = *reinterpret_cast<const float4*>(red + 1024 + c);
      float4 r2 = *reinterpret_cast<const float4*>(red + 2048 + c);
      float4 r3 = *reinterpret_cast<const float4*>(red + 3072 + c);
      y[0] = ALPHA * xx.x + (r0.x + r1.x + r2.x + r3.x);
      y[1] = ALPHA * xx.y + (r0.y + r1.y + r2.y + r3.y);
      y[2] = ALPHA * xx.z + (r0.z + r1.z + r2.z + r3.z);
      y[3] = ALPHA * xx.w + (r0.w + r1.w + r2.w + r3.w);
    }
    float s = wave_sum(y[0] + y[1] + y[2] + y[3]);
    if (lane == 0) stat[w] = s;
    __syncthreads();
    float mu = (stat[0] + stat[1] + stat[2] + stat[3]) * (1.f / 1024.f);
    float ss = 0.f;
#pragma unroll
    for (int i = 0; i < 4; ++i) { float dl = y[i] - mu; ss += dl * dl; }
    ss = wave_sum(ss);
    if (lane == 0) stat[4 + w] = ss;
    __syncthreads();
    float rs = rsqrtf((stat[4] + stat[5] + stat[6] + stat[7]) * (1.f / 1024.f) + 1e-5f);
    float o[4];
#pragma unroll
    for (int i = 0; i < 4; ++i) o[i] = (y[i] - mu) * rs * g2[c + i] + b2[c + i];
    *reinterpret_cast<float4*>(xr + c) = make_float4(o[0], o[1], o[2], o[3]);
    store4bf(xb + (long)it * 1024 + c, o);
  }
}

#define XB_TMO      128
#define XB_XCNT(j)  (256  + 64 * (j))
#define XB_XSUB(j)  (1280 + 64 * (j))
#define XB_XGEN(j)  (2304 + 64 * (j))
#define XB_TOP      3328
#define XB_TOPGEN   3392
#define XCD_BAR_WORDS 3456
#define XB_SPIN_CAP (1u << 18)
DEVI unsigned xb_ld(unsigned* p) { return __hip_atomic_load(p, __ATOMIC_RELAXED, __HIP_MEMORY_SCOPE_AGENT); }
DEVI unsigned xb_add(unsigned* p, unsigned v) { return __hip_atomic_fetch_add(p, v, __ATOMIC_RELAXED, __HIP_MEMORY_SCOPE_AGENT); }
DEVI unsigned xb_xcc_id() { return (unsigned)__builtin_amdgcn_s_getreg((3 << 11) | 20) & 0xFu; }
#define XB_SPIN(cond, bar) do { unsigned _sp = 0; while (cond) { __builtin_amdgcn_s_sleep(1); \
    if ((++_sp & 255u) == 0u) { if (xb_ld(&(bar)[XB_TMO])) break; if (_sp > XB_SPIN_CAP) { atomicAdd(&(bar)[XB_TMO], 1u); break; } } } } while (0)
DEVI void xcd_census(unsigned* bar, unsigned x, unsigned& nloc, unsigned& nx) {
  const unsigned G = gridDim.x;
  unsigned sum, cnt, mine, sp = 0u;
  for (;;) {
    sum = 0u; cnt = 0u; mine = 0u;
#pragma unroll
    for (unsigned j = 0; j < 16; ++j) { const unsigned c = xb_ld(&bar[XB_XCNT(j)]); sum += c; cnt += (c > 0u) ? 1u : 0u; mine = (j == x) ? c : mine; }
    if (sum == G) break;
    __builtin_amdgcn_s_sleep(1);
    if ((++sp & 255u) == 0u) { if (xb_ld(&bar[XB_TMO])) break; if (sp > XB_SPIN_CAP) { atomicAdd(&bar[XB_TMO], 1u); break; } }
  }
  nloc = mine > 0u ? mine : 1u; nx = cnt > 0u ? cnt : 1u;
}
DEVI void xcd_barrier(unsigned* bar, unsigned x, unsigned nloc, unsigned nx) {
  asm volatile("s_waitcnt vmcnt(0)" ::: "memory");
  __syncthreads();
  if (threadIdx.x == 0) {
    __builtin_amdgcn_s_waitcnt(0);
    const unsigned old = xb_add(&bar[XB_XSUB(x)], 1u);
    const unsigned gen = old / nloc;
    if (old + 1u == (gen + 1u) * nloc) {
      __builtin_amdgcn_fence(__ATOMIC_RELEASE, "agent");
      asm volatile("s_waitcnt vmcnt(0)" ::: "memory");
      const unsigned og = xb_add(&bar[XB_TOP], 1u);
      const unsigned tg = og / nx;
      if (og + 1u == (tg + 1u) * nx) xb_add(&bar[XB_TOPGEN], 1u);
      else XB_SPIN(xb_ld(&bar[XB_TOPGEN]) == tg, bar);
      __builtin_amdgcn_fence(__ATOMIC_ACQUIRE, "agent");
      xb_add(&bar[XB_XGEN(x)], 1u);
      asm volatile("s_waitcnt vmcnt(0)" ::: "memory");
    } else {
      XB_SPIN(xb_ld(&bar[XB_XGEN(x)]) == gen, bar);
      __builtin_amdgcn_fence(__ATOMIC_ACQUIRE, "agent");
      asm volatile("s_waitcnt vmcnt(0)" ::: "memory");
    }
  }
  __syncthreads();
}

__global__ void __launch_bounds__(256, 2) fwd_megakernel(Params P) {
  __shared__ __attribute__((aligned(16))) char smem[65536];
  cg::grid_group grid = cg::this_grid();
  unsigned* bar = (unsigned*)(P.ws + O_BAR);
  const unsigned xcc = xb_xcc_id();
  if (threadIdx.x == 0) (void)xb_add(&bar[XB_XCNT(xcc)], 1u);
  unsigned nloc = 1u, nx = 1u;
#define LND asm volatile("" : "+s"(l), "+s"(pass))
#define GSYNC xcd_barrier(bar, xcc, nloc, nx)
#pragma unroll 1
  for (int l = 0; l < 2; ++l) {
    phase_prep(P, l, smem);
    if (l == 0) {
      phase_xcopy(P);
      grid.sync();
      if (threadIdx.x == 0) xcd_census(bar, xcc, nloc, nx);
    } else {
      GSYNC;
    }
#pragma unroll 1
    for (int pass = 0; pass < 2; ++pass) {
      LND; phase_inproj(P, l, pass, smem); GSYNC;
      LND; phase2(P, l, pass, smem); GSYNC;
      LND; phase3(P, l, pass, smem); GSYNC;
      LND; phase4(P, l, pass, smem); GSYNC;
      LND; phase5(P, l, pass); GSYNC;
      LND; phase6(P, l, pass, smem); GSYNC;
      LND; phase7(P, l, pass, smem); GSYNC;
      LND; phase8(P, l, pass); GSYNC;
      LND; phase9(P, l, pass, smem); GSYNC;
      LND; phase10(P, l, pass, smem); GSYNC;
      LND; phase11(P, l, pass, smem); if (!(l == 1 && pass == 1)) GSYNC;
    }
  }
}

extern "C" void kernel_launch(void* const* d_in, const int* in_sizes, int n_in, void* d_out, int out_size,
                              void* d_ws, size_t ws_size, hipStream_t stream) {
  static int grid_blocks = 0;
  if (!grid_blocks) {
    int dev = 0, cus = 0, per_cu = 0;
    hipGetDevice(&dev);
    hipDeviceGetAttribute(&cus, hipDeviceAttributeMultiprocessorCount, dev);
    hipOccupancyMaxActiveBlocksPerMultiprocessor(&per_cu, fwd_megakernel, 256, 0);
    if (per_cu > 2) per_cu = 2;
    if (per_cu < 1) per_cu = 1;
    grid_blocks = cus * per_cu;
  }
  if (ws_size < O_END) fprintf(stderr, "workspace too small: %zu < %zu\n", ws_size, (size_t)O_END);
  hipMemsetAsync((char*)d_ws + O_BAR, 0, 16384, stream);
  Params p{};
  for (int i = 0; i < 30; ++i) p.in[i] = (const float*)d_in[i];
  p.out = (float*)d_out;
  p.ws = (char*)d_ws;
  void* args[] = {&p};
  hipError_t e = hipLaunchCooperativeKernel((void*)fwd_megakernel, dim3(grid_blocks), dim3(256), args, 0, stream);
  if (e != hipSuccess) fprintf(stderr, "cooperative launch failed: %s (grid %d)\n", hipGetErrorString(e), grid_blocks);
}
```

```cpp
#include <hip/hip_runtime.h>
#include <hip/hip_bf16.h>
#include <hip/hip_cooperative_groups.h>
#include <cstdio>
namespace cg = cooperative_groups;

typedef unsigned short bfu;
using bf16x8 = __attribute__((ext_vector_type(8))) short;
using f32x4 = __attribute__((ext_vector_type(4))) float;
#define DEVI __device__ __forceinline__

constexpr float ALPHA = 1.41421356237f;
constexpr int NCOL = 12288;

constexpr size_t O_WIN = 0;
constexpr size_t O_WOA = O_WIN + 25165824;
constexpr size_t O_WOB = O_WOA + 2097152;
constexpr size_t O_WOC = O_WOB + 2097152;
constexpr size_t O_WO = O_WOC + 2097152;
constexpr size_t O_WQ = O_WO + 2097152;
constexpr size_t O_KEYS = O_WQ + 4194304;
constexpr size_t O_LRU = O_KEYS + 524288;
constexpr size_t O_UTB = O_LRU + 524288;
constexpr size_t O_VTB = O_UTB + 33554432;
constexpr size_t O_LBS = O_VTB + 33554432;
constexpr size_t O_XB = O_LBS + 8192;
constexpr size_t O_Z = O_XB + 34078720;
constexpr size_t O_UA = O_Z + 207618048;
constexpr size_t O_UB = O_UA + 17301504;
constexpr size_t O_UC = O_UB + 17301504;
constexpr size_t O_CB = O_UC + 17301504;
constexpr size_t O_AU = O_CB + 17301504;
constexpr size_t O_LSUM = O_AU + 69206016;
constexpr size_t O_US = O_LSUM + 540672;
constexpr size_t O_DEC = O_US + 33554432;
constexpr size_t O_BAR = O_DEC + 524288;
constexpr size_t O_END = O_BAR + 16384;
constexpr size_t O_PRE = O_Z;
constexpr size_t O_QP = O_Z + 34603008;
constexpr size_t O_SC = O_QP + 34603008;

constexpr long OUT_YS = 16777216;
constexpr long OUT_CAP = 17039360;
constexpr long OUT_CBP = 17055744;
constexpr long OUT_LRP = 17080320;
constexpr long OUT_HGP = 17088512;
constexpr long OUT_CAS = 18137088;
constexpr long OUT_CBS = 18169856;
constexpr long OUT_LRS = 18219008;
constexpr long OUT_HGS = 18235392;

struct Params {
  const float* in[30];
  float* out;
  char* ws;
};

DEVI bfu f2b(float f) {
  unsigned u = __float_as_uint(f);
  u += 0x7FFFu + ((u >> 16) & 1u);
  return (bfu)(u >> 16);
}
DEVI float b2f(bfu b) { return __uint_as_float(((unsigned)b) << 16); }
DEVI float sigmoidf_(float x) { return 1.f / (1.f + __expf(-x)); }
DEVI float siluf_(float x) { return x / (1.f + __expf(-x)); }
DEVI float geluf_(float x) { return 0.5f * x * (1.f + erff(x * 0.70710678118f)); }
DEVI float wave_sum(float v) {
#pragma unroll
  for (int o = 32; o; o >>= 1) v += __shfl_xor(v, o);
  return v;
}

DEVI int ltid() { int t = threadIdx.x; asm volatile("" : "+v"(t)); return t; }
struct TokInfo { int sample, seq, t; };
DEVI TokInfo tokinfo(int it) {
  TokInfo r;
  if (it < 8192) { r.sample = 0; r.seq = it >> 12; r.t = it & 4095; }
  else if (it < 8448) { int q = it - 8192; r.sample = 1; r.seq = q >> 5; r.t = q & 31; }
  else { int q = it - 8448; r.sample = 0; r.seq = 2 + (q >> 12); r.t = q & 4095; }
  return r;
}
DEVI float* xrow(const Params& P, int it) {
  TokInfo ti = tokinfo(it);
  return ti.sample ? P.out + OUT_YS + (long)(ti.seq * 32 + ti.t) * 1024
                   : P.out + (long)(ti.seq * 4096 + ti.t) * 1024;
}

DEVI void stage_tile(const bfu* __restrict__ g, int ld, int k0, char* lds, int tid) {
#pragma unroll
  for (int i = 0; i < 4; ++i) {
    int b = tid * 16 + i * 4096;
    int r = b >> 7, cp = (b >> 4) & 7, gc = cp ^ (r & 7);
    __builtin_amdgcn_global_load_lds((const unsigned*)(g + (long)r * ld + k0 + gc * 8),
                                     (unsigned*)(lds + b), 16, 0, 0);
  }
}
DEVI bf16x8 ldfrag(const char* tile, int r, int kc) {
  return *reinterpret_cast<const bf16x8*>(tile + r * 128 + ((kc ^ (r & 7)) << 4));
}
DEVI void stage_tile_gate(const bfu* __restrict__ Wa, const bfu* __restrict__ Wx, int k0, char* lds, int tid) {
#pragma unroll
  for (int i = 0; i < 4; ++i) {
    int b = tid * 16 + i * 4096;
    int r = b >> 7, cp = (b >> 4) & 7, gc = cp ^ (r & 7);
    const bfu* base = (r & 32) ? Wx : Wa;
    int c = (r >> 6) * 32 + (r & 31);
    __builtin_amdgcn_global_load_lds((const unsigned*)(base + (long)c * 128 + k0 + gc * 8),
                                     (unsigned*)(lds + b), 16, 0, 0);
  }
}
template <int GATE>
DEVI void gemm_core_t(f32x4 (&acc)[4][4], const bfu* __restrict__ A, int lda,
                    const bfu* __restrict__ B, int ldb, int K, char* smem, int tid, const bfu* __restrict__ B2 = nullptr) {
  const int wid = tid >> 6, lane = tid & 63;
  const int wr = wid >> 1, wc = wid & 1, fr = lane & 15, fq = lane >> 4;
  const int nt = K >> 6;
  __syncthreads();
  stage_tile(A, lda, 0, smem, tid);
  if (GATE) stage_tile_gate(B, B2, 0, smem + 16384, tid); else stage_tile(B, ldb, 0, smem + 16384, tid);
  for (int t = 0; t < nt; ++t) {
    asm volatile("s_waitcnt vmcnt(0)" ::: "memory");
    __syncthreads();
    char* cur = smem + (t & 1) * 32768;
    if (t + 1 < nt) {
      char* nx = smem + ((t + 1) & 1) * 32768;
      stage_tile(A, lda, (t + 1) * 64, nx, tid);
      if (GATE) stage_tile_gate(B, B2, (t + 1) * 64, nx + 16384, tid); else stage_tile(B, ldb, (t + 1) * 64, nx + 16384, tid);
    }
#pragma unroll
    for (int kk = 0; kk < 2; ++kk) {
      bf16x8 af[4], bfr[4];
#pragma unroll
      for (int m = 0; m < 4; ++m) af[m] = ldfrag(cur, wr * 64 + m * 16 + fr, kk * 4 + fq);
#pragma unroll
      for (int n = 0; n < 4; ++n) bfr[n] = ldfrag(cur + 16384, wc * 64 + n * 16 + fr, kk * 4 + fq);
#pragma unroll
      for (int m = 0; m < 4; ++m)
#pragma unroll
        for (int n = 0; n < 4; ++n)
          acc[m][n] = __builtin_amdgcn_mfma_f32_16x16x32_bf16(af[m], bfr[n], acc[m][n], 0, 0, 0);
    }
  }
}
DEVI void gemm_core(f32x4 (&acc)[4][4], const bfu* __restrict__ A, int lda,
                    const bfu* __restrict__ B, int ldb, int K, char* smem, int tid) {
  gemm_core_t<0>(acc, A, lda, B, ldb, K, smem, tid);
}
DEVI void tile_rc(int id, int nM, int nN, int& pm, int& pn) {
  const int x = id & 7, q = id >> 3;
  const int gfull = nM >> 3;
  const int g = q / nN;
  if (g < gfull) {
    int r = q - g * nN;
    pn = (r >> 3) * 8 + x;
    pm = g * 8 + (r & 7);
  } else {
    int gsz = nM - gfull * 8;
    int r = q - gfull * nN;
    pn = (r / gsz) * 8 + x;
    pm = gfull * 8 + (r % gsz);
  }
}
#define ZERO_ACC(a) _Pragma("unroll") for (int m_ = 0; m_ < 4; ++m_) _Pragma("unroll") for (int n_ = 0; n_ < 4; ++n_) a[m_][n_] = f32x4{0.f, 0.f, 0.f, 0.f}
#define EPI_LOOP \
  const int wid_ = tid >> 6, lane_ = tid & 63; \
  const int wr_ = wid_ >> 1, wc_ = wid_ & 1, fr_ = lane_ & 15, fq_ = lane_ >> 4; \
  _Pragma("unroll") for (int m = 0; m < 4; ++m) for (int sb_ = (__builtin_amdgcn_sched_barrier(0), 0); sb_ < 1; ++sb_) _Pragma("unroll") for (int n = 0; n < 4; ++n) _Pragma("unroll") for (int j = 0; j < 4; ++j)
#define EPI_ROW (wr_ * 64 + m * 16 + fq_ * 4 + j)
#define EPI_COL (wc_ * 64 + n * 16 + fr_)

DEVI void transpose_tile(const float* __restrict__ src, bfu* __restrict__ dst, int R, int C, int r0, int c0, float* tile, int tid) {
  __syncthreads();
  {
    int tx = tid & 15, ty = tid >> 4;
#pragma unroll
    for (int i = 0; i < 4; ++i) {
      int r = ty + i * 16;
      float4 v = *reinterpret_cast<const float4*>(src + (long)(r0 + r) * C + c0 + tx * 4);
      float* tp = tile + r * 65 + tx * 4;
      tp[0] = v.x; tp[1] = v.y; tp[2] = v.z; tp[3] = v.w;
    }
  }
  __syncthreads();
  {
    int c = tid >> 2, rs = (tid & 3) * 16;
    unsigned pk[8];
#pragma unroll
    for (int i = 0; i < 8; ++i) {
      unsigned lo = f2b(tile[(rs + 2 * i) * 65 + c]);
      unsigned hi = f2b(tile[(rs + 2 * i + 1) * 65 + c]);
      pk[i] = lo | (hi << 16);
    }
    uint4* dp = reinterpret_cast<uint4*>(dst + (long)(c0 + c) * R + r0 + rs);
    dp[0] = make_uint4(pk[0], pk[1], pk[2], pk[3]);
    dp[1] = make_uint4(pk[4], pk[5], pk[6], pk[7]);
  }
}
DEVI void convert_chunk(const float* __restrict__ src, bfu* __restrict__ dst, int tid) {
  int o = tid * 8;
  float4 a = *reinterpret_cast<const float4*>(src + o);
  float4 b = *reinterpret_cast<const float4*>(src + o + 4);
  uint4 r;
  r.x = f2b(a.x) | ((unsigned)f2b(a.y) << 16);
  r.y = f2b(a.z) | ((unsigned)f2b(a.w) << 16);
  r.z = f2b(b.x) | ((unsigned)f2b(b.y) << 16);
  r.w = f2b(b.z) | ((unsigned)f2b(b.w) << 16);
  *reinterpret_cast<uint4*>(dst + o) = r;
}

typedef float f32x2 __attribute__((ext_vector_type(2)));
constexpr float U_SCALE = 64.f, V_SCALE = 8.f;
DEVI void convert_chunk_fp8(const float* __restrict__ src, unsigned char* __restrict__ dst, float scale, int tid) {
  int o = tid * 16;
  uint4 r;
  unsigned rr[4];
#pragma unroll
  for (int q = 0; q < 4; ++q) {
    float4 a = *reinterpret_cast<const float4*>(src + o + q * 4);
    int p = __builtin_amdgcn_cvt_pk_fp8_f32(a.x * scale, a.y * scale, 0, false);
    p = __builtin_amdgcn_cvt_pk_fp8_f32(a.z * scale, a.w * scale, p, true);
    rr[q] = (unsigned)p;
  }
  r = make_uint4(rr[0], rr[1], rr[2], rr[3]);
  *reinterpret_cast<uint4*>(dst + o) = r;
}

DEVI void phase_prep(const Params& P, int l, char* smem) {
  const int tid = ltid();
  char* ws = P.ws;
  float* tile = reinterpret_cast<float*>(smem);
  const int NT_WIN = 3072, NT_SQ = 256, NT_WQ = 512, NT_LRU = 64;
  const int T0 = NT_WIN, T1 = T0 + 4 * NT_SQ, T2 = T1 + NT_WQ, T3 = T2 + NT_LRU;
  const int C0 = T3 + 128, C1 = C0 + 4096, C2 = C1 + 4096;
  const int X0 = C2;
  const int L0 = X0 + (l == 0 ? 8 : 0);
  for (int id = blockIdx.x; id < L0; id += gridDim.x) {
    if (id < T0) {
      int tr = id / 192, tc = id % 192;
      transpose_tile(P.in[6] + (long)l * 1024 * 12288, (bfu*)(ws + O_WIN), 1024, 12288, tr * 64, tc * 64, tile, tid);
    } else if (id < T1) {
      int q = id - T0, w = q >> 8, t = q & 255;
      const float* src = P.in[18 + w] + (long)l * 1048576;
      bfu* dst = (bfu*)(ws + (w == 0 ? O_WOA : w == 1 ? O_WOB : w == 2 ? O_WOC : O_WO));
      transpose_tile(src, dst, 1024, 1024, (t >> 4) * 64, (t & 15) * 64, tile, tid);
    } else if (id < T2) {
      int q = id - T1;
      transpose_tile(P.in[24] + (long)l * 2097152, (bfu*)(ws + O_WQ), 1024, 2048, (q >> 5) * 64, (q & 31) * 64, tile, tid);
    } else if (id < T3) {
      int q = id - T2, mtx = q >> 2, t = q & 3, g = mtx >> 3, nb = mtx & 7;
      const float* src = P.in[g == 0 ? 11 : 13] + (long)l * 131072 + nb * 16384;
      transpose_tile(src, (bfu*)(ws + O_LRU) + mtx * 16384, 128, 128, (t >> 1) * 64, (t & 1) * 64, tile, tid);
    } else if (id < C0) {
      int q = id - T3;
      convert_chunk(P.in[25] + (long)l * 262144 + (long)q * 2048, (bfu*)(ws + O_KEYS) + (long)q * 2048, tid);
    } else if (id < C1) {
      int q = id - C0;
      convert_chunk_fp8(P.in[26] + (long)l * 16777216 + (long)q * 4096, (unsigned char*)(ws + O_UTB) + (long)q * 4096, U_SCALE, tid);
    } else if (id < C2) {
      int q = id - C1;
      convert_chunk_fp8(P.in[27] + (long)l * 16777216 + (long)q * 4096, (unsigned char*)(ws + O_VTB) + (long)q * 4096, V_SCALE, tid);
    } else {
      int q = id - X0;
      int c = (q & 3) * 256 + tid, ll = q >> 2;
      float a0 = P.in[16][c], a1 = P.in[16][1024 + c];
      float mx = fmaxf(a0, a1);
      float e0 = __expf(a0 - mx), e1 = __expf(a1 - mx);
      float p1 = e1 / (e0 + e1);
      float* lbs = (float*)(ws + O_LBS);
      lbs[ll * 1024 + c] = (ll == 0) ? 0.f : p1;
    }
  }
}

DEVI void phase_xcopy(const Params& P) {
  const int tid = ltid();
  bfu* xb = (bfu*)(P.ws + O_XB);
  for (int it = blockIdx.x; it < 16640; it += gridDim.x) {
    TokInfo ti = tokinfo(it);
    const float* src = ti.sample ? P.in[1] + (long)(ti.seq * 32 + ti.t) * 1024 : P.in[0] + (long)(ti.seq * 4096 + ti.t) * 1024;
    float* dst = xrow(P, it);
    int c = tid * 4;
    float4 v = *reinterpret_cast<const float4*>(src + c);
    *reinterpret_cast<float4*>(dst + c) = v;
    uint2 r;
    r.x = f2b(v.x) | ((unsigned)f2b(v.y) << 16);
    r.y = f2b(v.z) | ((unsigned)f2b(v.w) << 16);
    *reinterpret_cast<uint2*>(xb + (long)it * 1024 + c) = r;
  }
}

DEVI void phase_inproj(const Params& P, int l, int pass, char* smem) {
  const int tid = ltid();
  const int ntok = pass ? 8192 : 8448, base = pass ? 8448 : 0;
  const int nM = ntok / 128, nN = 96;
  const bfu* xb = (const bfu*)(P.ws + O_XB) + (long)base * 1024;
  const bfu* wT = (const bfu*)(P.ws + O_WIN);
  bfu* z = (bfu*)(P.ws + O_Z);
  const float* bin = P.in[7] + l * NCOL;
  for (int id = blockIdx.x; id < nM * nN; id += gridDim.x) {
    int pm, pn; tile_rc(id, nM, nN, pm, pn);
    f32x4 acc[4][4]; ZERO_ACC(acc);
    gemm_core(acc, xb + (long)pm * 128 * 1024, 1024, wT + (long)pn * 128 * 1024, 1024, 1024, smem, tid);
    EPI_LOOP {
      int row = pm * 128 + EPI_ROW, col = pn * 128 + EPI_COL;
      z[(long)row * NCOL + col] = f2b(acc[m][n][j] + bin[col]);
    }
  }
}

DEVI void load4bf(const bfu* p, float (&o)[4]) {
  uint2 v = *reinterpret_cast<const uint2*>(p);
  o[0] = __uint_as_float(v.x << 16); o[1] = __uint_as_float(v.x & 0xFFFF0000u);
  o[2] = __uint_as_float(v.y << 16); o[3] = __uint_as_float(v.y & 0xFFFF0000u);
}
DEVI void store4bf(bfu* p, const float (&v)[4]) {
  uint2 r;
  r.x = f2b(v[0]) | ((unsigned)f2b(v[1]) << 16);
  r.y = f2b(v[2]) | ((unsigned)f2b(v[3]) << 16);
  *reinterpret_cast<uint2*>(p) = r;
}
DEVI void mixab_row(const Params& P, int l, int base, int lt, int tid) {
  const int it = base + lt;
  const TokInfo ti = tokinfo(it);
  const int T = ti.sample ? 32 : 4096;
  const bfu* z = (const bfu*)(P.ws + O_Z);
  const int c = tid * 4;
  float pk[3][4];
#pragma unroll
  for (int k = 0; k < 3; ++k) {
    int tt = ti.t - 2 + k;
    if (tt >= 0) {
      const bfu* zr = z + (long)(lt - 2 + k) * NCOL;
      float ac[4], ax[4];
      load4bf(zr + 1024 + c, ac); load4bf(zr + 2048 + c, ax);
#pragma unroll
      for (int i = 0; i < 4; ++i) pk[k][i] = ac[i] * ax[i];
    } else if (ti.sample) {
      float4 v = *reinterpret_cast<const float4*>(P.in[2] + ((long)(l * 8 + ti.seq) * 2 + (tt + 2)) * 1024 + c);
      pk[k][0] = v.x; pk[k][1] = v.y; pk[k][2] = v.z; pk[k][3] = v.w;
    } else {
#pragma unroll
      for (int i = 0; i < 4; ++i) pk[k][i] = 0.f;
    }
  }
  {
    float ab[4], o[4];
    load4bf(z + (long)lt * NCOL + c, ab);
    const float* w = P.in[8] + (long)l * 3 * 1024 + c;
#pragma unroll
    for (int i = 0; i < 4; ++i) o[i] = ab[i] * (w[i] * pk[0][i] + w[1024 + i] * pk[1][i] + w[2048 + i] * pk[2][i]);
    store4bf((bfu*)(P.ws + O_UA) + (long)lt * 1024 + c, o);
    if (ti.t >= T - 2) {
      int r = ti.t - (T - 2);
      float* dst = ti.sample ? P.out + OUT_CAS + ((long)(l * 8 + ti.seq) * 2 + r) * 1024 + c
                             : P.out + OUT_CAP + ((long)(l * 4 + ti.seq) * 2 + r) * 1024 + c;
      *reinterpret_cast<float4*>(dst) = make_float4(pk[2][0], pk[2][1], pk[2][2], pk[2][3]);
    }
  }
  float xk[4][4];
#pragma unroll
  for (int k = 0; k < 4; ++k) {
    int tt = ti.t - 3 + k;
    if (tt >= 0) {
      load4bf(z + (long)(lt - 3 + k) * NCOL + 3072 + c, xk[k]);
    } else if (ti.sample) {
      float4 v = *reinterpret_cast<const float4*>(P.in[3] + ((long)(l * 8 + ti.seq) * 3 + (tt + 3)) * 1024 + c);
      xk[k][0] = v.x; xk[k][1] = v.y; xk[k][2] = v.z; xk[k][3] = v.w;
    } else {
#pragma unroll
      for (int i = 0; i < 4; ++i) xk[k][i] = 0.f;
    }
  }
  {
    const float* w = P.in[9] + (long)l * 4 * 1024 + c;
    const float* bb = P.in[10] + (long)l * 1024 + c;
    float o[4];
#pragma unroll
    for (int i = 0; i < 4; ++i)
      o[i] = w[i] * xk[0][i] + w[1024 + i] * xk[1][i] + w[2048 + i] * xk[2][i] + w[3072 + i] * xk[3][i] + bb[i];
    store4bf((bfu*)(P.ws + O_CB) + (long)lt * 1024 + c, o);
    if (ti.t >= T - 3) {
      int r = ti.t - (T - 3);
      float* dst = ti.sample ? P.out + OUT_CBS + ((long)(l * 8 + ti.seq) * 3 + r) * 1024 + c
                             : P.out + OUT_CBP + ((long)(l * 4 + ti.seq) * 3 + r) * 1024 + c;
      *reinterpret_cast<float4*>(dst) = make_float4(xk[3][0], xk[3][1], xk[3][2], xk[3][3]);
    }
  }
}

struct ChunkInfo { int lt0, L, sample, seqi, c; };
DEVI ChunkInfo chunkinfo(int ck) {
  ChunkInfo r;
  if (ck < 128) { r.seqi = ck >> 6; r.c = ck & 63; r.lt0 = r.seqi * 4096 + r.c * 64; r.L = 64; r.sample = 0; }
  else { r.seqi = ck - 128; r.c = 0; r.lt0 = 8192 + r.seqi * 32; r.L = 32; r.sample = 1; }
  return r;
}

DEVI void h1_item(const Params& P, int l, int ck, int h, char* smem, int tid) {
  const ChunkInfo ci = chunkinfo(ck);
  const int lane = tid & 63, w = tid >> 6, fr = lane & 15, fq = lane >> 4;
  bfu* VT = (bfu*)smem;
  bfu* KT = VT + 128 * 72;
  float* tots = (float*)(smem + 36864);
  float* decl = tots + 256;
  const int d = tid & 127, hf = tid >> 7, L = ci.L, Lh = L >> 1;
  const float lb = ((const float*)(P.ws + O_LBS))[l * 1024 + h * 128 + d];
  const bfu* Z = (const bfu*)(P.ws + O_Z);
  const bfu* zf = Z + (long)ci.lt0 * NCOL + 6 * 1024 + h * 128 + d;
  const bfu* zi = Z + (long)ci.lt0 * NCOL + 7 * 1024 + h * 128 + d;
  __syncthreads();
  float tot = 0.f;
#pragma unroll 8
  for (int s = hf * Lh; s < hf * Lh + Lh; ++s) {
    float f = lb + (1.f - lb) * sigmoidf_(b2f(zf[(long)s * NCOL]));
    tot += __logf(f);
  }
  tots[hf * 128 + d] = tot;
  __syncthreads();
  float run = hf ? 0.f : tots[128 + d];
#pragma unroll 8
  for (int s = hf * Lh + Lh - 1; s >= hf * Lh; --s) {
    float f = lb + (1.f - lb) * sigmoidf_(b2f(zf[(long)s * NCOL]));
    KT[d * 72 + s] = f2b((1.f - f) * __expf(run));
    VT[d * 72 + s] = zi[(long)s * NCOL];
    run += __logf(f);
  }
  if (L == 32) {
    for (int s = 32 + hf * 16; s < 48 + hf * 16; ++s) { KT[d * 72 + s] = 0; VT[d * 72 + s] = 0; }
  }
  if (hf == 0) {
    float dc = __expf(tots[d] + tots[128 + d]);
    decl[d] = dc;
    if (!ci.sample) ((float*)(P.ws + O_DEC))[((ci.seqi * 8 + h) * 64 + ci.c) * 128 + d] = dc;
  }
  __syncthreads();
  f32x4 acc[2][8];
#pragma unroll
  for (int mi = 0; mi < 2; ++mi)
#pragma unroll
    for (int n = 0; n < 8; ++n) acc[mi][n] = f32x4{0.f, 0.f, 0.f, 0.f};
#pragma unroll
  for (int kk = 0; kk < 2; ++kk) {
    bf16x8 a[2];
#pragma unroll
    for (int mi = 0; mi < 2; ++mi) a[mi] = *reinterpret_cast<const bf16x8*>(VT + ((2 * w + mi) * 16 + fr) * 72 + kk * 32 + fq * 8);
#pragma unroll
    for (int n = 0; n < 8; ++n) {
      bf16x8 b = *reinterpret_cast<const bf16x8*>(KT + (n * 16 + fr) * 72 + kk * 32 + fq * 8);
#pragma unroll
      for (int mi = 0; mi < 2; ++mi) acc[mi][n] = __builtin_amdgcn_mfma_f32_16x16x32_bf16(a[mi], b, acc[mi][n], 0, 0, 0);
    }
  }
  if (!ci.sample) {
    bfu* US = (bfu*)(P.ws + O_US) + ((long)((ci.seqi * 8 + h) * 64 + ci.c) << 14);
#pragma unroll
    for (int mi = 0; mi < 2; ++mi) {
      __builtin_amdgcn_sched_barrier(0);
      bfu* bp = US + ((2 * w + mi) * 16 + fq * 4) * 128 + fr;
#pragma unroll
      for (int n = 0; n < 8; ++n)
#pragma unroll
        for (int j = 0; j < 4; ++j) bp[j * 128 + n * 16] = f2b(acc[mi][n][j]);
    }
  } else {
    long sb = ((long)((l * 8 + ci.seqi) * 8 + h)) << 14;
    const float* S0 = P.in[5] + sb;
    float* So = P.out + OUT_HGS + sb;
#pragma unroll
    for (int mi = 0; mi < 2; ++mi)
#pragma unroll
      for (int n = 0; n < 8; ++n) {
        __builtin_amdgcn_sched_barrier(0);
        int e0 = (2 * w + mi) * 16 + fq * 4, dd = n * 16 + fr;
        float4 s0 = *reinterpret_cast<const float4*>(S0 + dd * 128 + e0);
        float dcl = decl[dd];
        float4 r;
        r.x = dcl * s0.x + acc[mi][n][0]; r.y = dcl * s0.y + acc[mi][n][1];
        r.z = dcl * s0.z + acc[mi][n][2]; r.w = dcl * s0.w + acc[mi][n][3];
        *reinterpret_cast<float4*>(So + dd * 128 + e0) = r;
      }
  }
}

DEVI void phase2(const Params& P, int l, int pass, char* smem) {
  const int tid = ltid();
  const int ntok = pass ? 8192 : 8448, base = pass ? 8448 : 0;
  const int nck = pass ? 128 : 136;
  const int nH = nck * 8;
  const int total = nH + ntok;
  for (int id = blockIdx.x; id < total; id += gridDim.x) {
    if (id < nH) h1_item(P, l, id >> 3, id & 7, smem, tid);
    else mixab_row(P, l, base, id - nH, tid);
  }
}

DEVI void gate_tile(const Params& P, int l, int pm, int q, char* smem, int tid) {
  const int nb = q >> 1, hb = q & 1;
  const bfu* cb = (const bfu*)(P.ws + O_CB);
  const bfu* A = cb + (long)pm * 128 * 1024 + nb * 128;
  const bfu* Wa = (const bfu*)(P.ws + O_LRU) + nb * 16384 + hb * 64 * 128;
  const bfu* Wx = Wa + 8 * 16384;
  float* au0 = (float*)(P.ws + O_AU);
  float* au1 = au0 + (long)8448 * 1024;
  const float* ba = P.in[12] + l * 1024;
  const float* bx = P.in[14] + l * 1024;
  const float* lam = P.in[15] + l * 1024;
  f32x4 acc[4][4]; ZERO_ACC(acc);
  gemm_core_t<1>(acc, A, 1024, Wa, 128, 128, smem, tid, Wx);
  const int wid = tid >> 6, lane = tid & 63, wr = wid >> 1, wc = wid & 1, fr = lane & 15, fq = lane >> 4;
#pragma unroll
  for (int n = 0; n < 2; ++n) {
    const int col = nb * 128 + hb * 64 + wc * 32 + n * 16 + fr;
    const float sp8 = -8.f * log1pf(__expf(-lam[col]));
    const float bav = ba[col], bxv = bx[col];
#pragma unroll
    for (int m = 0; m < 4; ++m) {
      __builtin_amdgcn_sched_barrier(0);
#pragma unroll
      for (int j = 0; j < 4; ++j) {
        const long row = pm * 128 + wr * 64 + m * 16 + fq * 4 + j;
        float r = sigmoidf_(acc[m][n][j] + bav);
        float gi = sigmoidf_(acc[m][n + 2][j] + bxv);
        float a = __expf(sp8 * r);
        float mult = sqrtf(fmaxf(1.f - a * a, 0.f));
        float xv = b2f(cb[row * 1024 + col]);
        au0[row * 1024 + col] = a;
        au1[row * 1024 + col] = mult * gi * xv;
      }
    }
  }
}
DEVI void h2_item(const Params& P, int l, int pass, int item, int tid) {
  const int sh = item >> 6, blk = item & 63;
  const int idx = blk * 256 + tid, e = idx >> 7, d = idx & 127;
  bfu* US = (bfu*)(P.ws + O_US) + ((long)sh * 64 << 14) + idx;
  const float* dec = (const float*)(P.ws + O_DEC) + (long)sh * 64 * 128 + d;
  float S = 0.f;
  for (int c0 = 0; c0 < 64; c0 += 8) {
    float u[8], dc[8];
#pragma unroll
    for (int i = 0; i < 8; ++i) { u[i] = b2f(US[(long)(c0 + i) << 14]); dc[i] = dec[(c0 + i) * 128]; }
#pragma unroll
    for (int i = 0; i < 8; ++i) { US[(long)(c0 + i) << 14] = f2b(S); S = dc[i] * S + u[i]; }
  }
  const int sl = sh >> 3, h = sh & 7, b = pass * 2 + sl;
  P.out[OUT_HGP + (((long)((l * 4 + b) * 8 + h)) << 14) + d * 128 + e] = S;
}
DEVI void phase3(const Params& P, int l, int pass, char* smem) {
  const int tid = ltid();
  const int ntok = pass ? 8192 : 8448;
  const int nG = (ntok / 128) * 16, nH2 = 1024;
  for (int id = blockIdx.x; id < nG + nH2; id += gridDim.x) {
    if (id < nG) gate_tile(P, l, id >> 4, id & 15, smem, tid);
    else h2_item(P, l, pass, id - nG, tid);
  }
}

DEVI void lsum_item(const Params& P, int tile, int cg4, int tid) {
  const int w = tid >> 6, lane = tid & 63;
  const int ch = (cg4 * 4 + w) * 64 + lane;
  const float* a0 = (const float*)(P.ws + O_AU) + (long)tile * 128 * 1024 + ch;
  const float* u0 = a0 + (long)8448 * 1024;
  float A = 1.f, H = 0.f;
  for (int r0 = 0; r0 < 128; r0 += 16) {
    float av[16], uv[16];
#pragma unroll
    for (int i = 0; i < 16; ++i) { av[i] = a0[(long)(r0 + i) * 1024]; uv[i] = u0[(long)(r0 + i) * 1024]; }
#pragma unroll
    for (int i = 0; i < 16; ++i) { H = av[i] * H + uv[i]; A *= av[i]; }
  }
  float* ls = (float*)(P.ws + O_LSUM) + (long)tile * 2048;
  ls[ch] = A; ls[1024 + ch] = H;
}

DEVI void h3_item(const Params& P, int l, int ck, int h, char* smem, int tid) {
  const ChunkInfo ci = chunkinfo(ck);
  const int lane = tid & 63, w = tid >> 6, fr = lane & 15, fq = lane >> 4;
  bfu* QT = (bfu*)smem;
  bfu* KT = QT + 64 * 136;
  bfu* AT = KT + 64 * 136;
  bfu* BS = AT + 64 * 72;
  float* bmid = (float*)(BS + 128 * 72);
  const int d = tid & 127, hf = tid >> 7, L = ci.L, Lh = L >> 1;
  const float lb = ((const float*)(P.ws + O_LBS))[l * 1024 + h * 128 + d];
  const bfu* Z = (const bfu*)(P.ws + O_Z);
  const bfu* zq = Z + (long)ci.lt0 * NCOL + 5 * 1024 + h * 128 + d;
  const bfu* zf = zq + 1024;
  const bfu* zi = zq + 2048;
  __syncthreads();
  if (hf == 0) {
    float rel = 0.f;
#pragma unroll 8
    for (int t = Lh - 1; t >= 0; --t) {
      float f = lb + (1.f - lb) * sigmoidf_(b2f(zf[(long)t * NCOL]));
      float q = siluf_(b2f(zq[(long)t * NCOL]));
      QT[t * 136 + d] = f2b(q * __expf(fminf(rel, 80.f)));
      KT[t * 136 + d] = f2b((1.f - f) * __expf(-rel));
      rel -= __logf(f);
    }
    bmid[d] = -rel;
  } else {
    float rel = 0.f;
#pragma unroll 8
    for (int t = Lh; t < L; ++t) {
      float f = lb + (1.f - lb) * sigmoidf_(b2f(zf[(long)t * NCOL]));
      float q = siluf_(b2f(zq[(long)t * NCOL]));
      rel += __logf(f);
      QT[t * 136 + d] = f2b(q * __expf(rel));
      KT[t * 136 + d] = f2b((1.f - f) * __expf(fminf(-rel, 80.f)));
    }
  }
  if (L == 32) {
    for (int t = 32 + hf * 16; t < 48 + hf * 16; ++t) { QT[t * 136 + d] = 0; KT[t * 136 + d] = 0; }
  }
#pragma unroll 8
  for (int s = hf * 32; s < hf * 32 + 32; ++s) BS[d * 72 + s] = (s < L) ? zi[(long)s * NCOL] : (bfu)0;
  __syncthreads();
  bf16x8 aq[4];
#pragma unroll
  for (int kk = 0; kk < 4; ++kk) aq[kk] = *reinterpret_cast<const bf16x8*>(QT + (16 * w + fr) * 136 + kk * 32 + fq * 8);
  {
    f32x4 sa[4];
#pragma unroll
    for (int n = 0; n < 4; ++n) sa[n] = f32x4{0.f, 0.f, 0.f, 0.f};
#pragma unroll
    for (int kk = 0; kk < 4; ++kk)
#pragma unroll
      for (int n = 0; n < 4; ++n) {
        bf16x8 bk = *reinterpret_cast<const bf16x8*>(KT + (n * 16 + fr) * 136 + kk * 32 + fq * 8);
        sa[n] = __builtin_amdgcn_mfma_f32_16x16x32_bf16(aq[kk], bk, sa[n], 0, 0, 0);
      }
#pragma unroll
    for (int n = 0; n < 4; ++n)
#pragma unroll
      for (int j = 0; j < 4; ++j) {
        int t = 16 * w + fq * 4 + j, s = n * 16 + fr;
        AT[t * 72 + s] = (s <= t) ? f2b(sa[n][j]) : (bfu)0;
      }
  }
  __syncthreads();
  f32x4 o[8];
#pragma unroll
  for (int n = 0; n < 8; ++n) o[n] = f32x4{0.f, 0.f, 0.f, 0.f};
#pragma unroll
  for (int kk = 0; kk < 2; ++kk) {
    bf16x8 a = *reinterpret_cast<const bf16x8*>(AT + (16 * w + fr) * 72 + kk * 32 + fq * 8);
#pragma unroll
    for (int n = 0; n < 8; ++n) {
      bf16x8 b = *reinterpret_cast<const bf16x8*>(BS + (n * 16 + fr) * 72 + kk * 32 + fq * 8);
      o[n] = __builtin_amdgcn_mfma_f32_16x16x32_bf16(a, b, o[n], 0, 0, 0);
    }
  }
#pragma unroll
  for (int sl = 0; sl < 2; ++sl) {
    __syncthreads();
    if (!ci.sample) {
      const bfu* src = (const bfu*)(P.ws + O_US) + ((long)((ci.seqi * 8 + h) * 64 + ci.c) << 14);
      int e2 = tid >> 1, dd0 = (tid & 1) * 32;
#pragma unroll
      for (int q4 = 0; q4 < 4; ++q4) {
        uint4 v = *reinterpret_cast<const uint4*>(src + e2 * 128 + sl * 64 + dd0 + q4 * 8);
        const float* bm = bmid + sl * 64 + dd0 + q4 * 8;
        unsigned vv[4] = {v.x, v.y, v.z, v.w};
        unsigned rr[4];
#pragma unroll
        for (int i = 0; i < 4; ++i) {
          float lo = __uint_as_float(vv[i] << 16) * __expf(bm[2 * i]);
          float hi = __uint_as_float(vv[i] & 0xFFFF0000u) * __expf(bm[2 * i + 1]);
          rr[i] = f2b(lo) | ((unsigned)f2b(hi) << 16);
        }
        *reinterpret_cast<uint4*>(BS + e2 * 72 + dd0 + q4 * 8) = make_uint4(rr[0], rr[1], rr[2], rr[3]);
      }
    } else {
      const float* S0 = P.in[5] + (((long)((l * 8 + ci.seqi) * 8 + h)) << 14);
#pragma unroll 4
      for (int dd = hf * 32; dd < hf * 32 + 32; ++dd)
        BS[d * 72 + dd] = f2b(S0[(sl * 64 + dd) * 128 + d] * __expf(bmid[sl * 64 + dd]));
    }
    __syncthreads();
#pragma unroll
    for (int kk = 0; kk < 2; ++kk) {
#pragma unroll
      for (int n = 0; n < 8; ++n) {
        bf16x8 b = *reinterpret_cast<const bf16x8*>(BS + (n * 16 + fr) * 72 + kk * 32 + fq * 8);
        o[n] = __builtin_amdgcn_mfma_f32_16x16x32_bf16(aq[sl * 2 + kk], b, o[n], 0, 0, 0);
      }
    }
  }
  float rinv[4];
#pragma unroll
  for (int j = 0; j < 4; ++j) {
    float ss = 0.f;
#pragma unroll
    for (int n = 0; n < 8; ++n) ss += o[n][j] * o[n][j];
    ss += __shfl_xor(ss, 1); ss += __shfl_xor(ss, 2); ss += __shfl_xor(ss, 4); ss += __shfl_xor(ss, 8);
    rinv[j] = rsqrtf(ss * (1.f / 128.f) + 1e-6f);
  }
  const float* ng = P.in[17] + l * 128;
  bfu* UC = (bfu*)(P.ws + O_UC);
#pragma unroll
  for (int n = 0; n < 8; ++n)
#pragma unroll
    for (int j = 0; j < 4; ++j) {
      int t = 16 * w + fq * 4 + j, e = n * 16 + fr;
      if (t < L) {
        float g = b2f(Z[(long)(ci.lt0 + t) * NCOL + 8 * 1024 + h * 128 + e]);
        UC[(long)(ci.lt0 + t) * 1024 + h * 128 + e] = f2b(o[n][j] * rinv[j] * ng[e] * siluf_(g));
      }
    }
}
DEVI void phase4(const Params& P, int l, int pass, char* smem) {
  const int tid = ltid();
  const int nck = pass ? 128 : 136;
  const int nH = nck * 8;
  const int nL = 64 * 4;
  for (int id = blockIdx.x; id < nH + nL; id += gridDim.x) {
    if (id < nH) h3_item(P, l, id >> 3, id & 7, smem, tid);
    else { int q = id - nH; lsum_item(P, q >> 2, q & 3, tid); }
  }
}

DEVI void phase5(const Params& P, int l, int pass) {
  const int tid = ltid();
  const int ntok = pass ? 8192 : 8448, base = pass ? 8448 : 0;
  const int nItems = (ntok / 128) * 4;
  const int w = tid >> 6, lane = tid & 63;
  const float* AU0 = (const float*)(P.ws + O_AU);
  const float* AU1 = AU0 + (long)8448 * 1024;
  const float* LS = (const float*)(P.ws + O_LSUM);
  const bfu* Z = (const bfu*)(P.ws + O_Z);
  bfu* UB = (bfu*)(P.ws + O_UB);
  for (int id = blockIdx.x; id < nItems; id += gridDim.x) {
    const int tile = id >> 2, ch = ((id & 3) * 4 + w) * 64 + lane;
    const int lt0 = tile * 128;
    const TokInfo t0 = tokinfo(base + lt0);
    float hcur = 0.f;
    if (!t0.sample) {
      int jf = tile - (t0.t >> 7);
#pragma unroll 4
      for (int i = jf; i < tile; ++i) hcur = LS[(long)i * 2048 + ch] * hcur + LS[(long)i * 2048 + 1024 + ch];
    }
    for (int r0 = 0; r0 < 128; r0 += 8) {
      float av[8], uv[8], gv[8];
#pragma unroll
      for (int i = 0; i < 8; ++i) {
        long row = lt0 + r0 + i;
        av[i] = AU0[row * 1024 + ch]; uv[i] = AU1[row * 1024 + ch];
        gv[i] = b2f(Z[row * NCOL + 4 * 1024 + ch]);
      }
#pragma unroll
      for (int i = 0; i < 8; ++i) {
        int r = r0 + i;
        if (t0.sample && (r & 31) == 0) hcur = P.in[4][(long)(l * 8 + t0.seq + (r >> 5)) * 1024 + ch];
        hcur = av[i] * hcur + uv[i];
        UB[(long)(lt0 + r) * 1024 + ch] = f2b(geluf_(gv[i]) * hcur);
        if (t0.sample && (r & 31) == 31) P.out[OUT_LRS + (long)(l * 8 + t0.seq + (r >> 5)) * 1024 + ch] = hcur;
      }
    }
    if (!t0.sample && t0.t + 128 == 4096) P.out[OUT_LRP + (long)(l * 4 + t0.seq) * 1024 + ch] = hcur;
  }
}

template <int BR>
DEVI void p6_branch(const Params& P, int pm, int pn, float* macc, char* smem, int tid) {
  asm volatile("" : "+s"(pm), "+s"(pn));
  const bfu* Z = (const bfu*)(P.ws + O_Z);
  bfu* M = (bfu*)(P.ws + O_CB);
  const bfu* A = (const bfu*)(P.ws + (BR == 0 ? O_UA : BR == 1 ? O_UB : O_UC)) + (long)pm * 128 * 1024;
  const bfu* B = (const bfu*)(P.ws + (BR == 0 ? O_WOA : BR == 1 ? O_WOB : O_WOC)) + (long)pn * 128 * 1024;
  f32x4 acc[4][4]; ZERO_ACC(acc);
  gemm_core(acc, A, 1024, B, 1024, 1024, smem, tid);
  EPI_LOOP {
    int row = pm * 128 + EPI_ROW, col = pn * 128 + EPI_COL;
    float g = sigmoidf_(b2f(Z[(long)row * NCOL + (9 + BR) * 1024 + col]));
    float v = g * acc[m][n][j];
    if (BR > 0) v += macc[(long)row * 1024 + col];
    if (BR < 2) macc[(long)row * 1024 + col] = v;
    else M[(long)row * 1024 + col] = f2b(v);
  }
}
DEVI void phase6(const Params& P, int l, int pass, char* smem) {
  const int tid = ltid();
  const int ntok = pass ? 8192 : 8448;
  const int nM = ntok / 128, nN = 8;
  const bfu* Z = (const bfu*)(P.ws + O_Z);
  bfu* M = (bfu*)(P.ws + O_CB);
  for (int id = blockIdx.x; id < nM * nN; id += gridDim.x) {
    int pm = id >> 3, pn = id & 7;
    float* macc = (float*)(P.ws + O_AU);
    p6_branch<0>(P, pm, pn, macc, smem, tid);
    p6_branch<1>(P, pm, pn, macc, smem, tid);
    p6_branch<2>(P, pm, pn, macc, smem, tid);
  }
}

DEVI void phase7(const Params& P, int l, int pass, char* smem) {
  const int tid = ltid();
  const int ntok = pass ? 8192 : 8448, base = pass ? 8448 : 0;
  const int nM = ntok / 128, nN = 8;
  const bfu* M = (const bfu*)(P.ws + O_CB);
  const bfu* W = (const bfu*)(P.ws + O_WO);
  float* pre = (float*)(P.ws + O_PRE);
  for (int id = blockIdx.x; id < nM * nN; id += gridDim.x) {
    int pm = id >> 3, pn = id & 7;
    f32x4 acc[4][4]; ZERO_ACC(acc);
    gemm_core(acc, M + (long)pm * 128 * 1024, 1024, W + (long)pn * 128 * 1024, 1024, 1024, smem, tid);
    EPI_LOOP {
      int row = pm * 128 + EPI_ROW, col = pn * 128 + EPI_COL;
      const float* xr = xrow(P, base + row);
      pre[(long)row * 1024 + col] = ALPHA * xr[col] + acc[m][n][j];
    }
  }
}

DEVI void phase8(const Params& P, int l, int pass) {
  const int tid = ltid();
  const int ntok = pass ? 8192 : 8448, base = pass ? 8448 : 0;
  const int w = tid >> 6, lane = tid & 63;
  const float* pre = (const float*)(P.ws + O_PRE);
  const float* g = P.in[22] + l * 1024;
  const float* b = P.in[23] + l * 1024;
  bfu* xb = (bfu*)(P.ws + O_XB);
  for (int id = blockIdx.x; id < ntok / 4; id += gridDim.x) {
    int lt = id * 4 + w, it = base + lt;
    const float* src = pre + (long)lt * 1024;
    float v[16];
#pragma unroll
    for (int q = 0; q < 4; ++q) {
      float4 t = *reinterpret_cast<const float4*>(src + q * 256 + lane * 4);
      v[q * 4] = t.x; v[q * 4 + 1] = t.y; v[q * 4 + 2] = t.z; v[q * 4 + 3] = t.w;
    }
    float s = 0.f;
#pragma unroll
    for (int i = 0; i < 16; ++i) s += v[i];
    float mu = wave_sum(s) * (1.f / 1024.f);
    float ss = 0.f;
#pragma unroll
    for (int i = 0; i < 16; ++i) { float dlt = v[i] - mu; ss += dlt * dlt; }
    float rs = rsqrtf(wave_sum(ss) * (1.f / 1024.f) + 1e-5f);
    float* xr = xrow(P, it);
#pragma unroll
    for (int q = 0; q < 4; ++q) {
      int c = q * 256 + lane * 4;
      float o[4];
#pragma unroll
      for (int i = 0; i < 4; ++i) o[i] = (v[q * 4 + i] - mu) * rs * g[c + i] + b[c + i];
      *reinterpret_cast<float4*>(xr + c) = make_float4(o[0], o[1], o[2], o[3]);
      store4bf(xb + (long)it * 1024 + c, o);
    }
  }
}

DEVI void phase9(const Params& P, int l, int pass, char* smem) {
  const int tid = ltid();
  const int ntok = pass ? 8192 : 8448, base = pass ? 8448 : 0;
  const int nM = ntok / 128, nN = 16;
  const bfu* xb = (const bfu*)(P.ws + O_XB) + (long)base * 1024;
  const bfu* W = (const bfu*)(P.ws + O_WQ);
  bfu* qp = (bfu*)(P.ws + O_QP);
  for (int id = blockIdx.x; id < nM * nN; id += gridDim.x) {
    int pm, pn; tile_rc(id, nM, nN, pm, pn);
    f32x4 acc[4][4]; ZERO_ACC(acc);
    gemm_core(acc, xb + (long)pm * 128 * 1024, 1024, W + (long)pn * 128 * 1024, 1024, 1024, smem, tid);
    EPI_LOOP {
      int row = pm * 128 + EPI_ROW, col = pn * 128 + EPI_COL;
      qp[(long)row * 2048 + col] = f2b(acc[m][n][j]);
    }
  }
}
DEVI void phase10(const Params& P, int l, int pass, char* smem) {
  const int tid = ltid();
  const int ntok = pass ? 8192 : 8448;
  const int nM = ntok / 128, nN = 16;
  const bfu* qp = (const bfu*)(P.ws + O_QP);
  const bfu* KB = (const bfu*)(P.ws + O_KEYS);
  float* sc = (float*)(P.ws + O_SC);
  for (int id = blockIdx.x; id < nM * nN; id += gridDim.x) {
    int pm = id >> 4, pn = id & 15;
    f32x4 acc[4][4]; ZERO_ACC(acc);
    gemm_core(acc, qp + (long)pm * 128 * 2048 + pn * 128, 2048, KB + (long)pn * 16384, 128, 128, smem, tid);
    EPI_LOOP {
      int row = pm * 128 + EPI_ROW, col = pn * 128 + EPI_COL;
      sc[(long)row * 2048 + col] = acc[m][n][j];
    }
  }
}

constexpr int KLOW = 12;
__constant__ unsigned char CAND_IJ[50] = {
  0x00,0x01,0x02,0x03,0x04,0x05,0x06,0x07,0x08,0x09,0x0A,0x0B,0x0C,0x0D,0x0E,0x0F,
  0x10,0x11,0x12,0x13,0x14,0x15,0x16,0x17,
  0x20,0x21,0x22,0x23,0x24,
  0x30,0x31,0x32,0x33,
  0x40,0x41,0x42,
  0x50,0x51, 0x60,0x61, 0x70,0x71,
  0x80,0x90,0xA0,0xB0,0xC0,0xD0,0xE0,0xF0};
DEVI unsigned fkey(float f) {
  unsigned u = __float_as_uint(f);
  return (u & 0x80000000u) ? ~u : (u | 0x80000000u);
}
DEVI void dec16(uint4 v, f32x2 (&o)[8]) {
  o[0] = __builtin_amdgcn_cvt_pk_f32_fp8((int)v.x, false); o[1] = __builtin_amdgcn_cvt_pk_f32_fp8((int)v.x, true);
  o[2] = __builtin_amdgcn_cvt_pk_f32_fp8((int)v.y, false); o[3] = __builtin_amdgcn_cvt_pk_f32_fp8((int)v.y, true);
  o[4] = __builtin_amdgcn_cvt_pk_f32_fp8((int)v.z, false); o[5] = __builtin_amdgcn_cvt_pk_f32_fp8((int)v.z, true);
  o[6] = __builtin_amdgcn_cvt_pk_f32_fp8((int)v.w, false); o[7] = __builtin_amdgcn_cvt_pk_f32_fp8((int)v.w, true);
}
DEVI void phase11(const Params& P, int l, int pass, char* smem) {
  const int ntok = pass ? 8192 : 8448, base = pass ? 8448 : 0;
  const int tid = ltid(); const int w = tid >> 6, lane = tid & 63;
  float* scl = (float*)smem;
  float* sv = scl + 2048;
  int* si = (int*)(sv + 256);
  float* tops = (float*)(si + 256);
  int* tope = (int*)(tops + 128);
  float* wgt = (float*)(tope + 128);
  float* svs = wgt + 128;
  int* sis = (int*)(svs + 256);
  float* red = (float*)(sis + 256);
  float* stat = red + 4096;
  const float* SC = (const float*)(P.ws + O_SC);
  const unsigned char* UT = (const unsigned char*)(P.ws + O_UTB);
  const unsigned char* VTb = (const unsigned char*)(P.ws + O_VTB);
  const float* g2 = P.in[28] + l * 1024;
  const float* b2 = P.in[29] + l * 1024;
  bfu* xb = (bfu*)(P.ws + O_XB);
  const unsigned long long ltmask = (1ull << lane) - 1ull;
  for (int lt = blockIdx.x; lt < ntok; lt += gridDim.x) {
    const int it = base + lt;
    float* xr = xrow(P, it);
    __syncthreads();
    {
      const float4* s4 = reinterpret_cast<const float4*>(SC + (long)lt * 2048);
      reinterpret_cast<float4*>(scl)[tid] = s4[tid];
      reinterpret_cast<float4*>(scl)[tid + 256] = s4[tid + 256];
    }
    __syncthreads();
    {
      float v0[4], v1[4]; unsigned k0[4], k1[4], T[4];
#pragma unroll
      for (int li = 0; li < 4; ++li) {
        const int Lx = w * 4 + li;
        v0[li] = scl[Lx * 128 + lane]; v1[li] = scl[Lx * 128 + 64 + lane];
        k0[li] = fkey(v0[li]); k1[li] = fkey(v1[li]); T[li] = 0;
      }
      for (int b = 31; b >= KLOW; --b) {
#pragma unroll
        for (int li = 0; li < 4; ++li) {
          unsigned cand = T[li] | (1u << b);
          int cnt = __popcll(__ballot(k0[li] >= cand)) + __popcll(__ballot(k1[li] >= cand));
          if (cnt >= 16) T[li] = cand;
        }
      }
#pragma unroll
      for (int li = 0; li < 4; ++li) {
        const int Lx = w * 4 + li;
        const unsigned T2 = T[li] + (1u << KLOW);
        bool g0 = k0[li] >= T2, g1 = k1[li] >= T2;
        bool q0 = (k0[li] >= T[li]) && !g0, q1 = (k1[li] >= T[li]) && !g1;
        unsigned long long mg0 = __ballot(g0), mg1 = __ballot(g1), mq0 = __ballot(q0), mq1 = __ballot(q1);
        int ng0 = __popcll(mg0), ng = ng0 + __popcll(mg1);
        int p0 = g0 ? __popcll(mg0 & ltmask) : ng + __popcll(mq0 & ltmask);
        int p1 = g1 ? ng0 + __popcll(mg1 & ltmask) : ng + __popcll(mq0) + __popcll(mq1 & ltmask);
        if ((g0 || q0) && p0 < 16) { sv[Lx * 16 + p0] = v0[li]; si[Lx * 16 + p0] = lane; }
        if ((g1 || q1) && p1 < 16) { sv[Lx * 16 + p1] = v1[li]; si[Lx * 16 + p1] = lane + 64; }
      }
    }
    __builtin_amdgcn_wave_barrier();
    {
      const int Lx = w * 4 + (lane >> 4), e = lane & 15;
      const float v = sv[Lx * 16 + e];
      const int id = si[Lx * 16 + e];
      int rank = 0;
#pragma unroll
      for (int q = 0; q < 4; ++q) {
        float4 o = *reinterpret_cast<const float4*>(sv + Lx * 16 + q * 4);
        rank += (o.x > v || (o.x == v && q * 4 + 0 < e)) ? 1 : 0;
        rank += (o.y > v || (o.y == v && q * 4 + 1 < e)) ? 1 : 0;
        rank += (o.z > v || (o.z == v && q * 4 + 2 < e)) ? 1 : 0;
        rank += (o.w > v || (o.w == v && q * 4 + 3 < e)) ? 1 : 0;
      }
      __builtin_amdgcn_wave_barrier();
      svs[Lx * 16 + rank] = v; sis[Lx * 16 + rank] = id;
    }
    __builtin_amdgcn_wave_barrier();
    {
      float cv[2]; unsigned ck[2], T[2]; int ce[2];
      const int cij = (lane < 50) ? (int)CAND_IJ[lane] : 0;
      const int ci = cij >> 4, cj = cij & 15;
#pragma unroll
      for (int hi = 0; hi < 2; ++hi) {
        const int h = w * 2 + hi;
        T[hi] = 0;
        cv[hi] = svs[(2 * h) * 16 + ci] + svs[(2 * h + 1) * 16 + cj];
        ce[hi] = sis[(2 * h) * 16 + ci] * 128 + sis[(2 * h + 1) * 16 + cj];
        ck[hi] = (lane < 50) ? fkey(cv[hi]) : 0u;
      }
      for (int b = 31; b >= KLOW; --b) {
#pragma unroll
        for (int hi = 0; hi < 2; ++hi) {
          unsigned cand = T[hi] | (1u << b);
          int cnt = __popcll(__ballot(ck[hi] >= cand));
          if (cnt >= 16) T[hi] = cand;
        }
      }
#pragma unroll
      for (int hi = 0; hi < 2; ++hi) {
        const int h = w * 2 + hi;
        const unsigned T2 = T[hi] + (1u << KLOW);
        bool g = ck[hi] >= T2, q = (ck[hi] >= T[hi]) && !g && (lane < 50);
        unsigned long long mg = __ballot(g), mq = __ballot(q);
        int p = g ? __popcll(mg & ltmask) : __popcll(mg) + __popcll(mq & ltmask);
        if ((g || q) && p < 16) { tops[h * 16 + p] = cv[hi]; tope[h * 16 + p] = ce[hi]; }
      }
    }
    __syncthreads();
    if (tid < 128) {
      float s = tops[tid];
      float mx = s;
      mx = fmaxf(mx, __shfl_xor(mx, 1)); mx = fmaxf(mx, __shfl_xor(mx, 2));
      mx = fmaxf(mx, __shfl_xor(mx, 4)); mx = fmaxf(mx, __shfl_xor(mx, 8));
      float e = __expf(s - mx);
      float sm = e;
      sm += __shfl_xor(sm, 1); sm += __shfl_xor(sm, 2); sm += __shfl_xor(sm, 4); sm += __shfl_xor(sm, 8);
      tops[tid] = e / sm;
    }
    __syncthreads();
    f32x2 xv[8];
    {
      const float4* xp = reinterpret_cast<const float4*>(xr + lane * 16);
#pragma unroll
      for (int q = 0; q < 4; ++q) {
        float4 a = xp[q];
        xv[2 * q] = f32x2{a.x, a.y}; xv[2 * q + 1] = f32x2{a.z, a.w};
      }
    }
    f32x2 oacc[8];
#pragma unroll
    for (int q = 0; q < 8; ++q) oacc[q] = f32x2{0.f, 0.f};
#pragma unroll 1
    for (int p0 = 0; p0 < 32; p0 += 8) {
      uint4 ru[8], rv[8];
#pragma unroll
      for (int i = 0; i < 8; ++i) {
        int e = tope[w * 32 + p0 + i];
        ru[i] = *reinterpret_cast<const uint4*>(UT + (long)e * 1024 + lane * 16);
        rv[i] = *reinterpret_cast<const uint4*>(VTb + (long)e * 1024 + lane * 16);
      }
      float dsum[8];
#pragma unroll
      for (int i = 0; i < 8; ++i) {
        f32x2 f[8];
        dec16(ru[i], f);
        f32x2 acc = f[0] * xv[0];
#pragma unroll
        for (int q = 1; q < 8; ++q) acc = __builtin_elementwise_fma(f[q], xv[q], acc);
        dsum[i] = acc.x + acc.y;
      }
      float e4[4], e2[2], e1;
      {
        const bool hi = (lane & 32) != 0;
#pragma unroll
        for (int i = 0; i < 4; ++i) {
          float snd = hi ? dsum[i] : dsum[i + 4];
          float kp = hi ? dsum[i + 4] : dsum[i];
          e4[i] = kp + __shfl_xor(snd, 32);
        }
        const bool hi2 = (lane & 16) != 0;
#pragma unroll
        for (int i = 0; i < 2; ++i) {
          float snd = hi2 ? e4[i] : e4[i + 2];
          float kp = hi2 ? e4[i + 2] : e4[i];
          e2[i] = kp + __shfl_xor(snd, 16);
        }
        const bool hi3 = (lane & 8) != 0;
        {
          float snd = hi3 ? e2[0] : e2[1];
          float kp = hi3 ? e2[1] : e2[0];
          e1 = kp + __shfl_xor(snd, 8);
        }
        e1 += __shfl_xor(e1, 4); e1 += __shfl_xor(e1, 2); e1 += __shfl_xor(e1, 1);
      }
      {
        int r = ((lane >> 5) & 1) * 4 + ((lane >> 4) & 1) * 2 + ((lane >> 3) & 1);
        float wv_ = tops[w * 32 + p0 + r] * geluf_(e1 * (1.f / U_SCALE)) * (1.f / V_SCALE);
        if ((lane & 7) == 0) wgt[w * 32 + p0 + r] = wv_;
      }
      __builtin_amdgcn_wave_barrier();
      float wg[8];
      {
        float4 wa = *reinterpret_cast<const float4*>(wgt + w * 32 + p0);
        float4 wb = *reinterpret_cast<const float4*>(wgt + w * 32 + p0 + 4);
        wg[0] = wa.x; wg[1] = wa.y; wg[2] = wa.z; wg[3] = wa.w; wg[4] = wb.x; wg[5] = wb.y; wg[6] = wb.z; wg[7] = wb.w;
      }
#pragma unroll
      for (int i = 0; i < 8; ++i) {
        f32x2 f[8];
        dec16(rv[i], f);
        f32x2 wv = f32x2{wg[i], wg[i]};
#pragma unroll
        for (int q = 0; q < 8; ++q) oacc[q] = __builtin_elementwise_fma(f[q], wv, oacc[q]);
      }
    }
    {
      float4* rwp = reinterpret_cast<float4*>(red + w * 1024 + lane * 16);
#pragma unroll
      for (int q = 0; q < 4; ++q) rwp[q] = make_float4(oacc[2 * q].x, oacc[2 * q].y, oacc[2 * q + 1].x, oacc[2 * q + 1].y);
    }
    __syncthreads();
    const int c = tid * 4;
    float y[4];
    {
      float4 xx = *reinterpret_cast<const float4*>(xr + c);
      float4 r0 = *reinterpret_cast<const float4*>(red + c);
      float4 r1 = *reinterpret_cast<const float4*>(red + 1024 + c);
      float4 r2 = *reinterpret_cast<const float4*>(red + 2048 + c);
      float4 r3 = *reinterpret_cast<const float4*>(red + 3072 + c);
      y[0] = ALPHA * xx.x + (r0.x + r1.x + r2.x + r3.x);
      y[1] = ALPHA * xx.y + (r0.y + r1.y + r2.y + r3.y);
      y[2] = ALPHA * xx.z + (r0.z + r1.z + r2.z + r3.z);
      y[3] = ALPHA * xx.w + (r0.w + r1.w + r2.w + r3.w);
    }
    float s = wave_sum(y[0] + y[1] + y[2] + y[3]);
    if (lane == 0) stat[w] = s;
    __syncthreads();
    float mu = (stat[0] + stat[1] + stat[2] + stat[3]) * (1.f / 1024.f);
    float ss = 0.f;
#pragma unroll
    for (int i = 0; i < 4; ++i) { float dl = y[i] - mu; ss += dl * dl; }
    ss = wave_sum(ss);
    if (lane == 0) stat[4 + w] = ss;
    __syncthreads();
    float rs = rsqrtf((stat[4] + stat[5] + stat[6] + stat[7]) * (1.f / 1024.f) + 1e-5f);
    float o[4];
#pragma unroll
    for (int i = 0; i < 4; ++i) o[i] = (y[i] - mu) * rs * g2[c + i] + b2[c + i];
    *reinterpret_cast<float4*>(xr + c) = make_float4(o[0], o[1], o[2], o[3]);
    store4bf(xb + (long)it * 1024 + c, o);
  }
}

#define XB_TMO      128
#define XB_XCNT(j)  (256  + 64 * (j))
#define XB_XSUB(j)  (1280 + 64 * (j))
#define XB_XGEN(j)  (2304 + 64 * (j))
#define XB_TOP      3328
#define XB_TOPGEN   3392
#define XCD_BAR_WORDS 3456
#define XB_SPIN_CAP (1u << 18)
DEVI unsigned xb_ld(unsigned* p) { return __hip_atomic_load(p, __ATOMIC_RELAXED, __HIP_MEMORY_SCOPE_AGENT); }
DEVI unsigned xb_add(unsigned* p, unsigned v) { return __hip_atomic_fetch_add(p, v, __ATOMIC_RELAXED, __HIP_MEMORY_SCOPE_AGENT); }
DEVI unsigned xb_xcc_id() { return (unsigned)__builtin_amdgcn_s_getreg((3 << 11) | 20) & 0xFu; }
#define XB_SPIN(cond, bar) do { unsigned _sp = 0; while (cond) { __builtin_amdgcn_s_sleep(1); \
    if ((++_sp & 255u) == 0u) { if (xb_ld(&(bar)[XB_TMO])) break; if (_sp > XB_SPIN_CAP) { atomicAdd(&(bar)[XB_TMO], 1u); break; } } } } while (0)
DEVI void xcd_census(unsigned* bar, unsigned x, unsigned& nloc, unsigned& nx) {
  const unsigned G = gridDim.x;
  unsigned sum, cnt, mine, sp = 0u;
  for (;;) {
    sum = 0u; cnt = 0u; mine = 0u;
#pragma unroll
    for (unsigned j = 0; j < 16; ++j) { const unsigned c = xb_ld(&bar[XB_XCNT(j)]); sum += c; cnt += (c > 0u) ? 1u : 0u; mine = (j == x) ? c : mine; }
    if (sum == G) break;
    __builtin_amdgcn_s_sleep(1);
    if ((++sp & 255u) == 0u) { if (xb_ld(&bar[XB_TMO])) break; if (sp > XB_SPIN_CAP) { atomicAdd(&bar[XB_TMO], 1u); break; } }
  }
  nloc = mine > 0u ? mine : 1u; nx = cnt > 0u ? cnt : 1u;
}
DEVI void xcd_barrier(unsigned* bar, unsigned x, unsigned nloc, unsigned nx) {
  asm volatile("s_waitcnt vmcnt(0)" ::: "memory");
  __syncthreads();
  if (threadIdx.x == 0) {
    __builtin_amdgcn_s_waitcnt(0);
    const unsigned old = xb_add(&bar[XB_XSUB(x)], 1u);
    const unsigned gen = old / nloc;
    if (old + 1u == (gen + 1u) * nloc) {
      __builtin_amdgcn_fence(__ATOMIC_RELEASE, "agent");
      asm volatile("s_waitcnt vmcnt(0)" ::: "memory");
      const unsigned og = xb_add(&bar[XB_TOP], 1u);
      const unsigned tg = og / nx;
      if (og + 1u == (tg + 1u) * nx) xb_add(&bar[XB_TOPGEN], 1u);
      else XB_SPIN(xb_ld(&bar[XB_TOPGEN]) == tg, bar);
      __builtin_amdgcn_fence(__ATOMIC_ACQUIRE, "agent");
      xb_add(&bar[XB_XGEN(x)], 1u);
      asm volatile("s_waitcnt vmcnt(0)" ::: "memory");
    } else {
      XB_SPIN(xb_ld(&bar[XB_XGEN(x)]) == gen, bar);
      __builtin_amdgcn_fence(__ATOMIC_ACQUIRE, "agent");
      asm volatile("s_waitcnt vmcnt(0)" ::: "memory");
    }
  }
  __syncthreads();
}

__global__ void __launch_bounds__(256, 2) fwd_megakernel(Params P) {
  __shared__ __attribute__((aligned(16))) char smem[65536];
  cg::grid_group grid = cg::this_grid();
  unsigned* bar = (unsigned*)(P.ws + O_BAR);
  const unsigned xcc = xb_xcc_id();
  if (threadIdx.x == 0) (void)xb_add(&bar[XB_XCNT(xcc)], 1u);
  unsigned nloc = 1u, nx = 1u;
#define LND asm volatile("" : "+s"(l), "+s"(pass))
#define GSYNC xcd_barrier(bar, xcc, nloc, nx)
#pragma unroll 1
  for (int l = 0; l < 2; ++l) {
    phase_prep(P, l, smem);
    if (l == 0) {
      phase_xcopy(P);
      grid.sync();
      if (threadIdx.x == 0) xcd_census(bar, xcc, nloc, nx);
    } else {
      GSYNC;
    }
#pragma unroll 1
    for (int pass = 0; pass < 2; ++pass) {
      LND; phase_inproj(P, l, pass, smem); GSYNC;
      LND; phase2(P, l, pass, smem); GSYNC;
      LND; phase3(P, l, pass, smem); GSYNC;
      LND; phase4(P, l, pass, smem); GSYNC;
      LND; phase5(P, l, pass); GSYNC;
      LND; phase6(P, l, pass, smem); GSYNC;
      LND; phase7(P, l, pass, smem); GSYNC;
      LND; phase8(P, l, pass); GSYNC;
      LND; phase9(P, l, pass, smem); GSYNC;
      LND; phase10(P, l, pass, smem); GSYNC;
      LND; phase11(P, l, pass, smem); if (!(l == 1 && pass == 1)) GSYNC;
    }
  }
}

extern "C" void kernel_launch(void* const* d_in, const int* in_sizes, int n_in, void* d_out, int out_size,
                              void* d_ws, size_t ws_size, hipStream_t stream) {
  static int grid_blocks = 0;
  if (!grid_blocks) {
    int dev = 0, cus = 0, per_cu = 0;
    hipGetDevice(&dev);
    hipDeviceGetAttribute(&cus, hipDeviceAttributeMultiprocessorCount, dev);
    hipOccupancyMaxActiveBlocksPerMultiprocessor(&per_cu, fwd_megakernel, 256, 0);
    if (per_cu > 2) per_cu = 2;
    if (per_cu < 1) per_cu = 1;
    grid_blocks = cus * per_cu;
  }
  if (ws_size < O_END) fprintf(stderr, "workspace too small: %zu < %zu\n", ws_size, (size_t)O_END);
  hipMemsetAsync((char*)d_ws + O_BAR, 0, 16384, stream);
  Params p{};
  for (int i = 0; i < 30; ++i) p.in[i] = (const float*)d_in[i];
  p.out = (float*)d_out;
  p.ws = (char*)d_ws;
  void* args[] = {&p};
  hipError_t e = hipLaunchCooperativeKernel((void*)fwd_megakernel, dim3(grid_blocks), dim3(256), args, 0, stream);
  if (e != hipSuccess) fprintf(stderr, "cooperative launch failed: %s (grid %d)\n", hipGetErrorString(e), grid_blocks);
}
```

```cpp
#include <hip/hip_runtime.h>
#include <hip/hip_bf16.h>
#include <hip/hip_cooperative_groups.h>
#include <cstdio>
namespace cg = cooperative_groups;

typedef unsigned short bfu;
using bf16x8 = __attribute__((ext_vector_type(8))) short;
using f32x4 = __attribute__((ext_vector_type(4))) float;
#define DEVI __device__ __forceinline__

constexpr float ALPHA = 1.41421356237f;
constexpr int NCOL = 12288;

constexpr size_t O_WIN = 0;
constexpr size_t O_WOA = O_WIN + 25165824;
constexpr size_t O_WOB = O_WOA + 2097152;
constexpr size_t O_WOC = O_WOB + 2097152;
constexpr size_t O_WO = O_WOC + 2097152;
constexpr size_t O_WQ = O_WO + 2097152;
constexpr size_t O_KEYS = O_WQ + 4194304;
constexpr size_t O_LRU = O_KEYS + 524288;
constexpr size_t O_UTB = O_LRU + 524288;
constexpr size_t O_VTB = O_UTB + 33554432;
constexpr size_t O_LBS = O_VTB + 33554432;
constexpr size_t O_XB = O_LBS + 8192;
constexpr size_t O_Z = O_XB + 34078720;
constexpr size_t O_UA = O_Z + 207618048;
constexpr size_t O_UB = O_UA + 17301504;
constexpr size_t O_UC = O_UB + 17301504;
constexpr size_t O_CB = O_UC + 17301504;
constexpr size_t O_AU = O_CB + 17301504;
constexpr size_t O_LSUM = O_AU + 69206016;
constexpr size_t O_US = O_LSUM + 540672;
constexpr size_t O_DEC = O_US + 33554432;
constexpr size_t O_BAR = O_DEC + 524288;
constexpr size_t O_END = O_BAR + 16384;
constexpr size_t O_PRE = O_Z;
constexpr size_t O_QP = O_Z + 34603008;
constexpr size_t O_SC = O_QP + 34603008;

constexpr long OUT_YS = 16777216;
constexpr long OUT_CAP = 17039360;
constexpr long OUT_CBP = 17055744;
constexpr long OUT_LRP = 17080320;
constexpr long OUT_HGP = 17088512;
constexpr long OUT_CAS = 18137088;
constexpr long OUT_CBS = 18169856;
constexpr long OUT_LRS = 18219008;
constexpr long OUT_HGS = 18235392;

struct Params {
  const float* in[30];
  float* out;
  char* ws;
};

DEVI bfu f2b(float f) {
  unsigned u = __float_as_uint(f);
  u += 0x7FFFu + ((u >> 16) & 1u);
  return (bfu)(u >> 16);
}
DEVI float b2f(bfu b) { return __uint_as_float(((unsigned)b) << 16); }
DEVI float sigmoidf_(float x) { return 1.f / (1.f + __expf(-x)); }
DEVI float siluf_(float x) { return x / (1.f + __expf(-x)); }
DEVI float geluf_(float x) { return 0.5f * x * (1.f + erff(x * 0.70710678118f)); }
DEVI float wave_sum(float v) {
#pragma unroll
  for (int o = 32; o; o >>= 1) v += __shfl_xor(v, o);
  return v;
}

DEVI int ltid() { int t = threadIdx.x; asm volatile("" : "+v"(t)); return t; }
struct TokInfo { int sample, seq, t; };
DEVI TokInfo tokinfo(int it) {
  TokInfo r;
  if (it < 8192) { r.sample = 0; r.seq = it >> 12; r.t = it & 4095; }
  else if (it < 8448) { int q = it - 8192; r.sample = 1; r.seq = q >> 5; r.t = q & 31; }
  else { int q = it - 8448; r.sample = 0; r.seq = 2 + (q >> 12); r.t = q & 4095; }
  return r;
}
DEVI float* xrow(const Params& P, int it) {
  TokInfo ti = tokinfo(it);
  return ti.sample ? P.out + OUT_YS + (long)(ti.seq * 32 + ti.t) * 1024
                   : P.out + (long)(ti.seq * 4096 + ti.t) * 1024;
}

DEVI void stage_tile(const bfu* __restrict__ g, int ld, int k0, char* lds, int tid) {
#pragma unroll
  for (int i = 0; i < 4; ++i) {
    int b = tid * 16 + i * 4096;
    int r = b >> 7, cp = (b >> 4) & 7, gc = cp ^ (r & 7);
    __builtin_amdgcn_global_load_lds((const unsigned*)(g + (long)r * ld + k0 + gc * 8),
                                     (unsigned*)(lds + b), 16, 0, 0);
  }
}
DEVI bf16x8 ldfrag(const char* tile, int r, int kc) {
  return *reinterpret_cast<const bf16x8*>(tile + r * 128 + ((kc ^ (r & 7)) << 4));
}
DEVI void stage_tile_gate(const bfu* __restrict__ Wa, const bfu* __restrict__ Wx, int k0, char* lds, int tid) {
#pragma unroll
  for (int i = 0; i < 4; ++i) {
    int b = tid * 16 + i * 4096;
    int r = b >> 7, cp = (b >> 4) & 7, gc = cp ^ (r & 7);
    const bfu* base = (r & 32) ? Wx : Wa;
    int c = (r >> 6) * 32 + (r & 31);
    __builtin_amdgcn_global_load_lds((const unsigned*)(base + (long)c * 128 + k0 + gc * 8),
                                     (unsigned*)(lds + b), 16, 0, 0);
  }
}
template <int GATE>
DEVI void gemm_core_t(f32x4 (&acc)[4][4], const bfu* __restrict__ A, int lda,
                    const bfu* __restrict__ B, int ldb, int K, char* smem, int tid, const bfu* __restrict__ B2 = nullptr) {
  const int wid = tid >> 6, lane = tid & 63;
  const int wr = wid >> 1, wc = wid & 1, fr = lane & 15, fq = lane >> 4;
  const int nt = K >> 6;
  __syncthreads();
  stage_tile(A, lda, 0, smem, tid);
  if (GATE) stage_tile_gate(B, B2, 0, smem + 16384, tid); else stage_tile(B, ldb, 0, smem + 16384, tid);
  for (int t = 0; t < nt; ++t) {
    asm volatile("s_waitcnt vmcnt(0)" ::: "memory");
    __syncthreads();
    char* cur = smem + (t & 1) * 32768;
    if (t + 1 < nt) {
      char* nx = smem + ((t + 1) & 1) * 32768;
      stage_tile(A, lda, (t + 1) * 64, nx, tid);
      if (GATE) stage_tile_gate(B, B2, (t + 1) * 64, nx + 16384, tid); else stage_tile(B, ldb, (t + 1) * 64, nx + 16384, tid);
    }
#pragma unroll
    for (int kk = 0; kk < 2; ++kk) {
      bf16x8 af[4], bfr[4];
#pragma unroll
      for (int m = 0; m < 4; ++m) af[m] = ldfrag(cur, wr * 64 + m * 16 + fr, kk * 4 + fq);
#pragma unroll
      for (int n = 0; n < 4; ++n) bfr[n] = ldfrag(cur + 16384, wc * 64 + n * 16 + fr, kk * 4 + fq);
#pragma unroll
      for (int m = 0; m < 4; ++m)
#pragma unroll
        for (int n = 0; n < 4; ++n)
          acc[m][n] = __builtin_amdgcn_mfma_f32_16x16x32_bf16(af[m], bfr[n], acc[m][n], 0, 0, 0);
    }
  }
}
DEVI void gemm_core(f32x4 (&acc)[4][4], const bfu* __restrict__ A, int lda,
                    const bfu* __restrict__ B, int ldb, int K, char* smem, int tid) {
  gemm_core_t<0>(acc, A, lda, B, ldb, K, smem, tid);
}
DEVI void tile_rc(int id, int nM, int nN, int& pm, int& pn) {
  const int x = id & 7, q = id >> 3;
  const int gfull = nM >> 3;
  const int g = q / nN;
  if (g < gfull) {
    int r = q - g * nN;
    pn = (r >> 3) * 8 + x;
    pm = g * 8 + (r & 7);
  } else {
    int gsz = nM - gfull * 8;
    int r = q - gfull * nN;
    pn = (r / gsz) * 8 + x;
    pm = gfull * 8 + (r % gsz);
  }
}
#define ZERO_ACC(a) _Pragma("unroll") for (int m_ = 0; m_ < 4; ++m_) _Pragma("unroll") for (int n_ = 0; n_ < 4; ++n_) a[m_][n_] = f32x4{0.f, 0.f, 0.f, 0.f}
#define EPI_LOOP \
  const int wid_ = tid >> 6, lane_ = tid & 63; \
  const int wr_ = wid_ >> 1, wc_ = wid_ & 1, fr_ = lane_ & 15, fq_ = lane_ >> 4; \
  _Pragma("unroll") for (int m = 0; m < 4; ++m) for (int sb_ = (__builtin_amdgcn_sched_barrier(0), 0); sb_ < 1; ++sb_) _Pragma("unroll") for (int n = 0; n < 4; ++n) _Pragma("unroll") for (int j = 0; j < 4; ++j)
#define EPI_ROW (wr_ * 64 + m * 16 + fq_ * 4 + j)
#define EPI_COL (wc_ * 64 + n * 16 + fr_)

DEVI void transpose_tile(const float* __restrict__ src, bfu* __restrict__ dst, int R, int C, int r0, int c0, float* tile, int tid) {
  __syncthreads();
  {
    int tx = tid & 15, ty = tid >> 4;
#pragma unroll
    for (int i = 0; i < 4; ++i) {
      int r = ty + i * 16;
      float4 v = *reinterpret_cast<const float4*>(src + (long)(r0 + r) * C + c0 + tx * 4);
      float* tp = tile + r * 65 + tx * 4;
      tp[0] = v.x; tp[1] = v.y; tp[2] = v.z; tp[3] = v.w;
    }
  }
  __syncthreads();
  {
    int c = tid >> 2, rs = (tid & 3) * 16;
    unsigned pk[8];
#pragma unroll
    for (int i = 0; i < 8; ++i) {
      unsigned lo = f2b(tile[(rs + 2 * i) * 65 + c]);
      unsigned hi = f2b(tile[(rs + 2 * i + 1) * 65 + c]);
      pk[i] = lo | (hi << 16);
    }
    uint4* dp = reinterpret_cast<uint4*>(dst + (long)(c0 + c) * R + r0 + rs);
    dp[0] = make_uint4(pk[0], pk[1], pk[2], pk[3]);
    dp[1] = make_uint4(pk[4], pk[5], pk[6], pk[7]);
  }
}
DEVI void convert_chunk(const float* __restrict__ src, bfu* __restrict__ dst, int tid) {
  int o = tid * 8;
  float4 a = *reinterpret_cast<const float4*>(src + o);
  float4 b = *reinterpret_cast<const float4*>(src + o + 4);
  uint4 r;
  r.x = f2b(a.x) | ((unsigned)f2b(a.y) << 16);
  r.y = f2b(a.z) | ((unsigned)f2b(a.w) << 16);
  r.z = f2b(b.x) | ((unsigned)f2b(b.y) << 16);
  r.w = f2b(b.z) | ((unsigned)f2b(b.w) << 16);
  *reinterpret_cast<uint4*>(dst + o) = r;
}

typedef float f32x2 __attribute__((ext_vector_type(2)));
constexpr float U_SCALE = 64.f, V_SCALE = 8.f;
DEVI void convert_chunk_fp8(const float* __restrict__ src, unsigned char* __restrict__ dst, float scale, int tid) {
  int o = tid * 16;
  uint4 r;
  unsigned rr[4];
#pragma unroll
  for (int q = 0; q < 4; ++q) {
    float4 a = *reinterpret_cast<const float4*>(src + o + q * 4);
    int p = __builtin_amdgcn_cvt_pk_fp8_f32(a.x * scale, a.y * scale, 0, false);
    p = __builtin_amdgcn_cvt_pk_fp8_f32(a.z * scale, a.w * scale, p, true);
    rr[q] = (unsigned)p;
  }
  r = make_uint4(rr[0], rr[1], rr[2], rr[3]);
  *reinterpret_cast<uint4*>(dst + o) = r;
}

DEVI void phase_prep(const Params& P, int l, char* smem) {
  const int tid = ltid();
  char* ws = P.ws;
  float* tile = reinterpret_cast<float*>(smem);
  const int NT_WIN = 3072, NT_SQ = 256, NT_WQ = 512, NT_LRU = 64;
  const int T0 = NT_WIN, T1 = T0 + 4 * NT_SQ, T2 = T1 + NT_WQ, T3 = T2 + NT_LRU;
  const int C0 = T3 + 128, C1 = C0 + 4096, C2 = C1 + 4096;
  const int X0 = C2;
  const int L0 = X0 + (l == 0 ? 8 : 0);
  for (int id = blockIdx.x; id < L0; id += gridDim.x) {
    if (id < T0) {
      int tr = id / 192, tc = id % 192;
      transpose_tile(P.in[6] + (long)l * 1024 * 12288, (bfu*)(ws + O_WIN), 1024, 12288, tr * 64, tc * 64, tile, tid);
    } else if (id < T1) {
      int q = id - T0, w = q >> 8, t = q & 255;
      const float* src = P.in[18 + w] + (long)l * 1048576;
      bfu* dst = (bfu*)(ws + (w == 0 ? O_WOA : w == 1 ? O_WOB : w == 2 ? O_WOC : O_WO));
      transpose_tile(src, dst, 1024, 1024, (t >> 4) * 64, (t & 15) * 64, tile, tid);
    } else if (id < T2) {
      int q = id - T1;
      transpose_tile(P.in[24] + (long)l * 2097152, (bfu*)(ws + O_WQ), 1024, 2048, (q >> 5) * 64, (q & 31) * 64, tile, tid);
    } else if (id < T3) {
      int q = id - T2, mtx = q >> 2, t = q & 3, g = mtx >> 3, nb = mtx & 7;
      const float* src = P.in[g == 0 ? 11 : 13] + (long)l * 131072 + nb * 16384;
      transpose_tile(src, (bfu*)(ws + O_LRU) + mtx * 16384, 128, 128, (t >> 1) * 64, (t & 1) * 64, tile, tid);
    } else if (id < C0) {
      int q = id - T3;
      convert_chunk(P.in[25] + (long)l * 262144 + (long)q * 2048, (bfu*)(ws + O_KEYS) + (long)q * 2048, tid);
    } else if (id < C1) {
      int q = id - C0;
      convert_chunk_fp8(P.in[26] + (long)l * 16777216 + (long)q * 4096, (unsigned char*)(ws + O_UTB) + (long)q * 4096, U_SCALE, tid);
    } else if (id < C2) {
      int q = id - C1;
      convert_chunk_fp8(P.in[27] + (long)l * 16777216 + (long)q * 4096, (unsigned char*)(ws + O_VTB) + (long)q * 4096, V_SCALE, tid);
    } else {
      int q = id - X0;
      int c = (q & 3) * 256 + tid, ll = q >> 2;
      float a0 = P.in[16][c], a1 = P.in[16][1024 + c];
      float mx = fmaxf(a0, a1);
      float e0 = __expf(a0 - mx), e1 = __expf(a1 - mx);
      float p1 = e1 / (e0 + e1);
      float* lbs = (float*)(ws + O_LBS);
      lbs[ll * 1024 + c] = (ll == 0) ? 0.f : p1;
    }
  }
}

DEVI void phase_xcopy(const Params& P) {
  const int tid = ltid();
  bfu* xb = (bfu*)(P.ws + O_XB);
  for (int it = blockIdx.x; it < 16640; it += gridDim.x) {
    TokInfo ti = tokinfo(it);
    const float* src = ti.sample ? P.in[1] + (long)(ti.seq * 32 + ti.t) * 1024 : P.in[0] + (long)(ti.seq * 4096 + ti.t) * 1024;
    float* dst = xrow(P, it);
    int c = tid * 4;
    float4 v = *reinterpret_cast<const float4*>(src + c);
    *reinterpret_cast<float4*>(dst + c) = v;
    uint2 r;
    r.x = f2b(v.x) | ((unsigned)f2b(v.y) << 16);
    r.y = f2b(v.z) | ((unsigned)f2b(v.w) << 16);
    *reinterpret_cast<uint2*>(xb + (long)it * 1024 + c) = r;
  }
}

DEVI void phase_inproj(const Params& P, int l, int pass, char* smem) {
  const int tid = ltid();
  const int ntok = pass ? 8192 : 8448, base = pass ? 8448 : 0;
  const int nM = ntok / 128, nN = 96;
  const bfu* xb = (const bfu*)(P.ws + O_XB) + (long)base * 1024;
  const bfu* wT = (const bfu*)(P.ws + O_WIN);
  bfu* z = (bfu*)(P.ws + O_Z);
  const float* bin = P.in[7] + l * NCOL;
  for (int id = blockIdx.x; id < nM * nN; id += gridDim.x) {
    int pm, pn; tile_rc(id, nM, nN, pm, pn);
    f32x4 acc[4][4]; ZERO_ACC(acc);
    gemm_core(acc, xb + (long)pm * 128 * 1024, 1024, wT + (long)pn * 128 * 1024, 1024, 1024, smem, tid);
    EPI_LOOP {
      int row = pm * 128 + EPI_ROW, col = pn * 128 + EPI_COL;
      z[(long)row * NCOL + col] = f2b(acc[m][n][j] + bin[col]);
    }
  }
}

DEVI void load4bf(const bfu* p, float (&o)[4]) {
  uint2 v = *reinterpret_cast<const uint2*>(p);
  o[0] = __uint_as_float(v.x << 16); o[1] = __uint_as_float(v.x & 0xFFFF0000u);
  o[2] = __uint_as_float(v.y << 16); o[3] = __uint_as_float(v.y & 0xFFFF0000u);
}
DEVI void store4bf(bfu* p, const float (&v)[4]) {
  uint2 r;
  r.x = f2b(v[0]) | ((unsigned)f2b(v[1]) << 16);
  r.y = f2b(v[2]) | ((unsigned)f2b(v[3]) << 16);
  *reinterpret_cast<uint2*>(p) = r;
}
DEVI void ld4f(const float* p, float (&o)[4]) {
  float4 v = *reinterpret_cast<const float4*>(p);
  o[0] = v.x; o[1] = v.y; o[2] = v.z; o[3] = v.w;
}
DEVI void mixab_row4(const Params& P, int l, int base, int lt0, int tid) {
  const int it0 = base + lt0;
  const TokInfo ti = tokinfo(it0);
  const int T = ti.sample ? 32 : 4096;
  const int t0 = ti.t;
  const bfu* z = (const bfu*)(P.ws + O_Z);
  const int c = tid * 4;
  {
    float pk[6][4], ab[4][4], wa[3][4];
#pragma unroll
    for (int k = 0; k < 6; ++k) {
      const int tt = t0 - 2 + k;
      if (tt >= 0) {
        const bfu* zr = z + (long)(lt0 - 2 + k) * NCOL;
        float ac[4], ax[4];
        load4bf(zr + 1024 + c, ac); load4bf(zr + 2048 + c, ax);
#pragma unroll
        for (int i = 0; i < 4; ++i) pk[k][i] = ac[i] * ax[i];
      } else if (ti.sample) {
        ld4f(P.in[2] + ((long)(l * 8 + ti.seq) * 2 + (tt + 2)) * 1024 + c, pk[k]);
      } else {
#pragma unroll
        for (int i = 0; i < 4; ++i) pk[k][i] = 0.f;
      }
    }
#pragma unroll
    for (int r = 0; r < 4; ++r) load4bf(z + (long)(lt0 + r) * NCOL + c, ab[r]);
#pragma unroll
    for (int k = 0; k < 3; ++k) ld4f(P.in[8] + (long)(l * 3 + k) * 1024 + c, wa[k]);
#pragma unroll
    for (int r = 0; r < 4; ++r) {
      float o[4];
#pragma unroll
      for (int i = 0; i < 4; ++i) o[i] = ab[r][i] * (wa[0][i] * pk[r][i] + wa[1][i] * pk[r + 1][i] + wa[2][i] * pk[r + 2][i]);
      store4bf((bfu*)(P.ws + O_UA) + (long)(lt0 + r) * 1024 + c, o);
    }
    if (t0 + 4 == T) {
      float* ca = ti.sample ? P.out + OUT_CAS + (long)(l * 8 + ti.seq) * 2 * 1024 + c : P.out + OUT_CAP + (long)(l * 4 + ti.seq) * 2 * 1024 + c;
#pragma unroll
      for (int r = 0; r < 2; ++r)
        *reinterpret_cast<float4*>(ca + r * 1024) = make_float4(pk[r + 4][0], pk[r + 4][1], pk[r + 4][2], pk[r + 4][3]);
    }
  }
  __builtin_amdgcn_sched_barrier(0);
  {
    float xk[7][4], wb[4][4], bb[4];
#pragma unroll
    for (int k = 0; k < 7; ++k) {
      const int tt = t0 - 3 + k;
      if (tt >= 0) {
        load4bf(z + (long)(lt0 - 3 + k) * NCOL + 3072 + c, xk[k]);
      } else if (ti.sample) {
        ld4f(P.in[3] + ((long)(l * 8 + ti.seq) * 3 + (tt + 3)) * 1024 + c, xk[k]);
      } else {
#pragma unroll
        for (int i = 0; i < 4; ++i) xk[k][i] = 0.f;
      }
    }
#pragma unroll
    for (int k = 0; k < 4; ++k) ld4f(P.in[9] + (long)(l * 4 + k) * 1024 + c, wb[k]);
    ld4f(P.in[10] + (long)l * 1024 + c, bb);
#pragma unroll
    for (int r = 0; r < 4; ++r) {
      float o2[4];
#pragma unroll
      for (int i = 0; i < 4; ++i)
        o2[i] = wb[0][i] * xk[r][i] + wb[1][i] * xk[r + 1][i] + wb[2][i] * xk[r + 2][i] + wb[3][i] * xk[r + 3][i] + bb[i];
      store4bf((bfu*)(P.ws + O_CB) + (long)(lt0 + r) * 1024 + c, o2);
    }
    if (t0 + 4 == T) {
      float* cbp = ti.sample ? P.out + OUT_CBS + (long)(l * 8 + ti.seq) * 3 * 1024 + c : P.out + OUT_CBP + (long)(l * 4 + ti.seq) * 3 * 1024 + c;
#pragma unroll
      for (int r = 0; r < 3; ++r)
        *reinterpret_cast<float4*>(cbp + r * 1024) = make_float4(xk[r + 4][0], xk[r + 4][1], xk[r + 4][2], xk[r + 4][3]);
    }
  }
}

struct ChunkInfo { int lt0, L, sample, seqi, c; };
DEVI ChunkInfo chunkinfo(int ck) {
  ChunkInfo r;
  if (ck < 128) { r.seqi = ck >> 6; r.c = ck & 63; r.lt0 = r.seqi * 4096 + r.c * 64; r.L = 64; r.sample = 0; }
  else { r.seqi = ck - 128; r.c = 0; r.lt0 = 8192 + r.seqi * 32; r.L = 32; r.sample = 1; }
  return r;
}

DEVI void h1_item(const Params& P, int l, int ck, int h, char* smem, int tid) {
  const ChunkInfo ci = chunkinfo(ck);
  const int lane = tid & 63, w = tid >> 6, fr = lane & 15, fq = lane >> 4;
  bfu* VT = (bfu*)smem;
  bfu* KT = VT + 128 * 72;
  bfu* FS = KT + 128 * 72;
  float* tots = (float*)(smem + 54272);
  float* decl = tots + 256;
  const int d = tid & 127, hf = tid >> 7, L = ci.L, Lh = L >> 1;
  const float lb = ((const float*)(P.ws + O_LBS))[l * 1024 + h * 128 + d];
  const bfu* Z = (const bfu*)(P.ws + O_Z);
  const bfu* zfb = Z + (long)ci.lt0 * NCOL + 6 * 1024 + h * 128;
  const bfu* zib = Z + (long)ci.lt0 * NCOL + 7 * 1024 + h * 128;
  __syncthreads();
  {
    uint4 vf[4], vi[4];
#pragma unroll
    for (int q = 0; q < 4; ++q) {
      const int idx = tid + 256 * q;
      const int sr = (idx & 15) | (((idx >> 8) & 3) << 4), c16 = ((idx >> 4) & 3) | (((idx >> 6) & 3) << 2);
      if (sr < L) {
        vf[q] = *reinterpret_cast<const uint4*>(zfb + (long)sr * NCOL + c16 * 8);
        vi[q] = *reinterpret_cast<const uint4*>(zib + (long)sr * NCOL + c16 * 8);
      } else { vf[q] = make_uint4(0, 0, 0, 0); vi[q] = make_uint4(0, 0, 0, 0); }
    }
#pragma unroll
    for (int q = 0; q < 4; ++q) {
      const int idx = tid + 256 * q;
      const int sr = (idx & 15) | (((idx >> 8) & 3) << 4), c16 = ((idx >> 4) & 3) | (((idx >> 6) & 3) << 2);
      *reinterpret_cast<uint4*>(FS + sr * 136 + c16 * 8) = vf[q];
      const unsigned vv[4] = {vi[q].x, vi[q].y, vi[q].z, vi[q].w};
#pragma unroll
      for (int i = 0; i < 4; ++i) {
        VT[(c16 * 8 + 2 * i) * 72 + sr] = (bfu)(vv[i] & 0xFFFFu);
        VT[(c16 * 8 + 2 * i + 1) * 72 + sr] = (bfu)(vv[i] >> 16);
      }
    }
  }
  __syncthreads();
  float tot = 0.f;
#pragma unroll 8
  for (int i = 0; i < Lh; ++i) {
    float f = lb + (1.f - lb) * sigmoidf_(b2f(FS[(hf * Lh + i) * 136 + d]));
    tot += __logf(f);
  }
  tots[hf * 128 + d] = tot;
  __syncthreads();
  float run = hf ? 0.f : tots[128 + d];
#pragma unroll 8
  for (int i = Lh - 1; i >= 0; --i) {
    const int sr = hf * Lh + i;
    float f = lb + (1.f - lb) * sigmoidf_(b2f(FS[sr * 136 + d]));
    KT[d * 72 + sr] = f2b((1.f - f) * __expf(run));
    run += __logf(f);
  }
  if (L == 32) {
    for (int sr = 32 + hf * 16; sr < 48 + hf * 16; ++sr) KT[d * 72 + sr] = 0;
  }
  if (hf == 0) {
    float dc = __expf(tots[d] + tots[128 + d]);
    decl[d] = dc;
    if (!ci.sample) ((float*)(P.ws + O_DEC))[((ci.seqi * 8 + h) * 64 + ci.c) * 128 + d] = dc;
  }
  __syncthreads();
  f32x4 acc[2][8];
#pragma unroll
  for (int mi = 0; mi < 2; ++mi)
#pragma unroll
    for (int n = 0; n < 8; ++n) acc[mi][n] = f32x4{0.f, 0.f, 0.f, 0.f};
#pragma unroll
  for (int kk = 0; kk < 2; ++kk) {
    bf16x8 a[2];
#pragma unroll
    for (int mi = 0; mi < 2; ++mi) a[mi] = *reinterpret_cast<const bf16x8*>(VT + ((2 * w + mi) * 16 + fr) * 72 + kk * 32 + fq * 8);
#pragma unroll
    for (int n = 0; n < 8; ++n) {
      bf16x8 b = *reinterpret_cast<const bf16x8*>(KT + (n * 16 + fr) * 72 + kk * 32 + fq * 8);
#pragma unroll
      for (int mi = 0; mi < 2; ++mi) acc[mi][n] = __builtin_amdgcn_mfma_f32_16x16x32_bf16(a[mi], b, acc[mi][n], 0, 0, 0);
    }
  }
  if (!ci.sample) {
    bfu* US = (bfu*)(P.ws + O_US) + ((long)((ci.seqi * 8 + h) * 64 + ci.c) << 14);
#pragma unroll
    for (int mi = 0; mi < 2; ++mi) {
      __builtin_amdgcn_sched_barrier(0);
      bfu* bp = US + ((2 * w + mi) * 16 + fq * 4) * 128 + fr;
#pragma unroll
      for (int n = 0; n < 8; ++n)
#pragma unroll
        for (int j = 0; j < 4; ++j) bp[j * 128 + n * 16] = f2b(acc[mi][n][j]);
    }
  } else {
    long sb = ((long)((l * 8 + ci.seqi) * 8 + h)) << 14;
    const float* S0 = P.in[5] + sb;
    float* So = P.out + OUT_HGS + sb;
#pragma unroll
    for (int mi = 0; mi < 2; ++mi)
#pragma unroll
      for (int n = 0; n < 8; ++n) {
        __builtin_amdgcn_sched_barrier(0);
        int e0 = (2 * w + mi) * 16 + fq * 4, dd = n * 16 + fr;
        float4 s0 = *reinterpret_cast<const float4*>(S0 + dd * 128 + e0);
        float dcl = decl[dd];
        float4 r;
        r.x = dcl * s0.x + acc[mi][n][0]; r.y = dcl * s0.y + acc[mi][n][1];
        r.z = dcl * s0.z + acc[mi][n][2]; r.w = dcl * s0.w + acc[mi][n][3];
        *reinterpret_cast<float4*>(So + dd * 128 + e0) = r;
      }
  }
}

DEVI void phase2(const Params& P, int l, int pass, char* smem) {
  const int tid = ltid();
  const int ntok = pass ? 8192 : 8448, base = pass ? 8448 : 0;
  const int nck = pass ? 128 : 136;
  const int nH = nck * 8;
  const int total = nH + ntok / 4;
  for (int id = blockIdx.x; id < total; id += gridDim.x) {
    if (id < nH) h1_item(P, l, id >> 3, id & 7, smem, tid);
    else mixab_row4(P, l, base, (id - nH) * 4, tid);
  }
}

DEVI void gate_tile(const Params& P, int l, int pm, int q, char* smem, int tid) {
  const int nb = q >> 1, hb = q & 1;
  const bfu* cb = (const bfu*)(P.ws + O_CB);
  const bfu* A = cb + (long)pm * 128 * 1024 + nb * 128;
  const bfu* Wa = (const bfu*)(P.ws + O_LRU) + nb * 16384 + hb * 64 * 128;
  const bfu* Wx = Wa + 8 * 16384;
  float* au0 = (float*)(P.ws + O_AU);
  float* au1 = au0 + (long)8448 * 1024;
  const float* ba = P.in[12] + l * 1024;
  const float* bx = P.in[14] + l * 1024;
  const float* lam = P.in[15] + l * 1024;
  f32x4 acc[4][4]; ZERO_ACC(acc);
  gemm_core_t<1>(acc, A, 1024, Wa, 128, 128, smem, tid, Wx);
  const int wid = tid >> 6, lane = tid & 63, wr = wid >> 1, wc = wid & 1, fr = lane & 15, fq = lane >> 4;
#pragma unroll
  for (int n = 0; n < 2; ++n) {
    const int col = nb * 128 + hb * 64 + wc * 32 + n * 16 + fr;
    const float sp8 = -8.f * log1pf(__expf(-lam[col]));
    const float bav = ba[col], bxv = bx[col];
#pragma unroll
    for (int m = 0; m < 4; ++m) {
      __builtin_amdgcn_sched_barrier(0);
#pragma unroll
      for (int j = 0; j < 4; ++j) {
        const long row = pm * 128 + wr * 64 + m * 16 + fq * 4 + j;
        float r = sigmoidf_(acc[m][n][j] + bav);
        float gi = sigmoidf_(acc[m][n + 2][j] + bxv);
        float a = __expf(sp8 * r);
        float mult = sqrtf(fmaxf(1.f - a * a, 0.f));
        float xv = b2f(cb[row * 1024 + col]);
        au0[row * 1024 + col] = a;
        au1[row * 1024 + col] = mult * gi * xv;
      }
    }
  }
}
DEVI void h2_item(const Params& P, int l, int pass, int item, int tid) {
  const int sh = item >> 6, blk = item & 63;
  const int idx = blk * 256 + tid, e = idx >> 7, d = idx & 127;
  bfu* US = (bfu*)(P.ws + O_US) + ((long)sh * 64 << 14) + idx;
  const float* dec = (const float*)(P.ws + O_DEC) + (long)sh * 64 * 128 + d;
  float S = 0.f;
  for (int c0 = 0; c0 < 64; c0 += 8) {
    float u[8], dc[8];
#pragma unroll
    for (int i = 0; i < 8; ++i) { u[i] = b2f(US[(long)(c0 + i) << 14]); dc[i] = dec[(c0 + i) * 128]; }
#pragma unroll
    for (int i = 0; i < 8; ++i) { US[(long)(c0 + i) << 14] = f2b(S); S = dc[i] * S + u[i]; }
  }
  const int sl = sh >> 3, h = sh & 7, b = pass * 2 + sl;
  P.out[OUT_HGP + (((long)((l * 4 + b) * 8 + h)) << 14) + d * 128 + e] = S;
}
DEVI void phase3(const Params& P, int l, int pass, char* smem) {
  const int tid = ltid();
  const int ntok = pass ? 8192 : 8448;
  const int nG = (ntok / 128) * 16, nH2 = 1024;
  for (int id = blockIdx.x; id < nG + nH2; id += gridDim.x) {
    if (id < nG) gate_tile(P, l, id >> 4, id & 15, smem, tid);
    else h2_item(P, l, pass, id - nG, tid);
  }
}

DEVI void lsum_item(const Params& P, int tile, int cg4, int tid) {
  const int w = tid >> 6, lane = tid & 63;
  const int ch = (cg4 * 4 + w) * 64 + lane;
  const float* a0 = (const float*)(P.ws + O_AU) + (long)tile * 128 * 1024 + ch;
  const float* u0 = a0 + (long)8448 * 1024;
  float A = 1.f, H = 0.f;
  for (int r0 = 0; r0 < 128; r0 += 16) {
    float av[16], uv[16];
#pragma unroll
    for (int i = 0; i < 16; ++i) { av[i] = a0[(long)(r0 + i) * 1024]; uv[i] = u0[(long)(r0 + i) * 1024]; }
#pragma unroll
    for (int i = 0; i < 16; ++i) { H = av[i] * H + uv[i]; A *= av[i]; }
  }
  float* ls = (float*)(P.ws + O_LSUM) + (long)tile * 2048;
  ls[ch] = A; ls[1024 + ch] = H;
}

DEVI void h3_item(const Params& P, int l, int ck, int h, char* smem, int tid) {
  const ChunkInfo ci = chunkinfo(ck);
  const int lane = tid & 63, w = tid >> 6, fr = lane & 15, fq = lane >> 4;
  bfu* QT = (bfu*)smem;
  bfu* KT = QT + 64 * 136;
  bfu* AT = KT + 64 * 136;
  bfu* BS = AT + 64 * 72;
  float* bmid = (float*)(BS + 128 * 72);
  const int d = tid & 127, hf = tid >> 7, L = ci.L, Lh = L >> 1;
  const float lb = ((const float*)(P.ws + O_LBS))[l * 1024 + h * 128 + d];
  const bfu* Z = (const bfu*)(P.ws + O_Z);
  const bfu* zqb = Z + (long)ci.lt0 * NCOL + 5 * 1024 + h * 128;
  __syncthreads();
  {
    uint4 vq[4], vf[4], vi[4];
#pragma unroll
    for (int q = 0; q < 4; ++q) {
      const int idx = tid + 256 * q;
      const int sr = (idx & 15) | (((idx >> 8) & 3) << 4), c16 = ((idx >> 4) & 3) | (((idx >> 6) & 3) << 2);
      if (sr < L) {
        const bfu* rp = zqb + (long)sr * NCOL + c16 * 8;
        vq[q] = *reinterpret_cast<const uint4*>(rp);
        vf[q] = *reinterpret_cast<const uint4*>(rp + 1024);
        vi[q] = *reinterpret_cast<const uint4*>(rp + 2048);
      } else { vq[q] = make_uint4(0, 0, 0, 0); vf[q] = vq[q]; vi[q] = vq[q]; }
    }
#pragma unroll
    for (int q = 0; q < 4; ++q) {
      const int idx = tid + 256 * q;
      const int sr = (idx & 15) | (((idx >> 8) & 3) << 4), c16 = ((idx >> 4) & 3) | (((idx >> 6) & 3) << 2);
      *reinterpret_cast<uint4*>(QT + sr * 136 + c16 * 8) = vq[q];
      *reinterpret_cast<uint4*>(KT + sr * 136 + c16 * 8) = vf[q];
      const unsigned vv[4] = {vi[q].x, vi[q].y, vi[q].z, vi[q].w};
#pragma unroll
      for (int i = 0; i < 4; ++i) {
        BS[(c16 * 8 + 2 * i) * 72 + sr] = (bfu)(vv[i] & 0xFFFFu);
        BS[(c16 * 8 + 2 * i + 1) * 72 + sr] = (bfu)(vv[i] >> 16);
      }
    }
  }
  __syncthreads();
  if (hf == 0) {
    float rel = 0.f;
#pragma unroll 8
    for (int t = Lh - 1; t >= 0; --t) {
      float f = lb + (1.f - lb) * sigmoidf_(b2f(KT[t * 136 + d]));
      float q = siluf_(b2f(QT[t * 136 + d]));
      QT[t * 136 + d] = f2b(q * __expf(fminf(rel, 80.f)));
      KT[t * 136 + d] = f2b((1.f - f) * __expf(-rel));
      rel -= __logf(f);
    }
    bmid[d] = -rel;
  } else {
    float rel = 0.f;
#pragma unroll 8
    for (int t = Lh; t < L; ++t) {
      float f = lb + (1.f - lb) * sigmoidf_(b2f(KT[t * 136 + d]));
      float q = siluf_(b2f(QT[t * 136 + d]));
      rel += __logf(f);
      QT[t * 136 + d] = f2b(q * __expf(rel));
      KT[t * 136 + d] = f2b((1.f - f) * __expf(fminf(-rel, 80.f)));
    }
  }
  if (L == 32) {
    for (int t = 32 + hf * 16; t < 48 + hf * 16; ++t) { QT[t * 136 + d] = 0; KT[t * 136 + d] = 0; }
  }
  uint4 vg[4];
#pragma unroll
  for (int q = 0; q < 4; ++q) {
    const int idx = tid + 256 * q;
    const int sr = (idx & 15) | (((idx >> 8) & 3) << 4), c16 = ((idx >> 4) & 3) | (((idx >> 6) & 3) << 2);
    vg[q] = (sr < L) ? *reinterpret_cast<const uint4*>(zqb + (long)sr * NCOL + 3072 + c16 * 8) : make_uint4(0, 0, 0, 0);
  }
  __syncthreads();
  bf16x8 aq[4];
#pragma unroll
  for (int kk = 0; kk < 4; ++kk) aq[kk] = *reinterpret_cast<const bf16x8*>(QT + (16 * w + fr) * 136 + kk * 32 + fq * 8);
  {
    f32x4 sa[4];
#pragma unroll
    for (int n = 0; n < 4; ++n) sa[n] = f32x4{0.f, 0.f, 0.f, 0.f};
#pragma unroll
    for (int kk = 0; kk < 4; ++kk)
#pragma unroll
      for (int n = 0; n < 4; ++n) {
        bf16x8 bk = *reinterpret_cast<const bf16x8*>(KT + (n * 16 + fr) * 136 + kk * 32 + fq * 8);
        sa[n] = __builtin_amdgcn_mfma_f32_16x16x32_bf16(aq[kk], bk, sa[n], 0, 0, 0);
      }
#pragma unroll
    for (int n = 0; n < 4; ++n)
#pragma unroll
      for (int j = 0; j < 4; ++j) {
        int t = 16 * w + fq * 4 + j, s = n * 16 + fr;
        AT[t * 72 + s] = (s <= t) ? f2b(sa[n][j]) : (bfu)0;
      }
  }
  __syncthreads();
#pragma unroll
  for (int q = 0; q < 4; ++q) {
    const int idx = tid + 256 * q;
    const int sr = (idx & 15) | (((idx >> 8) & 3) << 4), c16 = ((idx >> 4) & 3) | (((idx >> 6) & 3) << 2);
    *reinterpret_cast<uint4*>(QT + sr * 136 + c16 * 8) = vg[q];
  }
  f32x4 o[8];
#pragma unroll
  for (int n = 0; n < 8; ++n) o[n] = f32x4{0.f, 0.f, 0.f, 0.f};
#pragma unroll
  for (int kk = 0; kk < 2; ++kk) {
    bf16x8 a = *reinterpret_cast<const bf16x8*>(AT + (16 * w + fr) * 72 + kk * 32 + fq * 8);
#pragma unroll
    for (int n = 0; n < 8; ++n) {
      bf16x8 b = *reinterpret_cast<const bf16x8*>(BS + (n * 16 + fr) * 72 + kk * 32 + fq * 8);
      o[n] = __builtin_amdgcn_mfma_f32_16x16x32_bf16(a, b, o[n], 0, 0, 0);
    }
  }
#pragma unroll
  for (int sl = 0; sl < 2; ++sl) {
    __syncthreads();
    if (!ci.sample) {
      const bfu* src = (const bfu*)(P.ws + O_US) + ((long)((ci.seqi * 8 + h) * 64 + ci.c) << 14);
      int e2 = tid >> 1, dd0 = (tid & 1) * 32;
#pragma unroll
      for (int q4 = 0; q4 < 4; ++q4) {
        uint4 v = *reinterpret_cast<const uint4*>(src + e2 * 128 + sl * 64 + dd0 + q4 * 8);
        const float* bm = bmid + sl * 64 + dd0 + q4 * 8;
        unsigned vv[4] = {v.x, v.y, v.z, v.w};
        unsigned rr[4];
#pragma unroll
        for (int i = 0; i < 4; ++i) {
          float lo = __uint_as_float(vv[i] << 16) * __expf(bm[2 * i]);
          float hi = __uint_as_float(vv[i] & 0xFFFF0000u) * __expf(bm[2 * i + 1]);
          rr[i] = f2b(lo) | ((unsigned)f2b(hi) << 16);
        }
        *reinterpret_cast<uint4*>(BS + e2 * 72 + dd0 + q4 * 8) = make_uint4(rr[0], rr[1], rr[2], rr[3]);
      }
    } else {
      const float* S0 = P.in[5] + (((long)((l * 8 + ci.seqi) * 8 + h)) << 14);
#pragma unroll 4
      for (int dd = hf * 32; dd < hf * 32 + 32; ++dd)
        BS[d * 72 + dd] = f2b(S0[(sl * 64 + dd) * 128 + d] * __expf(bmid[sl * 64 + dd]));
    }
    __syncthreads();
#pragma unroll
    for (int kk = 0; kk < 2; ++kk) {
#pragma unroll
      for (int n = 0; n < 8; ++n) {
        bf16x8 b = *reinterpret_cast<const bf16x8*>(BS + (n * 16 + fr) * 72 + kk * 32 + fq * 8);
        o[n] = __builtin_amdgcn_mfma_f32_16x16x32_bf16(aq[sl * 2 + kk], b, o[n], 0, 0, 0);
      }
    }
  }
  float rinv[4];
#pragma unroll
  for (int j = 0; j < 4; ++j) {
    float ss = 0.f;
#pragma unroll
    for (int n = 0; n < 8; ++n) ss += o[n][j] * o[n][j];
    ss += __shfl_xor(ss, 1); ss += __shfl_xor(ss, 2); ss += __shfl_xor(ss, 4); ss += __shfl_xor(ss, 8);
    rinv[j] = rsqrtf(ss * (1.f / 128.f) + 1e-6f);
  }
  const float* ng = P.in[17] + l * 128;
  bfu* UC = (bfu*)(P.ws + O_UC);
#pragma unroll
  for (int n = 0; n < 8; ++n)
#pragma unroll
    for (int j = 0; j < 4; ++j) {
      int t = 16 * w + fq * 4 + j, e = n * 16 + fr;
      if (t < L) {
        float g = b2f(QT[t * 136 + e]);
        UC[(long)(ci.lt0 + t) * 1024 + h * 128 + e] = f2b(o[n][j] * rinv[j] * ng[e] * siluf_(g));
      }
    }
}
DEVI void phase4(const Params& P, int l, int pass, char* smem) {
  const int tid = ltid();
  const int nck = pass ? 128 : 136;
  const int nH = nck * 8;
  const int nL = 64 * 4;
  for (int id = blockIdx.x; id < nH + nL; id += gridDim.x) {
    if (id < nH) h3_item(P, l, id >> 3, id & 7, smem, tid);
    else { int q = id - nH; lsum_item(P, q >> 2, q & 3, tid); }
  }
}

DEVI void phase5(const Params& P, int l, int pass) {
  const int tid = ltid();
  const int ntok = pass ? 8192 : 8448, base = pass ? 8448 : 0;
  const int nItems = (ntok / 128) * 4;
  const int w = tid >> 6, lane = tid & 63;
  const float* AU0 = (const float*)(P.ws + O_AU);
  const float* AU1 = AU0 + (long)8448 * 1024;
  const float* LS = (const float*)(P.ws + O_LSUM);
  const bfu* Z = (const bfu*)(P.ws + O_Z);
  bfu* UB = (bfu*)(P.ws + O_UB);
  for (int id = blockIdx.x; id < nItems; id += gridDim.x) {
    const int tile = id >> 2, ch = ((id & 3) * 4 + w) * 64 + lane;
    const int lt0 = tile * 128;
    const TokInfo t0 = tokinfo(base + lt0);
    float hcur = 0.f;
    if (!t0.sample) {
      int jf = tile - (t0.t >> 7);
#pragma unroll 4
      for (int i = jf; i < tile; ++i) hcur = LS[(long)i * 2048 + ch] * hcur + LS[(long)i * 2048 + 1024 + ch];
    }
    for (int r0 = 0; r0 < 128; r0 += 8) {
      float av[8], uv[8], gv[8];
#pragma unroll
      for (int i = 0; i < 8; ++i) {
        long row = lt0 + r0 + i;
        av[i] = AU0[row * 1024 + ch]; uv[i] = AU1[row * 1024 + ch];
        gv[i] = b2f(Z[row * NCOL + 4 * 1024 + ch]);
      }
#pragma unroll
      for (int i = 0; i < 8; ++i) {
        int r = r0 + i;
        if (t0.sample && (r & 31) == 0) hcur = P.in[4][(long)(l * 8 + t0.seq + (r >> 5)) * 1024 + ch];
        hcur = av[i] * hcur + uv[i];
        UB[(long)(lt0 + r) * 1024 + ch] = f2b(geluf_(gv[i]) * hcur);
        if (t0.sample && (r & 31) == 31) P.out[OUT_LRS + (long)(l * 8 + t0.seq + (r >> 5)) * 1024 + ch] = hcur;
      }
    }
    if (!t0.sample && t0.t + 128 == 4096) P.out[OUT_LRP + (long)(l * 4 + t0.seq) * 1024 + ch] = hcur;
  }
}

template <int BR>
DEVI void p6_branch(const Params& P, int pm, int pn, float* macc, char* smem, int tid) {
  asm volatile("" : "+s"(pm), "+s"(pn));
  const bfu* Z = (const bfu*)(P.ws + O_Z);
  bfu* M = (bfu*)(P.ws + O_CB);
  const bfu* A = (const bfu*)(P.ws + (BR == 0 ? O_UA : BR == 1 ? O_UB : O_UC)) + (long)pm * 128 * 1024;
  const bfu* B = (const bfu*)(P.ws + (BR == 0 ? O_WOA : BR == 1 ? O_WOB : O_WOC)) + (long)pn * 128 * 1024;
  f32x4 acc[4][4]; ZERO_ACC(acc);
  gemm_core(acc, A, 1024, B, 1024, 1024, smem, tid);
  EPI_LOOP {
    int row = pm * 128 + EPI_ROW, col = pn * 128 + EPI_COL;
    float g = sigmoidf_(b2f(Z[(long)row * NCOL + (9 + BR) * 1024 + col]));
    float v = g * acc[m][n][j];
    if (BR > 0) v += macc[(long)row * 1024 + col];
    if (BR < 2) macc[(long)row * 1024 + col] = v;
    else M[(long)row * 1024 + col] = f2b(v);
  }
}
DEVI void phase6(const Params& P, int l, int pass, char* smem) {
  const int tid = ltid();
  const int ntok = pass ? 8192 : 8448;
  const int nM = ntok / 128, nN = 8;
  const bfu* Z = (const bfu*)(P.ws + O_Z);
  bfu* M = (bfu*)(P.ws + O_CB);
  for (int id = blockIdx.x; id < nM * nN; id += gridDim.x) {
    int pm = id >> 3, pn = id & 7;
    float* macc = (float*)(P.ws + O_AU);
    p6_branch<0>(P, pm, pn, macc, smem, tid);
    p6_branch<1>(P, pm, pn, macc, smem, tid);
    p6_branch<2>(P, pm, pn, macc, smem, tid);
  }
}

DEVI void phase7(const Params& P, int l, int pass, char* smem) {
  const int tid = ltid();
  const int ntok = pass ? 8192 : 8448, base = pass ? 8448 : 0;
  const int nM = ntok / 128, nN = 8;
  const bfu* M = (const bfu*)(P.ws + O_CB);
  const bfu* W = (const bfu*)(P.ws + O_WO);
  float* pre = (float*)(P.ws + O_PRE);
  for (int id = blockIdx.x; id < nM * nN; id += gridDim.x) {
    int pm = id >> 3, pn = id & 7;
    f32x4 acc[4][4]; ZERO_ACC(acc);
    gemm_core(acc, M + (long)pm * 128 * 1024, 1024, W + (long)pn * 128 * 1024, 1024, 1024, smem, tid);
    EPI_LOOP {
      int row = pm * 128 + EPI_ROW, col = pn * 128 + EPI_COL;
      const float* xr = xrow(P, base + row);
      pre[(long)row * 1024 + col] = ALPHA * xr[col] + acc[m][n][j];
    }
  }
}

DEVI void phase8(const Params& P, int l, int pass) {
  const int tid = ltid();
  const int ntok = pass ? 8192 : 8448, base = pass ? 8448 : 0;
  const int w = tid >> 6, lane = tid & 63;
  const float* pre = (const float*)(P.ws + O_PRE);
  const float* g = P.in[22] + l * 1024;
  const float* b = P.in[23] + l * 1024;
  bfu* xb = (bfu*)(P.ws + O_XB);
  for (int id = blockIdx.x; id < ntok / 4; id += gridDim.x) {
    int lt = id * 4 + w, it = base + lt;
    const float* src = pre + (long)lt * 1024;
    float v[16];
#pragma unroll
    for (int q = 0; q < 4; ++q) {
      float4 t = *reinterpret_cast<const float4*>(src + q * 256 + lane * 4);
      v[q * 4] = t.x; v[q * 4 + 1] = t.y; v[q * 4 + 2] = t.z; v[q * 4 + 3] = t.w;
    }
    float s = 0.f;
#pragma unroll
    for (int i = 0; i < 16; ++i) s += v[i];
    float mu = wave_sum(s) * (1.f / 1024.f);
    float ss = 0.f;
#pragma unroll
    for (int i = 0; i < 16; ++i) { float dlt = v[i] - mu; ss += dlt * dlt; }
    float rs = rsqrtf(wave_sum(ss) * (1.f / 1024.f) + 1e-5f);
    float* xr = xrow(P, it);
#pragma unroll
    for (int q = 0; q < 4; ++q) {
      int c = q * 256 + lane * 4;
      float o[4];
#pragma unroll
      for (int i = 0; i < 4; ++i) o[i] = (v[q * 4 + i] - mu) * rs * g[c + i] + b[c + i];
      *reinterpret_cast<float4*>(xr + c) = make_float4(o[0], o[1], o[2], o[3]);
      store4bf(xb + (long)it * 1024 + c, o);
    }
  }
}

DEVI void phase9(const Params& P, int l, int pass, char* smem) {
  const int tid = ltid();
  const int ntok = pass ? 8192 : 8448, base = pass ? 8448 : 0;
  const int nM = ntok / 128, nN = 16;
  const bfu* xb = (const bfu*)(P.ws + O_XB) + (long)base * 1024;
  const bfu* W = (const bfu*)(P.ws + O_WQ);
  bfu* qp = (bfu*)(P.ws + O_QP);
  for (int id = blockIdx.x; id < nM * nN; id += gridDim.x) {
    int pm, pn; tile_rc(id, nM, nN, pm, pn);
    f32x4 acc[4][4]; ZERO_ACC(acc);
    gemm_core(acc, xb + (long)pm * 128 * 1024, 1024, W + (long)pn * 128 * 1024, 1024, 1024, smem, tid);
    EPI_LOOP {
      int row = pm * 128 + EPI_ROW, col = pn * 128 + EPI_COL;
      qp[(long)row * 2048 + col] = f2b(acc[m][n][j]);
    }
  }
}
DEVI void phase10(const Params& P, int l, int pass, char* smem) {
  const int tid = ltid();
  const int ntok = pass ? 8192 : 8448;
  const int nM = ntok / 128, nN = 16;
  const bfu* qp = (const bfu*)(P.ws + O_QP);
  const bfu* KB = (const bfu*)(P.ws + O_KEYS);
  float* sc = (float*)(P.ws + O_SC);
  for (int id = blockIdx.x; id < nM * nN; id += gridDim.x) {
    int pm = id >> 4, pn = id & 15;
    f32x4 acc[4][4]; ZERO_ACC(acc);
    gemm_core(acc, qp + (long)pm * 128 * 2048 + pn * 128, 2048, KB + (long)pn * 16384, 128, 128, smem, tid);
    EPI_LOOP {
      int row = pm * 128 + EPI_ROW, col = pn * 128 + EPI_COL;
      sc[(long)row * 2048 + col] = acc[m][n][j];
    }
  }
}

constexpr int KLOW = 12;
__constant__ unsigned char CAND_IJ[50] = {
  0x00,0x01,0x02,0x03,0x04,0x05,0x06,0x07,0x08,0x09,0x0A,0x0B,0x0C,0x0D,0x0E,0x0F,
  0x10,0x11,0x12,0x13,0x14,0x15,0x16,0x17,
  0x20,0x21,0x22,0x23,0x24,
  0x30,0x31,0x32,0x33,
  0x40,0x41,0x42,
  0x50,0x51, 0x60,0x61, 0x70,0x71,
  0x80,0x90,0xA0,0xB0,0xC0,0xD0,0xE0,0xF0};
DEVI unsigned fkey(float f) {
  unsigned u = __float_as_uint(f);
  return (u & 0x80000000u) ? ~u : (u | 0x80000000u);
}
DEVI void dec16(uint4 v, f32x2 (&o)[8]) {
  o[0] = __builtin_amdgcn_cvt_pk_f32_fp8((int)v.x, false); o[1] = __builtin_amdgcn_cvt_pk_f32_fp8((int)v.x, true);
  o[2] = __builtin_amdgcn_cvt_pk_f32_fp8((int)v.y, false); o[3] = __builtin_amdgcn_cvt_pk_f32_fp8((int)v.y, true);
  o[4] = __builtin_amdgcn_cvt_pk_f32_fp8((int)v.z, false); o[5] = __builtin_amdgcn_cvt_pk_f32_fp8((int)v.z, true);
  o[6] = __builtin_amdgcn_cvt_pk_f32_fp8((int)v.w, false); o[7] = __builtin_amdgcn_cvt_pk_f32_fp8((int)v.w, true);
}
DEVI void phase11(const Params& P, int l, int pass, char* smem) {
  const int ntok = pass ? 8192 : 8448, base = pass ? 8448 : 0;
  const int tid = ltid(); const int w = tid >> 6, lane = tid & 63;
  float* scl = (float*)smem;
  float* sv = scl + 2048;
  int* si = (int*)(sv + 256);
  float* tops = (float*)(si + 256);
  int* tope = (int*)(tops + 128);
  float* wgt = (float*)(tope + 128);
  float* svs = wgt + 128;
  int* sis = (int*)(svs + 256);
  float* red = (float*)(sis + 256);
  float* stat = red + 4096;
  const float* SC = (const float*)(P.ws + O_SC);
  const unsigned char* UT = (const unsigned char*)(P.ws + O_UTB);
  const unsigned char* VTb = (const unsigned char*)(P.ws + O_VTB);
  const float* g2 = P.in[28] + l * 1024;
  const float* b2 = P.in[29] + l * 1024;
  bfu* xb = (bfu*)(P.ws + O_XB);
  const unsigned long long ltmask = (1ull << lane) - 1ull;
  for (int lt = blockIdx.x; lt < ntok; lt += gridDim.x) {
    const int it = base + lt;
    float* xr = xrow(P, it);
    __syncthreads();
    {
      const float4* s4 = reinterpret_cast<const float4*>(SC + (long)lt * 2048);
      reinterpret_cast<float4*>(scl)[tid] = s4[tid];
      reinterpret_cast<float4*>(scl)[tid + 256] = s4[tid + 256];
    }
    __syncthreads();
    {
      float v0[4], v1[4]; unsigned k0[4], k1[4], T[4];
#pragma unroll
      for (int li = 0; li < 4; ++li) {
        const int Lx = w * 4 + li;
        v0[li] = scl[Lx * 128 + lane]; v1[li] = scl[Lx * 128 + 64 + lane];
        k0[li] = fkey(v0[li]); k1[li] = fkey(v1[li]); T[li] = 0;
      }
      for (int b = 31; b >= KLOW; --b) {
#pragma unroll
        for (int li = 0; li < 4; ++li) {
          unsigned cand = T[li] | (1u << b);
          int cnt = __popcll(__ballot(k0[li] >= cand)) + __popcll(__ballot(k1[li] >= cand));
          if (cnt >= 16) T[li] = cand;
        }
      }
#pragma unroll
      for (int li = 0; li < 4; ++li) {
        const int Lx = w * 4 + li;
        const unsigned T2 = T[li] + (1u << KLOW);
        bool g0 = k0[li] >= T2, g1 = k1[li] >= T2;
        bool q0 = (k0[li] >= T[li]) && !g0, q1 = (k1[li] >= T[li]) && !g1;
        unsigned long long mg0 = __ballot(g0), mg1 = __ballot(g1), mq0 = __ballot(q0), mq1 = __ballot(q1);
        int ng0 = __popcll(mg0), ng = ng0 + __popcll(mg1);
        int p0 = g0 ? __popcll(mg0 & ltmask) : ng + __popcll(mq0 & ltmask);
        int p1 = g1 ? ng0 + __popcll(mg1 & ltmask) : ng + __popcll(mq0) + __popcll(mq1 & ltmask);
        if ((g0 || q0) && p0 < 16) { sv[Lx * 16 + p0] = v0[li]; si[Lx * 16 + p0] = lane; }
        if ((g1 || q1) && p1 < 16) { sv[Lx * 16 + p1] = v1[li]; si[Lx * 16 + p1] = lane + 64; }
      }
    }
    __builtin_amdgcn_wave_barrier();
    {
      const int Lx = w * 4 + (lane >> 4), e = lane & 15;
      const float v = sv[Lx * 16 + e];
      const int id = si[Lx * 16 + e];
      int rank = 0;
#pragma unroll
      for (int q = 0; q < 4; ++q) {
        float4 o = *reinterpret_cast<const float4*>(sv + Lx * 16 + q * 4);
        rank += (o.x > v || (o.x == v && q * 4 + 0 < e)) ? 1 : 0;
        rank += (o.y > v || (o.y == v && q * 4 + 1 < e)) ? 1 : 0;
        rank += (o.z > v || (o.z == v && q * 4 + 2 < e)) ? 1 : 0;
        rank += (o.w > v || (o.w == v && q * 4 + 3 < e)) ? 1 : 0;
      }
      __builtin_amdgcn_wave_barrier();
      svs[Lx * 16 + rank] = v; sis[Lx * 16 + rank] = id;
    }
    __builtin_amdgcn_wave_barrier();
    {
      float cv[2]; unsigned ck[2], T[2]; int ce[2];
      const int cij = (lane < 50) ? (int)CAND_IJ[lane] : 0;
      const int ci = cij >> 4, cj = cij & 15;
#pragma unroll
      for (int hi = 0; hi < 2; ++hi) {
        const int h = w * 2 + hi;
        T[hi] = 0;
        cv[hi] = svs[(2 * h) * 16 + ci] + svs[(2 * h + 1) * 16 + cj];
        ce[hi] = sis[(2 * h) * 16 + ci] * 128 + sis[(2 * h + 1) * 16 + cj];
        ck[hi] = (lane < 50) ? fkey(cv[hi]) : 0u;
      }
      for (int b = 31; b >= KLOW; --b) {
#pragma unroll
        for (int hi = 0; hi < 2; ++hi) {
          unsigned cand = T[hi] | (1u << b);
          int cnt = __popcll(__ballot(ck[hi] >= cand));
          if (cnt >= 16) T[hi] = cand;
        }
      }
#pragma unroll
      for (int hi = 0; hi < 2; ++hi) {
        const int h = w * 2 + hi;
        const unsigned T2 = T[hi] + (1u << KLOW);
        bool g = ck[hi] >= T2, q = (ck[hi] >= T[hi]) && !g && (lane < 50);
        unsigned long long mg = __ballot(g), mq = __ballot(q);
        int p = g ? __popcll(mg & ltmask) : __popcll(mg) + __popcll(mq & ltmask);
        if ((g || q) && p < 16) { tops[h * 16 + p] = cv[hi]; tope[h * 16 + p] = ce[hi]; }
      }
    }
    __syncthreads();
    if (tid < 128) {
      float s = tops[tid];
      float mx = s;
      mx = fmaxf(mx, __shfl_xor(mx, 1)); mx = fmaxf(mx, __shfl_xor(mx, 2));
      mx = fmaxf(mx, __shfl_xor(mx, 4)); mx = fmaxf(mx, __shfl_xor(mx, 8));
      float e = __expf(s - mx);
      float sm = e;
      sm += __shfl_xor(sm, 1); sm += __shfl_xor(sm, 2); sm += __shfl_xor(sm, 4); sm += __shfl_xor(sm, 8);
      tops[tid] = e / sm;
    }
    __syncthreads();
    f32x2 xv[8];
    {
      const float4* xp = reinterpret_cast<const float4*>(xr + lane * 16);
#pragma unroll
      for (int q = 0; q < 4; ++q) {
        float4 a = xp[q];
        xv[2 * q] = f32x2{a.x, a.y}; xv[2 * q + 1] = f32x2{a.z, a.w};
      }
    }
    f32x2 oacc[8];
#pragma unroll
    for (int q = 0; q < 8; ++q) oacc[q] = f32x2{0.f, 0.f};
#pragma unroll 1
    for (int p0 = 0; p0 < 32; p0 += 8) {
      uint4 ru[8], rv[8];
#pragma unroll
      for (int i = 0; i < 8; ++i) {
        int e = tope[w * 32 + p0 + i];
        ru[i] = *reinterpret_cast<const uint4*>(UT + (long)e * 1024 + lane * 16);
        rv[i] = *reinterpret_cast<const uint4*>(VTb + (long)e * 1024 + lane * 16);
      }
      float dsum[8];
#pragma unroll
      for (int i = 0; i < 8; ++i) {
        f32x2 f[8];
        dec16(ru[i], f);
        f32x2 acc = f[0] * xv[0];
#pragma unroll
        for (int q = 1; q < 8; ++q) acc = __builtin_elementwise_fma(f[q], xv[q], acc);
        dsum[i] = acc.x + acc.y;
      }
      float e4[4], e2[2], e1;
      {
        const bool hi = (lane & 32) != 0;
#pragma unroll
        for (int i = 0; i < 4; ++i) {
          float snd = hi ? dsum[i] : dsum[i + 4];
          float kp = hi ? dsum[i + 4] : dsum[i];
          e4[i] = kp + __shfl_xor(snd, 32);
        }
        const bool hi2 = (lane & 16) != 0;
#pragma unroll
        for (int i = 0; i < 2; ++i) {
          float snd = hi2 ? e4[i] : e4[i + 2];
          float kp = hi2 ? e4[i + 2] : e4[i];
          e2[i] = kp + __shfl_xor(snd, 16);
        }
        const bool hi3 = (lane & 8) != 0;
        {
          float snd = hi3 ? e2[0] : e2[1];
          float kp = hi3 ? e2[1] : e2[0];
          e1 = kp + __shfl_xor(snd, 8);
        }
        e1 += __shfl_xor(e1, 4); e1 += __shfl_xor(e1, 2); e1 += __shfl_xor(e1, 1);
      }
      {
        int r = ((lane >> 5) & 1) * 4 + ((lane >> 4) & 1) * 2 + ((lane >> 3) & 1);
        float wv_ = tops[w * 32 + p0 + r] * geluf_(e1 * (1.f / U_SCALE)) * (1.f / V_SCALE);
        if ((lane & 7) == 0) wgt[w * 32 + p0 + r] = wv_;
      }
      __builtin_amdgcn_wave_barrier();
      float wg[8];
      {
        float4 wa = *reinterpret_cast<const float4*>(wgt + w * 32 + p0);
        float4 wb = *reinterpret_cast<const float4*>(wgt + w * 32 + p0 + 4);
        wg[0] = wa.x; wg[1] = wa.y; wg[2] = wa.z; wg[3] = wa.w; wg[4] = wb.x; wg[5] = wb.y; wg[6] = wb.z; wg[7] = wb.w;
      }
#pragma unroll
      for (int i = 0; i < 8; ++i) {
        f32x2 f[8];
        dec16(rv[i], f);
        f32x2 wv = f32x2{wg[i], wg[i]};
#pragma unroll
        for (int q = 0; q < 8; ++q) oacc[q] = __builtin_elementwise_fma(f[q], wv, oacc[q]);
      }
    }
    {
      float4* rwp = reinterpret_cast<float4*>(red + w * 1024 + lane * 16);
#pragma unroll
      for (int q = 0; q < 4; ++q) rwp[q] = make_float4(oacc[2 * q].x, oacc[2 * q].y, oacc[2 * q + 1].x, oacc[2 * q + 1].y);
    }
    __syncthreads();
    const int c = tid * 4;
    float y[4];
    {
      float4 xx = *reinterpret_cast<const float4*>(xr + c);
      float4 r0 = *reinterpret_cast<const float4*>(red + c);
      float4 r1 = *reinterpret_cast<const float4*>(red + 1024 + c);
      float4 r2 = *reinterpret_cast<const float4*>(red + 2048 + c);
      float4 r3 = *reinterpret_cast<const float4*>(red + 3072 + c);
      y[0] = ALPHA * xx.x + (r0.x + r1.x + r2.x + r3.x);
      y[1] = ALPHA * xx.y + (r0.y + r1.y + r2.y + r3.y);
      y[2] = ALPHA * xx.z + (r0.z + r1.z + r2.z + r3.z);
      y[3] = ALPHA * xx.w + (r0.w + r1.w + r2.w + r3.w);
    }
    float s = wave_sum(y[0] + y[1] + y[2] + y[3]);
    if (lane == 0) stat[w] = s;
    __syncthreads();
    float mu = (stat[0] + stat[1] + stat[2] + stat[3]) * (1.f / 1024.f);
    float ss = 0.f;
#pragma unroll
    for (int i = 0; i < 4; ++i) { float dl = y[i] - mu; ss += dl * dl; }
    ss = wave_sum(ss);
    if (lane == 0) stat[4 + w] = ss;
    __syncthreads();
    float rs = rsqrtf((stat[4] + stat[5] + stat[6] + stat[7]) * (1.f / 1024.f) + 1e-5f);
    float o[4];
#pragma unroll
    for (int i = 0; i < 4; ++i) o[i] = (y[i] - mu) * rs * g2[c + i] + b2[c + i];
    *reinterpret_cast<float4*>(xr + c) = make_float4(o[0], o[1], o[2], o[3]);
    store4bf(xb + (long)it * 1024 + c, o);
  }
}

#define XB_TMO      128
#define XB_XCNT(j)  (256  + 64 * (j))
#define XB_XSUB(j)  (1280 + 64 * (j))
#define XB_XGEN(j)  (2304 + 64 * (j))
#define XB_TOP      3328
#define XB_TOPGEN   3392
#define XCD_BAR_WORDS 3456
#define XB_SPIN_CAP (1u << 18)
DEVI unsigned xb_ld(unsigned* p) { return __hip_atomic_load(p, __ATOMIC_RELAXED, __HIP_MEMORY_SCOPE_AGENT); }
DEVI unsigned xb_add(unsigned* p, unsigned v) { return __hip_atomic_fetch_add(p, v, __ATOMIC_RELAXED, __HIP_MEMORY_SCOPE_AGENT); }
DEVI unsigned xb_xcc_id() { return (unsigned)__builtin_amdgcn_s_getreg((3 << 11) | 20) & 0xFu; }
#define XB_SPIN(cond, bar) do { unsigned _sp = 0; while (cond) { __builtin_amdgcn_s_sleep(1); \
    if ((++_sp & 255u) == 0u) { if (xb_ld(&(bar)[XB_TMO])) break; if (_sp > XB_SPIN_CAP) { atomicAdd(&(bar)[XB_TMO], 1u); break; } } } } while (0)
DEVI void xcd_census(unsigned* bar, unsigned x, unsigned& nloc, unsigned& nx) {
  const unsigned G = gridDim.x;
  unsigned sum, cnt, mine, sp = 0u;
  for (;;) {
    sum = 0u; cnt = 0u; mine = 0u;
#pragma unroll
    for (unsigned j = 0; j < 16; ++j) { const unsigned c = xb_ld(&bar[XB_XCNT(j)]); sum += c; cnt += (c > 0u) ? 1u : 0u; mine = (j == x) ? c : mine; }
    if (sum == G) break;
    __builtin_amdgcn_s_sleep(1);
    if ((++sp & 255u) == 0u) { if (xb_ld(&bar[XB_TMO])) break; if (sp > XB_SPIN_CAP) { atomicAdd(&bar[XB_TMO], 1u); break; } }
  }
  nloc = mine > 0u ? mine : 1u; nx = cnt > 0u ? cnt : 1u;
}
DEVI void xcd_barrier(unsigned* bar, unsigned x, unsigned nloc, unsigned nx) {
  asm volatile("s_waitcnt vmcnt(0)" ::: "memory");
  __syncthreads();
  if (threadIdx.x == 0) {
    __builtin_amdgcn_s_waitcnt(0);
    const unsigned old = xb_add(&bar[XB_XSUB(x)], 1u);
    const unsigned gen = old / nloc;
    if (old + 1u == (gen + 1u) * nloc) {
      __builtin_amdgcn_fence(__ATOMIC_RELEASE, "agent");
      asm volatile("s_waitcnt vmcnt(0)" ::: "memory");
      const unsigned og = xb_add(&bar[XB_TOP], 1u);
      const unsigned tg = og / nx;
      if (og + 1u == (tg + 1u) * nx) xb_add(&bar[XB_TOPGEN], 1u);
      else XB_SPIN(xb_ld(&bar[XB_TOPGEN]) == tg, bar);
      __builtin_amdgcn_fence(__ATOMIC_ACQUIRE, "agent");
      xb_add(&bar[XB_XGEN(x)], 1u);
      asm volatile("s_waitcnt vmcnt(0)" ::: "memory");
    } else {
      XB_SPIN(xb_ld(&bar[XB_XGEN(x)]) == gen, bar);
      __builtin_amdgcn_fence(__ATOMIC_ACQUIRE, "agent");
      asm volatile("s_waitcnt vmcnt(0)" ::: "memory");
    }
  }
  __syncthreads();
}

__global__ void __launch_bounds__(256, 2) fwd_megakernel(Params P) {
  __shared__ __attribute__((aligned(16))) char smem[65536];
  cg::grid_group grid = cg::this_grid();
  unsigned* bar = (unsigned*)(P.ws + O_BAR);
  const unsigned xcc = xb_xcc_id();
  if (threadIdx.x == 0) (void)xb_add(&bar[XB_XCNT(xcc)], 1u);
  unsigned nloc = 1u, nx = 1u;
#define LND asm volatile("" : "+s"(l), "+s"(pass))
#define GSYNC xcd_barrier(bar, xcc, nloc, nx)
#pragma unroll 1
  for (int l = 0; l < 2; ++l) {
    phase_prep(P, l, smem);
    if (l == 0) {
      phase_xcopy(P);
      grid.sync();
      if (threadIdx.x == 0) xcd_census(bar, xcc, nloc, nx);
    } else {
      GSYNC;
    }
#pragma unroll 1
    for (int pass = 0; pass < 2; ++pass) {
      LND; phase_inproj(P, l, pass, smem); GSYNC;
      LND; phase2(P, l, pass, smem); GSYNC;
      LND; phase3(P, l, pass, smem); GSYNC;
      LND; phase4(P, l, pass, smem); GSYNC;
      LND; phase5(P, l, pass); GSYNC;
      LND; phase6(P, l, pass, smem); GSYNC;
      LND; phase7(P, l, pass, smem); GSYNC;
      LND; phase8(P, l, pass); GSYNC;
      LND; phase9(P, l, pass, smem); GSYNC;
      LND; phase10(P, l, pass, smem); GSYNC;
      LND; phase11(P, l, pass, smem); if (!(l == 1 && pass == 1)) GSYNC;
    }
  }
}

extern "C" void kernel_launch(void* const* d_in, const int* in_sizes, int n_in, void* d_out, int out_size,
                              void* d_ws, size_t ws_size, hipStream_t stream) {
  static int grid_blocks = 0;
  if (!grid_blocks) {
    int dev = 0, cus = 0, per_cu = 0;
    hipGetDevice(&dev);
    hipDeviceGetAttribute(&cus, hipDeviceAttributeMultiprocessorCount, dev);
    hipOccupancyMaxActiveBlocksPerMultiprocessor(&per_cu, fwd_megakernel, 256, 0);
    if (per_cu > 2) per_cu = 2;
    if (per_cu < 1) per_cu = 1;
    grid_blocks = cus * per_cu;
  }
  if (ws_size < O_END) fprintf(stderr, "workspace too small: %zu < %zu\n", ws_size, (size_t)O_END);
  hipMemsetAsync((char*)d_ws + O_BAR, 0, 16384, stream);
  Params p{};
  for (int i = 0; i < 30; ++i) p.in[i] = (const float*)d_in[i];
  p.out = (float*)d_out;
  p.ws = (char*)d_ws;
  void* args[] = {&p};
  hipError_t e = hipLaunchCooperativeKernel((void*)fwd_megakernel, dim3(grid_blocks), dim3(256), args, 0, stream);
  if (e != hipSuccess) fprintf(stderr, "cooperative launch failed: %s (grid %d)\n", hipGetErrorString(e), grid_blocks);
}
```

```cpp
#include <hip/hip_runtime.h>
#include <hip/hip_bf16.h>
#include <hip/hip_cooperative_groups.h>
#include <cstdio>
namespace cg = cooperative_groups;

typedef unsigned short bfu;
using bf16x8 = __attribute__((ext_vector_type(8))) short;
using f32x4 = __attribute__((ext_vector_type(4))) float;
#define DEVI __device__ __forceinline__

constexpr float ALPHA = 1.41421356237f;
constexpr int NCOL = 12288;

constexpr size_t O_WIN = 0;
constexpr size_t O_WOA = O_WIN + 25165824;
constexpr size_t O_WOB = O_WOA + 2097152;
constexpr size_t O_WOC = O_WOB + 2097152;
constexpr size_t O_WO = O_WOC + 2097152;
constexpr size_t O_WQ = O_WO + 2097152;
constexpr size_t O_KEYS = O_WQ + 4194304;
constexpr size_t O_LRU = O_KEYS + 524288;
constexpr size_t O_UTB = O_LRU + 524288;
constexpr size_t O_VTB = O_UTB + 33554432;
constexpr size_t O_LBS = O_VTB + 33554432;
constexpr size_t O_XB = O_LBS + 8192;
constexpr size_t O_Z = O_XB + 34078720;
constexpr size_t O_UA = O_Z + 207618048;
constexpr size_t O_UB = O_UA + 17301504;
constexpr size_t O_UC = O_UB + 17301504;
constexpr size_t O_CB = O_UC + 17301504;
constexpr size_t O_AU = O_CB + 17301504;
constexpr size_t O_LSUM = O_AU + 69206016;
constexpr size_t O_US = O_LSUM + 540672;
constexpr size_t O_DEC = O_US + 33554432;
constexpr size_t O_BAR = O_DEC + 524288;
constexpr size_t O_END = O_BAR + 16384;
constexpr size_t O_PRE = O_Z;
constexpr size_t O_QP = O_Z + 34603008;
constexpr size_t O_SC = O_QP + 34603008;

constexpr long OUT_YS = 16777216;
constexpr long OUT_CAP = 17039360;
constexpr long OUT_CBP = 17055744;
constexpr long OUT_LRP = 17080320;
constexpr long OUT_HGP = 17088512;
constexpr long OUT_CAS = 18137088;
constexpr long OUT_CBS = 18169856;
constexpr long OUT_LRS = 18219008;
constexpr long OUT_HGS = 18235392;

struct Params {
  const float* in[30];
  float* out;
  char* ws;
};

DEVI bfu f2b(float f) {
  unsigned u = __float_as_uint(f);
  u += 0x7FFFu + ((u >> 16) & 1u);
  return (bfu)(u >> 16);
}
DEVI float b2f(bfu b) { return __uint_as_float(((unsigned)b) << 16); }
DEVI float sigmoidf_(float x) { return 1.f / (1.f + __expf(-x)); }
DEVI float siluf_(float x) { return x / (1.f + __expf(-x)); }
DEVI float geluf_(float x) { return 0.5f * x * (1.f + erff(x * 0.70710678118f)); }
DEVI float wave_sum(float v) {
#pragma unroll
  for (int o = 32; o; o >>= 1) v += __shfl_xor(v, o);
  return v;
}

DEVI char* wsp(const Params& P, size_t off) { asm volatile("" : "+s"(off)); return P.ws + off; }
DEVI int ltid() { int t = threadIdx.x; asm volatile("" : "+v"(t)); return t; }
struct TokInfo { int sample, seq, t; };
DEVI TokInfo tokinfo(int it) {
  TokInfo r;
  if (it < 8192) { r.sample = 0; r.seq = it >> 12; r.t = it & 4095; }
  else if (it < 8448) { int q = it - 8192; r.sample = 1; r.seq = q >> 5; r.t = q & 31; }
  else { int q = it - 8448; r.sample = 0; r.seq = 2 + (q >> 12); r.t = q & 4095; }
  return r;
}
DEVI float* xrow(const Params& P, int it) {
  TokInfo ti = tokinfo(it);
  return ti.sample ? P.out + OUT_YS + (long)(ti.seq * 32 + ti.t) * 1024
                   : P.out + (long)(ti.seq * 4096 + ti.t) * 1024;
}

DEVI void stage_tile(const bfu* __restrict__ g, int ld, int k0, char* lds, int tid) {
#pragma unroll
  for (int i = 0; i < 4; ++i) {
    int b = tid * 16 + i * 4096;
    int r = b >> 7, cp = (b >> 4) & 7, gc = cp ^ (r & 7);
    __builtin_amdgcn_global_load_lds((const unsigned*)(g + (long)r * ld + k0 + gc * 8),
                                     (unsigned*)(lds + b), 16, 0, 0);
  }
}
DEVI bf16x8 ldfrag(const char* tile, int r, int kc) {
  return *reinterpret_cast<const bf16x8*>(tile + r * 128 + ((kc ^ (r & 7)) << 4));
}
DEVI void stage_tile_gate(const bfu* __restrict__ Wa, const bfu* __restrict__ Wx, int k0, char* lds, int tid) {
#pragma unroll
  for (int i = 0; i < 4; ++i) {
    int b = tid * 16 + i * 4096;
    int r = b >> 7, cp = (b >> 4) & 7, gc = cp ^ (r & 7);
    const bfu* base = (r & 32) ? Wx : Wa;
    int c = (r >> 6) * 32 + (r & 31);
    __builtin_amdgcn_global_load_lds((const unsigned*)(base + (long)c * 128 + k0 + gc * 8),
                                     (unsigned*)(lds + b), 16, 0, 0);
  }
}
template <int GATE>
DEVI void gemm_core_t(f32x4 (&acc)[4][4], const bfu* __restrict__ A, int lda,
                    const bfu* __restrict__ B, int ldb, int K, char* smem, int tid, const bfu* __restrict__ B2 = nullptr) {
  const int wid = tid >> 6, lane = tid & 63;
  const int wr = wid >> 1, wc = wid & 1, fr = lane & 15, fq = lane >> 4;
  const int nt = K >> 6;
  __syncthreads();
  stage_tile(A, lda, 0, smem, tid);
  if (GATE) stage_tile_gate(B, B2, 0, smem + 16384, tid); else stage_tile(B, ldb, 0, smem + 16384, tid);
  for (int t = 0; t < nt; ++t) {
    asm volatile("s_waitcnt vmcnt(0)" ::: "memory");
    __syncthreads();
    char* cur = smem + (t & 1) * 32768;
    if (t + 1 < nt) {
      char* nx = smem + ((t + 1) & 1) * 32768;
      stage_tile(A, lda, (t + 1) * 64, nx, tid);
      if (GATE) stage_tile_gate(B, B2, (t + 1) * 64, nx + 16384, tid); else stage_tile(B, ldb, (t + 1) * 64, nx + 16384, tid);
    }
#pragma unroll
    for (int kk = 0; kk < 2; ++kk) {
      bf16x8 af[4], bfr[4];
#pragma unroll
      for (int m = 0; m < 4; ++m) af[m] = ldfrag(cur, wr * 64 + m * 16 + fr, kk * 4 + fq);
#pragma unroll
      for (int n = 0; n < 4; ++n) bfr[n] = ldfrag(cur + 16384, wc * 64 + n * 16 + fr, kk * 4 + fq);
#pragma unroll
      for (int m = 0; m < 4; ++m)
#pragma unroll
        for (int n = 0; n < 4; ++n)
          acc[m][n] = __builtin_amdgcn_mfma_f32_16x16x32_bf16(af[m], bfr[n], acc[m][n], 0, 0, 0);
    }
  }
}
DEVI void gemm_core(f32x4 (&acc)[4][4], const bfu* __restrict__ A, int lda,
                    const bfu* __restrict__ B, int ldb, int K, char* smem, int tid) {
  gemm_core_t<0>(acc, A, lda, B, ldb, K, smem, tid);
}
DEVI void tile_rc(int id, int nM, int nN, int& pm, int& pn) {
  const int x = id & 7, q = id >> 3;
  const int gfull = nM >> 3;
  const int g = q / nN;
  if (g < gfull) {
    int r = q - g * nN;
    pn = (r >> 3) * 8 + x;
    pm = g * 8 + (r & 7);
  } else {
    int gsz = nM - gfull * 8;
    int r = q - gfull * nN;
    pn = (r / gsz) * 8 + x;
    pm = gfull * 8 + (r % gsz);
  }
}
#define ZERO_ACC(a) _Pragma("unroll") for (int m_ = 0; m_ < 4; ++m_) _Pragma("unroll") for (int n_ = 0; n_ < 4; ++n_) a[m_][n_] = f32x4{0.f, 0.f, 0.f, 0.f}
#define EPI_LOOP \
  const int wid_ = tid >> 6, lane_ = tid & 63; \
  const int wr_ = wid_ >> 1, wc_ = wid_ & 1, fr_ = lane_ & 15, fq_ = lane_ >> 4; \
  _Pragma("unroll") for (int m = 0; m < 4; ++m) for (int sb_ = (__builtin_amdgcn_sched_barrier(0), 0); sb_ < 1; ++sb_) _Pragma("unroll") for (int n = 0; n < 4; ++n) _Pragma("unroll") for (int j = 0; j < 4; ++j)
#define EPI_ROW (wr_ * 64 + m * 16 + fq_ * 4 + j)
#define EPI_COL (wc_ * 64 + n * 16 + fr_)

DEVI void epi_stage_f32(const f32x4 (&acc)[4][4], char* smem, int tid) {
  const int wid = tid >> 6, lane = tid & 63, wr = wid >> 1, wc = wid & 1, fr = lane & 15, fq = lane >> 4;
  float* T = reinterpret_cast<float*>(smem);
  __syncthreads();
#pragma unroll
  for (int m = 0; m < 4; ++m)
#pragma unroll
    for (int n = 0; n < 4; ++n)
#pragma unroll
      for (int j = 0; j < 4; ++j)
        T[(wr * 64 + m * 16 + fq * 4 + j) * 128 + wc * 64 + n * 16 + fr] = acc[m][n][j];
  __syncthreads();
}
DEVI void epi_store_bf16(const f32x4 (&acc)[4][4], const float* colbias, bfu* dst, long ld, char* smem, int tid) {
  const int wid = tid >> 6, lane = tid & 63, wr = wid >> 1, wc = wid & 1, fr = lane & 15, fq = lane >> 4;
  bfu* T = reinterpret_cast<bfu*>(smem);
  __syncthreads();
#pragma unroll
  for (int n = 0; n < 4; ++n) {
    const int col = wc * 64 + n * 16 + fr;
    const float bias = colbias ? colbias[col] : 0.f;
#pragma unroll
    for (int m = 0; m < 4; ++m)
#pragma unroll
      for (int j = 0; j < 4; ++j)
        T[(wr * 64 + m * 16 + fq * 4 + j) * 136 + col] = f2b(acc[m][n][j] + bias);
  }
  __syncthreads();
#pragma unroll
  for (int q = 0; q < 8; ++q) {
    const int id = tid + 256 * q, row = id >> 4, c16 = id & 15;
    uint4 v = *reinterpret_cast<const uint4*>(T + row * 136 + c16 * 8);
    *reinterpret_cast<uint4*>(dst + (long)row * ld + c16 * 8) = v;
  }
}

DEVI void transpose_tile(const float* __restrict__ src, bfu* __restrict__ dst, int R, int C, int r0, int c0, float* tile, int tid) {
  __syncthreads();
  {
    int tx = tid & 15, ty = tid >> 4;
#pragma unroll
    for (int i = 0; i < 4; ++i) {
      int r = ty + i * 16;
      float4 v = *reinterpret_cast<const float4*>(src + (long)(r0 + r) * C + c0 + tx * 4);
      float* tp = tile + r * 65 + tx * 4;
      tp[0] = v.x; tp[1] = v.y; tp[2] = v.z; tp[3] = v.w;
    }
  }
  __syncthreads();
  {
    int c = tid >> 2, rs = (tid & 3) * 16;
    unsigned pk[8];
#pragma unroll
    for (int i = 0; i < 8; ++i) {
      unsigned lo = f2b(tile[(rs + 2 * i) * 65 + c]);
      unsigned hi = f2b(tile[(rs + 2 * i + 1) * 65 + c]);
      pk[i] = lo | (hi << 16);
    }
    uint4* dp = reinterpret_cast<uint4*>(dst + (long)(c0 + c) * R + r0 + rs);
    dp[0] = make_uint4(pk[0], pk[1], pk[2], pk[3]);
    dp[1] = make_uint4(pk[4], pk[5], pk[6], pk[7]);
  }
}
DEVI void convert_chunk(const float* __restrict__ src, bfu* __restrict__ dst, int tid) {
  int o = tid * 8;
  float4 a = *reinterpret_cast<const float4*>(src + o);
  float4 b = *reinterpret_cast<const float4*>(src + o + 4);
  uint4 r;
  r.x = f2b(a.x) | ((unsigned)f2b(a.y) << 16);
  r.y = f2b(a.z) | ((unsigned)f2b(a.w) << 16);
  r.z = f2b(b.x) | ((unsigned)f2b(b.y) << 16);
  r.w = f2b(b.z) | ((unsigned)f2b(b.w) << 16);
  *reinterpret_cast<uint4*>(dst + o) = r;
}

typedef float f32x2 __attribute__((ext_vector_type(2)));
constexpr float U_SCALE = 64.f, V_SCALE = 8.f;
DEVI void convert_chunk_fp8(const float* __restrict__ src, unsigned char* __restrict__ dst, float scale, int tid) {
  int o = tid * 16;
  uint4 r;
  unsigned rr[4];
#pragma unroll
  for (int q = 0; q < 4; ++q) {
    float4 a = *reinterpret_cast<const float4*>(src + o + q * 4);
    int p = __builtin_amdgcn_cvt_pk_fp8_f32(a.x * scale, a.y * scale, 0, false);
    p = __builtin_amdgcn_cvt_pk_fp8_f32(a.z * scale, a.w * scale, p, true);
    rr[q] = (unsigned)p;
  }
  r = make_uint4(rr[0], rr[1], rr[2], rr[3]);
  *reinterpret_cast<uint4*>(dst + o) = r;
}

DEVI void phase_prep(const Params& P, int l, char* smem) {
  const int tid = ltid();
  char* ws = P.ws;
  float* tile = reinterpret_cast<float*>(smem);
  const int NT_WIN = 3072, NT_SQ = 256, NT_WQ = 512, NT_LRU = 64;
  const int T0 = NT_WIN, T1 = T0 + 4 * NT_SQ, T2 = T1 + NT_WQ, T3 = T2 + NT_LRU;
  const int C0 = T3 + 128, C1 = C0 + 4096, C2 = C1 + 4096;
  const int X0 = C2;
  const int L0 = X0 + (l == 0 ? 8 : 0);
  for (int id = blockIdx.x; id < L0; id += gridDim.x) {
    if (id < T0) {
      int tr = id / 192, tc = id % 192;
      transpose_tile(P.in[6] + (long)l * 1024 * 12288, (bfu*)(ws + O_WIN), 1024, 12288, tr * 64, tc * 64, tile, tid);
    } else if (id < T1) {
      int q = id - T0, w = q >> 8, t = q & 255;
      const float* src = P.in[18 + w] + (long)l * 1048576;
      bfu* dst = (bfu*)(ws + (w == 0 ? O_WOA : w == 1 ? O_WOB : w == 2 ? O_WOC : O_WO));
      transpose_tile(src, dst, 1024, 1024, (t >> 4) * 64, (t & 15) * 64, tile, tid);
    } else if (id < T2) {
      int q = id - T1;
      transpose_tile(P.in[24] + (long)l * 2097152, (bfu*)(ws + O_WQ), 1024, 2048, (q >> 5) * 64, (q & 31) * 64, tile, tid);
    } else if (id < T3) {
      int q = id - T2, mtx = q >> 2, t = q & 3, g = mtx >> 3, nb = mtx & 7;
      const float* src = P.in[g == 0 ? 11 : 13] + (long)l * 131072 + nb * 16384;
      transpose_tile(src, (bfu*)(ws + O_LRU) + mtx * 16384, 128, 128, (t >> 1) * 64, (t & 1) * 64, tile, tid);
    } else if (id < C0) {
      int q = id - T3;
      convert_chunk(P.in[25] + (long)l * 262144 + (long)q * 2048, (bfu*)(ws + O_KEYS) + (long)q * 2048, tid);
    } else if (id < C1) {
      int q = id - C0;
      convert_chunk_fp8(P.in[26] + (long)l * 16777216 + (long)q * 4096, (unsigned char*)(ws + O_UTB) + (long)q * 4096, U_SCALE, tid);
    } else if (id < C2) {
      int q = id - C1;
      convert_chunk_fp8(P.in[27] + (long)l * 16777216 + (long)q * 4096, (unsigned char*)(ws + O_VTB) + (long)q * 4096, V_SCALE, tid);
    } else {
      int q = id - X0;
      int c = (q & 3) * 256 + tid, ll = q >> 2;
      float a0 = P.in[16][c], a1 = P.in[16][1024 + c];
      float mx = fmaxf(a0, a1);
      float e0 = __expf(a0 - mx), e1 = __expf(a1 - mx);
      float p1 = e1 / (e0 + e1);
      float* lbs = (float*)(ws + O_LBS);
      lbs[ll * 1024 + c] = (ll == 0) ? 0.f : p1;
    }
  }
}

DEVI void phase_xcopy(const Params& P) {
  const int tid = ltid();
  bfu* xb = (bfu*)(P.ws + O_XB);
  for (int it = blockIdx.x; it < 16640; it += gridDim.x) {
    TokInfo ti = tokinfo(it);
    const float* src = ti.sample ? P.in[1] + (long)(ti.seq * 32 + ti.t) * 1024 : P.in[0] + (long)(ti.seq * 4096 + ti.t) * 1024;
    float* dst = xrow(P, it);
    int c = tid * 4;
    float4 v = *reinterpret_cast<const float4*>(src + c);
    *reinterpret_cast<float4*>(dst + c) = v;
    uint2 r;
    r.x = f2b(v.x) | ((unsigned)f2b(v.y) << 16);
    r.y = f2b(v.z) | ((unsigned)f2b(v.w) << 16);
    *reinterpret_cast<uint2*>(xb + (long)it * 1024 + c) = r;
  }
}

DEVI void phase_inproj(const Params& P, int l, int pass, char* smem) {
  const int tid = ltid();
  const int ntok = pass ? 8192 : 8448, base = pass ? 8448 : 0;
  const int nM = ntok / 128, nN = 96;
  const bfu* xb = (const bfu*)wsp(P, O_XB) + (long)base * 1024;
  const bfu* wT = (const bfu*)wsp(P, O_WIN);
  bfu* z = (bfu*)wsp(P, O_Z);
  const float* bin = P.in[7] + l * NCOL;
  for (int id = blockIdx.x; id < nM * nN; id += gridDim.x) {
    int pm, pn; tile_rc(id, nM, nN, pm, pn);
    f32x4 acc[4][4]; ZERO_ACC(acc);
    gemm_core(acc, xb + (long)pm * 128 * 1024, 1024, wT + (long)pn * 128 * 1024, 1024, 1024, smem, tid);
    epi_store_bf16(acc, bin + pn * 128, z + (long)pm * 128 * NCOL + pn * 128, NCOL, smem, tid);
  }
}

DEVI void load4bf(const bfu* p, float (&o)[4]) {
  uint2 v = *reinterpret_cast<const uint2*>(p);
  o[0] = __uint_as_float(v.x << 16); o[1] = __uint_as_float(v.x & 0xFFFF0000u);
  o[2] = __uint_as_float(v.y << 16); o[3] = __uint_as_float(v.y & 0xFFFF0000u);
}
DEVI void store4bf(bfu* p, const float (&v)[4]) {
  uint2 r;
  r.x = f2b(v[0]) | ((unsigned)f2b(v[1]) << 16);
  r.y = f2b(v[2]) | ((unsigned)f2b(v[3]) << 16);
  *reinterpret_cast<uint2*>(p) = r;
}
DEVI void ld4f(const float* p, float (&o)[4]) {
  float4 v = *reinterpret_cast<const float4*>(p);
  o[0] = v.x; o[1] = v.y; o[2] = v.z; o[3] = v.w;
}
DEVI void mixab_row4(const Params& P, int l, int base, int lt0, int tid) {
  const int it0 = base + lt0;
  const TokInfo ti = tokinfo(it0);
  const int T = ti.sample ? 32 : 4096;
  const int t0 = ti.t;
  const bfu* z = (const bfu*)(P.ws + O_Z);
  const int c = tid * 4;
  {
    float pk[6][4], ab[4][4], wa[3][4];
#pragma unroll
    for (int k = 0; k < 6; ++k) {
      const int tt = t0 - 2 + k;
      if (tt >= 0) {
        const bfu* zr = z + (long)(lt0 - 2 + k) * NCOL;
        float ac[4], ax[4];
        load4bf(zr + 1024 + c, ac); load4bf(zr + 2048 + c, ax);
#pragma unroll
        for (int i = 0; i < 4; ++i) pk[k][i] = ac[i] * ax[i];
      } else if (ti.sample) {
        ld4f(P.in[2] + ((long)(l * 8 + ti.seq) * 2 + (tt + 2)) * 1024 + c, pk[k]);
      } else {
#pragma unroll
        for (int i = 0; i < 4; ++i) pk[k][i] = 0.f;
      }
    }
#pragma unroll
    for (int r = 0; r < 4; ++r) load4bf(z + (long)(lt0 + r) * NCOL + c, ab[r]);
#pragma unroll
    for (int k = 0; k < 3; ++k) ld4f(P.in[8] + (long)(l * 3 + k) * 1024 + c, wa[k]);
#pragma unroll
    for (int r = 0; r < 4; ++r) {
      float o[4];
#pragma unroll
      for (int i = 0; i < 4; ++i) o[i] = ab[r][i] * (wa[0][i] * pk[r][i] + wa[1][i] * pk[r + 1][i] + wa[2][i] * pk[r + 2][i]);
      store4bf((bfu*)(P.ws + O_UA) + (long)(lt0 + r) * 1024 + c, o);
    }
    if (t0 + 4 == T) {
      float* ca = ti.sample ? P.out + OUT_CAS + (long)(l * 8 + ti.seq) * 2 * 1024 + c : P.out + OUT_CAP + (long)(l * 4 + ti.seq) * 2 * 1024 + c;
#pragma unroll
      for (int r = 0; r < 2; ++r)
        *reinterpret_cast<float4*>(ca + r * 1024) = make_float4(pk[r + 4][0], pk[r + 4][1], pk[r + 4][2], pk[r + 4][3]);
    }
  }
  __builtin_amdgcn_sched_barrier(0);
  {
    float xk[7][4], wb[4][4], bb[4];
#pragma unroll
    for (int k = 0; k < 7; ++k) {
      const int tt = t0 - 3 + k;
      if (tt >= 0) {
        load4bf(z + (long)(lt0 - 3 + k) * NCOL + 3072 + c, xk[k]);
      } else if (ti.sample) {
        ld4f(P.in[3] + ((long)(l * 8 + ti.seq) * 3 + (tt + 3)) * 1024 + c, xk[k]);
      } else {
#pragma unroll
        for (int i = 0; i < 4; ++i) xk[k][i] = 0.f;
      }
    }
#pragma unroll
    for (int k = 0; k < 4; ++k) ld4f(P.in[9] + (long)(l * 4 + k) * 1024 + c, wb[k]);
    ld4f(P.in[10] + (long)l * 1024 + c, bb);
#pragma unroll
    for (int r = 0; r < 4; ++r) {
      float o2[4];
#pragma unroll
      for (int i = 0; i < 4; ++i)
        o2[i] = wb[0][i] * xk[r][i] + wb[1][i] * xk[r + 1][i] + wb[2][i] * xk[r + 2][i] + wb[3][i] * xk[r + 3][i] + bb[i];
      store4bf((bfu*)(P.ws + O_CB) + (long)(lt0 + r) * 1024 + c, o2);
    }
    if (t0 + 4 == T) {
      float* cbp = ti.sample ? P.out + OUT_CBS + (long)(l * 8 + ti.seq) * 3 * 1024 + c : P.out + OUT_CBP + (long)(l * 4 + ti.seq) * 3 * 1024 + c;
#pragma unroll
      for (int r = 0; r < 3; ++r)
        *reinterpret_cast<float4*>(cbp + r * 1024) = make_float4(xk[r + 4][0], xk[r + 4][1], xk[r + 4][2], xk[r + 4][3]);
    }
  }
}

struct ChunkInfo { int lt0, L, sample, seqi, c; };
DEVI ChunkInfo chunkinfo(int ck) {
  ChunkInfo r;
  if (ck < 128) { r.seqi = ck >> 6; r.c = ck & 63; r.lt0 = r.seqi * 4096 + r.c * 64; r.L = 64; r.sample = 0; }
  else { r.seqi = ck - 128; r.c = 0; r.lt0 = 8192 + r.seqi * 32; r.L = 32; r.sample = 1; }
  return r;
}

DEVI void h1_item(const Params& P, int l, int ck, int h, char* smem, int tid) {
  const ChunkInfo ci = chunkinfo(ck);
  const int lane = tid & 63, w = tid >> 6, fr = lane & 15, fq = lane >> 4;
  bfu* VT = (bfu*)smem;
  bfu* KT = VT + 128 * 72;
  bfu* FS = KT + 128 * 72;
  float* tots = (float*)(smem + 54272);
  float* decl = tots + 256;
  const int d = tid & 127, hf = tid >> 7, L = ci.L, Lh = L >> 1;
  const float lb = ((const float*)(P.ws + O_LBS))[l * 1024 + h * 128 + d];
  const bfu* Z = (const bfu*)(P.ws + O_Z);
  const bfu* zfb = Z + (long)ci.lt0 * NCOL + 6 * 1024 + h * 128;
  const bfu* zib = Z + (long)ci.lt0 * NCOL + 7 * 1024 + h * 128;
  __syncthreads();
#pragma unroll 1
  for (int q0 = 0; q0 < 4; q0 += 2) {
    uint4 vf[2], vi[2];
#pragma unroll
    for (int qq = 0; qq < 2; ++qq) {
      const int idx = tid + 256 * (q0 + qq);
      const int sr = (idx & 15) | (((idx >> 8) & 3) << 4), c16 = ((idx >> 4) & 3) | (((idx >> 6) & 3) << 2);
      if (sr < L) {
        vf[qq] = *reinterpret_cast<const uint4*>(zfb + (long)sr * NCOL + c16 * 8);
        vi[qq] = *reinterpret_cast<const uint4*>(zib + (long)sr * NCOL + c16 * 8);
      } else { vf[qq] = make_uint4(0, 0, 0, 0); vi[qq] = make_uint4(0, 0, 0, 0); }
    }
#pragma unroll
    for (int qq = 0; qq < 2; ++qq) {
      const int idx = tid + 256 * (q0 + qq);
      const int sr = (idx & 15) | (((idx >> 8) & 3) << 4), c16 = ((idx >> 4) & 3) | (((idx >> 6) & 3) << 2);
      *reinterpret_cast<uint4*>(FS + sr * 136 + c16 * 8) = vf[qq];
      const unsigned vv[4] = {vi[qq].x, vi[qq].y, vi[qq].z, vi[qq].w};
#pragma unroll
      for (int i = 0; i < 4; ++i) {
        VT[(c16 * 8 + 2 * i) * 72 + sr] = (bfu)(vv[i] & 0xFFFFu);
        VT[(c16 * 8 + 2 * i + 1) * 72 + sr] = (bfu)(vv[i] >> 16);
      }
    }
  }
  __syncthreads();
  float tot = 0.f;
#pragma unroll 8
  for (int i = 0; i < Lh; ++i) {
    float f = lb + (1.f - lb) * sigmoidf_(b2f(FS[(hf * Lh + i) * 136 + d]));
    tot += __logf(f);
  }
  tots[hf * 128 + d] = tot;
  __syncthreads();
  float run = hf ? 0.f : tots[128 + d];
#pragma unroll 8
  for (int i = Lh - 1; i >= 0; --i) {
    const int sr = hf * Lh + i;
    float f = lb + (1.f - lb) * sigmoidf_(b2f(FS[sr * 136 + d]));
    KT[d * 72 + sr] = f2b((1.f - f) * __expf(run));
    run += __logf(f);
  }
  if (L == 32) {
    for (int sr = 32 + hf * 16; sr < 48 + hf * 16; ++sr) KT[d * 72 + sr] = 0;
  }
  if (hf == 0) {
    float dc = __expf(tots[d] + tots[128 + d]);
    decl[d] = dc;
    if (!ci.sample) ((float*)(P.ws + O_DEC))[((ci.seqi * 8 + h) * 64 + ci.c) * 128 + d] = dc;
  }
  __syncthreads();
  f32x4 acc[2][8];
#pragma unroll
  for (int mi = 0; mi < 2; ++mi)
#pragma unroll
    for (int n = 0; n < 8; ++n) acc[mi][n] = f32x4{0.f, 0.f, 0.f, 0.f};
#pragma unroll
  for (int kk = 0; kk < 2; ++kk) {
    bf16x8 a[2];
#pragma unroll
    for (int mi = 0; mi < 2; ++mi) a[mi] = *reinterpret_cast<const bf16x8*>(VT + ((2 * w + mi) * 16 + fr) * 72 + kk * 32 + fq * 8);
#pragma unroll
    for (int n = 0; n < 8; ++n) {
      bf16x8 b = *reinterpret_cast<const bf16x8*>(KT + (n * 16 + fr) * 72 + kk * 32 + fq * 8);
#pragma unroll
      for (int mi = 0; mi < 2; ++mi) acc[mi][n] = __builtin_amdgcn_mfma_f32_16x16x32_bf16(a[mi], b, acc[mi][n], 0, 0, 0);
    }
  }
  if (!ci.sample) {
    bfu* US = (bfu*)(P.ws + O_US) + ((long)((ci.seqi * 8 + h) * 64 + ci.c) << 14);
#pragma unroll
    for (int mi = 0; mi < 2; ++mi) {
      __builtin_amdgcn_sched_barrier(0);
      bfu* bp = US + ((2 * w + mi) * 16 + fq * 4) * 128 + fr;
#pragma unroll
      for (int n = 0; n < 8; ++n)
#pragma unroll
        for (int j = 0; j < 4; ++j) bp[j * 128 + n * 16] = f2b(acc[mi][n][j]);
    }
  } else {
    long sb = ((long)((l * 8 + ci.seqi) * 8 + h)) << 14;
    const float* S0 = P.in[5] + sb;
    float* So = P.out + OUT_HGS + sb;
#pragma unroll
    for (int mi = 0; mi < 2; ++mi)
#pragma unroll
      for (int n = 0; n < 8; ++n) {
        __builtin_amdgcn_sched_barrier(0);
        int e0 = (2 * w + mi) * 16 + fq * 4, dd = n * 16 + fr;
        float4 s0 = *reinterpret_cast<const float4*>(S0 + dd * 128 + e0);
        float dcl = decl[dd];
        float4 r;
        r.x = dcl * s0.x + acc[mi][n][0]; r.y = dcl * s0.y + acc[mi][n][1];
        r.z = dcl * s0.z + acc[mi][n][2]; r.w = dcl * s0.w + acc[mi][n][3];
        *reinterpret_cast<float4*>(So + dd * 128 + e0) = r;
      }
  }
}

DEVI void phase2(const Params& P, int l, int pass, char* smem) {
  const int tid = ltid();
  const int ntok = pass ? 8192 : 8448, base = pass ? 8448 : 0;
  const int nck = pass ? 128 : 136;
  const int nH = nck * 8;
  const int total = nH + ntok / 4;
  for (int id = blockIdx.x; id < total; id += gridDim.x) {
    if (id < nH) h1_item(P, l, id >> 3, id & 7, smem, tid);
    else mixab_row4(P, l, base, (id - nH) * 4, tid);
  }
}

DEVI void gate_tile(const Params& P, int l, int pm, int q, char* smem, int tid) {
  const int nb = q >> 1, hb = q & 1;
  const bfu* cb = (const bfu*)(P.ws + O_CB);
  const bfu* A = cb + (long)pm * 128 * 1024 + nb * 128;
  const bfu* Wa = (const bfu*)(P.ws + O_LRU) + nb * 16384 + hb * 64 * 128;
  const bfu* Wx = Wa + 8 * 16384;
  float* au0 = (float*)(P.ws + O_AU);
  float* au1 = au0 + (long)8448 * 1024;
  const float* ba = P.in[12] + l * 1024;
  const float* bx = P.in[14] + l * 1024;
  const float* lam = P.in[15] + l * 1024;
  f32x4 acc[4][4]; ZERO_ACC(acc);
  gemm_core_t<1>(acc, A, 1024, Wa, 128, 128, smem, tid, Wx);
  epi_stage_f32(acc, smem, tid);
  const float* T = reinterpret_cast<const float*>(smem);
#pragma unroll 2
  for (int q = 0; q < 8; ++q) {
    const int id = tid + 256 * q, row = id >> 4, g4 = id & 15;
    const int cl = g4 * 4, wcc = cl >> 5, c32 = cl & 31;
    const long grow = (long)pm * 128 + row;
    const int col = nb * 128 + hb * 64 + cl;
    float4 rp = *reinterpret_cast<const float4*>(T + row * 128 + wcc * 64 + c32);
    float4 gp = *reinterpret_cast<const float4*>(T + row * 128 + wcc * 64 + 32 + c32);
    float xv[4], bav[4], bxv[4], lmv[4];
    load4bf(cb + grow * 1024 + col, xv);
    ld4f(ba + col, bav); ld4f(bx + col, bxv); ld4f(lam + col, lmv);
    const float rpa[4] = {rp.x, rp.y, rp.z, rp.w}, gpa[4] = {gp.x, gp.y, gp.z, gp.w};
    float av[4], uv[4];
#pragma unroll
    for (int i = 0; i < 4; ++i) {
      float r = sigmoidf_(rpa[i] + bav[i]);
      float gi = sigmoidf_(gpa[i] + bxv[i]);
      float a = __expf(-8.f * log1pf(__expf(-lmv[i])) * r);
      av[i] = a;
      uv[i] = sqrtf(fmaxf(1.f - a * a, 0.f)) * gi * xv[i];
    }
    *reinterpret_cast<float4*>(au0 + grow * 1024 + col) = make_float4(av[0], av[1], av[2], av[3]);
    *reinterpret_cast<float4*>(au1 + grow * 1024 + col) = make_float4(uv[0], uv[1], uv[2], uv[3]);
  }
}
DEVI void h2_item(const Params& P, int l, int pass, int item, int tid) {
  const int sh = item >> 6, blk = item & 63;
  const int idx = blk * 256 + tid, e = idx >> 7, d = idx & 127;
  bfu* US = (bfu*)(P.ws + O_US) + ((long)sh * 64 << 14) + idx;
  const float* dec = (const float*)(P.ws + O_DEC) + (long)sh * 64 * 128 + d;
  float S = 0.f;
  for (int c0 = 0; c0 < 64; c0 += 8) {
    float u[8], dc[8];
#pragma unroll
    for (int i = 0; i < 8; ++i) { u[i] = b2f(US[(long)(c0 + i) << 14]); dc[i] = dec[(c0 + i) * 128]; }
#pragma unroll
    for (int i = 0; i < 8; ++i) { US[(long)(c0 + i) << 14] = f2b(S); S = dc[i] * S + u[i]; }
  }
  const int sl = sh >> 3, h = sh & 7, b = pass * 2 + sl;
  P.out[OUT_HGP + (((long)((l * 4 + b) * 8 + h)) << 14) + d * 128 + e] = S;
}
DEVI void phase3(const Params& P, int l, int pass, char* smem) {
  const int tid = ltid();
  const int ntok = pass ? 8192 : 8448;
  const int nG = (ntok / 128) * 16, nH2 = 1024;
  for (int id = blockIdx.x; id < nG + nH2; id += gridDim.x) {
    if (id < nG) gate_tile(P, l, id >> 4, id & 15, smem, tid);
    else h2_item(P, l, pass, id - nG, tid);
  }
}

DEVI void lsum_item(const Params& P, int tile, int cg4, int tid) {
  const int w = tid >> 6, lane = tid & 63;
  const int ch = (cg4 * 4 + w) * 64 + lane;
  const float* a0 = (const float*)(P.ws + O_AU) + (long)tile * 128 * 1024 + ch;
  const float* u0 = a0 + (long)8448 * 1024;
  float A = 1.f, H = 0.f;
  for (int r0 = 0; r0 < 128; r0 += 16) {
    float av[16], uv[16];
#pragma unroll
    for (int i = 0; i < 16; ++i) { av[i] = a0[(long)(r0 + i) * 1024]; uv[i] = u0[(long)(r0 + i) * 1024]; }
#pragma unroll
    for (int i = 0; i < 16; ++i) { H = av[i] * H + uv[i]; A *= av[i]; }
  }
  float* ls = (float*)(P.ws + O_LSUM) + (long)tile * 2048;
  ls[ch] = A; ls[1024 + ch] = H;
}

DEVI void h3_item(const Params& P, int l, int ck, int h, char* smem, int tid) {
  const ChunkInfo ci = chunkinfo(ck);
  const int lane = tid & 63, w = tid >> 6, fr = lane & 15, fq = lane >> 4;
  bfu* QT = (bfu*)smem;
  bfu* KT = QT + 64 * 136;
  bfu* AT = KT + 64 * 136;
  bfu* BS = AT + 64 * 72;
  float* bmid = (float*)(BS + 128 * 72);
  const int d = tid & 127, hf = tid >> 7, L = ci.L, Lh = L >> 1;
  const float lb = ((const float*)(P.ws + O_LBS))[l * 1024 + h * 128 + d];
  const bfu* Z = (const bfu*)(P.ws + O_Z);
  const bfu* zqb = Z + (long)ci.lt0 * NCOL + 5 * 1024 + h * 128;
  __syncthreads();
  {
    uint4 vq[4], vf[4], vi[4];
#pragma unroll
    for (int q = 0; q < 4; ++q) {
      const int idx = tid + 256 * q;
      const int sr = (idx & 15) | (((idx >> 8) & 3) << 4), c16 = ((idx >> 4) & 3) | (((idx >> 6) & 3) << 2);
      if (sr < L) {
        const bfu* rp = zqb + (long)sr * NCOL + c16 * 8;
        vq[q] = *reinterpret_cast<const uint4*>(rp);
        vf[q] = *reinterpret_cast<const uint4*>(rp + 1024);
        vi[q] = *reinterpret_cast<const uint4*>(rp + 2048);
      } else { vq[q] = make_uint4(0, 0, 0, 0); vf[q] = vq[q]; vi[q] = vq[q]; }
    }
#pragma unroll
    for (int q = 0; q < 4; ++q) {
      const int idx = tid + 256 * q;
      const int sr = (idx & 15) | (((idx >> 8) & 3) << 4), c16 = ((idx >> 4) & 3) | (((idx >> 6) & 3) << 2);
      *reinterpret_cast<uint4*>(QT + sr * 136 + c16 * 8) = vq[q];
      *reinterpret_cast<uint4*>(KT + sr * 136 + c16 * 8) = vf[q];
      const unsigned vv[4] = {vi[q].x, vi[q].y, vi[q].z, vi[q].w};
#pragma unroll
      for (int i = 0; i < 4; ++i) {
        BS[(c16 * 8 + 2 * i) * 72 + sr] = (bfu)(vv[i] & 0xFFFFu);
        BS[(c16 * 8 + 2 * i + 1) * 72 + sr] = (bfu)(vv[i] >> 16);
      }
    }
  }
  __syncthreads();
  if (hf == 0) {
    float rel = 0.f;
#pragma unroll 8
    for (int t = Lh - 1; t >= 0; --t) {
      float f = lb + (1.f - lb) * sigmoidf_(b2f(KT[t * 136 + d]));
      float q = siluf_(b2f(QT[t * 136 + d]));
      QT[t * 136 + d] = f2b(q * __expf(fminf(rel, 80.f)));
      KT[t * 136 + d] = f2b((1.f - f) * __expf(-rel));
      rel -= __logf(f);
    }
    bmid[d] = -rel;
  } else {
    float rel = 0.f;
#pragma unroll 8
    for (int t = Lh; t < L; ++t) {
      float f = lb + (1.f - lb) * sigmoidf_(b2f(KT[t * 136 + d]));
      float q = siluf_(b2f(QT[t * 136 + d]));
      rel += __logf(f);
      QT[t * 136 + d] = f2b(q * __expf(rel));
      KT[t * 136 + d] = f2b((1.f - f) * __expf(fminf(-rel, 80.f)));
    }
  }
  if (L == 32) {
    for (int t = 32 + hf * 16; t < 48 + hf * 16; ++t) { QT[t * 136 + d] = 0; KT[t * 136 + d] = 0; }
  }
  uint4 vg[4];
#pragma unroll
  for (int q = 0; q < 4; ++q) {
    const int idx = tid + 256 * q;
    const int sr = (idx & 15) | (((idx >> 8) & 3) << 4), c16 = ((idx >> 4) & 3) | (((idx >> 6) & 3) << 2);
    vg[q] = (sr < L) ? *reinterpret_cast<const uint4*>(zqb + (long)sr * NCOL + 3072 + c16 * 8) : make_uint4(0, 0, 0, 0);
  }
  __syncthreads();
  bf16x8 aq[4];
#pragma unroll
  for (int kk = 0; kk < 4; ++kk) aq[kk] = *reinterpret_cast<const bf16x8*>(QT + (16 * w + fr) * 136 + kk * 32 + fq * 8);
  {
    f32x4 sa[4];
#pragma unroll
    for (int n = 0; n < 4; ++n) sa[n] = f32x4{0.f, 0.f, 0.f, 0.f};
#pragma unroll
    for (int kk = 0; kk < 4; ++kk)
#pragma unroll
      for (int n = 0; n < 4; ++n) {
        bf16x8 bk = *reinterpret_cast<const bf16x8*>(KT + (n * 16 + fr) * 136 + kk * 32 + fq * 8);
        sa[n] = __builtin_amdgcn_mfma_f32_16x16x32_bf16(aq[kk], bk, sa[n], 0, 0, 0);
      }
#pragma unroll
    for (int n = 0; n < 4; ++n)
#pragma unroll
      for (int j = 0; j < 4; ++j) {
        int t = 16 * w + fq * 4 + j, s = n * 16 + fr;
        AT[t * 72 + s] = (s <= t) ? f2b(sa[n][j]) : (bfu)0;
      }
  }
  __syncthreads();
#pragma unroll
  for (int q = 0; q < 4; ++q) {
    const int idx = tid + 256 * q;
    const int sr = (idx & 15) | (((idx >> 8) & 3) << 4), c16 = ((idx >> 4) & 3) | (((idx >> 6) & 3) << 2);
    *reinterpret_cast<uint4*>(QT + sr * 136 + c16 * 8) = vg[q];
  }
  f32x4 o[8];
#pragma unroll
  for (int n = 0; n < 8; ++n) o[n] = f32x4{0.f, 0.f, 0.f, 0.f};
#pragma unroll
  for (int kk = 0; kk < 2; ++kk) {
    bf16x8 a = *reinterpret_cast<const bf16x8*>(AT + (16 * w + fr) * 72 + kk * 32 + fq * 8);
#pragma unroll
    for (int n = 0; n < 8; ++n) {
      bf16x8 b = *reinterpret_cast<const bf16x8*>(BS + (n * 16 + fr) * 72 + kk * 32 + fq * 8);
      o[n] = __builtin_amdgcn_mfma_f32_16x16x32_bf16(a, b, o[n], 0, 0, 0);
    }
  }
#pragma unroll
  for (int sl = 0; sl < 2; ++sl) {
    __syncthreads();
    if (!ci.sample) {
      const bfu* src = (const bfu*)(P.ws + O_US) + ((long)((ci.seqi * 8 + h) * 64 + ci.c) << 14);
      int e2 = tid >> 1, dd0 = (tid & 1) * 32;
#pragma unroll
      for (int q4 = 0; q4 < 4; ++q4) {
        uint4 v = *reinterpret_cast<const uint4*>(src + e2 * 128 + sl * 64 + dd0 + q4 * 8);
        const float* bm = bmid + sl * 64 + dd0 + q4 * 8;
        unsigned vv[4] = {v.x, v.y, v.z, v.w};
        unsigned rr[4];
#pragma unroll
        for (int i = 0; i < 4; ++i) {
          float lo = __uint_as_float(vv[i] << 16) * __expf(bm[2 * i]);
          float hi = __uint_as_float(vv[i] & 0xFFFF0000u) * __expf(bm[2 * i + 1]);
          rr[i] = f2b(lo) | ((unsigned)f2b(hi) << 16);
        }
        *reinterpret_cast<uint4*>(BS + e2 * 72 + dd0 + q4 * 8) = make_uint4(rr[0], rr[1], rr[2], rr[3]);
      }
    } else {
      const float* S0 = P.in[5] + (((long)((l * 8 + ci.seqi) * 8 + h)) << 14);
#pragma unroll 4
      for (int dd = hf * 32; dd < hf * 32 + 32; ++dd)
        BS[d * 72 + dd] = f2b(S0[(sl * 64 + dd) * 128 + d] * __expf(bmid[sl * 64 + dd]));
    }
    __syncthreads();
#pragma unroll
    for (int kk = 0; kk < 2; ++kk) {
#pragma unroll
      for (int n = 0; n < 8; ++n) {
        bf16x8 b = *reinterpret_cast<const bf16x8*>(BS + (n * 16 + fr) * 72 + kk * 32 + fq * 8);
        o[n] = __builtin_amdgcn_mfma_f32_16x16x32_bf16(aq[sl * 2 + kk], b, o[n], 0, 0, 0);
      }
    }
  }
  float rinv[4];
#pragma unroll
  for (int j = 0; j < 4; ++j) {
    float ss = 0.f;
#pragma unroll
    for (int n = 0; n < 8; ++n) ss += o[n][j] * o[n][j];
    ss += __shfl_xor(ss, 1); ss += __shfl_xor(ss, 2); ss += __shfl_xor(ss, 4); ss += __shfl_xor(ss, 8);
    rinv[j] = rsqrtf(ss * (1.f / 128.f) + 1e-6f);
  }
  const float* ng = P.in[17] + l * 128;
  bfu* UC = (bfu*)(P.ws + O_UC);
#pragma unroll
  for (int n = 0; n < 8; ++n)
#pragma unroll
    for (int j = 0; j < 4; ++j) {
      int t = 16 * w + fq * 4 + j, e = n * 16 + fr;
      if (t < L) {
        float g = b2f(QT[t * 136 + e]);
        UC[(long)(ci.lt0 + t) * 1024 + h * 128 + e] = f2b(o[n][j] * rinv[j] * ng[e] * siluf_(g));
      }
    }
}
DEVI void phase4(const Params& P, int l, int pass, char* smem) {
  const int tid = ltid();
  const int nck = pass ? 128 : 136;
  const int nH = nck * 8;
  const int nL = 64 * 4;
  for (int id = blockIdx.x; id < nH + nL; id += gridDim.x) {
    if (id < nH) h3_item(P, l, id >> 3, id & 7, smem, tid);
    else { int q = id - nH; lsum_item(P, q >> 2, q & 3, tid); }
  }
}

DEVI void phase5(const Params& P, int l, int pass) {
  const int tid = ltid();
  const int ntok = pass ? 8192 : 8448, base = pass ? 8448 : 0;
  const int nItems = (ntok / 128) * 4;
  const int w = tid >> 6, lane = tid & 63;
  const float* AU0 = (const float*)(P.ws + O_AU);
  const float* AU1 = AU0 + (long)8448 * 1024;
  const float* LS = (const float*)(P.ws + O_LSUM);
  const bfu* Z = (const bfu*)(P.ws + O_Z);
  bfu* UB = (bfu*)(P.ws + O_UB);
  for (int id = blockIdx.x; id < nItems; id += gridDim.x) {
    const int tile = id >> 2, ch = ((id & 3) * 4 + w) * 64 + lane;
    const int lt0 = tile * 128;
    const TokInfo t0 = tokinfo(base + lt0);
    float hcur = 0.f;
    if (!t0.sample) {
      int jf = tile - (t0.t >> 7);
#pragma unroll 4
      for (int i = jf; i < tile; ++i) hcur = LS[(long)i * 2048 + ch] * hcur + LS[(long)i * 2048 + 1024 + ch];
    }
    for (int r0 = 0; r0 < 128; r0 += 8) {
      float av[8], uv[8], gv[8];
#pragma unroll
      for (int i = 0; i < 8; ++i) {
        long row = lt0 + r0 + i;
        av[i] = AU0[row * 1024 + ch]; uv[i] = AU1[row * 1024 + ch];
        gv[i] = b2f(Z[row * NCOL + 4 * 1024 + ch]);
      }
#pragma unroll
      for (int i = 0; i < 8; ++i) {
        int r = r0 + i;
        if (t0.sample && (r & 31) == 0) hcur = P.in[4][(long)(l * 8 + t0.seq + (r >> 5)) * 1024 + ch];
        hcur = av[i] * hcur + uv[i];
        UB[(long)(lt0 + r) * 1024 + ch] = f2b(geluf_(gv[i]) * hcur);
        if (t0.sample && (r & 31) == 31) P.out[OUT_LRS + (long)(l * 8 + t0.seq + (r >> 5)) * 1024 + ch] = hcur;
      }
    }
    if (!t0.sample && t0.t + 128 == 4096) P.out[OUT_LRP + (long)(l * 4 + t0.seq) * 1024 + ch] = hcur;
  }
}

template <int BR>
DEVI void p6_branch(const Params& P, int pm, int pn, float* macc, char* smem, int tid) {
  asm volatile("" : "+s"(pm), "+s"(pn));
  const bfu* Z = (const bfu*)(P.ws + O_Z);
  bfu* M = (bfu*)(P.ws + O_CB);
  const bfu* A = (const bfu*)(P.ws + (BR == 0 ? O_UA : BR == 1 ? O_UB : O_UC)) + (long)pm * 128 * 1024;
  const bfu* B = (const bfu*)(P.ws + (BR == 0 ? O_WOA : BR == 1 ? O_WOB : O_WOC)) + (long)pn * 128 * 1024;
  f32x4 acc[4][4]; ZERO_ACC(acc);
  gemm_core(acc, A, 1024, B, 1024, 1024, smem, tid);
  epi_stage_f32(acc, smem, tid);
  const float* T = reinterpret_cast<const float*>(smem);
#pragma unroll 4
  for (int q = 0; q < 16; ++q) {
    const int id = tid + 256 * q, row = id >> 5, c4 = id & 31;
    const long grow = (long)pm * 128 + row;
    const int gcol = pn * 128 + c4 * 4;
    float4 a = *reinterpret_cast<const float4*>(T + row * 128 + c4 * 4);
    float g[4];
    load4bf(Z + grow * NCOL + (9 + BR) * 1024 + gcol, g);
    float v[4] = {sigmoidf_(g[0]) * a.x, sigmoidf_(g[1]) * a.y, sigmoidf_(g[2]) * a.z, sigmoidf_(g[3]) * a.w};
    if (BR > 0) {
      float4 mo = *reinterpret_cast<const float4*>(macc + grow * 1024 + gcol);
      v[0] += mo.x; v[1] += mo.y; v[2] += mo.z; v[3] += mo.w;
    }
    if (BR < 2) *reinterpret_cast<float4*>(macc + grow * 1024 + gcol) = make_float4(v[0], v[1], v[2], v[3]);
    else store4bf(M + grow * 1024 + gcol, v);
  }
}
DEVI void phase6(const Params& P, int l, int pass, char* smem) {
  const int tid = ltid();
  const int ntok = pass ? 8192 : 8448;
  const int nM = ntok / 128, nN = 8;
  const bfu* Z = (const bfu*)(P.ws + O_Z);
  bfu* M = (bfu*)(P.ws + O_CB);
  for (int id = blockIdx.x; id < nM * nN; id += gridDim.x) {
    int pm = id >> 3, pn = id & 7;
    float* macc = (float*)(P.ws + O_AU);
    p6_branch<0>(P, pm, pn, macc, smem, tid);
    p6_branch<1>(P, pm, pn, macc, smem, tid);
    p6_branch<2>(P, pm, pn, macc, smem, tid);
  }
}

DEVI void phase7(const Params& P, int l, int pass, char* smem) {
  const int tid = ltid();
  const int ntok = pass ? 8192 : 8448, base = pass ? 8448 : 0;
  const int nM = ntok / 128, nN = 8;
  const bfu* M = (const bfu*)wsp(P, O_CB);
  const bfu* W = (const bfu*)wsp(P, O_WO);
  float* pre = (float*)wsp(P, O_PRE);
  for (int id = blockIdx.x; id < nM * nN; id += gridDim.x) {
    int pm = id >> 3, pn = id & 7;
    f32x4 acc[4][4]; ZERO_ACC(acc);
    gemm_core(acc, M + (long)pm * 128 * 1024, 1024, W + (long)pn * 128 * 1024, 1024, 1024, smem, tid);
    epi_stage_f32(acc, smem, tid);
    {
      const float* T = reinterpret_cast<const float*>(smem);
#pragma unroll 4
      for (int q = 0; q < 16; ++q) {
        const int id = tid + 256 * q, row = id >> 5, c4 = id & 31;
        const int grow = pm * 128 + row, gcol = pn * 128 + c4 * 4;
        float4 a = *reinterpret_cast<const float4*>(T + row * 128 + c4 * 4);
        float4 xx = *reinterpret_cast<const float4*>(xrow(P, base + grow) + gcol);
        *reinterpret_cast<float4*>(pre + (long)grow * 1024 + gcol) =
            make_float4(ALPHA * xx.x + a.x, ALPHA * xx.y + a.y, ALPHA * xx.z + a.z, ALPHA * xx.w + a.w);
      }
    }
  }
}

DEVI void phase8(const Params& P, int l, int pass) {
  const int tid = ltid();
  const int ntok = pass ? 8192 : 8448, base = pass ? 8448 : 0;
  const int w = tid >> 6, lane = tid & 63;
  const float* pre = (const float*)wsp(P, O_PRE);
  const float* g = P.in[22] + l * 1024;
  const float* b = P.in[23] + l * 1024;
  bfu* xb = (bfu*)wsp(P, O_XB);
  for (int id = blockIdx.x; id < ntok / 4; id += gridDim.x) {
    int lt = id * 4 + w, it = base + lt;
    const float* src = pre + (long)lt * 1024;
    float v[16];
#pragma unroll
    for (int q = 0; q < 4; ++q) {
      float4 t = *reinterpret_cast<const float4*>(src + q * 256 + lane * 4);
      v[q * 4] = t.x; v[q * 4 + 1] = t.y; v[q * 4 + 2] = t.z; v[q * 4 + 3] = t.w;
    }
    float s = 0.f;
#pragma unroll
    for (int i = 0; i < 16; ++i) s += v[i];
    float mu = wave_sum(s) * (1.f / 1024.f);
    float ss = 0.f;
#pragma unroll
    for (int i = 0; i < 16; ++i) { float dlt = v[i] - mu; ss += dlt * dlt; }
    float rs = rsqrtf(wave_sum(ss) * (1.f / 1024.f) + 1e-5f);
    float* xr = xrow(P, it);
#pragma unroll
    for (int q = 0; q < 4; ++q) {
      int c = q * 256 + lane * 4;
      float o[4];
#pragma unroll
      for (int i = 0; i < 4; ++i) o[i] = (v[q * 4 + i] - mu) * rs * g[c + i] + b[c + i];
      *reinterpret_cast<float4*>(xr + c) = make_float4(o[0], o[1], o[2], o[3]);
      store4bf(xb + (long)it * 1024 + c, o);
    }
  }
}

DEVI void phase9(const Params& P, int l, int pass, char* smem) {
  const int tid = ltid();
  const int ntok = pass ? 8192 : 8448, base = pass ? 8448 : 0;
  const int nM = ntok / 128, nN = 16;
  const bfu* xb = (const bfu*)wsp(P, O_XB) + (long)base * 1024;
  const bfu* W = (const bfu*)wsp(P, O_WQ);
  bfu* qp = (bfu*)wsp(P, O_QP);
  for (int id = blockIdx.x; id < nM * nN; id += gridDim.x) {
    int pm, pn; tile_rc(id, nM, nN, pm, pn);
    f32x4 acc[4][4]; ZERO_ACC(acc);
    gemm_core(acc, xb + (long)pm * 128 * 1024, 1024, W + (long)pn * 128 * 1024, 1024, 1024, smem, tid);
    epi_store_bf16(acc, nullptr, qp + (long)pm * 128 * 2048 + pn * 128, 2048, smem, tid);
  }
}
DEVI void phase10(const Params& P, int l, int pass, char* smem) {
  const int tid = ltid();
  const int ntok = pass ? 8192 : 8448;
  const int nM = ntok / 128, nN = 16;
  const bfu* qp = (const bfu*)wsp(P, O_QP);
  const bfu* KB = (const bfu*)wsp(P, O_KEYS);
  float* sc = (float*)wsp(P, O_SC);
  for (int id = blockIdx.x; id < nM * nN; id += gridDim.x) {
    int pm = id >> 4, pn = id & 15;
    f32x4 acc[4][4]; ZERO_ACC(acc);
    gemm_core(acc, qp + (long)pm * 128 * 2048 + pn * 128, 2048, KB + (long)pn * 16384, 128, 128, smem, tid);
    epi_stage_f32(acc, smem, tid);
    {
      const float* T = reinterpret_cast<const float*>(smem);
#pragma unroll 4
      for (int q = 0; q < 16; ++q) {
        const int id = tid + 256 * q, row = id >> 5, c4 = id & 31;
        *reinterpret_cast<float4*>(sc + (long)(pm * 128 + row) * 2048 + pn * 128 + c4 * 4) =
            *reinterpret_cast<const float4*>(T + row * 128 + c4 * 4);
      }
    }
  }
}

constexpr int KLOW = 12;
__constant__ unsigned char CAND_IJ[50] = {
  0x00,0x01,0x02,0x03,0x04,0x05,0x06,0x07,0x08,0x09,0x0A,0x0B,0x0C,0x0D,0x0E,0x0F,
  0x10,0x11,0x12,0x13,0x14,0x15,0x16,0x17,
  0x20,0x21,0x22,0x23,0x24,
  0x30,0x31,0x32,0x33,
  0x40,0x41,0x42,
  0x50,0x51, 0x60,0x61, 0x70,0x71,
  0x80,0x90,0xA0,0xB0,0xC0,0xD0,0xE0,0xF0};
DEVI unsigned fkey(float f) {
  unsigned u = __float_as_uint(f);
  return (u & 0x80000000u) ? ~u : (u | 0x80000000u);
}
DEVI void dec16(uint4 v, f32x2 (&o)[8]) {
  o[0] = __builtin_amdgcn_cvt_pk_f32_fp8((int)v.x, false); o[1] = __builtin_amdgcn_cvt_pk_f32_fp8((int)v.x, true);
  o[2] = __builtin_amdgcn_cvt_pk_f32_fp8((int)v.y, false); o[3] = __builtin_amdgcn_cvt_pk_f32_fp8((int)v.y, true);
  o[4] = __builtin_amdgcn_cvt_pk_f32_fp8((int)v.z, false); o[5] = __builtin_amdgcn_cvt_pk_f32_fp8((int)v.z, true);
  o[6] = __builtin_amdgcn_cvt_pk_f32_fp8((int)v.w, false); o[7] = __builtin_amdgcn_cvt_pk_f32_fp8((int)v.w, true);
}
DEVI void phase11(const Params& P, int l, int pass, char* smem) {
  const int ntok = pass ? 8192 : 8448, base = pass ? 8448 : 0;
  const int tid = ltid(); const int w = tid >> 6, lane = tid & 63;
  float* scl = (float*)smem;
  float* sv = scl + 2048;
  int* si = (int*)(sv + 256);
  float* tops = (float*)(si + 256);
  int* tope = (int*)(tops + 128);
  float* wgt = (float*)(tope + 128);
  float* svs = wgt + 128;
  int* sis = (int*)(svs + 256);
  float* red = (float*)(sis + 256);
  float* stat = red + 4096;
  const float* SC = (const float*)(P.ws + O_SC);
  const unsigned char* UT = (const unsigned char*)(P.ws + O_UTB);
  const unsigned char* VTb = (const unsigned char*)(P.ws + O_VTB);
  const float* g2 = P.in[28] + l * 1024;
  const float* b2 = P.in[29] + l * 1024;
  bfu* xb = (bfu*)(P.ws + O_XB);
  const unsigned long long ltmask = (1ull << lane) - 1ull;
  for (int lt = blockIdx.x; lt < ntok; lt += gridDim.x) {
    const int it = base + lt;
    float* xr = xrow(P, it);
    __syncthreads();
    {
      const float4* s4 = reinterpret_cast<const float4*>(SC + (long)lt * 2048);
      reinterpret_cast<float4*>(scl)[tid] = s4[tid];
      reinterpret_cast<float4*>(scl)[tid + 256] = s4[tid + 256];
    }
    __syncthreads();
    {
      float v0[4], v1[4]; unsigned k0[4], k1[4], T[4];
#pragma unroll
      for (int li = 0; li < 4; ++li) {
        const int Lx = w * 4 + li;
        v0[li] = scl[Lx * 128 + lane]; v1[li] = scl[Lx * 128 + 64 + lane];
        k0[li] = fkey(v0[li]); k1[li] = fkey(v1[li]); T[li] = 0;
      }
      for (int b = 31; b >= KLOW; --b) {
#pragma unroll
        for (int li = 0; li < 4; ++li) {
          unsigned cand = T[li] | (1u << b);
          int cnt = __popcll(__ballot(k0[li] >= cand)) + __popcll(__ballot(k1[li] >= cand));
          if (cnt >= 16) T[li] = cand;
        }
      }
#pragma unroll
      for (int li = 0; li < 4; ++li) {
        const int Lx = w * 4 + li;
        const unsigned T2 = T[li] + (1u << KLOW);
        bool g0 = k0[li] >= T2, g1 = k1[li] >= T2;
        bool q0 = (k0[li] >= T[li]) && !g0, q1 = (k1[li] >= T[li]) && !g1;
        unsigned long long mg0 = __ballot(g0), mg1 = __ballot(g1), mq0 = __ballot(q0), mq1 = __ballot(q1);
        int ng0 = __popcll(mg0), ng = ng0 + __popcll(mg1);
        int p0 = g0 ? __popcll(mg0 & ltmask) : ng + __popcll(mq0 & ltmask);
        int p1 = g1 ? ng0 + __popcll(mg1 & ltmask) : ng + __popcll(mq0) + __popcll(mq1 & ltmask);
        if ((g0 || q0) && p0 < 16) { sv[Lx * 16 + p0] = v0[li]; si[Lx * 16 + p0] = lane; }
        if ((g1 || q1) && p1 < 16) { sv[Lx * 16 + p1] = v1[li]; si[Lx * 16 + p1] = lane + 64; }
      }
    }
    __builtin_amdgcn_wave_barrier();
    {
      const int Lx = w * 4 + (lane >> 4), e = lane & 15;
      const float v = sv[Lx * 16 + e];
      const int id = si[Lx * 16 + e];
      int rank = 0;
#pragma unroll
      for (int q = 0; q < 4; ++q) {
        float4 o = *reinterpret_cast<const float4*>(sv + Lx * 16 + q * 4);
        rank += (o.x > v || (o.x == v && q * 4 + 0 < e)) ? 1 : 0;
        rank += (o.y > v || (o.y == v && q * 4 + 1 < e)) ? 1 : 0;
        rank += (o.z > v || (o.z == v && q * 4 + 2 < e)) ? 1 : 0;
        rank += (o.w > v || (o.w == v && q * 4 + 3 < e)) ? 1 : 0;
      }
      __builtin_amdgcn_wave_barrier();
      svs[Lx * 16 + rank] = v; sis[Lx * 16 + rank] = id;
    }
    __builtin_amdgcn_wave_barrier();
    {
      float cv[2]; unsigned ck[2], T[2]; int ce[2];
      const int cij = (lane < 50) ? (int)CAND_IJ[lane] : 0;
      const int ci = cij >> 4, cj = cij & 15;
#pragma unroll
      for (int hi = 0; hi < 2; ++hi) {
        const int h = w * 2 + hi;
        T[hi] = 0;
        cv[hi] = svs[(2 * h) * 16 + ci] + svs[(2 * h + 1) * 16 + cj];
        ce[hi] = sis[(2 * h) * 16 + ci] * 128 + sis[(2 * h + 1) * 16 + cj];
        ck[hi] = (lane < 50) ? fkey(cv[hi]) : 0u;
      }
      for (int b = 31; b >= KLOW; --b) {
#pragma unroll
        for (int hi = 0; hi < 2; ++hi) {
          unsigned cand = T[hi] | (1u << b);
          int cnt = __popcll(__ballot(ck[hi] >= cand));
          if (cnt >= 16) T[hi] = cand;
        }
      }
#pragma unroll
      for (int hi = 0; hi < 2; ++hi) {
        const int h = w * 2 + hi;
        const unsigned T2 = T[hi] + (1u << KLOW);
        bool g = ck[hi] >= T2, q = (ck[hi] >= T[hi]) && !g && (lane < 50);
        unsigned long long mg = __ballot(g), mq = __ballot(q);
        int p = g ? __popcll(mg & ltmask) : __popcll(mg) + __popcll(mq & ltmask);
        if ((g || q) && p < 16) { tops[h * 16 + p] = cv[hi]; tope[h * 16 + p] = ce[hi]; }
      }
    }
    __syncthreads();
    if (tid < 128) {
      float s = tops[tid];
      float mx = s;
      mx = fmaxf(mx, __shfl_xor(mx, 1)); mx = fmaxf(mx, __shfl_xor(mx, 2));
      mx = fmaxf(mx, __shfl_xor(mx, 4)); mx = fmaxf(mx, __shfl_xor(mx, 8));
      float e = __expf(s - mx);
      float sm = e;
      sm += __shfl_xor(sm, 1); sm += __shfl_xor(sm, 2); sm += __shfl_xor(sm, 4); sm += __shfl_xor(sm, 8);
      tops[tid] = e / sm;
    }
    __syncthreads();
    f32x2 xv[8];
    {
      const float4* xp = reinterpret_cast<const float4*>(xr + lane * 16);
#pragma unroll
      for (int q = 0; q < 4; ++q) {
        float4 a = xp[q];
        xv[2 * q] = f32x2{a.x, a.y}; xv[2 * q + 1] = f32x2{a.z, a.w};
      }
    }
    f32x2 oacc[8];
#pragma unroll
    for (int q = 0; q < 8; ++q) oacc[q] = f32x2{0.f, 0.f};
#pragma unroll 1
    for (int p0 = 0; p0 < 32; p0 += 8) {
      uint4 ru[8], rv[8];
#pragma unroll
      for (int i = 0; i < 8; ++i) {
        int e = tope[w * 32 + p0 + i];
        ru[i] = *reinterpret_cast<const uint4*>(UT + (long)e * 1024 + lane * 16);
        rv[i] = *reinterpret_cast<const uint4*>(VTb + (long)e * 1024 + lane * 16);
      }
      float dsum[8];
#pragma unroll
      for (int i = 0; i < 8; ++i) {
        f32x2 f[8];
        dec16(ru[i], f);
        f32x2 acc = f[0] * xv[0];
#pragma unroll
        for (int q = 1; q < 8; ++q) acc = __builtin_elementwise_fma(f[q], xv[q], acc);
        dsum[i] = acc.x + acc.y;
      }
      float e4[4], e2[2], e1;
      {
        const bool hi = (lane & 32) != 0;
#pragma unroll
        for (int i = 0; i < 4; ++i) {
          float snd = hi ? dsum[i] : dsum[i + 4];
          float kp = hi ? dsum[i + 4] : dsum[i];
          e4[i] = kp + __shfl_xor(snd, 32);
        }
        const bool hi2 = (lane & 16) != 0;
#pragma unroll
        for (int i = 0; i < 2; ++i) {
          float snd = hi2 ? e4[i] : e4[i + 2];
          float kp = hi2 ? e4[i + 2] : e4[i];
          e2[i] = kp + __shfl_xor(snd, 16);
        }
        const bool hi3 = (lane & 8) != 0;
        {
          float snd = hi3 ? e2[0] : e2[1];
          float kp = hi3 ? e2[1] : e2[0];
          e1 = kp + __shfl_xor(snd, 8);
        }
        e1 += __shfl_xor(e1, 4); e1 += __shfl_xor(e1, 2); e1 += __shfl_xor(e1, 1);
      }
      {
        int r = ((lane >> 5) & 1) * 4 + ((lane >> 4) & 1) * 2 + ((lane >> 3) & 1);
        float wv_ = tops[w * 32 + p0 + r] * geluf_(e1 * (1.f / U_SCALE)) * (1.f / V_SCALE);
        if ((lane & 7) == 0) wgt[w * 32 + p0 + r] = wv_;
      }
      __builtin_amdgcn_wave_barrier();
      float wg[8];
      {
        float4 wa = *reinterpret_cast<const float4*>(wgt + w * 32 + p0);
        float4 wb = *reinterpret_cast<const float4*>(wgt + w * 32 + p0 + 4);
        wg[0] = wa.x; wg[1] = wa.y; wg[2] = wa.z; wg[3] = wa.w; wg[4] = wb.x; wg[5] = wb.y; wg[6] = wb.z; wg[7] = wb.w;
      }
#pragma unroll
      for (int i = 0; i < 8; ++i) {
        f32x2 f[8];
        dec16(rv[i], f);
        f32x2 wv = f32x2{wg[i], wg[i]};
#pragma unroll
        for (int q = 0; q < 8; ++q) oacc[q] = __builtin_elementwise_fma(f[q], wv, oacc[q]);
      }
    }
    {
      float4* rwp = reinterpret_cast<float4*>(red + w * 1024 + lane * 16);
#pragma unroll
      for (int q = 0; q < 4; ++q) rwp[q] = make_float4(oacc[2 * q].x, oacc[2 * q].y, oacc[2 * q + 1].x, oacc[2 * q + 1].y);
    }
    __syncthreads();
    const int c = tid * 4;
    float y[4];
    {
      float4 xx = *reinterpret_cast<const float4*>(xr + c);
      float4 r0 = *reinterpret_cast<const float4*>(red + c);
      float4 r1 = *reinterpret_cast<const float4*>(red + 1024 + c);
      float4 r2 = *reinterpret_cast<const float4*>(red + 2048 + c);
      float4 r3 = *reinterpret_cast<const float4*>(red + 3072 + c);
      y[0] = ALPHA * xx.x + (r0.x + r1.x + r2.x + r3.x);
      y[1] = ALPHA * xx.y + (r0.y + r1.y + r2.y + r3.y);
      y[2] = ALPHA * xx.z + (r0.z + r1.z + r2.z + r3.z);
      y[3] = ALPHA * xx.w + (r0.w + r1.w + r2.w + r3.w);
    }
    float s = wave_sum(y[0] + y[1] + y[2] + y[3]);
    if (lane == 0) stat[w] = s;
    __syncthreads();
    float mu = (stat[0] + stat[1] + stat[2] + stat[3]) * (1.f / 1024.f);
    float ss = 0.f;
#pragma unroll
    for (int i = 0; i < 4; ++i) { float dl = y[i] - mu; ss += dl * dl; }
    ss = wave_sum(ss);
    if (lane == 0) stat[4 + w] = ss;
    __syncthreads();
    float rs = rsqrtf((stat[4] + stat[5] + stat[6] + stat[7]) * (1.f / 1024.f) + 1e-5f);
    float o[4];
#pragma unroll
    for (int i = 0; i < 4; ++i) o[i] = (y[i] - mu) * rs * g2[c + i] + b2[c + i];
    *reinterpret_cast<float4*>(xr + c) = make_float4(o[0], o[1], o[2], o[3]);
    store4bf(xb + (long)it * 1024 + c, o);
  }
}

#define XB_TMO      128
#define XB_XCNT(j)  (256  + 64 * (j))
#define XB_XSUB(j)  (1280 + 64 * (j))
#define XB_XGEN(j)  (2304 + 64 * (j))
#define XB_TOP      3328
#define XB_TOPGEN   3392
#define XCD_BAR_WORDS 3456
#define XB_SPIN_CAP (1u << 18)
DEVI unsigned xb_ld(unsigned* p) { return __hip_atomic_load(p, __ATOMIC_RELAXED, __HIP_MEMORY_SCOPE_AGENT); }
DEVI unsigned xb_add(unsigned* p, unsigned v) { return __hip_atomic_fetch_add(p, v, __ATOMIC_RELAXED, __HIP_MEMORY_SCOPE_AGENT); }
DEVI unsigned xb_xcc_id() { return (unsigned)__builtin_amdgcn_s_getreg((3 << 11) | 20) & 0xFu; }
#define XB_SPIN(cond, bar) do { unsigned _sp = 0; while (cond) { __builtin_amdgcn_s_sleep(1); \
    if ((++_sp & 255u) == 0u) { if (xb_ld(&(bar)[XB_TMO])) break; if (_sp > XB_SPIN_CAP) { atomicAdd(&(bar)[XB_TMO], 1u); break; } } } } while (0)
DEVI void xcd_census(unsigned* bar, unsigned x, unsigned& nloc, unsigned& nx) {
  const unsigned G = gridDim.x;
  unsigned sum, cnt, mine, sp = 0u;
  for (;;) {
    sum = 0u; cnt = 0u; mine = 0u;
#pragma unroll
    for (unsigned j = 0; j < 16; ++j) { const unsigned c = xb_ld(&bar[XB_XCNT(j)]); sum += c; cnt += (c > 0u) ? 1u : 0u; mine = (j == x) ? c : mine; }
    if (sum == G) break;
    __builtin_amdgcn_s_sleep(1);
    if ((++sp & 255u) == 0u) { if (xb_ld(&bar[XB_TMO])) break; if (sp > XB_SPIN_CAP) { atomicAdd(&bar[XB_TMO], 1u); break; } }
  }
  nloc = mine > 0u ? mine : 1u; nx = cnt > 0u ? cnt : 1u;
}
DEVI void xcd_barrier(unsigned* bar, unsigned x, unsigned nloc, unsigned nx) {
  asm volatile("s_waitcnt vmcnt(0)" ::: "memory");
  __syncthreads();
  if (threadIdx.x == 0) {
    __builtin_amdgcn_s_waitcnt(0);
    const unsigned old = xb_add(&bar[XB_XSUB(x)], 1u);
    const unsigned gen = old / nloc;
    if (old + 1u == (gen + 1u) * nloc) {
      __builtin_amdgcn_fence(__ATOMIC_RELEASE, "agent");
      asm volatile("s_waitcnt vmcnt(0)" ::: "memory");
      const unsigned og = xb_add(&bar[XB_TOP], 1u);
      const unsigned tg = og / nx;
      if (og + 1u == (tg + 1u) * nx) xb_add(&bar[XB_TOPGEN], 1u);
      else XB_SPIN(xb_ld(&bar[XB_TOPGEN]) == tg, bar);
      __builtin_amdgcn_fence(__ATOMIC_ACQUIRE, "agent");
      xb_add(&bar[XB_XGEN(x)], 1u);
      asm volatile("s_waitcnt vmcnt(0)" ::: "memory");
    } else {
      XB_SPIN(xb_ld(&bar[XB_XGEN(x)]) == gen, bar);
      __builtin_amdgcn_fence(__ATOMIC_ACQUIRE, "agent");
      asm volatile("s_waitcnt vmcnt(0)" ::: "memory");
    }
  }
  __syncthreads();
}

__global__ void __launch_bounds__(256, 2) fwd_megakernel(Params P) {
  __shared__ __attribute__((aligned(16))) char smem[65536];
  cg::grid_group grid = cg::this_grid();
  unsigned* bar = (unsigned*)(P.ws + O_BAR);
  const unsigned xcc = xb_xcc_id();
  if (threadIdx.x == 0) (void)xb_add(&bar[XB_XCNT(xcc)], 1u);
  unsigned nloc = 1u, nx = 1u;
#define LND asm volatile("" : "+s"(l), "+s"(pass))
#define GSYNC xcd_barrier(bar, xcc, nloc, nx)
#pragma unroll 1
  for (int l = 0; l < 2; ++l) {
    phase_prep(P, l, smem);
    if (l == 0) {
      phase_xcopy(P);
      grid.sync();
      if (threadIdx.x == 0) xcd_census(bar, xcc, nloc, nx);
    } else {
      GSYNC;
    }
#pragma unroll 1
    for (int pass = 0; pass < 2; ++pass) {
      LND; phase_inproj(P, l, pass, smem); GSYNC;
      LND; phase2(P, l, pass, smem); GSYNC;
      LND; phase3(P, l, pass, smem); GSYNC;
      LND; phase4(P, l, pass, smem); GSYNC;
      LND; phase5(P, l, pass); GSYNC;
      LND; phase6(P, l, pass, smem); GSYNC;
      LND; phase7(P, l, pass, smem); GSYNC;
      LND; phase8(P, l, pass); GSYNC;
      LND; phase9(P, l, pass, smem); GSYNC;
      LND; phase10(P, l, pass, smem); GSYNC;
      LND; phase11(P, l, pass, smem); if (!(l == 1 && pass == 1)) GSYNC;
    }
  }
}

extern "C" void kernel_launch(void* const* d_in, const int* in_sizes, int n_in, void* d_out, int out_size,
                              void* d_ws, size_t ws_size, hipStream_t stream) {
  static int grid_blocks = 0;
  if (!grid_blocks) {
    int dev = 0, cus = 0, per_cu = 0;
    hipGetDevice(&dev);
    hipDeviceGetAttribute(&cus, hipDeviceAttributeMultiprocessorCount, dev);
    hipOccupancyMaxActiveBlocksPerMultiprocessor(&per_cu, fwd_megakernel, 256, 0);
    if (per_cu > 2) per_cu = 2;
    if (per_cu < 1) per_cu = 1;
    grid_blocks = cus * per_cu;
  }
  if (ws_size < O_END) fprintf(stderr, "workspace too small: %zu < %zu\n", ws_size, (size_t)O_END);
  hipMemsetAsync((char*)d_ws + O_BAR, 0, 16384, stream);
  Params p{};
  for (int i = 0; i < 30; ++i) p.in[i] = (const float*)d_in[i];
  p.out = (float*)d_out;
  p.ws = (char*)d_ws;
  void* args[] = {&p};
  hipError_t e = hipLaunchCooperativeKernel((void*)fwd_megakernel, dim3(grid_blocks), dim3(256), args, 0, stream);
  if (e != hipSuccess) fprintf(stderr, "cooperative launch failed: %s (grid %d)\n", hipGetErrorString(e), grid_blocks);
}
```

```cpp
#include <hip/hip_runtime.h>
#include <hip/hip_bf16.h>
#include <hip/hip_cooperative_groups.h>
#include <cstdio>
namespace cg = cooperative_groups;

typedef unsigned short bfu;
using bf16x8 = __attribute__((ext_vector_type(8))) short;
using f32x4 = __attribute__((ext_vector_type(4))) float;
#define DEVI __device__ __forceinline__

constexpr float ALPHA = 1.41421356237f;
constexpr int NCOL = 12288;

constexpr size_t O_WIN = 0;
constexpr size_t O_WOA = O_WIN + 25165824;
constexpr size_t O_WOB = O_WOA + 2097152;
constexpr size_t O_WOC = O_WOB + 2097152;
constexpr size_t O_WO = O_WOC + 2097152;
constexpr size_t O_WQ = O_WO + 2097152;
constexpr size_t O_KEYS = O_WQ + 4194304;
constexpr size_t O_LRU = O_KEYS + 524288;
constexpr size_t O_UTB = O_LRU + 524288;
constexpr size_t O_VTB = O_UTB + 33554432;
constexpr size_t O_LBS = O_VTB + 33554432;
constexpr size_t O_XB = O_LBS + 8192;
constexpr size_t O_Z = O_XB + 34078720;
constexpr size_t O_UA = O_Z + 207618048;
constexpr size_t O_UB = O_UA + 17301504;
constexpr size_t O_UC = O_UB + 17301504;
constexpr size_t O_CB = O_UC + 17301504;
constexpr size_t O_AU = O_CB + 17301504;
constexpr size_t O_LSUM = O_AU + 69206016;
constexpr size_t O_US = O_LSUM + 540672;
constexpr size_t O_DEC = O_US + 33554432;
constexpr size_t O_BAR = O_DEC + 524288;
constexpr size_t O_END = O_BAR + 16384;
constexpr size_t O_PRE = O_Z;
constexpr size_t O_QP = O_Z + 34603008;
constexpr size_t O_SC = O_QP + 34603008;

constexpr long OUT_YS = 16777216;
constexpr long OUT_CAP = 17039360;
constexpr long OUT_CBP = 17055744;
constexpr long OUT_LRP = 17080320;
constexpr long OUT_HGP = 17088512;
constexpr long OUT_CAS = 18137088;
constexpr long OUT_CBS = 18169856;
constexpr long OUT_LRS = 18219008;
constexpr long OUT_HGS = 18235392;

struct Params {
  const float* in[30];
  float* out;
  char* ws;
};

DEVI bfu f2b(float f) {
  unsigned u = __float_as_uint(f);
  u += 0x7FFFu + ((u >> 16) & 1u);
  return (bfu)(u >> 16);
}
DEVI float b2f(bfu b) { return __uint_as_float(((unsigned)b) << 16); }
DEVI float sigmoidf_(float x) { return 1.f / (1.f + __expf(-x)); }
DEVI float siluf_(float x) { return x / (1.f + __expf(-x)); }
DEVI float geluf_(float x) { return 0.5f * x * (1.f + erff(x * 0.70710678118f)); }
DEVI float wave_sum(float v) {
#pragma unroll
  for (int o = 32; o; o >>= 1) v += __shfl_xor(v, o);
  return v;
}

DEVI char* wsp(const Params& P, size_t off) { asm volatile("" : "+s"(off)); return P.ws + off; }
DEVI int ltid() { int t = threadIdx.x; asm volatile("" : "+v"(t)); return t; }
struct TokInfo { int sample, seq, t; };
DEVI TokInfo tokinfo(int it) {
  TokInfo r;
  if (it < 8192) { r.sample = 0; r.seq = it >> 12; r.t = it & 4095; }
  else if (it < 8448) { int q = it - 8192; r.sample = 1; r.seq = q >> 5; r.t = q & 31; }
  else { int q = it - 8448; r.sample = 0; r.seq = 2 + (q >> 12); r.t = q & 4095; }
  return r;
}
DEVI float* xrow(const Params& P, int it) {
  TokInfo ti = tokinfo(it);
  return ti.sample ? P.out + OUT_YS + (long)(ti.seq * 32 + ti.t) * 1024
                   : P.out + (long)(ti.seq * 4096 + ti.t) * 1024;
}

DEVI void stage_tile(const bfu* __restrict__ g, int ld, int k0, char* lds, int tid) {
#pragma unroll
  for (int i = 0; i < 4; ++i) {
    int b = tid * 16 + i * 4096;
    int r = b >> 7, cp = (b >> 4) & 7, gc = cp ^ (r & 7);
    __builtin_amdgcn_global_load_lds((const unsigned*)(g + (long)r * ld + k0 + gc * 8),
                                     (unsigned*)(lds + b), 16, 0, 0);
  }
}
DEVI bf16x8 ldfrag(const char* tile, int r, int kc) {
  return *reinterpret_cast<const bf16x8*>(tile + r * 128 + ((kc ^ (r & 7)) << 4));
}
DEVI void stage_tile_gate(const bfu* __restrict__ Wa, const bfu* __restrict__ Wx, int k0, char* lds, int tid) {
#pragma unroll
  for (int i = 0; i < 4; ++i) {
    int b = tid * 16 + i * 4096;
    int r = b >> 7, cp = (b >> 4) & 7, gc = cp ^ (r & 7);
    const bfu* base = (r & 32) ? Wx : Wa;
    int c = (r >> 6) * 32 + (r & 31);
    __builtin_amdgcn_global_load_lds((const unsigned*)(base + (long)c * 128 + k0 + gc * 8),
                                     (unsigned*)(lds + b), 16, 0, 0);
  }
}
template <int GATE>
DEVI void gemm_core_t(f32x4 (&acc)[4][4], const bfu* __restrict__ A, int lda,
                    const bfu* __restrict__ B, int ldb, int K, char* smem, int tid, const bfu* __restrict__ B2 = nullptr) {
  const int wid = tid >> 6, lane = tid & 63;
  const int wr = wid >> 1, wc = wid & 1, fr = lane & 15, fq = lane >> 4;
  const int nt = K >> 6;
  __syncthreads();
  stage_tile(A, lda, 0, smem, tid);
  if (GATE) stage_tile_gate(B, B2, 0, smem + 16384, tid); else stage_tile(B, ldb, 0, smem + 16384, tid);
  for (int t = 0; t < nt; ++t) {
    asm volatile("s_waitcnt vmcnt(0)" ::: "memory");
    __syncthreads();
    char* cur = smem + (t & 1) * 32768;
    if (t + 1 < nt) {
      char* nx = smem + ((t + 1) & 1) * 32768;
      stage_tile(A, lda, (t + 1) * 64, nx, tid);
      if (GATE) stage_tile_gate(B, B2, (t + 1) * 64, nx + 16384, tid); else stage_tile(B, ldb, (t + 1) * 64, nx + 16384, tid);
    }
#pragma unroll
    for (int kk = 0; kk < 2; ++kk) {
      bf16x8 af[4], bfr[4];
#pragma unroll
      for (int m = 0; m < 4; ++m) af[m] = ldfrag(cur, wr * 64 + m * 16 + fr, kk * 4 + fq);
#pragma unroll
      for (int n = 0; n < 4; ++n) bfr[n] = ldfrag(cur + 16384, wc * 64 + n * 16 + fr, kk * 4 + fq);
#pragma unroll
      for (int m = 0; m < 4; ++m)
#pragma unroll
        for (int n = 0; n < 4; ++n)
          acc[m][n] = __builtin_amdgcn_mfma_f32_16x16x32_bf16(af[m], bfr[n], acc[m][n], 0, 0, 0);
    }
  }
}
DEVI void gemm_core(f32x4 (&acc)[4][4], const bfu* __restrict__ A, int lda,
                    const bfu* __restrict__ B, int ldb, int K, char* smem, int tid) {
  gemm_core_t<0>(acc, A, lda, B, ldb, K, smem, tid);
}
DEVI void tile_rc(int id, int nM, int nN, int& pm, int& pn) {
  const int x = id & 7, q = id >> 3;
  const int gfull = nM >> 3;
  const int g = q / nN;
  if (g < gfull) {
    int r = q - g * nN;
    pn = (r >> 3) * 8 + x;
    pm = g * 8 + (r & 7);
  } else {
    int gsz = nM - gfull * 8;
    int r = q - gfull * nN;
    pn = (r / gsz) * 8 + x;
    pm = gfull * 8 + (r % gsz);
  }
}
DEVI void tile_rc_m(int id, int nM, int nN, int& pm, int& pn) {
  const int gfull = nM >> 3;
  const int nfull = gfull * 8 * nN;
  if (id < nfull) {
    const int x = id & 7, q = id >> 3;
    const int g = q / nN;
    pn = q - g * nN;
    pm = g * 8 + x;
  } else {
    const int r = id - nfull;
    pm = gfull * 8 + r / nN;
    pn = r % nN;
  }
}
#define ZERO_ACC(a) _Pragma("unroll") for (int m_ = 0; m_ < 4; ++m_) _Pragma("unroll") for (int n_ = 0; n_ < 4; ++n_) a[m_][n_] = f32x4{0.f, 0.f, 0.f, 0.f}
#define EPI_LOOP \
  const int wid_ = tid >> 6, lane_ = tid & 63; \
  const int wr_ = wid_ >> 1, wc_ = wid_ & 1, fr_ = lane_ & 15, fq_ = lane_ >> 4; \
  _Pragma("unroll") for (int m = 0; m < 4; ++m) for (int sb_ = (__builtin_amdgcn_sched_barrier(0), 0); sb_ < 1; ++sb_) _Pragma("unroll") for (int n = 0; n < 4; ++n) _Pragma("unroll") for (int j = 0; j < 4; ++j)
#define EPI_ROW (wr_ * 64 + m * 16 + fq_ * 4 + j)
#define EPI_COL (wc_ * 64 + n * 16 + fr_)

DEVI void epi_stage_f32(const f32x4 (&acc)[4][4], char* smem, int tid) {
  const int wid = tid >> 6, lane = tid & 63, wr = wid >> 1, wc = wid & 1, fr = lane & 15, fq = lane >> 4;
  float* T = reinterpret_cast<float*>(smem);
  __syncthreads();
#pragma unroll
  for (int m = 0; m < 4; ++m)
#pragma unroll
    for (int n = 0; n < 4; ++n)
#pragma unroll
      for (int j = 0; j < 4; ++j)
        T[(wr * 64 + m * 16 + fq * 4 + j) * 128 + wc * 64 + n * 16 + fr] = acc[m][n][j];
  __syncthreads();
}
DEVI void epi_store_bf16(const f32x4 (&acc)[4][4], const float* colbias, bfu* dst, long ld, char* smem, int tid) {
  const int wid = tid >> 6, lane = tid & 63, wr = wid >> 1, wc = wid & 1, fr = lane & 15, fq = lane >> 4;
  bfu* T = reinterpret_cast<bfu*>(smem);
  __syncthreads();
#pragma unroll
  for (int n = 0; n < 4; ++n) {
    const int col = wc * 64 + n * 16 + fr;
    const float bias = colbias ? colbias[col] : 0.f;
#pragma unroll
    for (int m = 0; m < 4; ++m)
#pragma unroll
      for (int j = 0; j < 4; ++j)
        T[(wr * 64 + m * 16 + fq * 4 + j) * 136 + col] = f2b(acc[m][n][j] + bias);
  }
  __syncthreads();
#pragma unroll
  for (int q = 0; q < 8; ++q) {
    const int id = tid + 256 * q, row = id >> 4, c16 = id & 15;
    uint4 v = *reinterpret_cast<const uint4*>(T + row * 136 + c16 * 8);
    *reinterpret_cast<uint4*>(dst + (long)row * ld + c16 * 8) = v;
  }
}

DEVI void transpose_tile(const float* __restrict__ src, bfu* __restrict__ dst, int R, int C, int r0, int c0, float* tile, int tid) {
  __syncthreads();
  {
    int tx = tid & 15, ty = tid >> 4;
#pragma unroll
    for (int i = 0; i < 4; ++i) {
      int r = ty + i * 16;
      float4 v = *reinterpret_cast<const float4*>(src + (long)(r0 + r) * C + c0 + tx * 4);
      float* tp = tile + r * 65 + tx * 4;
      tp[0] = v.x; tp[1] = v.y; tp[2] = v.z; tp[3] = v.w;
    }
  }
  __syncthreads();
  {
    int c = tid >> 2, rs = (tid & 3) * 16;
    unsigned pk[8];
#pragma unroll
    for (int i = 0; i < 8; ++i) {
      unsigned lo = f2b(tile[(rs + 2 * i) * 65 + c]);
      unsigned hi = f2b(tile[(rs + 2 * i + 1) * 65 + c]);
      pk[i] = lo | (hi << 16);
    }
    uint4* dp = reinterpret_cast<uint4*>(dst + (long)(c0 + c) * R + r0 + rs);
    dp[0] = make_uint4(pk[0], pk[1], pk[2], pk[3]);
    dp[1] = make_uint4(pk[4], pk[5], pk[6], pk[7]);
  }
}
DEVI void convert_chunk(const float* __restrict__ src, bfu* __restrict__ dst, int tid) {
  int o = tid * 8;
  float4 a = *reinterpret_cast<const float4*>(src + o);
  float4 b = *reinterpret_cast<const float4*>(src + o + 4);
  uint4 r;
  r.x = f2b(a.x) | ((unsigned)f2b(a.y) << 16);
  r.y = f2b(a.z) | ((unsigned)f2b(a.w) << 16);
  r.z = f2b(b.x) | ((unsigned)f2b(b.y) << 16);
  r.w = f2b(b.z) | ((unsigned)f2b(b.w) << 16);
  *reinterpret_cast<uint4*>(dst + o) = r;
}

typedef float f32x2 __attribute__((ext_vector_type(2)));
constexpr float U_SCALE = 64.f, V_SCALE = 8.f;
DEVI void convert_chunk_fp8(const float* __restrict__ src, unsigned char* __restrict__ dst, float scale, int tid) {
  int o = tid * 16;
  uint4 r;
  unsigned rr[4];
#pragma unroll
  for (int q = 0; q < 4; ++q) {
    float4 a = *reinterpret_cast<const float4*>(src + o + q * 4);
    int p = __builtin_amdgcn_cvt_pk_fp8_f32(a.x * scale, a.y * scale, 0, false);
    p = __builtin_amdgcn_cvt_pk_fp8_f32(a.z * scale, a.w * scale, p, true);
    rr[q] = (unsigned)p;
  }
  r = make_uint4(rr[0], rr[1], rr[2], rr[3]);
  *reinterpret_cast<uint4*>(dst + o) = r;
}

DEVI void phase_prep(const Params& P, int l, char* smem) {
  const int tid = ltid();
  char* ws = P.ws;
  float* tile = reinterpret_cast<float*>(smem);
  const int NT_WIN = 3072, NT_SQ = 256, NT_WQ = 512, NT_LRU = 64;
  const int T0 = NT_WIN, T1 = T0 + 4 * NT_SQ, T2 = T1 + NT_WQ, T3 = T2 + NT_LRU;
  const int C0 = T3 + 128, C1 = C0 + 4096, C2 = C1 + 4096;
  const int X0 = C2;
  const int L0 = X0 + (l == 0 ? 8 : 0);
  for (int id = blockIdx.x; id < L0; id += gridDim.x) {
    if (id < T0) {
      int tr = id / 192, tc = id % 192;
      transpose_tile(P.in[6] + (long)l * 1024 * 12288, (bfu*)(ws + O_WIN), 1024, 12288, tr * 64, tc * 64, tile, tid);
    } else if (id < T1) {
      int q = id - T0, w = q >> 8, t = q & 255;
      const float* src = P.in[18 + w] + (long)l * 1048576;
      bfu* dst = (bfu*)(ws + (w == 0 ? O_WOA : w == 1 ? O_WOB : w == 2 ? O_WOC : O_WO));
      transpose_tile(src, dst, 1024, 1024, (t >> 4) * 64, (t & 15) * 64, tile, tid);
    } else if (id < T2) {
      int q = id - T1;
      transpose_tile(P.in[24] + (long)l * 2097152, (bfu*)(ws + O_WQ), 1024, 2048, (q >> 5) * 64, (q & 31) * 64, tile, tid);
    } else if (id < T3) {
      int q = id - T2, mtx = q >> 2, t = q & 3, g = mtx >> 3, nb = mtx & 7;
      const float* src = P.in[g == 0 ? 11 : 13] + (long)l * 131072 + nb * 16384;
      transpose_tile(src, (bfu*)(ws + O_LRU) + mtx * 16384, 128, 128, (t >> 1) * 64, (t & 1) * 64, tile, tid);
    } else if (id < C0) {
      int q = id - T3;
      convert_chunk(P.in[25] + (long)l * 262144 + (long)q * 2048, (bfu*)(ws + O_KEYS) + (long)q * 2048, tid);
    } else if (id < C1) {
      int q = id - C0;
      convert_chunk_fp8(P.in[26] + (long)l * 16777216 + (long)q * 4096, (unsigned char*)(ws + O_UTB) + (long)q * 4096, U_SCALE, tid);
    } else if (id < C2) {
      int q = id - C1;
      convert_chunk_fp8(P.in[27] + (long)l * 16777216 + (long)q * 4096, (unsigned char*)(ws + O_VTB) + (long)q * 4096, V_SCALE, tid);
    } else {
      int q = id - X0;
      int c = (q & 3) * 256 + tid, ll = q >> 2;
      float a0 = P.in[16][c], a1 = P.in[16][1024 + c];
      float mx = fmaxf(a0, a1);
      float e0 = __expf(a0 - mx), e1 = __expf(a1 - mx);
      float p1 = e1 / (e0 + e1);
      float* lbs = (float*)(ws + O_LBS);
      lbs[ll * 1024 + c] = (ll == 0) ? 0.f : p1;
    }
  }
}

DEVI void phase_xcopy(const Params& P) {
  const int tid = ltid();
  bfu* xb = (bfu*)(P.ws + O_XB);
  for (int it = blockIdx.x; it < 16640; it += gridDim.x) {
    TokInfo ti = tokinfo(it);
    const float* src = ti.sample ? P.in[1] + (long)(ti.seq * 32 + ti.t) * 1024 : P.in[0] + (long)(ti.seq * 4096 + ti.t) * 1024;
    float* dst = xrow(P, it);
    int c = tid * 4;
    float4 v = *reinterpret_cast<const float4*>(src + c);
    *reinterpret_cast<float4*>(dst + c) = v;
    uint2 r;
    r.x = f2b(v.x) | ((unsigned)f2b(v.y) << 16);
    r.y = f2b(v.z) | ((unsigned)f2b(v.w) << 16);
    *reinterpret_cast<uint2*>(xb + (long)it * 1024 + c) = r;
  }
}

DEVI void phase_inproj(const Params& P, int l, int pass, char* smem) {
  const int tid = ltid();
  const int ntok = pass ? 8192 : 8448, base = pass ? 8448 : 0;
  const int nM = ntok / 128, nN = 96;
  const bfu* xb = (const bfu*)wsp(P, O_XB) + (long)base * 1024;
  const bfu* wT = (const bfu*)wsp(P, O_WIN);
  bfu* z = (bfu*)wsp(P, O_Z);
  const float* bin = P.in[7] + l * NCOL;
  for (int id = blockIdx.x; id < nM * nN; id += gridDim.x) {
    int pm, pn; tile_rc(id, nM, nN, pm, pn);
    f32x4 acc[4][4]; ZERO_ACC(acc);
    gemm_core(acc, xb + (long)pm * 128 * 1024, 1024, wT + (long)pn * 128 * 1024, 1024, 1024, smem, tid);
    epi_store_bf16(acc, bin + pn * 128, z + (long)pm * 128 * NCOL + pn * 128, NCOL, smem, tid);
  }
}

DEVI void load4bf(const bfu* p, float (&o)[4]) {
  uint2 v = *reinterpret_cast<const uint2*>(p);
  o[0] = __uint_as_float(v.x << 16); o[1] = __uint_as_float(v.x & 0xFFFF0000u);
  o[2] = __uint_as_float(v.y << 16); o[3] = __uint_as_float(v.y & 0xFFFF0000u);
}
DEVI void store4bf(bfu* p, const float (&v)[4]) {
  uint2 r;
  r.x = f2b(v[0]) | ((unsigned)f2b(v[1]) << 16);
  r.y = f2b(v[2]) | ((unsigned)f2b(v[3]) << 16);
  *reinterpret_cast<uint2*>(p) = r;
}
DEVI void ld4f(const float* p, float (&o)[4]) {
  float4 v = *reinterpret_cast<const float4*>(p);
  o[0] = v.x; o[1] = v.y; o[2] = v.z; o[3] = v.w;
}
DEVI void mixab_row4(const Params& P, int l, int base, int lt0, int tid) {
  const int it0 = base + lt0;
  const TokInfo ti = tokinfo(it0);
  const int T = ti.sample ? 32 : 4096;
  const int t0 = ti.t;
  const bfu* z = (const bfu*)(P.ws + O_Z);
  const int c = tid * 4;
  {
    float pk[6][4], ab[4][4], wa[3][4];
#pragma unroll
    for (int k = 0; k < 6; ++k) {
      const int tt = t0 - 2 + k;
      if (tt >= 0) {
        const bfu* zr = z + (long)(lt0 - 2 + k) * NCOL;
        float ac[4], ax[4];
        load4bf(zr + 1024 + c, ac); load4bf(zr + 2048 + c, ax);
#pragma unroll
        for (int i = 0; i < 4; ++i) pk[k][i] = ac[i] * ax[i];
      } else if (ti.sample) {
        ld4f(P.in[2] + ((long)(l * 8 + ti.seq) * 2 + (tt + 2)) * 1024 + c, pk[k]);
      } else {
#pragma unroll
        for (int i = 0; i < 4; ++i) pk[k][i] = 0.f;
      }
    }
#pragma unroll
    for (int r = 0; r < 4; ++r) load4bf(z + (long)(lt0 + r) * NCOL + c, ab[r]);
#pragma unroll
    for (int k = 0; k < 3; ++k) ld4f(P.in[8] + (long)(l * 3 + k) * 1024 + c, wa[k]);
#pragma unroll
    for (int r = 0; r < 4; ++r) {
      float o[4];
#pragma unroll
      for (int i = 0; i < 4; ++i) o[i] = ab[r][i] * (wa[0][i] * pk[r][i] + wa[1][i] * pk[r + 1][i] + wa[2][i] * pk[r + 2][i]);
      store4bf((bfu*)(P.ws + O_UA) + (long)(lt0 + r) * 1024 + c, o);
    }
    if (t0 + 4 == T) {
      float* ca = ti.sample ? P.out + OUT_CAS + (long)(l * 8 + ti.seq) * 2 * 1024 + c : P.out + OUT_CAP + (long)(l * 4 + ti.seq) * 2 * 1024 + c;
#pragma unroll
      for (int r = 0; r < 2; ++r)
        *reinterpret_cast<float4*>(ca + r * 1024) = make_float4(pk[r + 4][0], pk[r + 4][1], pk[r + 4][2], pk[r + 4][3]);
    }
  }
  __builtin_amdgcn_sched_barrier(0);
  {
    float xk[7][4], wb[4][4], bb[4];
#pragma unroll
    for (int k = 0; k < 7; ++k) {
      const int tt = t0 - 3 + k;
      if (tt >= 0) {
        load4bf(z + (long)(lt0 - 3 + k) * NCOL + 3072 + c, xk[k]);
      } else if (ti.sample) {
        ld4f(P.in[3] + ((long)(l * 8 + ti.seq) * 3 + (tt + 3)) * 1024 + c, xk[k]);
      } else {
#pragma unroll
        for (int i = 0; i < 4; ++i) xk[k][i] = 0.f;
      }
    }
#pragma unroll
    for (int k = 0; k < 4; ++k) ld4f(P.in[9] + (long)(l * 4 + k) * 1024 + c, wb[k]);
    ld4f(P.in[10] + (long)l * 1024 + c, bb);
#pragma unroll
    for (int r = 0; r < 4; ++r) {
      float o2[4];
#pragma unroll
      for (int i = 0; i < 4; ++i)
        o2[i] = wb[0][i] * xk[r][i] + wb[1][i] * xk[r + 1][i] + wb[2][i] * xk[r + 2][i] + wb[3][i] * xk[r + 3][i] + bb[i];
      store4bf((bfu*)(P.ws + O_CB) + (long)(lt0 + r) * 1024 + c, o2);
    }
    if (t0 + 4 == T) {
      float* cbp = ti.sample ? P.out + OUT_CBS + (long)(l * 8 + ti.seq) * 3 * 1024 + c : P.out + OUT_CBP + (long)(l * 4 + ti.seq) * 3 * 1024 + c;
#pragma unroll
      for (int r = 0; r < 3; ++r)
        *reinterpret_cast<float4*>(cbp + r * 1024) = make_float4(xk[r + 4][0], xk[r + 4][1], xk[r + 4][2], xk[r + 4][3]);
    }
  }
}

struct ChunkInfo { int lt0, L, sample, seqi, c; };
DEVI ChunkInfo chunkinfo(int ck) {
  ChunkInfo r;
  if (ck < 128) { r.seqi = ck >> 6; r.c = ck & 63; r.lt0 = r.seqi * 4096 + r.c * 64; r.L = 64; r.sample = 0; }
  else { r.seqi = ck - 128; r.c = 0; r.lt0 = 8192 + r.seqi * 32; r.L = 32; r.sample = 1; }
  return r;
}

DEVI void h1_item(const Params& P, int l, int ck, int h, char* smem, int tid) {
  const ChunkInfo ci = chunkinfo(ck);
  const int lane = tid & 63, w = tid >> 6, fr = lane & 15, fq = lane >> 4;
  bfu* VT = (bfu*)smem;
  bfu* KT = VT + 128 * 72;
  bfu* FS = KT + 128 * 72;
  float* tots = (float*)(smem + 54272);
  float* decl = tots + 256;
  const int d = tid & 127, hf = tid >> 7, L = ci.L, Lh = L >> 1;
  const float lb = ((const float*)(P.ws + O_LBS))[l * 1024 + h * 128 + d];
  const bfu* Z = (const bfu*)(P.ws + O_Z);
  const bfu* zfb = Z + (long)ci.lt0 * NCOL + 6 * 1024 + h * 128;
  const bfu* zib = Z + (long)ci.lt0 * NCOL + 7 * 1024 + h * 128;
  __syncthreads();
#pragma unroll 1
  for (int q0 = 0; q0 < 4; q0 += 2) {
    uint4 vf[2], vi[2];
#pragma unroll
    for (int qq = 0; qq < 2; ++qq) {
      const int idx = tid + 256 * (q0 + qq);
      const int sr = (idx & 15) | (((idx >> 8) & 3) << 4), c16 = ((idx >> 4) & 3) | (((idx >> 6) & 3) << 2);
      if (sr < L) {
        vf[qq] = *reinterpret_cast<const uint4*>(zfb + (long)sr * NCOL + c16 * 8);
        vi[qq] = *reinterpret_cast<const uint4*>(zib + (long)sr * NCOL + c16 * 8);
      } else { vf[qq] = make_uint4(0, 0, 0, 0); vi[qq] = make_uint4(0, 0, 0, 0); }
    }
#pragma unroll
    for (int qq = 0; qq < 2; ++qq) {
      const int idx = tid + 256 * (q0 + qq);
      const int sr = (idx & 15) | (((idx >> 8) & 3) << 4), c16 = ((idx >> 4) & 3) | (((idx >> 6) & 3) << 2);
      *reinterpret_cast<uint4*>(FS + sr * 136 + c16 * 8) = vf[qq];
      const unsigned vv[4] = {vi[qq].x, vi[qq].y, vi[qq].z, vi[qq].w};
#pragma unroll
      for (int i = 0; i < 4; ++i) {
        VT[(c16 * 8 + 2 * i) * 72 + sr] = (bfu)(vv[i] & 0xFFFFu);
        VT[(c16 * 8 + 2 * i + 1) * 72 + sr] = (bfu)(vv[i] >> 16);
      }
    }
  }
  __syncthreads();
  float tot = 0.f;
#pragma unroll 8
  for (int i = 0; i < Lh; ++i) {
    float f = lb + (1.f - lb) * sigmoidf_(b2f(FS[(hf * Lh + i) * 136 + d]));
    tot += __logf(f);
  }
  tots[hf * 128 + d] = tot;
  __syncthreads();
  float run = hf ? 0.f : tots[128 + d];
#pragma unroll 8
  for (int i = Lh - 1; i >= 0; --i) {
    const int sr = hf * Lh + i;
    float f = lb + (1.f - lb) * sigmoidf_(b2f(FS[sr * 136 + d]));
    KT[d * 72 + sr] = f2b((1.f - f) * __expf(run));
    run += __logf(f);
  }
  if (L == 32) {
    for (int sr = 32 + hf * 16; sr < 48 + hf * 16; ++sr) KT[d * 72 + sr] = 0;
  }
  if (hf == 0) {
    float dc = __expf(tots[d] + tots[128 + d]);
    decl[d] = dc;
    if (!ci.sample) ((float*)(P.ws + O_DEC))[((ci.seqi * 8 + h) * 64 + ci.c) * 128 + d] = dc;
  }
  __syncthreads();
  f32x4 acc[2][8];
#pragma unroll
  for (int mi = 0; mi < 2; ++mi)
#pragma unroll
    for (int n = 0; n < 8; ++n) acc[mi][n] = f32x4{0.f, 0.f, 0.f, 0.f};
#pragma unroll
  for (int kk = 0; kk < 2; ++kk) {
    bf16x8 a[2];
#pragma unroll
    for (int mi = 0; mi < 2; ++mi) a[mi] = *reinterpret_cast<const bf16x8*>(VT + ((2 * w + mi) * 16 + fr) * 72 + kk * 32 + fq * 8);
#pragma unroll
    for (int n = 0; n < 8; ++n) {
      bf16x8 b = *reinterpret_cast<const bf16x8*>(KT + (n * 16 + fr) * 72 + kk * 32 + fq * 8);
#pragma unroll
      for (int mi = 0; mi < 2; ++mi) acc[mi][n] = __builtin_amdgcn_mfma_f32_16x16x32_bf16(a[mi], b, acc[mi][n], 0, 0, 0);
    }
  }
  if (!ci.sample) {
    bfu* US = (bfu*)(P.ws + O_US) + ((long)((ci.seqi * 8 + h) * 64 + ci.c) << 14);
#pragma unroll
    for (int mi = 0; mi < 2; ++mi) {
      __builtin_amdgcn_sched_barrier(0);
      bfu* bp = US + ((2 * w + mi) * 16 + fq * 4) * 128 + fr;
#pragma unroll
      for (int n = 0; n < 8; ++n)
#pragma unroll
        for (int j = 0; j < 4; ++j) bp[j * 128 + n * 16] = f2b(acc[mi][n][j]);
    }
  } else {
    long sb = ((long)((l * 8 + ci.seqi) * 8 + h)) << 14;
    const float* S0 = P.in[5] + sb;
    float* So = P.out + OUT_HGS + sb;
#pragma unroll
    for (int mi = 0; mi < 2; ++mi)
#pragma unroll
      for (int n = 0; n < 8; ++n) {
        __builtin_amdgcn_sched_barrier(0);
        int e0 = (2 * w + mi) * 16 + fq * 4, dd = n * 16 + fr;
        float4 s0 = *reinterpret_cast<const float4*>(S0 + dd * 128 + e0);
        float dcl = decl[dd];
        float4 r;
        r.x = dcl * s0.x + acc[mi][n][0]; r.y = dcl * s0.y + acc[mi][n][1];
        r.z = dcl * s0.z + acc[mi][n][2]; r.w = dcl * s0.w + acc[mi][n][3];
        *reinterpret_cast<float4*>(So + dd * 128 + e0) = r;
      }
  }
}

DEVI void phase2(const Params& P, int l, int pass, char* smem) {
  const int tid = ltid();
  const int ntok = pass ? 8192 : 8448, base = pass ? 8448 : 0;
  const int nck = pass ? 128 : 136;
  const int nH = nck * 8;
  const int total = nH + ntok / 4;
  for (int id = blockIdx.x; id < total; id += gridDim.x) {
    if (id < nH) h1_item(P, l, id >> 3, id & 7, smem, tid);
    else mixab_row4(P, l, base, (id - nH) * 4, tid);
  }
}

DEVI void gate_tile(const Params& P, int l, int pm, int q, char* smem, int tid) {
  const int nb = q >> 1, hb = q & 1;
  const bfu* cb = (const bfu*)(P.ws + O_CB);
  const bfu* A = cb + (long)pm * 128 * 1024 + nb * 128;
  const bfu* Wa = (const bfu*)(P.ws + O_LRU) + nb * 16384 + hb * 64 * 128;
  const bfu* Wx = Wa + 8 * 16384;
  float* au0 = (float*)(P.ws + O_AU);
  float* au1 = au0 + (long)8448 * 1024;
  const float* ba = P.in[12] + l * 1024;
  const float* bx = P.in[14] + l * 1024;
  const float* lam = P.in[15] + l * 1024;
  f32x4 acc[4][4]; ZERO_ACC(acc);
  gemm_core_t<1>(acc, A, 1024, Wa, 128, 128, smem, tid, Wx);
  epi_stage_f32(acc, smem, tid);
  const float* T = reinterpret_cast<const float*>(smem);
#pragma unroll 4
  for (int q = 0; q < 8; ++q) {
    const int id = tid + 256 * q, row = id >> 4, g4 = id & 15;
    const int cl = g4 * 4, wcc = cl >> 5, c32 = cl & 31;
    const long grow = (long)pm * 128 + row;
    const int col = nb * 128 + hb * 64 + cl;
    float4 rp = *reinterpret_cast<const float4*>(T + row * 128 + wcc * 64 + c32);
    float4 gp = *reinterpret_cast<const float4*>(T + row * 128 + wcc * 64 + 32 + c32);
    float xv[4], bav[4], bxv[4], lmv[4];
    load4bf(cb + grow * 1024 + col, xv);
    ld4f(ba + col, bav); ld4f(bx + col, bxv); ld4f(lam + col, lmv);
    const float rpa[4] = {rp.x, rp.y, rp.z, rp.w}, gpa[4] = {gp.x, gp.y, gp.z, gp.w};
    float av[4], uv[4];
#pragma unroll
    for (int i = 0; i < 4; ++i) {
      float r = sigmoidf_(rpa[i] + bav[i]);
      float gi = sigmoidf_(gpa[i] + bxv[i]);
      float a = __expf(-8.f * log1pf(__expf(-lmv[i])) * r);
      av[i] = a;
      uv[i] = sqrtf(fmaxf(1.f - a * a, 0.f)) * gi * xv[i];
    }
    *reinterpret_cast<float4*>(au0 + grow * 1024 + col) = make_float4(av[0], av[1], av[2], av[3]);
    *reinterpret_cast<float4*>(au1 + grow * 1024 + col) = make_float4(uv[0], uv[1], uv[2], uv[3]);
  }
}
DEVI void h2_item(const Params& P, int l, int pass, int item, int tid) {
  const int sh = item >> 6, blk = item & 63;
  const int idx = blk * 256 + tid, e = idx >> 7, d = idx & 127;
  bfu* US = (bfu*)(P.ws + O_US) + ((long)sh * 64 << 14) + idx;
  const float* dec = (const float*)(P.ws + O_DEC) + (long)sh * 64 * 128 + d;
  float S = 0.f;
  for (int c0 = 0; c0 < 64; c0 += 8) {
    float u[8], dc[8];
#pragma unroll
    for (int i = 0; i < 8; ++i) { u[i] = b2f(US[(long)(c0 + i) << 14]); dc[i] = dec[(c0 + i) * 128]; }
#pragma unroll
    for (int i = 0; i < 8; ++i) { US[(long)(c0 + i) << 14] = f2b(S); S = dc[i] * S + u[i]; }
  }
  const int sl = sh >> 3, h = sh & 7, b = pass * 2 + sl;
  P.out[OUT_HGP + (((long)((l * 4 + b) * 8 + h)) << 14) + d * 128 + e] = S;
}
DEVI void phase3(const Params& P, int l, int pass, char* smem) {
  const int tid = ltid();
  const int ntok = pass ? 8192 : 8448;
  const int nG = (ntok / 128) * 16, nH2 = 1024;
  for (int id = blockIdx.x; id < nG + nH2; id += gridDim.x) {
    if (id < nG) gate_tile(P, l, id >> 4, id & 15, smem, tid);
    else h2_item(P, l, pass, id - nG, tid);
  }
}

DEVI void lsum_item(const Params& P, int tile, int cg4, int tid) {
  const int w = tid >> 6, lane = tid & 63;
  const int ch = (cg4 * 4 + w) * 64 + lane;
  const float* a0 = (const float*)(P.ws + O_AU) + (long)tile * 128 * 1024 + ch;
  const float* u0 = a0 + (long)8448 * 1024;
  float A = 1.f, H = 0.f;
  for (int r0 = 0; r0 < 128; r0 += 16) {
    float av[16], uv[16];
#pragma unroll
    for (int i = 0; i < 16; ++i) { av[i] = a0[(long)(r0 + i) * 1024]; uv[i] = u0[(long)(r0 + i) * 1024]; }
#pragma unroll
    for (int i = 0; i < 16; ++i) { H = av[i] * H + uv[i]; A *= av[i]; }
  }
  float* ls = (float*)(P.ws + O_LSUM) + (long)tile * 2048;
  ls[ch] = A; ls[1024 + ch] = H;
}

DEVI void h3_item(const Params& P, int l, int ck, int h, char* smem, int tid) {
  const ChunkInfo ci = chunkinfo(ck);
  const int lane = tid & 63, w = tid >> 6, fr = lane & 15, fq = lane >> 4;
  bfu* QT = (bfu*)smem;
  bfu* KT = QT + 64 * 136;
  bfu* AT = KT + 64 * 136;
  bfu* BS = AT + 64 * 72;
  float* bmid = (float*)(BS + 128 * 72);
  const int d = tid & 127, hf = tid >> 7, L = ci.L, Lh = L >> 1;
  const float lb = ((const float*)(P.ws + O_LBS))[l * 1024 + h * 128 + d];
  const bfu* Z = (const bfu*)(P.ws + O_Z);
  const bfu* zqb = Z + (long)ci.lt0 * NCOL + 5 * 1024 + h * 128;
  __syncthreads();
  {
    uint4 vq[4], vf[4], vi[4];
#pragma unroll
    for (int q = 0; q < 4; ++q) {
      const int idx = tid + 256 * q;
      const int sr = (idx & 15) | (((idx >> 8) & 3) << 4), c16 = ((idx >> 4) & 3) | (((idx >> 6) & 3) << 2);
      if (sr < L) {
        const bfu* rp = zqb + (long)sr * NCOL + c16 * 8;
        vq[q] = *reinterpret_cast<const uint4*>(rp);
        vf[q] = *reinterpret_cast<const uint4*>(rp + 1024);
        vi[q] = *reinterpret_cast<const uint4*>(rp + 2048);
      } else { vq[q] = make_uint4(0, 0, 0, 0); vf[q] = vq[q]; vi[q] = vq[q]; }
    }
#pragma unroll
    for (int q = 0; q < 4; ++q) {
      const int idx = tid + 256 * q;
      const int sr = (idx & 15) | (((idx >> 8) & 3) << 4), c16 = ((idx >> 4) & 3) | (((idx >> 6) & 3) << 2);
      *reinterpret_cast<uint4*>(QT + sr * 136 + c16 * 8) = vq[q];
      *reinterpret_cast<uint4*>(KT + sr * 136 + c16 * 8) = vf[q];
      const unsigned vv[4] = {vi[q].x, vi[q].y, vi[q].z, vi[q].w};
#pragma unroll
      for (int i = 0; i < 4; ++i) {
        BS[(c16 * 8 + 2 * i) * 72 + sr] = (bfu)(vv[i] & 0xFFFFu);
        BS[(c16 * 8 + 2 * i + 1) * 72 + sr] = (bfu)(vv[i] >> 16);
      }
    }
  }
  __syncthreads();
  if (hf == 0) {
    float rel = 0.f;
#pragma unroll 8
    for (int t = Lh - 1; t >= 0; --t) {
      float f = lb + (1.f - lb) * sigmoidf_(b2f(KT[t * 136 + d]));
      float q = siluf_(b2f(QT[t * 136 + d]));
      QT[t * 136 + d] = f2b(q * __expf(fminf(rel, 80.f)));
      KT[t * 136 + d] = f2b((1.f - f) * __expf(-rel));
      rel -= __logf(f);
    }
    bmid[d] = -rel;
  } else {
    float rel = 0.f;
#pragma unroll 8
    for (int t = Lh; t < L; ++t) {
      float f = lb + (1.f - lb) * sigmoidf_(b2f(KT[t * 136 + d]));
      float q = siluf_(b2f(QT[t * 136 + d]));
      rel += __logf(f);
      QT[t * 136 + d] = f2b(q * __expf(rel));
      KT[t * 136 + d] = f2b((1.f - f) * __expf(fminf(-rel, 80.f)));
    }
  }
  if (L == 32) {
    for (int t = 32 + hf * 16; t < 48 + hf * 16; ++t) { QT[t * 136 + d] = 0; KT[t * 136 + d] = 0; }
  }
  uint4 vg[4];
#pragma unroll
  for (int q = 0; q < 4; ++q) {
    const int idx = tid + 256 * q;
    const int sr = (idx & 15) | (((idx >> 8) & 3) << 4), c16 = ((idx >> 4) & 3) | (((idx >> 6) & 3) << 2);
    vg[q] = (sr < L) ? *reinterpret_cast<const uint4*>(zqb + (long)sr * NCOL + 3072 + c16 * 8) : make_uint4(0, 0, 0, 0);
  }
  __syncthreads();
  bf16x8 aq[4];
#pragma unroll
  for (int kk = 0; kk < 4; ++kk) aq[kk] = *reinterpret_cast<const bf16x8*>(QT + (16 * w + fr) * 136 + kk * 32 + fq * 8);
  {
    f32x4 sa[4];
#pragma unroll
    for (int n = 0; n < 4; ++n) sa[n] = f32x4{0.f, 0.f, 0.f, 0.f};
#pragma unroll
    for (int kk = 0; kk < 4; ++kk)
#pragma unroll
      for (int n = 0; n < 4; ++n) {
        bf16x8 bk = *reinterpret_cast<const bf16x8*>(KT + (n * 16 + fr) * 136 + kk * 32 + fq * 8);
        sa[n] = __builtin_amdgcn_mfma_f32_16x16x32_bf16(aq[kk], bk, sa[n], 0, 0, 0);
      }
#pragma unroll
    for (int n = 0; n < 4; ++n)
#pragma unroll
      for (int j = 0; j < 4; ++j) {
        int t = 16 * w + fq * 4 + j, s = n * 16 + fr;
        AT[t * 72 + s] = (s <= t) ? f2b(sa[n][j]) : (bfu)0;
      }
  }
  __syncthreads();
#pragma unroll
  for (int q = 0; q < 4; ++q) {
    const int idx = tid + 256 * q;
    const int sr = (idx & 15) | (((idx >> 8) & 3) << 4), c16 = ((idx >> 4) & 3) | (((idx >> 6) & 3) << 2);
    *reinterpret_cast<uint4*>(QT + sr * 136 + c16 * 8) = vg[q];
  }
  f32x4 o[8];
#pragma unroll
  for (int n = 0; n < 8; ++n) o[n] = f32x4{0.f, 0.f, 0.f, 0.f};
#pragma unroll
  for (int kk = 0; kk < 2; ++kk) {
    bf16x8 a = *reinterpret_cast<const bf16x8*>(AT + (16 * w + fr) * 72 + kk * 32 + fq * 8);
#pragma unroll
    for (int n = 0; n < 8; ++n) {
      bf16x8 b = *reinterpret_cast<const bf16x8*>(BS + (n * 16 + fr) * 72 + kk * 32 + fq * 8);
      o[n] = __builtin_amdgcn_mfma_f32_16x16x32_bf16(a, b, o[n], 0, 0, 0);
    }
  }
#pragma unroll
  for (int sl = 0; sl < 2; ++sl) {
    __syncthreads();
    if (!ci.sample) {
      const bfu* src = (const bfu*)(P.ws + O_US) + ((long)((ci.seqi * 8 + h) * 64 + ci.c) << 14);
      int e2 = tid >> 1, dd0 = (tid & 1) * 32;
#pragma unroll
      for (int q4 = 0; q4 < 4; ++q4) {
        uint4 v = *reinterpret_cast<const uint4*>(src + e2 * 128 + sl * 64 + dd0 + q4 * 8);
        const float* bm = bmid + sl * 64 + dd0 + q4 * 8;
        unsigned vv[4] = {v.x, v.y, v.z, v.w};
        unsigned rr[4];
#pragma unroll
        for (int i = 0; i < 4; ++i) {
          float lo = __uint_as_float(vv[i] << 16) * __expf(bm[2 * i]);
          float hi = __uint_as_float(vv[i] & 0xFFFF0000u) * __expf(bm[2 * i + 1]);
          rr[i] = f2b(lo) | ((unsigned)f2b(hi) << 16);
        }
        *reinterpret_cast<uint4*>(BS + e2 * 72 + dd0 + q4 * 8) = make_uint4(rr[0], rr[1], rr[2], rr[3]);
      }
    } else {
      const float* S0 = P.in[5] + (((long)((l * 8 + ci.seqi) * 8 + h)) << 14);
#pragma unroll 4
      for (int dd = hf * 32; dd < hf * 32 + 32; ++dd)
        BS[d * 72 + dd] = f2b(S0[(sl * 64 + dd) * 128 + d] * __expf(bmid[sl * 64 + dd]));
    }
    __syncthreads();
#pragma unroll
    for (int kk = 0; kk < 2; ++kk) {
#pragma unroll
      for (int n = 0; n < 8; ++n) {
        bf16x8 b = *reinterpret_cast<const bf16x8*>(BS + (n * 16 + fr) * 72 + kk * 32 + fq * 8);
        o[n] = __builtin_amdgcn_mfma_f32_16x16x32_bf16(aq[sl * 2 + kk], b, o[n], 0, 0, 0);
      }
    }
  }
  float rinv[4];
#pragma unroll
  for (int j = 0; j < 4; ++j) {
    float ss = 0.f;
#pragma unroll
    for (int n = 0; n < 8; ++n) ss += o[n][j] * o[n][j];
    ss += __shfl_xor(ss, 1); ss += __shfl_xor(ss, 2); ss += __shfl_xor(ss, 4); ss += __shfl_xor(ss, 8);
    rinv[j] = rsqrtf(ss * (1.f / 128.f) + 1e-6f);
  }
  const float* ng = P.in[17] + l * 128;
  bfu* UC = (bfu*)(P.ws + O_UC);
#pragma unroll
  for (int n = 0; n < 8; ++n)
#pragma unroll
    for (int j = 0; j < 4; ++j) {
      int t = 16 * w + fq * 4 + j, e = n * 16 + fr;
      if (t < L) {
        float g = b2f(QT[t * 136 + e]);
        UC[(long)(ci.lt0 + t) * 1024 + h * 128 + e] = f2b(o[n][j] * rinv[j] * ng[e] * siluf_(g));
      }
    }
}
DEVI void phase4(const Params& P, int l, int pass, char* smem) {
  const int tid = ltid();
  const int nck = pass ? 128 : 136;
  const int nH = nck * 8;
  const int nL = 64 * 4;
  for (int id = blockIdx.x; id < nH + nL; id += gridDim.x) {
    if (id < nH) h3_item(P, l, id >> 3, id & 7, smem, tid);
    else { int q = id - nH; lsum_item(P, q >> 2, q & 3, tid); }
  }
}

DEVI void phase5(const Params& P, int l, int pass) {
  const int tid = ltid();
  const int ntok = pass ? 8192 : 8448, base = pass ? 8448 : 0;
  const int nItems = (ntok / 128) * 4;
  const int w = tid >> 6, lane = tid & 63;
  const float* AU0 = (const float*)(P.ws + O_AU);
  const float* AU1 = AU0 + (long)8448 * 1024;
  const float* LS = (const float*)(P.ws + O_LSUM);
  const bfu* Z = (const bfu*)(P.ws + O_Z);
  bfu* UB = (bfu*)(P.ws + O_UB);
  for (int id = blockIdx.x; id < nItems; id += gridDim.x) {
    const int tile = id >> 2, ch = ((id & 3) * 4 + w) * 64 + lane;
    const int lt0 = tile * 128;
    const TokInfo t0 = tokinfo(base + lt0);
    float hcur = 0.f;
    if (!t0.sample) {
      int jf = tile - (t0.t >> 7);
#pragma unroll 4
      for (int i = jf; i < tile; ++i) hcur = LS[(long)i * 2048 + ch] * hcur + LS[(long)i * 2048 + 1024 + ch];
    }
    for (int r0 = 0; r0 < 128; r0 += 8) {
      float av[8], uv[8], gv[8];
#pragma unroll
      for (int i = 0; i < 8; ++i) {
        long row = lt0 + r0 + i;
        av[i] = AU0[row * 1024 + ch]; uv[i] = AU1[row * 1024 + ch];
        gv[i] = b2f(Z[row * NCOL + 4 * 1024 + ch]);
      }
#pragma unroll
      for (int i = 0; i < 8; ++i) {
        int r = r0 + i;
        if (t0.sample && (r & 31) == 0) hcur = P.in[4][(long)(l * 8 + t0.seq + (r >> 5)) * 1024 + ch];
        hcur = av[i] * hcur + uv[i];
        UB[(long)(lt0 + r) * 1024 + ch] = f2b(geluf_(gv[i]) * hcur);
        if (t0.sample && (r & 31) == 31) P.out[OUT_LRS + (long)(l * 8 + t0.seq + (r >> 5)) * 1024 + ch] = hcur;
      }
    }
    if (!t0.sample && t0.t + 128 == 4096) P.out[OUT_LRP + (long)(l * 4 + t0.seq) * 1024 + ch] = hcur;
  }
}

template <int BR>
DEVI void p6_branch(const Params& P, int pm, int pn, float* macc, char* smem, int tid) {
  asm volatile("" : "+s"(pm), "+s"(pn));
  const bfu* Z = (const bfu*)(P.ws + O_Z);
  bfu* M = (bfu*)(P.ws + O_CB);
  const bfu* A = (const bfu*)(P.ws + (BR == 0 ? O_UA : BR == 1 ? O_UB : O_UC)) + (long)pm * 128 * 1024;
  const bfu* B = (const bfu*)(P.ws + (BR == 0 ? O_WOA : BR == 1 ? O_WOB : O_WOC)) + (long)pn * 128 * 1024;
  f32x4 acc[4][4]; ZERO_ACC(acc);
  gemm_core(acc, A, 1024, B, 1024, 1024, smem, tid);
  epi_stage_f32(acc, smem, tid);
  const float* T = reinterpret_cast<const float*>(smem);
#pragma unroll 8
  for (int q = 0; q < 16; ++q) {
    const int id = tid + 256 * q, row = id >> 5, c4 = id & 31;
    const long grow = (long)pm * 128 + row;
    const int gcol = pn * 128 + c4 * 4;
    float4 a = *reinterpret_cast<const float4*>(T + row * 128 + c4 * 4);
    float g[4];
    load4bf(Z + grow * NCOL + (9 + BR) * 1024 + gcol, g);
    float v[4] = {sigmoidf_(g[0]) * a.x, sigmoidf_(g[1]) * a.y, sigmoidf_(g[2]) * a.z, sigmoidf_(g[3]) * a.w};
    if (BR > 0) {
      float4 mo = *reinterpret_cast<const float4*>(macc + grow * 1024 + gcol);
      v[0] += mo.x; v[1] += mo.y; v[2] += mo.z; v[3] += mo.w;
    }
    if (BR < 2) *reinterpret_cast<float4*>(macc + grow * 1024 + gcol) = make_float4(v[0], v[1], v[2], v[3]);
    else store4bf(M + grow * 1024 + gcol, v);
  }
}
DEVI void phase6(const Params& P, int l, int pass, char* smem) {
  const int tid = ltid();
  const int ntok = pass ? 8192 : 8448;
  const int nM = ntok / 128, nN = 8;
  const bfu* Z = (const bfu*)(P.ws + O_Z);
  bfu* M = (bfu*)(P.ws + O_CB);
  for (int id = blockIdx.x; id < nM * nN; id += gridDim.x) {
    int pm, pn; tile_rc_m(id, nM, nN, pm, pn);
    float* macc = (float*)(P.ws + O_AU);
    p6_branch<0>(P, pm, pn, macc, smem, tid);
    p6_branch<1>(P, pm, pn, macc, smem, tid);
    p6_branch<2>(P, pm, pn, macc, smem, tid);
  }
}

DEVI void phase7(const Params& P, int l, int pass, char* smem) {
  const int tid = ltid();
  const int ntok = pass ? 8192 : 8448, base = pass ? 8448 : 0;
  const int nM = ntok / 128, nN = 8;
  const bfu* M = (const bfu*)wsp(P, O_CB);
  const bfu* W = (const bfu*)wsp(P, O_WO);
  float* pre = (float*)wsp(P, O_PRE);
  for (int id = blockIdx.x; id < nM * nN; id += gridDim.x) {
    int pm, pn; tile_rc_m(id, nM, nN, pm, pn);
    f32x4 acc[4][4]; ZERO_ACC(acc);
    gemm_core(acc, M + (long)pm * 128 * 1024, 1024, W + (long)pn * 128 * 1024, 1024, 1024, smem, tid);
    epi_stage_f32(acc, smem, tid);
    {
      const float* T = reinterpret_cast<const float*>(smem);
#pragma unroll 8
      for (int q = 0; q < 16; ++q) {
        const int id = tid + 256 * q, row = id >> 5, c4 = id & 31;
        const int grow = pm * 128 + row, gcol = pn * 128 + c4 * 4;
        float4 a = *reinterpret_cast<const float4*>(T + row * 128 + c4 * 4);
        float4 xx = *reinterpret_cast<const float4*>(xrow(P, base + grow) + gcol);
        *reinterpret_cast<float4*>(pre + (long)grow * 1024 + gcol) =
            make_float4(ALPHA * xx.x + a.x, ALPHA * xx.y + a.y, ALPHA * xx.z + a.z, ALPHA * xx.w + a.w);
      }
    }
  }
}

DEVI void phase8(const Params& P, int l, int pass) {
  const int tid = ltid();
  const int ntok = pass ? 8192 : 8448, base = pass ? 8448 : 0;
  const int w = tid >> 6, lane = tid & 63;
  const float* pre = (const float*)wsp(P, O_PRE);
  const float* g = P.in[22] + l * 1024;
  const float* b = P.in[23] + l * 1024;
  bfu* xb = (bfu*)wsp(P, O_XB);
  for (int id = blockIdx.x; id < ntok / 4; id += gridDim.x) {
    int lt = id * 4 + w, it = base + lt;
    const float* src = pre + (long)lt * 1024;
    float v[16];
#pragma unroll
    for (int q = 0; q < 4; ++q) {
      float4 t = *reinterpret_cast<const float4*>(src + q * 256 + lane * 4);
      v[q * 4] = t.x; v[q * 4 + 1] = t.y; v[q * 4 + 2] = t.z; v[q * 4 + 3] = t.w;
    }
    float s = 0.f;
#pragma unroll
    for (int i = 0; i < 16; ++i) s += v[i];
    float mu = wave_sum(s) * (1.f / 1024.f);
    float ss = 0.f;
#pragma unroll
    for (int i = 0; i < 16; ++i) { float dlt = v[i] - mu; ss += dlt * dlt; }
    float rs = rsqrtf(wave_sum(ss) * (1.f / 1024.f) + 1e-5f);
    float* xr = xrow(P, it);
#pragma unroll
    for (int q = 0; q < 4; ++q) {
      int c = q * 256 + lane * 4;
      float o[4];
#pragma unroll
      for (int i = 0; i < 4; ++i) o[i] = (v[q * 4 + i] - mu) * rs * g[c + i] + b[c + i];
      *reinterpret_cast<float4*>(xr + c) = make_float4(o[0], o[1], o[2], o[3]);
      store4bf(xb + (long)it * 1024 + c, o);
    }
  }
}

DEVI void phase9(const Params& P, int l, int pass, char* smem) {
  const int tid = ltid();
  const int ntok = pass ? 8192 : 8448, base = pass ? 8448 : 0;
  const int nM = ntok / 128, nN = 16;
  const bfu* xb = (const bfu*)wsp(P, O_XB) + (long)base * 1024;
  const bfu* W = (const bfu*)wsp(P, O_WQ);
  bfu* qp = (bfu*)wsp(P, O_QP);
  for (int id = blockIdx.x; id < nM * nN; id += gridDim.x) {
    int pm, pn; tile_rc_m(id, nM, nN, pm, pn);
    f32x4 acc[4][4]; ZERO_ACC(acc);
    gemm_core(acc, xb + (long)pm * 128 * 1024, 1024, W + (long)pn * 128 * 1024, 1024, 1024, smem, tid);
    epi_store_bf16(acc, nullptr, qp + (long)pm * 128 * 2048 + pn * 128, 2048, smem, tid);
  }
}
DEVI void phase10(const Params& P, int l, int pass, char* smem) {
  const int tid = ltid();
  const int ntok = pass ? 8192 : 8448;
  const int nM = ntok / 128, nN = 16;
  const bfu* qp = (const bfu*)wsp(P, O_QP);
  const bfu* KB = (const bfu*)wsp(P, O_KEYS);
  float* sc = (float*)wsp(P, O_SC);
  for (int id = blockIdx.x; id < nM * nN; id += gridDim.x) {
    int pm = id >> 4, pn = id & 15;
    f32x4 acc[4][4]; ZERO_ACC(acc);
    gemm_core(acc, qp + (long)pm * 128 * 2048 + pn * 128, 2048, KB + (long)pn * 16384, 128, 128, smem, tid);
    epi_stage_f32(acc, smem, tid);
    {
      const float* T = reinterpret_cast<const float*>(smem);
#pragma unroll 8
      for (int q = 0; q < 16; ++q) {
        const int id = tid + 256 * q, row = id >> 5, c4 = id & 31;
        *reinterpret_cast<float4*>(sc + (long)(pm * 128 + row) * 2048 + pn * 128 + c4 * 4) =
            *reinterpret_cast<const float4*>(T + row * 128 + c4 * 4);
      }
    }
  }
}

constexpr int KLOW = 12;
__constant__ unsigned char CAND_IJ[50] = {
  0x00,0x01,0x02,0x03,0x04,0x05,0x06,0x07,0x08,0x09,0x0A,0x0B,0x0C,0x0D,0x0E,0x0F,
  0x10,0x11,0x12,0x13,0x14,0x15,0x16,0x17,
  0x20,0x21,0x22,0x23,0x24,
  0x30,0x31,0x32,0x33,
  0x40,0x41,0x42,
  0x50,0x51, 0x60,0x61, 0x70,0x71,
  0x80,0x90,0xA0,0xB0,0xC0,0xD0,0xE0,0xF0};
DEVI unsigned fkey(float f) {
  unsigned u = __float_as_uint(f);
  return (u & 0x80000000u) ? ~u : (u | 0x80000000u);
}
DEVI void dec16(uint4 v, f32x2 (&o)[8]) {
  o[0] = __builtin_amdgcn_cvt_pk_f32_fp8((int)v.x, false); o[1] = __builtin_amdgcn_cvt_pk_f32_fp8((int)v.x, true);
  o[2] = __builtin_amdgcn_cvt_pk_f32_fp8((int)v.y, false); o[3] = __builtin_amdgcn_cvt_pk_f32_fp8((int)v.y, true);
  o[4] = __builtin_amdgcn_cvt_pk_f32_fp8((int)v.z, false); o[5] = __builtin_amdgcn_cvt_pk_f32_fp8((int)v.z, true);
  o[6] = __builtin_amdgcn_cvt_pk_f32_fp8((int)v.w, false); o[7] = __builtin_amdgcn_cvt_pk_f32_fp8((int)v.w, true);
}
DEVI void phase11(const Params& P, int l, int pass, char* smem) {
  const int ntok = pass ? 8192 : 8448, base = pass ? 8448 : 0;
  const int tid = ltid(); const int w = tid >> 6, lane = tid & 63;
  float* scl = (float*)smem;
  float* sv = scl + 2048;
  int* si = (int*)(sv + 256);
  float* tops = (float*)(si + 256);
  int* tope = (int*)(tops + 128);
  float* wgt = (float*)(tope + 128);
  float* svs = wgt + 128;
  int* sis = (int*)(svs + 256);
  float* red = (float*)(sis + 256);
  float* stat = red + 4096;
  const float* SC = (const float*)(P.ws + O_SC);
  const unsigned char* UT = (const unsigned char*)(P.ws + O_UTB);
  const unsigned char* VTb = (const unsigned char*)(P.ws + O_VTB);
  const float* g2 = P.in[28] + l * 1024;
  const float* b2 = P.in[29] + l * 1024;
  bfu* xb = (bfu*)(P.ws + O_XB);
  const unsigned long long ltmask = (1ull << lane) - 1ull;
  for (int lt = blockIdx.x; lt < ntok; lt += gridDim.x) {
    const int it = base + lt;
    float* xr = xrow(P, it);
    __syncthreads();
    {
      const float4* s4 = reinterpret_cast<const float4*>(SC + (long)lt * 2048);
      reinterpret_cast<float4*>(scl)[tid] = s4[tid];
      reinterpret_cast<float4*>(scl)[tid + 256] = s4[tid + 256];
    }
    __syncthreads();
    {
      float v0[4], v1[4]; unsigned k0[4], k1[4], T[4];
#pragma unroll
      for (int li = 0; li < 4; ++li) {
        const int Lx = w * 4 + li;
        v0[li] = scl[Lx * 128 + lane]; v1[li] = scl[Lx * 128 + 64 + lane];
        k0[li] = fkey(v0[li]); k1[li] = fkey(v1[li]); T[li] = 0;
      }
      for (int b = 31; b >= KLOW; --b) {
#pragma unroll
        for (int li = 0; li < 4; ++li) {
          unsigned cand = T[li] | (1u << b);
          int cnt = __popcll(__ballot(k0[li] >= cand)) + __popcll(__ballot(k1[li] >= cand));
          if (cnt >= 16) T[li] = cand;
        }
      }
#pragma unroll
      for (int li = 0; li < 4; ++li) {
        const int Lx = w * 4 + li;
        const unsigned T2 = T[li] + (1u << KLOW);
        bool g0 = k0[li] >= T2, g1 = k1[li] >= T2;
        bool q0 = (k0[li] >= T[li]) && !g0, q1 = (k1[li] >= T[li]) && !g1;
        unsigned long long mg0 = __ballot(g0), mg1 = __ballot(g1), mq0 = __ballot(q0), mq1 = __ballot(q1);
        int ng0 = __popcll(mg0), ng = ng0 + __popcll(mg1);
        int p0 = g0 ? __popcll(mg0 & ltmask) : ng + __popcll(mq0 & ltmask);
        int p1 = g1 ? ng0 + __popcll(mg1 & ltmask) : ng + __popcll(mq0) + __popcll(mq1 & ltmask);
        if ((g0 || q0) && p0 < 16) { sv[Lx * 16 + p0] = v0[li]; si[Lx * 16 + p0] = lane; }
        if ((g1 || q1) && p1 < 16) { sv[Lx * 16 + p1] = v1[li]; si[Lx * 16 + p1] = lane + 64; }
      }
    }
    __builtin_amdgcn_wave_barrier();
    {
      const int Lx = w * 4 + (lane >> 4), e = lane & 15;
      const float v = sv[Lx * 16 + e];
      const int id = si[Lx * 16 + e];
      int rank = 0;
#pragma unroll
      for (int q = 0; q < 4; ++q) {
        float4 o = *reinterpret_cast<const float4*>(sv + Lx * 16 + q * 4);
        rank += (o.x > v || (o.x == v && q * 4 + 0 < e)) ? 1 : 0;
        rank += (o.y > v || (o.y == v && q * 4 + 1 < e)) ? 1 : 0;
        rank += (o.z > v || (o.z == v && q * 4 + 2 < e)) ? 1 : 0;
        rank += (o.w > v || (o.w == v && q * 4 + 3 < e)) ? 1 : 0;
      }
      __builtin_amdgcn_wave_barrier();
      svs[Lx * 16 + rank] = v; sis[Lx * 16 + rank] = id;
    }
    __builtin_amdgcn_wave_barrier();
    {
      float cv[2]; unsigned ck[2], T[2]; int ce[2];
      const int cij = (lane < 50) ? (int)CAND_IJ[lane] : 0;
      const int ci = cij >> 4, cj = cij & 15;
#pragma unroll
      for (int hi = 0; hi < 2; ++hi) {
        const int h = w * 2 + hi;
        T[hi] = 0;
        cv[hi] = svs[(2 * h) * 16 + ci] + svs[(2 * h + 1) * 16 + cj];
        ce[hi] = sis[(2 * h) * 16 + ci] * 128 + sis[(2 * h + 1) * 16 + cj];
        ck[hi] = (lane < 50) ? fkey(cv[hi]) : 0u;
      }
      for (int b = 31; b >= KLOW; --b) {
#pragma unroll
        for (int hi = 0; hi < 2; ++hi) {
          unsigned cand = T[hi] | (1u << b);
          int cnt = __popcll(__ballot(ck[hi] >= cand));
          if (cnt >= 16) T[hi] = cand;
        }
      }
#pragma unroll
      for (int hi = 0; hi < 2; ++hi) {
        const int h = w * 2 + hi;
        const unsigned T2 = T[hi] + (1u << KLOW);
        bool g = ck[hi] >= T2, q = (ck[hi] >= T[hi]) && !g && (lane < 50);
        unsigned long long mg = __ballot(g), mq = __ballot(q);
        int p = g ? __popcll(mg & ltmask) : __popcll(mg) + __popcll(mq & ltmask);
        if ((g || q) && p < 16) { tops[h * 16 + p] = cv[hi]; tope[h * 16 + p] = ce[hi]; }
      }
    }
    __syncthreads();
    if (tid < 128) {
      float s = tops[tid];
      float mx = s;
      mx = fmaxf(mx, __shfl_xor(mx, 1)); mx = fmaxf(mx, __shfl_xor(mx, 2));
      mx = fmaxf(mx, __shfl_xor(mx, 4)); mx = fmaxf(mx, __shfl_xor(mx, 8));
      float e = __expf(s - mx);
      float sm = e;
      sm += __shfl_xor(sm, 1); sm += __shfl_xor(sm, 2); sm += __shfl_xor(sm, 4); sm += __shfl_xor(sm, 8);
      tops[tid] = e / sm;
    }
    __syncthreads();
    f32x2 xv[8];
    {
      const float4* xp = reinterpret_cast<const float4*>(xr + lane * 16);
#pragma unroll
      for (int q = 0; q < 4; ++q) {
        float4 a = xp[q];
        xv[2 * q] = f32x2{a.x, a.y}; xv[2 * q + 1] = f32x2{a.z, a.w};
      }
    }
    f32x2 oacc[8];
#pragma unroll
    for (int q = 0; q < 8; ++q) oacc[q] = f32x2{0.f, 0.f};
#pragma unroll 1
    for (int p0 = 0; p0 < 32; p0 += 8) {
      uint4 ru[8], rv[8];
#pragma unroll
      for (int i = 0; i < 8; ++i) {
        int e = tope[w * 32 + p0 + i];
        ru[i] = *reinterpret_cast<const uint4*>(UT + (long)e * 1024 + lane * 16);
        rv[i] = *reinterpret_cast<const uint4*>(VTb + (long)e * 1024 + lane * 16);
      }
      float dsum[8];
#pragma unroll
      for (int i = 0; i < 8; ++i) {
        f32x2 f[8];
        dec16(ru[i], f);
        f32x2 acc = f[0] * xv[0];
#pragma unroll
        for (int q = 1; q < 8; ++q) acc = __builtin_elementwise_fma(f[q], xv[q], acc);
        dsum[i] = acc.x + acc.y;
      }
      float e4[4], e2[2], e1;
      {
        const bool hi = (lane & 32) != 0;
#pragma unroll
        for (int i = 0; i < 4; ++i) {
          float snd = hi ? dsum[i] : dsum[i + 4];
          float kp = hi ? dsum[i + 4] : dsum[i];
          e4[i] = kp + __shfl_xor(snd, 32);
        }
        const bool hi2 = (lane & 16) != 0;
#pragma unroll
        for (int i = 0; i < 2; ++i) {
          float snd = hi2 ? e4[i] : e4[i + 2];
          float kp = hi2 ? e4[i + 2] : e4[i];
          e2[i] = kp + __shfl_xor(snd, 16);
        }
        const bool hi3 = (lane & 8) != 0;
        {
          float snd = hi3 ? e2[0] : e2[1];
          float kp = hi3 ? e2[1] : e2[0];
          e1 = kp + __shfl_xor(snd, 8);
        }
        e1 += __shfl_xor(e1, 4); e1 += __shfl_xor(e1, 2); e1 += __shfl_xor(e1, 1);
      }
      {
        int r = ((lane >> 5) & 1) * 4 + ((lane >> 4) & 1) * 2 + ((lane >> 3) & 1);
        float wv_ = tops[w * 32 + p0 + r] * geluf_(e1 * (1.f / U_SCALE)) * (1.f / V_SCALE);
        if ((lane & 7) == 0) wgt[w * 32 + p0 + r] = wv_;
      }
      __builtin_amdgcn_wave_barrier();
      float wg[8];
      {
        float4 wa = *reinterpret_cast<const float4*>(wgt + w * 32 + p0);
        float4 wb = *reinterpret_cast<const float4*>(wgt + w * 32 + p0 + 4);
        wg[0] = wa.x; wg[1] = wa.y; wg[2] = wa.z; wg[3] = wa.w; wg[4] = wb.x; wg[5] = wb.y; wg[6] = wb.z; wg[7] = wb.w;
      }
#pragma unroll
      for (int i = 0; i < 8; ++i) {
        f32x2 f[8];
        dec16(rv[i], f);
        f32x2 wv = f32x2{wg[i], wg[i]};
#pragma unroll
        for (int q = 0; q < 8; ++q) oacc[q] = __builtin_elementwise_fma(f[q], wv, oacc[q]);
      }
    }
    {
      float4* rwp = reinterpret_cast<float4*>(red + w * 1024 + lane * 16);
#pragma unroll
      for (int q = 0; q < 4; ++q) rwp[q] = make_float4(oacc[2 * q].x, oacc[2 * q].y, oacc[2 * q + 1].x, oacc[2 * q + 1].y);
    }
    __syncthreads();
    const int c = tid * 4;
    float y[4];
    {
      float4 xx = *reinterpret_cast<const float4*>(xr + c);
      float4 r0 = *reinterpret_cast<const float4*>(red + c);
      float4 r1 = *reinterpret_cast<const float4*>(red + 1024 + c);
      float4 r2 = *reinterpret_cast<const float4*>(red + 2048 + c);
      float4 r3 = *reinterpret_cast<const float4*>(red + 3072 + c);
      y[0] = ALPHA * xx.x + (r0.x + r1.x + r2.x + r3.x);
      y[1] = ALPHA * xx.y + (r0.y + r1.y + r2.y + r3.y);
      y[2] = ALPHA * xx.z + (r0.z + r1.z + r2.z + r3.z);
      y[3] = ALPHA * xx.w + (r0.w + r1.w + r2.w + r3.w);
    }
    float s = wave_sum(y[0] + y[1] + y[2] + y[3]);
    if (lane == 0) stat[w] = s;
    __syncthreads();
    float mu = (stat[0] + stat[1] + stat[2] + stat[3]) * (1.f / 1024.f);
    float ss = 0.f;
#pragma unroll
    for (int i = 0; i < 4; ++i) { float dl = y[i] - mu; ss += dl * dl; }
    ss = wave_sum(ss);
    if (lane == 0) stat[4 + w] = ss;
    __syncthreads();
    float rs = rsqrtf((stat[4] + stat[5] + stat[6] + stat[7]) * (1.f / 1024.f) + 1e-5f);
    float o[4];
#pragma unroll
    for (int i = 0; i < 4; ++i) o[i] = (y[i] - mu) * rs * g2[c + i] + b2[c + i];
    *reinterpret_cast<float4*>(xr + c) = make_float4(o[0], o[1], o[2], o[3]);
    store4bf(xb + (long)it * 1024 + c, o);
  }
}

#define XB_TMO      128
#define XB_XCNT(j)  (256  + 64 * (j))
#define XB_XSUB(j)  (1280 + 64 * (j))
#define XB_XGEN(j)  (2304 + 64 * (j))
#define XB_TOP      3328
#define XB_TOPGEN   3392
#define XCD_BAR_WORDS 3456
#define XB_SPIN_CAP (1u << 18)
DEVI unsigned xb_ld(unsigned* p) { return __hip_atomic_load(p, __ATOMIC_RELAXED, __HIP_MEMORY_SCOPE_AGENT); }
DEVI unsigned xb_add(unsigned* p, unsigned v) { return __hip_atomic_fetch_add(p, v, __ATOMIC_RELAXED, __HIP_MEMORY_SCOPE_AGENT); }
DEVI unsigned xb_xcc_id() { return (unsigned)__builtin_amdgcn_s_getreg((3 << 11) | 20) & 0xFu; }
#define XB_SPIN(cond, bar) do { unsigned _sp = 0; while (cond) { __builtin_amdgcn_s_sleep(1); \
    if ((++_sp & 255u) == 0u) { if (xb_ld(&(bar)[XB_TMO])) break; if (_sp > XB_SPIN_CAP) { atomicAdd(&(bar)[XB_TMO], 1u); break; } } } } while (0)
DEVI void xcd_census(unsigned* bar, unsigned x, unsigned& nloc, unsigned& nx) {
  const unsigned G = gridDim.x;
  unsigned sum, cnt, mine, sp = 0u;
  for (;;) {
    sum = 0u; cnt = 0u; mine = 0u;
#pragma unroll
    for (unsigned j = 0; j < 16; ++j) { const unsigned c = xb_ld(&bar[XB_XCNT(j)]); sum += c; cnt += (c > 0u) ? 1u : 0u; mine = (j == x) ? c : mine; }
    if (sum == G) break;
    __builtin_amdgcn_s_sleep(1);
    if ((++sp & 255u) == 0u) { if (xb_ld(&bar[XB_TMO])) break; if (sp > XB_SPIN_CAP) { atomicAdd(&bar[XB_TMO], 1u); break; } }
  }
  nloc = mine > 0u ? mine : 1u; nx = cnt > 0u ? cnt : 1u;
}
DEVI void xcd_barrier(unsigned* bar, unsigned x, unsigned nloc, unsigned nx) {
  asm volatile("s_waitcnt vmcnt(0)" ::: "memory");
  __syncthreads();
  if (threadIdx.x == 0) {
    __builtin_amdgcn_s_waitcnt(0);
    const unsigned old = xb_add(&bar[XB_XSUB(x)], 1u);
    const unsigned gen = old / nloc;
    if (old + 1u == (gen + 1u) * nloc) {
      __builtin_amdgcn_fence(__ATOMIC_RELEASE, "agent");
      asm volatile("s_waitcnt vmcnt(0)" ::: "memory");
      const unsigned og = xb_add(&bar[XB_TOP], 1u);
      const unsigned tg = og / nx;
      if (og + 1u == (tg + 1u) * nx) xb_add(&bar[XB_TOPGEN], 1u);
      else XB_SPIN(xb_ld(&bar[XB_TOPGEN]) == tg, bar);
      __builtin_amdgcn_fence(__ATOMIC_ACQUIRE, "agent");
      xb_add(&bar[XB_XGEN(x)], 1u);
      asm volatile("s_waitcnt vmcnt(0)" ::: "memory");
    } else {
      XB_SPIN(xb_ld(&bar[XB_XGEN(x)]) == gen, bar);
      __builtin_amdgcn_fence(__ATOMIC_ACQUIRE, "agent");
      asm volatile("s_waitcnt vmcnt(0)" ::: "memory");
    }
  }
  __syncthreads();
}

__global__ void __launch_bounds__(256, 2) fwd_megakernel(Params P) {
  __shared__ __attribute__((aligned(16))) char smem[65536];
  cg::grid_group grid = cg::this_grid();
  unsigned* bar = (unsigned*)(P.ws + O_BAR);
  const unsigned xcc = xb_xcc_id();
  if (threadIdx.x == 0) (void)xb_add(&bar[XB_XCNT(xcc)], 1u);
  unsigned nloc = 1u, nx = 1u;
#define LND asm volatile("" : "+s"(l), "+s"(pass))
#define GSYNC xcd_barrier(bar, xcc, nloc, nx)
#pragma unroll 1
  for (int l = 0; l < 2; ++l) {
    phase_prep(P, l, smem);
    if (l == 0) {
      phase_xcopy(P);
      grid.sync();
      if (threadIdx.x == 0) xcd_census(bar, xcc, nloc, nx);
    } else {
      GSYNC;
    }
#pragma unroll 1
    for (int pass = 0; pass < 2; ++pass) {
      LND; phase_inproj(P, l, pass, smem); GSYNC;
      LND; phase2(P, l, pass, smem); GSYNC;
      LND; phase3(P, l, pass, smem); GSYNC;
      LND; phase4(P, l, pass, smem); GSYNC;
      LND; phase5(P, l, pass); GSYNC;
      LND; phase6(P, l, pass, smem); GSYNC;
      LND; phase7(P, l, pass, smem); GSYNC;
      LND; phase8(P, l, pass); GSYNC;
      LND; phase9(P, l, pass, smem); GSYNC;
      LND; phase10(P, l, pass, smem); GSYNC;
      LND; phase11(P, l, pass, smem); if (!(l == 1 && pass == 1)) GSYNC;
    }
  }
}

extern "C" void kernel_launch(void* const* d_in, const int* in_sizes, int n_in, void* d_out, int out_size,
                              void* d_ws, size_t ws_size, hipStream_t stream) {
  static int grid_blocks = 0;
  if (!grid_blocks) {
    int dev = 0, cus = 0, per_cu = 0;
    hipGetDevice(&dev);
    hipDeviceGetAttribute(&cus, hipDeviceAttributeMultiprocessorCount, dev);
    hipOccupancyMaxActiveBlocksPerMultiprocessor(&per_cu, fwd_megakernel, 256, 0);
    if (per_cu > 2) per_cu = 2;
    if (per_cu < 1) per_cu = 1;
    grid_blocks = cus * per_cu;
  }
  if (ws_size < O_END) fprintf(stderr, "workspace too small: %zu < %zu\n", ws_size, (size_t)O_END);
  hipMemsetAsync((char*)d_ws + O_BAR, 0, 16384, stream);
  Params p{};
  for (int i = 0; i < 30; ++i) p.in[i] = (const float*)d_in[i];
  p.out = (float*)d_out;
  p.ws = (char*)d_ws;
  void* args[] = {&p};
  hipError_t e = hipLaunchCooperativeKernel((void*)fwd_megakernel, dim3(grid_blocks), dim3(256), args, 0, stream);
  if (e != hipSuccess) fprintf(stderr, "cooperative launch failed: %s (grid %d)\n", hipGetErrorString(e), grid_blocks);
}
```

```cpp
#include <hip/hip_runtime.h>
#include <hip/hip_bf16.h>
#include <hip/hip_cooperative_groups.h>
#include <cstdio>
namespace cg = cooperative_groups;

typedef unsigned short bfu;
using bf16x8 = __attribute__((ext_vector_type(8))) short;
using f32x4 = __attribute__((ext_vector_type(4))) float;
#define DEVI __device__ __forceinline__

constexpr float ALPHA = 1.41421356237f;
constexpr int NCOL = 12288;

constexpr size_t O_WIN = 0;
constexpr size_t O_WOA = O_WIN + 25165824;
constexpr size_t O_WOB = O_WOA + 2097152;
constexpr size_t O_WOC = O_WOB + 2097152;
constexpr size_t O_WO = O_WOC + 2097152;
constexpr size_t O_WQ = O_WO + 2097152;
constexpr size_t O_KEYS = O_WQ + 4194304;
constexpr size_t O_LRU = O_KEYS + 524288;
constexpr size_t O_UTB = O_LRU + 524288;
constexpr size_t O_VTB = O_UTB + 33554432;
constexpr size_t O_LBS = O_VTB + 33554432;
constexpr size_t O_XB = O_LBS + 8192;
constexpr size_t O_Z = O_XB + 34078720;
constexpr size_t O_UA = O_Z + 207618048;
constexpr size_t O_UB = O_UA + 17301504;
constexpr size_t O_UC = O_UB + 17301504;
constexpr size_t O_CB = O_UC + 17301504;
constexpr size_t O_AU = O_CB + 17301504;
constexpr size_t O_LSUM = O_AU + 69206016;
constexpr size_t O_US = O_LSUM + 540672;
constexpr size_t O_DEC = O_US + 33554432;
constexpr size_t O_BAR = O_DEC + 524288;
constexpr size_t O_END = O_BAR + 16384;
constexpr size_t O_PRE = O_Z;
constexpr size_t O_QP = O_Z + 34603008;
constexpr size_t O_SC = O_QP + 34603008;

constexpr long OUT_YS = 16777216;
constexpr long OUT_CAP = 17039360;
constexpr long OUT_CBP = 17055744;
constexpr long OUT_LRP = 17080320;
constexpr long OUT_HGP = 17088512;
constexpr long OUT_CAS = 18137088;
constexpr long OUT_CBS = 18169856;
constexpr long OUT_LRS = 18219008;
constexpr long OUT_HGS = 18235392;

struct Params {
  const float* in[30];
  float* out;
  char* ws;
};

DEVI bfu f2b(float f) {
  unsigned u = __float_as_uint(f);
  u += 0x7FFFu + ((u >> 16) & 1u);
  return (bfu)(u >> 16);
}
DEVI float b2f(bfu b) { return __uint_as_float(((unsigned)b) << 16); }
DEVI float sigmoidf_(float x) { return 1.f / (1.f + __expf(-x)); }
DEVI float siluf_(float x) { return x / (1.f + __expf(-x)); }
DEVI float geluf_(float x) { return 0.5f * x * (1.f + erff(x * 0.70710678118f)); }
DEVI float wave_sum(float v) {
#pragma unroll
  for (int o = 32; o; o >>= 1) v += __shfl_xor(v, o);
  return v;
}

DEVI char* wsp(const Params& P, size_t off) { asm volatile("" : "+s"(off)); return P.ws + off; }
DEVI int ltid() { int t = threadIdx.x; asm volatile("" : "+v"(t)); return t; }
struct TokInfo { int sample, seq, t; };
DEVI TokInfo tokinfo(int it) {
  TokInfo r;
  if (it < 8192) { r.sample = 0; r.seq = it >> 12; r.t = it & 4095; }
  else if (it < 8448) { int q = it - 8192; r.sample = 1; r.seq = q >> 5; r.t = q & 31; }
  else { int q = it - 8448; r.sample = 0; r.seq = 2 + (q >> 12); r.t = q & 4095; }
  return r;
}
DEVI float* xrow(const Params& P, int it) {
  TokInfo ti = tokinfo(it);
  return ti.sample ? P.out + OUT_YS + (long)(ti.seq * 32 + ti.t) * 1024
                   : P.out + (long)(ti.seq * 4096 + ti.t) * 1024;
}

DEVI void stage_tile(const bfu* __restrict__ g, int ld, int k0, char* lds, int tid) {
#pragma unroll
  for (int i = 0; i < 4; ++i) {
    int b = tid * 16 + i * 4096;
    int r = b >> 7, cp = (b >> 4) & 7, gc = cp ^ (r & 7);
    __builtin_amdgcn_global_load_lds((const unsigned*)(g + (long)r * ld + k0 + gc * 8),
                                     (unsigned*)(lds + b), 16, 0, 0);
  }
}
DEVI bf16x8 ldfrag(const char* tile, int r, int kc) {
  return *reinterpret_cast<const bf16x8*>(tile + r * 128 + ((kc ^ (r & 7)) << 4));
}
DEVI void stage_tile_gate(const bfu* __restrict__ Wa, const bfu* __restrict__ Wx, int k0, char* lds, int tid) {
#pragma unroll
  for (int i = 0; i < 4; ++i) {
    int b = tid * 16 + i * 4096;
    int r = b >> 7, cp = (b >> 4) & 7, gc = cp ^ (r & 7);
    const bfu* base = (r & 32) ? Wx : Wa;
    int c = (r >> 6) * 32 + (r & 31);
    __builtin_amdgcn_global_load_lds((const unsigned*)(base + (long)c * 128 + k0 + gc * 8),
                                     (unsigned*)(lds + b), 16, 0, 0);
  }
}
template <int GATE>
DEVI void gemm_core_t(f32x4 (&acc)[4][4], const bfu* __restrict__ A, int lda,
                    const bfu* __restrict__ B, int ldb, int K, char* smem, int tid, const bfu* __restrict__ B2 = nullptr) {
  const int wid = tid >> 6, lane = tid & 63;
  const int wr = wid >> 1, wc = wid & 1, fr = lane & 15, fq = lane >> 4;
  const int nt = K >> 6;
  __syncthreads();
  stage_tile(A, lda, 0, smem, tid);
  if (GATE) stage_tile_gate(B, B2, 0, smem + 16384, tid); else stage_tile(B, ldb, 0, smem + 16384, tid);
  for (int t = 0; t < nt; ++t) {
    asm volatile("s_waitcnt vmcnt(0)" ::: "memory");
    __syncthreads();
    char* cur = smem + (t & 1) * 32768;
    if (t + 1 < nt) {
      char* nx = smem + ((t + 1) & 1) * 32768;
      stage_tile(A, lda, (t + 1) * 64, nx, tid);
      if (GATE) stage_tile_gate(B, B2, (t + 1) * 64, nx + 16384, tid); else stage_tile(B, ldb, (t + 1) * 64, nx + 16384, tid);
    }
#pragma unroll
    for (int kk = 0; kk < 2; ++kk) {
      bf16x8 af[4], bfr[4];
#pragma unroll
      for (int m = 0; m < 4; ++m) af[m] = ldfrag(cur, wr * 64 + m * 16 + fr, kk * 4 + fq);
#pragma unroll
      for (int n = 0; n < 4; ++n) bfr[n] = ldfrag(cur + 16384, wc * 64 + n * 16 + fr, kk * 4 + fq);
#pragma unroll
      for (int m = 0; m < 4; ++m)
#pragma unroll
        for (int n = 0; n < 4; ++n)
          acc[m][n] = __builtin_amdgcn_mfma_f32_16x16x32_bf16(af[m], bfr[n], acc[m][n], 0, 0, 0);
    }
  }
}
DEVI void gemm_core(f32x4 (&acc)[4][4], const bfu* __restrict__ A, int lda,
                    const bfu* __restrict__ B, int ldb, int K, char* smem, int tid) {
  gemm_core_t<0>(acc, A, lda, B, ldb, K, smem, tid);
}
DEVI void tile_rc(int id, int nM, int nN, int& pm, int& pn) {
  const int x = id & 7, q = id >> 3;
  const int gfull = nM >> 3;
  const int g = q / nN;
  if (g < gfull) {
    int r = q - g * nN;
    pn = (r >> 3) * 8 + x;
    pm = g * 8 + (r & 7);
  } else {
    int gsz = nM - gfull * 8;
    int r = q - gfull * nN;
    pn = (r / gsz) * 8 + x;
    pm = gfull * 8 + (r % gsz);
  }
}
DEVI void tile_rc_m(int id, int nM, int nN, int& pm, int& pn) {
  const int gfull = nM >> 3;
  const int nfull = gfull * 8 * nN;
  if (id < nfull) {
    const int x = id & 7, q = id >> 3;
    const int g = q / nN;
    pn = q - g * nN;
    pm = g * 8 + x;
  } else {
    const int r = id - nfull;
    pm = gfull * 8 + r / nN;
    pn = r % nN;
  }
}
#define ZERO_ACC(a) _Pragma("unroll") for (int m_ = 0; m_ < 4; ++m_) _Pragma("unroll") for (int n_ = 0; n_ < 4; ++n_) a[m_][n_] = f32x4{0.f, 0.f, 0.f, 0.f}
#define EPI_LOOP \
  const int wid_ = tid >> 6, lane_ = tid & 63; \
  const int wr_ = wid_ >> 1, wc_ = wid_ & 1, fr_ = lane_ & 15, fq_ = lane_ >> 4; \
  _Pragma("unroll") for (int m = 0; m < 4; ++m) for (int sb_ = (__builtin_amdgcn_sched_barrier(0), 0); sb_ < 1; ++sb_) _Pragma("unroll") for (int n = 0; n < 4; ++n) _Pragma("unroll") for (int j = 0; j < 4; ++j)
#define EPI_ROW (wr_ * 64 + m * 16 + fq_ * 4 + j)
#define EPI_COL (wc_ * 64 + n * 16 + fr_)

DEVI void epi_stage_f32(const f32x4 (&acc)[4][4], char* smem, int tid) {
  const int wid = tid >> 6, lane = tid & 63, wr = wid >> 1, wc = wid & 1, fr = lane & 15, fq = lane >> 4;
  float* T = reinterpret_cast<float*>(smem);
  __syncthreads();
#pragma unroll
  for (int m = 0; m < 4; ++m)
#pragma unroll
    for (int n = 0; n < 4; ++n)
#pragma unroll
      for (int j = 0; j < 4; ++j)
        T[(wr * 64 + m * 16 + fq * 4 + j) * 128 + wc * 64 + n * 16 + fr] = acc[m][n][j];
  __syncthreads();
}
DEVI void epi_store_bf16(const f32x4 (&acc)[4][4], const float* colbias, bfu* dst, long ld, char* smem, int tid) {
  const int wid = tid >> 6, lane = tid & 63, wr = wid >> 1, wc = wid & 1, fr = lane & 15, fq = lane >> 4;
  bfu* T = reinterpret_cast<bfu*>(smem);
  __syncthreads();
#pragma unroll
  for (int n = 0; n < 4; ++n) {
    const int col = wc * 64 + n * 16 + fr;
    const float bias = colbias ? colbias[col] : 0.f;
#pragma unroll
    for (int m = 0; m < 4; ++m)
#pragma unroll
      for (int j = 0; j < 4; ++j)
        T[(wr * 64 + m * 16 + fq * 4 + j) * 136 + col] = f2b(acc[m][n][j] + bias);
  }
  __syncthreads();
#pragma unroll
  for (int q = 0; q < 8; ++q) {
    const int id = tid + 256 * q, row = id >> 4, c16 = id & 15;
    uint4 v = *reinterpret_cast<const uint4*>(T + row * 136 + c16 * 8);
    *reinterpret_cast<uint4*>(dst + (long)row * ld + c16 * 8) = v;
  }
}

DEVI void transpose_tile(const float* __restrict__ src, bfu* __restrict__ dst, int R, int C, int r0, int c0, float* tile, int tid) {
  __syncthreads();
  {
    int tx = tid & 15, ty = tid >> 4;
#pragma unroll
    for (int i = 0; i < 4; ++i) {
      int r = ty + i * 16;
      float4 v = *reinterpret_cast<const float4*>(src + (long)(r0 + r) * C + c0 + tx * 4);
      float* tp = tile + r * 65 + tx * 4;
      tp[0] = v.x; tp[1] = v.y; tp[2] = v.z; tp[3] = v.w;
    }
  }
  __syncthreads();
  {
    int c = tid >> 2, rs = (tid & 3) * 16;
    unsigned pk[8];
#pragma unroll
    for (int i = 0; i < 8; ++i) {
      unsigned lo = f2b(tile[(rs + 2 * i) * 65 + c]);
      unsigned hi = f2b(tile[(rs + 2 * i + 1) * 65 + c]);
      pk[i] = lo | (hi << 16);
    }
    uint4* dp = reinterpret_cast<uint4*>(dst + (long)(c0 + c) * R + r0 + rs);
    dp[0] = make_uint4(pk[0], pk[1], pk[2], pk[3]);
    dp[1] = make_uint4(pk[4], pk[5], pk[6], pk[7]);
  }
}
DEVI void convert_chunk(const float* __restrict__ src, bfu* __restrict__ dst, int tid) {
  int o = tid * 8;
  float4 a = *reinterpret_cast<const float4*>(src + o);
  float4 b = *reinterpret_cast<const float4*>(src + o + 4);
  uint4 r;
  r.x = f2b(a.x) | ((unsigned)f2b(a.y) << 16);
  r.y = f2b(a.z) | ((unsigned)f2b(a.w) << 16);
  r.z = f2b(b.x) | ((unsigned)f2b(b.y) << 16);
  r.w = f2b(b.z) | ((unsigned)f2b(b.w) << 16);
  *reinterpret_cast<uint4*>(dst + o) = r;
}

typedef float f32x2 __attribute__((ext_vector_type(2)));
constexpr float U_SCALE = 64.f, V_SCALE = 8.f;
DEVI void convert_chunk_fp8(const float* __restrict__ src, unsigned char* __restrict__ dst, float scale, int tid) {
  int o = tid * 16;
  uint4 r;
  unsigned rr[4];
#pragma unroll
  for (int q = 0; q < 4; ++q) {
    float4 a = *reinterpret_cast<const float4*>(src + o + q * 4);
    int p = __builtin_amdgcn_cvt_pk_fp8_f32(a.x * scale, a.y * scale, 0, false);
    p = __builtin_amdgcn_cvt_pk_fp8_f32(a.z * scale, a.w * scale, p, true);
    rr[q] = (unsigned)p;
  }
  r = make_uint4(rr[0], rr[1], rr[2], rr[3]);
  *reinterpret_cast<uint4*>(dst + o) = r;
}

DEVI void phase_prep(const Params& P, int l, char* smem) {
  const int tid = ltid();
  char* ws = wsp(P, 0);
  float* tile = reinterpret_cast<float*>(smem);
  const int NT_WIN = 3072, NT_SQ = 256, NT_WQ = 512, NT_LRU = 64;
  const int T0 = NT_WIN, T1 = T0 + 4 * NT_SQ, T2 = T1 + NT_WQ, T3 = T2 + NT_LRU;
  const int C0 = T3 + 128, C1 = C0 + 4096, C2 = C1 + 4096;
  const int X0 = C2;
  const int L0 = X0 + (l == 0 ? 8 : 0);
  for (int id = blockIdx.x; id < L0; id += gridDim.x) {
    if (id < T0) {
      int tr = id / 192, tc = id % 192;
      transpose_tile(P.in[6] + (long)l * 1024 * 12288, (bfu*)(ws + O_WIN), 1024, 12288, tr * 64, tc * 64, tile, tid);
    } else if (id < T1) {
      int q = id - T0, w = q >> 8, t = q & 255;
      const float* src = P.in[18 + w] + (long)l * 1048576;
      bfu* dst = (bfu*)(ws + (w == 0 ? O_WOA : w == 1 ? O_WOB : w == 2 ? O_WOC : O_WO));
      transpose_tile(src, dst, 1024, 1024, (t >> 4) * 64, (t & 15) * 64, tile, tid);
    } else if (id < T2) {
      int q = id - T1;
      transpose_tile(P.in[24] + (long)l * 2097152, (bfu*)(ws + O_WQ), 1024, 2048, (q >> 5) * 64, (q & 31) * 64, tile, tid);
    } else if (id < T3) {
      int q = id - T2, mtx = q >> 2, t = q & 3, g = mtx >> 3, nb = mtx & 7;
      const float* src = P.in[g == 0 ? 11 : 13] + (long)l * 131072 + nb * 16384;
      transpose_tile(src, (bfu*)(ws + O_LRU) + mtx * 16384, 128, 128, (t >> 1) * 64, (t & 1) * 64, tile, tid);
    } else if (id < C0) {
      int q = id - T3;
      convert_chunk(P.in[25] + (long)l * 262144 + (long)q * 2048, (bfu*)(ws + O_KEYS) + (long)q * 2048, tid);
    } else if (id < C1) {
      int q = id - C0;
      convert_chunk_fp8(P.in[26] + (long)l * 16777216 + (long)q * 4096, (unsigned char*)(ws + O_UTB) + (long)q * 4096, U_SCALE, tid);
    } else if (id < C2) {
      int q = id - C1;
      convert_chunk_fp8(P.in[27] + (long)l * 16777216 + (long)q * 4096, (unsigned char*)(ws + O_VTB) + (long)q * 4096, V_SCALE, tid);
    } else {
      int q = id - X0;
      int c = (q & 3) * 256 + tid, ll = q >> 2;
      float a0 = P.in[16][c], a1 = P.in[16][1024 + c];
      float mx = fmaxf(a0, a1);
      float e0 = __expf(a0 - mx), e1 = __expf(a1 - mx);
      float p1 = e1 / (e0 + e1);
      float* lbs = (float*)(ws + O_LBS);
      lbs[ll * 1024 + c] = (ll == 0) ? 0.f : p1;
    }
  }
}

DEVI void phase_xcopy(const Params& P) {
  const int tid = ltid();
  bfu* xb = (bfu*)wsp(P, O_XB);
  for (int it = blockIdx.x; it < 16640; it += gridDim.x) {
    TokInfo ti = tokinfo(it);
    const float* src = ti.sample ? P.in[1] + (long)(ti.seq * 32 + ti.t) * 1024 : P.in[0] + (long)(ti.seq * 4096 + ti.t) * 1024;
    float* dst = xrow(P, it);
    int c = tid * 4;
    float4 v = *reinterpret_cast<const float4*>(src + c);
    *reinterpret_cast<float4*>(dst + c) = v;
    uint2 r;
    r.x = f2b(v.x) | ((unsigned)f2b(v.y) << 16);
    r.y = f2b(v.z) | ((unsigned)f2b(v.w) << 16);
    *reinterpret_cast<uint2*>(xb + (long)it * 1024 + c) = r;
  }
}

DEVI void phase_inproj(const Params& P, int l, int pass, char* smem) {
  const int tid = ltid();
  const int ntok = pass ? 8192 : 8448, base = pass ? 8448 : 0;
  const int nM = ntok / 128, nN = 96;
  const bfu* xb = (const bfu*)wsp(P, O_XB) + (long)base * 1024;
  const bfu* wT = (const bfu*)wsp(P, O_WIN);
  bfu* z = (bfu*)wsp(P, O_Z);
  const float* bin = P.in[7] + l * NCOL;
  for (int id = blockIdx.x; id < nM * nN; id += gridDim.x) {
    int pm, pn; tile_rc(id, nM, nN, pm, pn);
    f32x4 acc[4][4]; ZERO_ACC(acc);
    gemm_core(acc, xb + (long)pm * 128 * 1024, 1024, wT + (long)pn * 128 * 1024, 1024, 1024, smem, tid);
    epi_store_bf16(acc, bin + pn * 128, z + (long)pm * 128 * NCOL + pn * 128, NCOL, smem, tid);
  }
}

DEVI void load4bf(const bfu* p, float (&o)[4]) {
  uint2 v = *reinterpret_cast<const uint2*>(p);
  o[0] = __uint_as_float(v.x << 16); o[1] = __uint_as_float(v.x & 0xFFFF0000u);
  o[2] = __uint_as_float(v.y << 16); o[3] = __uint_as_float(v.y & 0xFFFF0000u);
}
DEVI void store4bf(bfu* p, const float (&v)[4]) {
  uint2 r;
  r.x = f2b(v[0]) | ((unsigned)f2b(v[1]) << 16);
  r.y = f2b(v[2]) | ((unsigned)f2b(v[3]) << 16);
  *reinterpret_cast<uint2*>(p) = r;
}
DEVI void ld4f(const float* p, float (&o)[4]) {
  float4 v = *reinterpret_cast<const float4*>(p);
  o[0] = v.x; o[1] = v.y; o[2] = v.z; o[3] = v.w;
}
DEVI void mixab_row4(const Params& P, int l, int base, int lt0, int tid) {
  const int it0 = base + lt0;
  const TokInfo ti = tokinfo(it0);
  const int T = ti.sample ? 32 : 4096;
  const int t0 = ti.t;
  const bfu* z = (const bfu*)(P.ws + O_Z);
  const int c = tid * 4;
  {
    float pk[6][4], ab[4][4], wa[3][4];
#pragma unroll
    for (int k = 0; k < 6; ++k) {
      const int tt = t0 - 2 + k;
      if (tt >= 0) {
        const bfu* zr = z + (long)(lt0 - 2 + k) * NCOL;
        float ac[4], ax[4];
        load4bf(zr + 1024 + c, ac); load4bf(zr + 2048 + c, ax);
#pragma unroll
        for (int i = 0; i < 4; ++i) pk[k][i] = ac[i] * ax[i];
      } else if (ti.sample) {
        ld4f(P.in[2] + ((long)(l * 8 + ti.seq) * 2 + (tt + 2)) * 1024 + c, pk[k]);
      } else {
#pragma unroll
        for (int i = 0; i < 4; ++i) pk[k][i] = 0.f;
      }
    }
#pragma unroll
    for (int r = 0; r < 4; ++r) load4bf(z + (long)(lt0 + r) * NCOL + c, ab[r]);
#pragma unroll
    for (int k = 0; k < 3; ++k) ld4f(P.in[8] + (long)(l * 3 + k) * 1024 + c, wa[k]);
#pragma unroll
    for (int r = 0; r < 4; ++r) {
      float o[4];
#pragma unroll
      for (int i = 0; i < 4; ++i) o[i] = ab[r][i] * (wa[0][i] * pk[r][i] + wa[1][i] * pk[r + 1][i] + wa[2][i] * pk[r + 2][i]);
      store4bf((bfu*)(P.ws + O_UA) + (long)(lt0 + r) * 1024 + c, o);
    }
    if (t0 + 4 == T) {
      float* ca = ti.sample ? P.out + OUT_CAS + (long)(l * 8 + ti.seq) * 2 * 1024 + c : P.out + OUT_CAP + (long)(l * 4 + ti.seq) * 2 * 1024 + c;
#pragma unroll
      for (int r = 0; r < 2; ++r)
        *reinterpret_cast<float4*>(ca + r * 1024) = make_float4(pk[r + 4][0], pk[r + 4][1], pk[r + 4][2], pk[r + 4][3]);
    }
  }
  __builtin_amdgcn_sched_barrier(0);
  {
    float xk[7][4], wb[4][4], bb[4];
#pragma unroll
    for (int k = 0; k < 7; ++k) {
      const int tt = t0 - 3 + k;
      if (tt >= 0) {
        load4bf(z + (long)(lt0 - 3 + k) * NCOL + 3072 + c, xk[k]);
      } else if (ti.sample) {
        ld4f(P.in[3] + ((long)(l * 8 + ti.seq) * 3 + (tt + 3)) * 1024 + c, xk[k]);
      } else {
#pragma unroll
        for (int i = 0; i < 4; ++i) xk[k][i] = 0.f;
      }
    }
#pragma unroll
    for (int k = 0; k < 4; ++k) ld4f(P.in[9] + (long)(l * 4 + k) * 1024 + c, wb[k]);
    ld4f(P.in[10] + (long)l * 1024 + c, bb);
#pragma unroll
    for (int r = 0; r < 4; ++r) {
      float o2[4];
#pragma unroll
      for (int i = 0; i < 4; ++i)
        o2[i] = wb[0][i] * xk[r][i] + wb[1][i] * xk[r + 1][i] + wb[2][i] * xk[r + 2][i] + wb[3][i] * xk[r + 3][i] + bb[i];
      store4bf((bfu*)(P.ws + O_CB) + (long)(lt0 + r) * 1024 + c, o2);
    }
    if (t0 + 4 == T) {
      float* cbp = ti.sample ? P.out + OUT_CBS + (long)(l * 8 + ti.seq) * 3 * 1024 + c : P.out + OUT_CBP + (long)(l * 4 + ti.seq) * 3 * 1024 + c;
#pragma unroll
      for (int r = 0; r < 3; ++r)
        *reinterpret_cast<float4*>(cbp + r * 1024) = make_float4(xk[r + 4][0], xk[r + 4][1], xk[r + 4][2], xk[r + 4][3]);
    }
  }
}

struct ChunkInfo { int lt0, L, sample, seqi, c; };
DEVI ChunkInfo chunkinfo(int ck) {
  ChunkInfo r;
  if (ck < 128) { r.seqi = ck >> 6; r.c = ck & 63; r.lt0 = r.seqi * 4096 + r.c * 64; r.L = 64; r.sample = 0; }
  else { r.seqi = ck - 128; r.c = 0; r.lt0 = 8192 + r.seqi * 32; r.L = 32; r.sample = 1; }
  return r;
}

DEVI void h1_item(const Params& P, int l, int ck, int h, char* smem, int tid) {
  const ChunkInfo ci = chunkinfo(ck);
  const int lane = tid & 63, w = tid >> 6, fr = lane & 15, fq = lane >> 4;
  bfu* VT = (bfu*)smem;
  bfu* KT = VT + 128 * 72;
  bfu* FS = KT + 128 * 72;
  float* tots = (float*)(smem + 54272);
  float* decl = tots + 256;
  const int d = tid & 127, hf = tid >> 7, L = ci.L, Lh = L >> 1;
  const float lb = ((const float*)(P.ws + O_LBS))[l * 1024 + h * 128 + d];
  const bfu* Z = (const bfu*)(P.ws + O_Z);
  const bfu* zfb = Z + (long)ci.lt0 * NCOL + 6 * 1024 + h * 128;
  const bfu* zib = Z + (long)ci.lt0 * NCOL + 7 * 1024 + h * 128;
  __syncthreads();
#pragma unroll 1
  for (int q0 = 0; q0 < 4; q0 += 2) {
    uint4 vf[2], vi[2];
#pragma unroll
    for (int qq = 0; qq < 2; ++qq) {
      const int idx = tid + 256 * (q0 + qq);
      const int sr = (idx & 15) | (((idx >> 8) & 3) << 4), c16 = ((idx >> 4) & 3) | (((idx >> 6) & 3) << 2);
      if (sr < L) {
        vf[qq] = *reinterpret_cast<const uint4*>(zfb + (long)sr * NCOL + c16 * 8);
        vi[qq] = *reinterpret_cast<const uint4*>(zib + (long)sr * NCOL + c16 * 8);
      } else { vf[qq] = make_uint4(0, 0, 0, 0); vi[qq] = make_uint4(0, 0, 0, 0); }
    }
#pragma unroll
    for (int qq = 0; qq < 2; ++qq) {
      const int idx = tid + 256 * (q0 + qq);
      const int sr = (idx & 15) | (((idx >> 8) & 3) << 4), c16 = ((idx >> 4) & 3) | (((idx >> 6) & 3) << 2);
      *reinterpret_cast<uint4*>(FS + sr * 136 + c16 * 8) = vf[qq];
      const unsigned vv[4] = {vi[qq].x, vi[qq].y, vi[qq].z, vi[qq].w};
#pragma unroll
      for (int i = 0; i < 4; ++i) {
        VT[(c16 * 8 + 2 * i) * 72 + sr] = (bfu)(vv[i] & 0xFFFFu);
        VT[(c16 * 8 + 2 * i + 1) * 72 + sr] = (bfu)(vv[i] >> 16);
      }
    }
  }
  __syncthreads();
  float tot = 0.f;
#pragma unroll 8
  for (int i = 0; i < Lh; ++i) {
    float f = lb + (1.f - lb) * sigmoidf_(b2f(FS[(hf * Lh + i) * 136 + d]));
    tot += __logf(f);
  }
  tots[hf * 128 + d] = tot;
  __syncthreads();
  float run = hf ? 0.f : tots[128 + d];
#pragma unroll 8
  for (int i = Lh - 1; i >= 0; --i) {
    const int sr = hf * Lh + i;
    float f = lb + (1.f - lb) * sigmoidf_(b2f(FS[sr * 136 + d]));
    KT[d * 72 + sr] = f2b((1.f - f) * __expf(run));
    run += __logf(f);
  }
  if (L == 32) {
    for (int sr = 32 + hf * 16; sr < 48 + hf * 16; ++sr) KT[d * 72 + sr] = 0;
  }
  if (hf == 0) {
    float dc = __expf(tots[d] + tots[128 + d]);
    decl[d] = dc;
    if (!ci.sample) ((float*)(P.ws + O_DEC))[((ci.seqi * 8 + h) * 64 + ci.c) * 128 + d] = dc;
  }
  __syncthreads();
  f32x4 acc[2][8];
#pragma unroll
  for (int mi = 0; mi < 2; ++mi)
#pragma unroll
    for (int n = 0; n < 8; ++n) acc[mi][n] = f32x4{0.f, 0.f, 0.f, 0.f};
#pragma unroll
  for (int kk = 0; kk < 2; ++kk) {
    bf16x8 a[2];
#pragma unroll
    for (int mi = 0; mi < 2; ++mi) a[mi] = *reinterpret_cast<const bf16x8*>(VT + ((2 * w + mi) * 16 + fr) * 72 + kk * 32 + fq * 8);
#pragma unroll
    for (int n = 0; n < 8; ++n) {
      bf16x8 b = *reinterpret_cast<const bf16x8*>(KT + (n * 16 + fr) * 72 + kk * 32 + fq * 8);
#pragma unroll
      for (int mi = 0; mi < 2; ++mi) acc[mi][n] = __builtin_amdgcn_mfma_f32_16x16x32_bf16(a[mi], b, acc[mi][n], 0, 0, 0);
    }
  }
  if (!ci.sample) {
    bfu* US = (bfu*)(P.ws + O_US) + ((long)((ci.seqi * 8 + h) * 64 + ci.c) << 14);
#pragma unroll
    for (int mi = 0; mi < 2; ++mi) {
      __builtin_amdgcn_sched_barrier(0);
      bfu* bp = US + ((2 * w + mi) * 16 + fq * 4) * 128 + fr;
#pragma unroll
      for (int n = 0; n < 8; ++n)
#pragma unroll
        for (int j = 0; j < 4; ++j) bp[j * 128 + n * 16] = f2b(acc[mi][n][j]);
    }
  } else {
    long sb = ((long)((l * 8 + ci.seqi) * 8 + h)) << 14;
    const float* S0 = P.in[5] + sb;
    float* So = P.out + OUT_HGS + sb;
#pragma unroll
    for (int mi = 0; mi < 2; ++mi)
#pragma unroll
      for (int n = 0; n < 8; ++n) {
        __builtin_amdgcn_sched_barrier(0);
        int e0 = (2 * w + mi) * 16 + fq * 4, dd = n * 16 + fr;
        float4 s0 = *reinterpret_cast<const float4*>(S0 + dd * 128 + e0);
        float dcl = decl[dd];
        float4 r;
        r.x = dcl * s0.x + acc[mi][n][0]; r.y = dcl * s0.y + acc[mi][n][1];
        r.z = dcl * s0.z + acc[mi][n][2]; r.w = dcl * s0.w + acc[mi][n][3];
        *reinterpret_cast<float4*>(So + dd * 128 + e0) = r;
      }
  }
}

DEVI void phase2(const Params& P, int l, int pass, char* smem) {
  const int tid = ltid();
  const int ntok = pass ? 8192 : 8448, base = pass ? 8448 : 0;
  const int nck = pass ? 128 : 136;
  const int nH = nck * 8;
  const int total = nH + ntok / 4;
  for (int id = blockIdx.x; id < total; id += gridDim.x) {
    if (id < nH) h1_item(P, l, id >> 3, id & 7, smem, tid);
    else mixab_row4(P, l, base, (id - nH) * 4, tid);
  }
}

DEVI void gate_tile(const Params& P, int l, int pm, int q, char* smem, int tid) {
  const int nb = q >> 1, hb = q & 1;
  const bfu* cb = (const bfu*)(P.ws + O_CB);
  const bfu* A = cb + (long)pm * 128 * 1024 + nb * 128;
  const bfu* Wa = (const bfu*)(P.ws + O_LRU) + nb * 16384 + hb * 64 * 128;
  const bfu* Wx = Wa + 8 * 16384;
  float* au0 = (float*)(P.ws + O_AU);
  float* au1 = au0 + (long)8448 * 1024;
  const float* ba = P.in[12] + l * 1024;
  const float* bx = P.in[14] + l * 1024;
  const float* lam = P.in[15] + l * 1024;
  f32x4 acc[4][4]; ZERO_ACC(acc);
  gemm_core_t<1>(acc, A, 1024, Wa, 128, 128, smem, tid, Wx);
  epi_stage_f32(acc, smem, tid);
  const float* T = reinterpret_cast<const float*>(smem);
  float* Tw = reinterpret_cast<float*>(smem);
#pragma unroll 4
  for (int q = 0; q < 8; ++q) {
    const int id = tid + 256 * q, row = id >> 4, g4 = id & 15;
    const int cl = g4 * 4, wcc = cl >> 5, c32 = cl & 31;
    const long grow = (long)pm * 128 + row;
    const int col = nb * 128 + hb * 64 + cl;
    float4 rp = *reinterpret_cast<const float4*>(T + row * 128 + wcc * 64 + c32);
    float4 gp = *reinterpret_cast<const float4*>(T + row * 128 + wcc * 64 + 32 + c32);
    float xv[4], bav[4], bxv[4], lmv[4];
    load4bf(cb + grow * 1024 + col, xv);
    ld4f(ba + col, bav); ld4f(bx + col, bxv); ld4f(lam + col, lmv);
    const float rpa[4] = {rp.x, rp.y, rp.z, rp.w}, gpa[4] = {gp.x, gp.y, gp.z, gp.w};
    float av[4], uv[4];
#pragma unroll
    for (int i = 0; i < 4; ++i) {
      float r = sigmoidf_(rpa[i] + bav[i]);
      float gi = sigmoidf_(gpa[i] + bxv[i]);
      float a = __expf(-8.f * log1pf(__expf(-lmv[i])) * r);
      av[i] = a;
      uv[i] = sqrtf(fmaxf(1.f - a * a, 0.f)) * gi * xv[i];
    }
    *reinterpret_cast<float4*>(au0 + grow * 1024 + col) = make_float4(av[0], av[1], av[2], av[3]);
    *reinterpret_cast<float4*>(au1 + grow * 1024 + col) = make_float4(uv[0], uv[1], uv[2], uv[3]);
    *reinterpret_cast<float4*>(Tw + row * 128 + wcc * 64 + c32) = make_float4(av[0], av[1], av[2], av[3]);
    *reinterpret_cast<float4*>(Tw + row * 128 + wcc * 64 + 32 + c32) = make_float4(uv[0], uv[1], uv[2], uv[3]);
  }
  __syncthreads();
  if (tid < 64) {
    const int wcc = tid >> 5, c32 = tid & 31;
    const float* ta = T + wcc * 64 + c32;
    float Ap = 1.f, Hp = 0.f;
#pragma unroll 1
    for (int r0 = 0; r0 < 128; r0 += 16) {
      float av[16], uv[16];
#pragma unroll
      for (int i = 0; i < 16; ++i) { av[i] = ta[(r0 + i) * 128]; uv[i] = ta[(r0 + i) * 128 + 32]; }
#pragma unroll
      for (int i = 0; i < 16; ++i) { Hp = av[i] * Hp + uv[i]; Ap *= av[i]; }
    }
    float* ls = (float*)(P.ws + O_LSUM) + (long)pm * 2048 + nb * 128 + hb * 64 + tid;
    ls[0] = Ap; ls[1024] = Hp;
  }
}
DEVI void h2_item(const Params& P, int l, int pass, int item, int tid) {
  const int sh = item >> 6, blk = item & 63;
  const int idx = blk * 256 + tid, e = idx >> 7, d = idx & 127;
  bfu* US = (bfu*)wsp(P, O_US) + ((long)sh * 64 << 14) + idx;
  const float* dec = (const float*)wsp(P, O_DEC) + (long)sh * 64 * 128 + d;
  float S = 0.f;
  for (int c0 = 0; c0 < 64; c0 += 8) {
    float u[8], dc[8];
#pragma unroll
    for (int i = 0; i < 8; ++i) { u[i] = b2f(US[(long)(c0 + i) << 14]); dc[i] = dec[(c0 + i) * 128]; }
#pragma unroll
    for (int i = 0; i < 8; ++i) { US[(long)(c0 + i) << 14] = f2b(S); S = dc[i] * S + u[i]; }
  }
  const int sl = sh >> 3, h = sh & 7, b = pass * 2 + sl;
  P.out[OUT_HGP + (((long)((l * 4 + b) * 8 + h)) << 14) + d * 128 + e] = S;
}
DEVI void phase3(const Params& P, int l, int pass, char* smem) {
  const int tid = ltid();
  const int ntok = pass ? 8192 : 8448;
  const int nG = (ntok / 128) * 16, nH2 = 1024;
  for (int id = blockIdx.x; id < nG + nH2; id += gridDim.x) {
    if (id < nG) gate_tile(P, l, id >> 4, id & 15, smem, tid);
    else h2_item(P, l, pass, id - nG, tid);
  }
}

DEVI void lsum_item(const Params& P, int tile, int cg4, int tid) {
  const int w = tid >> 6, lane = tid & 63;
  const int ch = (cg4 * 4 + w) * 64 + lane;
  const float* a0 = (const float*)wsp(P, O_AU) + (long)tile * 128 * 1024 + ch;
  const float* u0 = a0 + (long)8448 * 1024;
  float A = 1.f, H = 0.f;
  for (int r0 = 0; r0 < 128; r0 += 16) {
    float av[16], uv[16];
#pragma unroll
    for (int i = 0; i < 16; ++i) { av[i] = a0[(long)(r0 + i) * 1024]; uv[i] = u0[(long)(r0 + i) * 1024]; }
#pragma unroll
    for (int i = 0; i < 16; ++i) { H = av[i] * H + uv[i]; A *= av[i]; }
  }
  float* ls = (float*)wsp(P, O_LSUM) + (long)tile * 2048;
  ls[ch] = A; ls[1024 + ch] = H;
}

DEVI void h3_item(const Params& P, int l, int ck, int h, char* smem, int tid) {
  const ChunkInfo ci = chunkinfo(ck);
  const int lane = tid & 63, w = tid >> 6, fr = lane & 15, fq = lane >> 4;
  bfu* QT = (bfu*)smem;
  bfu* KT = QT + 64 * 136;
  bfu* AT = KT + 64 * 136;
  bfu* BS = AT + 64 * 72;
  float* bmid = (float*)(BS + 128 * 72);
  const int d = tid & 127, hf = tid >> 7, L = ci.L, Lh = L >> 1;
  const float lb = ((const float*)(P.ws + O_LBS))[l * 1024 + h * 128 + d];
  const bfu* Z = (const bfu*)(P.ws + O_Z);
  const bfu* zqb = Z + (long)ci.lt0 * NCOL + 5 * 1024 + h * 128;
  __syncthreads();
  {
    uint4 vq[4], vf[4], vi[4];
#pragma unroll
    for (int q = 0; q < 4; ++q) {
      const int idx = tid + 256 * q;
      const int sr = (idx & 15) | (((idx >> 8) & 3) << 4), c16 = ((idx >> 4) & 3) | (((idx >> 6) & 3) << 2);
      if (sr < L) {
        const bfu* rp = zqb + (long)sr * NCOL + c16 * 8;
        vq[q] = *reinterpret_cast<const uint4*>(rp);
        vf[q] = *reinterpret_cast<const uint4*>(rp + 1024);
        vi[q] = *reinterpret_cast<const uint4*>(rp + 2048);
      } else { vq[q] = make_uint4(0, 0, 0, 0); vf[q] = vq[q]; vi[q] = vq[q]; }
    }
#pragma unroll
    for (int q = 0; q < 4; ++q) {
      const int idx = tid + 256 * q;
      const int sr = (idx & 15) | (((idx >> 8) & 3) << 4), c16 = ((idx >> 4) & 3) | (((idx >> 6) & 3) << 2);
      *reinterpret_cast<uint4*>(QT + sr * 136 + c16 * 8) = vq[q];
      *reinterpret_cast<uint4*>(KT + sr * 136 + c16 * 8) = vf[q];
      const unsigned vv[4] = {vi[q].x, vi[q].y, vi[q].z, vi[q].w};
#pragma unroll
      for (int i = 0; i < 4; ++i) {
        BS[(c16 * 8 + 2 * i) * 72 + sr] = (bfu)(vv[i] & 0xFFFFu);
        BS[(c16 * 8 + 2 * i + 1) * 72 + sr] = (bfu)(vv[i] >> 16);
      }
    }
  }
  __syncthreads();
  if (hf == 0) {
    float rel = 0.f;
#pragma unroll 8
    for (int t = Lh - 1; t >= 0; --t) {
      float f = lb + (1.f - lb) * sigmoidf_(b2f(KT[t * 136 + d]));
      float q = siluf_(b2f(QT[t * 136 + d]));
      QT[t * 136 + d] = f2b(q * __expf(fminf(rel, 80.f)));
      KT[t * 136 + d] = f2b((1.f - f) * __expf(-rel));
      rel -= __logf(f);
    }
    bmid[d] = -rel;
  } else {
    float rel = 0.f;
#pragma unroll 8
    for (int t = Lh; t < L; ++t) {
      float f = lb + (1.f - lb) * sigmoidf_(b2f(KT[t * 136 + d]));
      float q = siluf_(b2f(QT[t * 136 + d]));
      rel += __logf(f);
      QT[t * 136 + d] = f2b(q * __expf(rel));
      KT[t * 136 + d] = f2b((1.f - f) * __expf(fminf(-rel, 80.f)));
    }
  }
  if (L == 32) {
    for (int t = 32 + hf * 16; t < 48 + hf * 16; ++t) { QT[t * 136 + d] = 0; KT[t * 136 + d] = 0; }
  }
  uint4 vg[4];
#pragma unroll
  for (int q = 0; q < 4; ++q) {
    const int idx = tid + 256 * q;
    const int sr = (idx & 15) | (((idx >> 8) & 3) << 4), c16 = ((idx >> 4) & 3) | (((idx >> 6) & 3) << 2);
    vg[q] = (sr < L) ? *reinterpret_cast<const uint4*>(zqb + (long)sr * NCOL + 3072 + c16 * 8) : make_uint4(0, 0, 0, 0);
  }
  __syncthreads();
  bf16x8 aq[4];
#pragma unroll
  for (int kk = 0; kk < 4; ++kk) aq[kk] = *reinterpret_cast<const bf16x8*>(QT + (16 * w + fr) * 136 + kk * 32 + fq * 8);
  {
    f32x4 sa[4];
#pragma unroll
    for (int n = 0; n < 4; ++n) sa[n] = f32x4{0.f, 0.f, 0.f, 0.f};
#pragma unroll
    for (int kk = 0; kk < 4; ++kk)
#pragma unroll
      for (int n = 0; n < 4; ++n) {
        bf16x8 bk = *reinterpret_cast<const bf16x8*>(KT + (n * 16 + fr) * 136 + kk * 32 + fq * 8);
        sa[n] = __builtin_amdgcn_mfma_f32_16x16x32_bf16(aq[kk], bk, sa[n], 0, 0, 0);
      }
#pragma unroll
    for (int n = 0; n < 4; ++n)
#pragma unroll
      for (int j = 0; j < 4; ++j) {
        int t = 16 * w + fq * 4 + j, s = n * 16 + fr;
        AT[t * 72 + s] = (s <= t) ? f2b(sa[n][j]) : (bfu)0;
      }
  }
  __syncthreads();
#pragma unroll
  for (int q = 0; q < 4; ++q) {
    const int idx = tid + 256 * q;
    const int sr = (idx & 15) | (((idx >> 8) & 3) << 4), c16 = ((idx >> 4) & 3) | (((idx >> 6) & 3) << 2);
    *reinterpret_cast<uint4*>(QT + sr * 136 + c16 * 8) = vg[q];
  }
  f32x4 o[8];
#pragma unroll
  for (int n = 0; n < 8; ++n) o[n] = f32x4{0.f, 0.f, 0.f, 0.f};
#pragma unroll
  for (int kk = 0; kk < 2; ++kk) {
    bf16x8 a = *reinterpret_cast<const bf16x8*>(AT + (16 * w + fr) * 72 + kk * 32 + fq * 8);
#pragma unroll
    for (int n = 0; n < 8; ++n) {
      bf16x8 b = *reinterpret_cast<const bf16x8*>(BS + (n * 16 + fr) * 72 + kk * 32 + fq * 8);
      o[n] = __builtin_amdgcn_mfma_f32_16x16x32_bf16(a, b, o[n], 0, 0, 0);
    }
  }
#pragma unroll
  for (int sl = 0; sl < 2; ++sl) {
    __syncthreads();
    if (!ci.sample) {
      const bfu* src = (const bfu*)(P.ws + O_US) + ((long)((ci.seqi * 8 + h) * 64 + ci.c) << 14);
      int e2 = tid >> 1, dd0 = (tid & 1) * 32;
#pragma unroll
      for (int q4 = 0; q4 < 4; ++q4) {
        uint4 v = *reinterpret_cast<const uint4*>(src + e2 * 128 + sl * 64 + dd0 + q4 * 8);
        const float* bm = bmid + sl * 64 + dd0 + q4 * 8;
        unsigned vv[4] = {v.x, v.y, v.z, v.w};
        unsigned rr[4];
#pragma unroll
        for (int i = 0; i < 4; ++i) {
          float lo = __uint_as_float(vv[i] << 16) * __expf(bm[2 * i]);
          float hi = __uint_as_float(vv[i] & 0xFFFF0000u) * __expf(bm[2 * i + 1]);
          rr[i] = f2b(lo) | ((unsigned)f2b(hi) << 16);
        }
        *reinterpret_cast<uint4*>(BS + e2 * 72 + dd0 + q4 * 8) = make_uint4(rr[0], rr[1], rr[2], rr[3]);
      }
    } else {
      const float* S0 = P.in[5] + (((long)((l * 8 + ci.seqi) * 8 + h)) << 14);
#pragma unroll 4
      for (int dd = hf * 32; dd < hf * 32 + 32; ++dd)
        BS[d * 72 + dd] = f2b(S0[(sl * 64 + dd) * 128 + d] * __expf(bmid[sl * 64 + dd]));
    }
    __syncthreads();
#pragma unroll
    for (int kk = 0; kk < 2; ++kk) {
#pragma unroll
      for (int n = 0; n < 8; ++n) {
        bf16x8 b = *reinterpret_cast<const bf16x8*>(BS + (n * 16 + fr) * 72 + kk * 32 + fq * 8);
        o[n] = __builtin_amdgcn_mfma_f32_16x16x32_bf16(aq[sl * 2 + kk], b, o[n], 0, 0, 0);
      }
    }
  }
  float rinv[4];
#pragma unroll
  for (int j = 0; j < 4; ++j) {
    float ss = 0.f;
#pragma unroll
    for (int n = 0; n < 8; ++n) ss += o[n][j] * o[n][j];
    ss += __shfl_xor(ss, 1); ss += __shfl_xor(ss, 2); ss += __shfl_xor(ss, 4); ss += __shfl_xor(ss, 8);
    rinv[j] = rsqrtf(ss * (1.f / 128.f) + 1e-6f);
  }
  const float* ng = P.in[17] + l * 128;
  bfu* UC = (bfu*)(P.ws + O_UC);
#pragma unroll
  for (int n = 0; n < 8; ++n)
#pragma unroll
    for (int j = 0; j < 4; ++j) {
      int t = 16 * w + fq * 4 + j, e = n * 16 + fr;
      if (t < L) {
        float g = b2f(QT[t * 136 + e]);
        UC[(long)(ci.lt0 + t) * 1024 + h * 128 + e] = f2b(o[n][j] * rinv[j] * ng[e] * siluf_(g));
      }
    }
}
DEVI void apply_item(const Params& P, int l, int pass, int id, int tid) {
  const int base = pass ? 8448 : 0;
  const int w = tid >> 6, lane = tid & 63;
  const float* AU0 = (const float*)wsp(P, O_AU);
  const float* AU1 = AU0 + (long)8448 * 1024;
  const float* LS = (const float*)wsp(P, O_LSUM);
  const bfu* Z = (const bfu*)wsp(P, O_Z);
  bfu* UB = (bfu*)wsp(P, O_UB);
  const int tile = id >> 2, ch = ((id & 3) * 4 + w) * 64 + lane;
  const int lt0 = tile * 128;
  const TokInfo t0 = tokinfo(base + lt0);
  float hcur = 0.f;
  if (!t0.sample) {
    int jf = tile - (t0.t >> 7);
#pragma unroll 4
    for (int i = jf; i < tile; ++i) hcur = LS[(long)i * 2048 + ch] * hcur + LS[(long)i * 2048 + 1024 + ch];
  }
  for (int r0 = 0; r0 < 128; r0 += 8) {
    float av[8], uv[8], gv[8];
#pragma unroll
    for (int i = 0; i < 8; ++i) {
      long row = lt0 + r0 + i;
      av[i] = AU0[row * 1024 + ch]; uv[i] = AU1[row * 1024 + ch];
      gv[i] = b2f(Z[row * NCOL + 4 * 1024 + ch]);
    }
#pragma unroll
    for (int i = 0; i < 8; ++i) {
      int r = r0 + i;
      if (t0.sample && (r & 31) == 0) hcur = P.in[4][(long)(l * 8 + t0.seq + (r >> 5)) * 1024 + ch];
      hcur = av[i] * hcur + uv[i];
      UB[(long)(lt0 + r) * 1024 + ch] = f2b(geluf_(gv[i]) * hcur);
      if (t0.sample && (r & 31) == 31) P.out[OUT_LRS + (long)(l * 8 + t0.seq + (r >> 5)) * 1024 + ch] = hcur;
    }
  }
  if (!t0.sample && t0.t + 128 == 4096) P.out[OUT_LRP + (long)(l * 4 + t0.seq) * 1024 + ch] = hcur;
}
DEVI void phase4(const Params& P, int l, int pass, char* smem) {
  const int tid = ltid();
  const int ntok = pass ? 8192 : 8448;
  const int nck = pass ? 128 : 136;
  const int nH = nck * 8;
  const int nA = (ntok / 128) * 4;
  for (int id = blockIdx.x; id < nA + nH; id += gridDim.x) {
    if (id < nA) apply_item(P, l, pass, id, tid);
    else { int q = id - nA; h3_item(P, l, q >> 3, q & 7, smem, tid); }
  }
}

template <int BR>
DEVI void p6_branch(const Params& P, int pm, int pn, float* macc, char* smem, int tid) {
  asm volatile("" : "+s"(pm), "+s"(pn));
  const bfu* Z = (const bfu*)(P.ws + O_Z);
  bfu* M = (bfu*)(P.ws + O_CB);
  const bfu* A = (const bfu*)(P.ws + (BR == 0 ? O_UA : BR == 1 ? O_UB : O_UC)) + (long)pm * 128 * 1024;
  const bfu* B = (const bfu*)(P.ws + (BR == 0 ? O_WOA : BR == 1 ? O_WOB : O_WOC)) + (long)pn * 128 * 1024;
  f32x4 acc[4][4]; ZERO_ACC(acc);
  gemm_core(acc, A, 1024, B, 1024, 1024, smem, tid);
  epi_stage_f32(acc, smem, tid);
  const float* T = reinterpret_cast<const float*>(smem);
#pragma unroll 8
  for (int q = 0; q < 16; ++q) {
    const int id = tid + 256 * q, row = id >> 5, c4 = id & 31;
    const long grow = (long)pm * 128 + row;
    const int gcol = pn * 128 + c4 * 4;
    float4 a = *reinterpret_cast<const float4*>(T + row * 128 + c4 * 4);
    float g[4];
    load4bf(Z + grow * NCOL + (9 + BR) * 1024 + gcol, g);
    float v[4] = {sigmoidf_(g[0]) * a.x, sigmoidf_(g[1]) * a.y, sigmoidf_(g[2]) * a.z, sigmoidf_(g[3]) * a.w};
    if (BR > 0) {
      float4 mo = *reinterpret_cast<const float4*>(macc + grow * 1024 + gcol);
      v[0] += mo.x; v[1] += mo.y; v[2] += mo.z; v[3] += mo.w;
    }
    if (BR < 2) *reinterpret_cast<float4*>(macc + grow * 1024 + gcol) = make_float4(v[0], v[1], v[2], v[3]);
    else store4bf(M + grow * 1024 + gcol, v);
  }
}
DEVI void phase6(const Params& P, int l, int pass, char* smem) {
  const int tid = ltid();
  const int ntok = pass ? 8192 : 8448;
  const int nM = ntok / 128, nN = 8;
  const bfu* Z = (const bfu*)(P.ws + O_Z);
  bfu* M = (bfu*)(P.ws + O_CB);
  for (int id = blockIdx.x; id < nM * nN; id += gridDim.x) {
    int pm, pn; tile_rc_m(id, nM, nN, pm, pn);
    float* macc = (float*)(P.ws + O_AU);
    p6_branch<0>(P, pm, pn, macc, smem, tid);
    p6_branch<1>(P, pm, pn, macc, smem, tid);
    p6_branch<2>(P, pm, pn, macc, smem, tid);
  }
}

DEVI void phase7(const Params& P, int l, int pass, char* smem) {
  const int tid = ltid();
  const int ntok = pass ? 8192 : 8448, base = pass ? 8448 : 0;
  const int nM = ntok / 128, nN = 8;
  const bfu* M = (const bfu*)wsp(P, O_CB);
  const bfu* W = (const bfu*)wsp(P, O_WO);
  float* pre = (float*)wsp(P, O_PRE);
  for (int id = blockIdx.x; id < nM * nN; id += gridDim.x) {
    int pm, pn; tile_rc_m(id, nM, nN, pm, pn);
    f32x4 acc[4][4]; ZERO_ACC(acc);
    gemm_core(acc, M + (long)pm * 128 * 1024, 1024, W + (long)pn * 128 * 1024, 1024, 1024, smem, tid);
    epi_stage_f32(acc, smem, tid);
    {
      const float* T = reinterpret_cast<const float*>(smem);
#pragma unroll 8
      for (int q = 0; q < 16; ++q) {
        const int id = tid + 256 * q, row = id >> 5, c4 = id & 31;
        const int grow = pm * 128 + row, gcol = pn * 128 + c4 * 4;
        float4 a = *reinterpret_cast<const float4*>(T + row * 128 + c4 * 4);
        float4 xx = *reinterpret_cast<const float4*>(xrow(P, base + grow) + gcol);
        *reinterpret_cast<float4*>(pre + (long)grow * 1024 + gcol) =
            make_float4(ALPHA * xx.x + a.x, ALPHA * xx.y + a.y, ALPHA * xx.z + a.z, ALPHA * xx.w + a.w);
      }
    }
  }
}

DEVI void phase8(const Params& P, int l, int pass) {
  const int tid = ltid();
  const int ntok = pass ? 8192 : 8448, base = pass ? 8448 : 0;
  const int w = tid >> 6, lane = tid & 63;
  const float* pre = (const float*)wsp(P, O_PRE);
  const float* g = P.in[22] + l * 1024;
  const float* b = P.in[23] + l * 1024;
  bfu* xb = (bfu*)wsp(P, O_XB);
  for (int id = blockIdx.x; id < ntok / 4; id += gridDim.x) {
    int lt = id * 4 + w, it = base + lt;
    const float* src = pre + (long)lt * 1024;
    float v[16];
#pragma unroll
    for (int q = 0; q < 4; ++q) {
      float4 t = *reinterpret_cast<const float4*>(src + q * 256 + lane * 4);
      v[q * 4] = t.x; v[q * 4 + 1] = t.y; v[q * 4 + 2] = t.z; v[q * 4 + 3] = t.w;
    }
    float s = 0.f;
#pragma unroll
    for (int i = 0; i < 16; ++i) s += v[i];
    float mu = wave_sum(s) * (1.f / 1024.f);
    float ss = 0.f;
#pragma unroll
    for (int i = 0; i < 16; ++i) { float dlt = v[i] - mu; ss += dlt * dlt; }
    float rs = rsqrtf(wave_sum(ss) * (1.f / 1024.f) + 1e-5f);
    float* xr = xrow(P, it);
#pragma unroll
    for (int q = 0; q < 4; ++q) {
      int c = q * 256 + lane * 4;
      float o[4];
#pragma unroll
      for (int i = 0; i < 4; ++i) o[i] = (v[q * 4 + i] - mu) * rs * g[c + i] + b[c + i];
      *reinterpret_cast<float4*>(xr + c) = make_float4(o[0], o[1], o[2], o[3]);
      store4bf(xb + (long)it * 1024 + c, o);
    }
  }
}

DEVI void phase9(const Params& P, int l, int pass, char* smem) {
  const int tid = ltid();
  const int ntok = pass ? 8192 : 8448, base = pass ? 8448 : 0;
  const int nM = ntok / 128, nN = 16;
  const bfu* xb = (const bfu*)wsp(P, O_XB) + (long)base * 1024;
  const bfu* W = (const bfu*)wsp(P, O_WQ);
  bfu* qp = (bfu*)wsp(P, O_QP);
  const bfu* KB = (const bfu*)wsp(P, O_KEYS);
  float* sc = (float*)wsp(P, O_SC);
  for (int id = blockIdx.x; id < nM * nN; id += gridDim.x) {
    int pm, pn; tile_rc_m(id, nM, nN, pm, pn);
    {
      f32x4 acc[4][4]; ZERO_ACC(acc);
      gemm_core(acc, xb + (long)pm * 128 * 1024, 1024, W + (long)pn * 128 * 1024, 1024, 1024, smem, tid);
      epi_store_bf16(acc, nullptr, qp + (long)pm * 128 * 2048 + pn * 128, 2048, smem, tid);
    }
    asm volatile("s_waitcnt vmcnt(0)" ::: "memory");
    __builtin_amdgcn_fence(__ATOMIC_RELEASE, "workgroup");
    __syncthreads();
    __builtin_amdgcn_fence(__ATOMIC_ACQUIRE, "workgroup");
    asm volatile("" : "+s"(pm), "+s"(pn));
    {
      f32x4 acc[4][4]; ZERO_ACC(acc);
      gemm_core(acc, qp + (long)pm * 128 * 2048 + pn * 128, 2048, KB + (long)pn * 16384, 128, 128, smem, tid);
      epi_stage_f32(acc, smem, tid);
      const float* T = reinterpret_cast<const float*>(smem);
#pragma unroll 8
      for (int q = 0; q < 16; ++q) {
        const int id2 = tid + 256 * q, row = id2 >> 5, c4 = id2 & 31;
        *reinterpret_cast<float4*>(sc + (long)(pm * 128 + row) * 2048 + pn * 128 + c4 * 4) =
            *reinterpret_cast<const float4*>(T + row * 128 + c4 * 4);
      }
    }
  }
}

constexpr int KLOW = 12;
__constant__ unsigned char CAND_IJ[50] = {
  0x00,0x01,0x02,0x03,0x04,0x05,0x06,0x07,0x08,0x09,0x0A,0x0B,0x0C,0x0D,0x0E,0x0F,
  0x10,0x11,0x12,0x13,0x14,0x15,0x16,0x17,
  0x20,0x21,0x22,0x23,0x24,
  0x30,0x31,0x32,0x33,
  0x40,0x41,0x42,
  0x50,0x51, 0x60,0x61, 0x70,0x71,
  0x80,0x90,0xA0,0xB0,0xC0,0xD0,0xE0,0xF0};
DEVI unsigned fkey(float f) {
  unsigned u = __float_as_uint(f);
  return (u & 0x80000000u) ? ~u : (u | 0x80000000u);
}
DEVI void dec16(uint4 v, f32x2 (&o)[8]) {
  o[0] = __builtin_amdgcn_cvt_pk_f32_fp8((int)v.x, false); o[1] = __builtin_amdgcn_cvt_pk_f32_fp8((int)v.x, true);
  o[2] = __builtin_amdgcn_cvt_pk_f32_fp8((int)v.y, false); o[3] = __builtin_amdgcn_cvt_pk_f32_fp8((int)v.y, true);
  o[4] = __builtin_amdgcn_cvt_pk_f32_fp8((int)v.z, false); o[5] = __builtin_amdgcn_cvt_pk_f32_fp8((int)v.z, true);
  o[6] = __builtin_amdgcn_cvt_pk_f32_fp8((int)v.w, false); o[7] = __builtin_amdgcn_cvt_pk_f32_fp8((int)v.w, true);
}
DEVI void phase11(const Params& P, int l, int pass, char* smem) {
  const int ntok = pass ? 8192 : 8448, base = pass ? 8448 : 0;
  const int tid = ltid(); const int w = tid >> 6, lane = tid & 63;
  float* scl = (float*)smem;
  float* sv = scl + 2048;
  int* si = (int*)(sv + 256);
  float* tops = (float*)(si + 256);
  int* tope = (int*)(tops + 128);
  float* wgt = (float*)(tope + 128);
  float* svs = wgt + 128;
  int* sis = (int*)(svs + 256);
  float* red = (float*)(sis + 256);
  float* stat = red + 4096;
  const float* SC = (const float*)(P.ws + O_SC);
  const unsigned char* UT = (const unsigned char*)(P.ws + O_UTB);
  const unsigned char* VTb = (const unsigned char*)(P.ws + O_VTB);
  const float* g2 = P.in[28] + l * 1024;
  const float* b2 = P.in[29] + l * 1024;
  bfu* xb = (bfu*)(P.ws + O_XB);
  const unsigned long long ltmask = (1ull << lane) - 1ull;
  for (int lt = blockIdx.x; lt < ntok; lt += gridDim.x) {
    const int it = base + lt;
    float* xr = xrow(P, it);
    __syncthreads();
    {
      const float4* s4 = reinterpret_cast<const float4*>(SC + (long)lt * 2048);
      reinterpret_cast<float4*>(scl)[tid] = s4[tid];
      reinterpret_cast<float4*>(scl)[tid + 256] = s4[tid + 256];
    }
    __syncthreads();
    {
      float v0[4], v1[4]; unsigned k0[4], k1[4], T[4];
#pragma unroll
      for (int li = 0; li < 4; ++li) {
        const int Lx = w * 4 + li;
        v0[li] = scl[Lx * 128 + lane]; v1[li] = scl[Lx * 128 + 64 + lane];
        k0[li] = fkey(v0[li]); k1[li] = fkey(v1[li]); T[li] = 0;
      }
      for (int b = 31; b >= KLOW; --b) {
#pragma unroll
        for (int li = 0; li < 4; ++li) {
          unsigned cand = T[li] | (1u << b);
          int cnt = __popcll(__ballot(k0[li] >= cand)) + __popcll(__ballot(k1[li] >= cand));
          if (cnt >= 16) T[li] = cand;
        }
      }
#pragma unroll
      for (int li = 0; li < 4; ++li) {
        const int Lx = w * 4 + li;
        const unsigned T2 = T[li] + (1u << KLOW);
        bool g0 = k0[li] >= T2, g1 = k1[li] >= T2;
        bool q0 = (k0[li] >= T[li]) && !g0, q1 = (k1[li] >= T[li]) && !g1;
        unsigned long long mg0 = __ballot(g0), mg1 = __ballot(g1), mq0 = __ballot(q0), mq1 = __ballot(q1);
        int ng0 = __popcll(mg0), ng = ng0 + __popcll(mg1);
        int p0 = g0 ? __popcll(mg0 & ltmask) : ng + __popcll(mq0 & ltmask);
        int p1 = g1 ? ng0 + __popcll(mg1 & ltmask) : ng + __popcll(mq0) + __popcll(mq1 & ltmask);
        if ((g0 || q0) && p0 < 16) { sv[Lx * 16 + p0] = v0[li]; si[Lx * 16 + p0] = lane; }
        if ((g1 || q1) && p1 < 16) { sv[Lx * 16 + p1] = v1[li]; si[Lx * 16 + p1] = lane + 64; }
      }
    }
    __builtin_amdgcn_wave_barrier();
    {
      const int Lx = w * 4 + (lane >> 4), e = lane & 15;
      const float v = sv[Lx * 16 + e];
      const int id = si[Lx * 16 + e];
      int rank = 0;
#pragma unroll
      for (int q = 0; q < 4; ++q) {
        float4 o = *reinterpret_cast<const float4*>(sv + Lx * 16 + q * 4);
        rank += (o.x > v || (o.x == v && q * 4 + 0 < e)) ? 1 : 0;
        rank += (o.y > v || (o.y == v && q * 4 + 1 < e)) ? 1 : 0;
        rank += (o.z > v || (o.z == v && q * 4 + 2 < e)) ? 1 : 0;
        rank += (o.w > v || (o.w == v && q * 4 + 3 < e)) ? 1 : 0;
      }
      __builtin_amdgcn_wave_barrier();
      svs[Lx * 16 + rank] = v; sis[Lx * 16 + rank] = id;
    }
    __builtin_amdgcn_wave_barrier();
    {
      float cv[2]; unsigned ck[2], T[2]; int ce[2];
      const int cij = (lane < 50) ? (int)CAND_IJ[lane] : 0;
      const int ci = cij >> 4, cj = cij & 15;
#pragma unroll
      for (int hi = 0; hi < 2; ++hi) {
        const int h = w * 2 + hi;
        T[hi] = 0;
        cv[hi] = svs[(2 * h) * 16 + ci] + svs[(2 * h + 1) * 16 + cj];
        ce[hi] = sis[(2 * h) * 16 + ci] * 128 + sis[(2 * h + 1) * 16 + cj];
        ck[hi] = (lane < 50) ? fkey(cv[hi]) : 0u;
      }
      for (int b = 31; b >= KLOW; --b) {
#pragma unroll
        for (int hi = 0; hi < 2; ++hi) {
          unsigned cand = T[hi] | (1u << b);
          int cnt = __popcll(__ballot(ck[hi] >= cand));
          if (cnt >= 16) T[hi] = cand;
        }
      }
#pragma unroll
      for (int hi = 0; hi < 2; ++hi) {
        const int h = w * 2 + hi;
        const unsigned T2 = T[hi] + (1u << KLOW);
        bool g = ck[hi] >= T2, q = (ck[hi] >= T[hi]) && !g && (lane < 50);
        unsigned long long mg = __ballot(g), mq = __ballot(q);
        int p = g ? __popcll(mg & ltmask) : __popcll(mg) + __popcll(mq & ltmask);
        if ((g || q) && p < 16) { tops[h * 16 + p] = cv[hi]; tope[h * 16 + p] = ce[hi]; }
      }
    }
    __syncthreads();
    if (tid < 128) {
      float s = tops[tid];
      float mx = s;
      mx = fmaxf(mx, __shfl_xor(mx, 1)); mx = fmaxf(mx, __shfl_xor(mx, 2));
      mx = fmaxf(mx, __shfl_xor(mx, 4)); mx = fmaxf(mx, __shfl_xor(mx, 8));
      float e = __expf(s - mx);
      float sm = e;
      sm += __shfl_xor(sm, 1); sm += __shfl_xor(sm, 2); sm += __shfl_xor(sm, 4); sm += __shfl_xor(sm, 8);
      tops[tid] = e / sm;
    }
    __syncthreads();
    f32x2 xv[8];
    {
      const float4* xp = reinterpret_cast<const float4*>(xr + lane * 16);
#pragma unroll
      for (int q = 0; q < 4; ++q) {
        float4 a = xp[q];
        xv[2 * q] = f32x2{a.x, a.y}; xv[2 * q + 1] = f32x2{a.z, a.w};
      }
    }
    f32x2 oacc[8];
#pragma unroll
    for (int q = 0; q < 8; ++q) oacc[q] = f32x2{0.f, 0.f};
#pragma unroll 1
    for (int p0 = 0; p0 < 32; p0 += 8) {
      uint4 ru[8], rv[8];
#pragma unroll
      for (int i = 0; i < 8; ++i) {
        int e = tope[w * 32 + p0 + i];
        ru[i] = *reinterpret_cast<const uint4*>(UT + (long)e * 1024 + lane * 16);
        rv[i] = *reinterpret_cast<const uint4*>(VTb + (long)e * 1024 + lane * 16);
      }
      float dsum[8];
#pragma unroll
      for (int i = 0; i < 8; ++i) {
        f32x2 f[8];
        dec16(ru[i], f);
        f32x2 acc = f[0] * xv[0];
#pragma unroll
        for (int q = 1; q < 8; ++q) acc = __builtin_elementwise_fma(f[q], xv[q], acc);
        dsum[i] = acc.x + acc.y;
      }
      float e4[4], e2[2], e1;
      {
        const bool hi = (lane & 32) != 0;
#pragma unroll
        for (int i = 0; i < 4; ++i) {
          float snd = hi ? dsum[i] : dsum[i + 4];
          float kp = hi ? dsum[i + 4] : dsum[i];
          e4[i] = kp + __shfl_xor(snd, 32);
        }
        const bool hi2 = (lane & 16) != 0;
#pragma unroll
        for (int i = 0; i < 2; ++i) {
          float snd = hi2 ? e4[i] : e4[i + 2];
          float kp = hi2 ? e4[i + 2] : e4[i];
          e2[i] = kp + __shfl_xor(snd, 16);
        }
        const bool hi3 = (lane & 8) != 0;
        {
          float snd = hi3 ? e2[0] : e2[1];
          float kp = hi3 ? e2[1] : e2[0];
          e1 = kp + __shfl_xor(snd, 8);
        }
        e1 += __shfl_xor(e1, 4); e1 += __shfl_xor(e1, 2); e1 += __shfl_xor(e1, 1);
      }
      {
        int r = ((lane >> 5) & 1) * 4 + ((lane >> 4) & 1) * 2 + ((lane >> 3) & 1);
        float wv_ = tops[w * 32 + p0 + r] * geluf_(e1 * (1.f / U_SCALE)) * (1.f / V_SCALE);
        if ((lane & 7) == 0) wgt[w * 32 + p0 + r] = wv_;
      }
      __builtin_amdgcn_wave_barrier();
      float wg[8];
      {
        float4 wa = *reinterpret_cast<const float4*>(wgt + w * 32 + p0);
        float4 wb = *reinterpret_cast<const float4*>(wgt + w * 32 + p0 + 4);
        wg[0] = wa.x; wg[1] = wa.y; wg[2] = wa.z; wg[3] = wa.w; wg[4] = wb.x; wg[5] = wb.y; wg[6] = wb.z; wg[7] = wb.w;
      }
#pragma unroll
      for (int i = 0; i < 8; ++i) {
        f32x2 f[8];
        dec16(rv[i], f);
        f32x2 wv = f32x2{wg[i], wg[i]};
#pragma unroll
        for (int q = 0; q < 8; ++q) oacc[q] = __builtin_elementwise_fma(f[q], wv, oacc[q]);
      }
    }
    {
      float4* rwp = reinterpret_cast<float4*>(red + w * 1024 + lane * 16);
#pragma unroll
      for (int q = 0; q < 4; ++q) rwp[q] = make_float4(oacc[2 * q].x, oacc[2 * q].y, oacc[2 * q + 1].x, oacc[2 * q + 1].y);
    }
    __syncthreads();
    const int c = tid * 4;
    float y[4];
    {
      float4 xx = *reinterpret_cast<const float4*>(xr + c);
      float4 r0 = *reinterpret_cast<const float4*>(red + c);
      float4 r1 = *reinterpret_cast<const float4*>(red + 1024 + c);
      float4 r2 = *reinterpret_cast<const float4*>(red + 2048 + c);
      float4 r3 = *reinterpret_cast<const float4*>(red + 3072 + c);
      y[0] = ALPHA * xx.x + (r0.x + r1.x + r2.x + r3.x);
      y[1] = ALPHA * xx.y + (r0.y + r1.y + r2.y + r3.y);
      y[2] = ALPHA * xx.z + (r0.z + r1.z + r2.z + r3.z);
      y[3] = ALPHA * xx.w + (r0.w + r1.w + r2.w + r3.w);
    }
    float s = wave_sum(y[0] + y[1] + y[2] + y[3]);
    if (lane == 0) stat[w] = s;
    __syncthreads();
    float mu = (stat[0] + stat[1] + stat[2] + stat[3]) * (1.f / 1024.f);
    float ss = 0.f;
#pragma unroll
    for (int i = 0; i < 4; ++i) { float dl = y[i] - mu; ss += dl * dl; }
    ss = wave_sum(ss);
    if (lane == 0) stat[4 + w] = ss;
    __syncthreads();
    float rs = rsqrtf((stat[4] + stat[5] + stat[6] + stat[7]) * (1.f / 1024.f) + 1e-5f);
    float o[4];
#pragma unroll
    for (int i = 0; i < 4; ++i) o[i] = (y[i] - mu) * rs * g2[c + i] + b2[c + i];
    *reinterpret_cast<float4*>(xr + c) = make_float4(o[0], o[1], o[2], o[3]);
    store4bf(xb + (long)it * 1024 + c, o);
  }
}

#define XB_TMO      128
#define XB_XCNT(j)  (256  + 64 * (j))
#define XB_XSUB(j)  (1280 + 64 * (j))
#define XB_XGEN(j)  (2304 + 64 * (j))
#define XB_TOP      3328
#define XB_TOPGEN   3392
#define XCD_BAR_WORDS 3456
#define XB_SPIN_CAP (1u << 18)
DEVI unsigned xb_ld(unsigned* p) { return __hip_atomic_load(p, __ATOMIC_RELAXED, __HIP_MEMORY_SCOPE_AGENT); }
DEVI unsigned xb_add(unsigned* p, unsigned v) { return __hip_atomic_fetch_add(p, v, __ATOMIC_RELAXED, __HIP_MEMORY_SCOPE_AGENT); }
DEVI unsigned xb_xcc_id() { return (unsigned)__builtin_amdgcn_s_getreg((3 << 11) | 20) & 0xFu; }
#define XB_SPIN(cond, bar) do { unsigned _sp = 0; while (cond) { __builtin_amdgcn_s_sleep(1); \
    if ((++_sp & 255u) == 0u) { if (xb_ld(&(bar)[XB_TMO])) break; if (_sp > XB_SPIN_CAP) { atomicAdd(&(bar)[XB_TMO], 1u); break; } } } } while (0)
DEVI void xcd_census(unsigned* bar, unsigned x, unsigned& nloc, unsigned& nx) {
  const unsigned G = gridDim.x;
  unsigned sum, cnt, mine, sp = 0u;
  for (;;) {
    sum = 0u; cnt = 0u; mine = 0u;
#pragma unroll
    for (unsigned j = 0; j < 16; ++j) { const unsigned c = xb_ld(&bar[XB_XCNT(j)]); sum += c; cnt += (c > 0u) ? 1u : 0u; mine = (j == x) ? c : mine; }
    if (sum == G) break;
    __builtin_amdgcn_s_sleep(1);
    if ((++sp & 255u) == 0u) { if (xb_ld(&bar[XB_TMO])) break; if (sp > XB_SPIN_CAP) { atomicAdd(&bar[XB_TMO], 1u); break; } }
  }
  nloc = mine > 0u ? mine : 1u; nx = cnt > 0u ? cnt : 1u;
}
DEVI void xcd_barrier(unsigned* bar, unsigned x, unsigned nloc, unsigned nx) {
  asm volatile("s_waitcnt vmcnt(0)" ::: "memory");
  __syncthreads();
  if (threadIdx.x == 0) {
    __builtin_amdgcn_s_waitcnt(0);
    const unsigned old = xb_add(&bar[XB_XSUB(x)], 1u);
    const unsigned gen = old / nloc;
    if (old + 1u == (gen + 1u) * nloc) {
      __builtin_amdgcn_fence(__ATOMIC_RELEASE, "agent");
      asm volatile("s_waitcnt vmcnt(0)" ::: "memory");
      const unsigned og = xb_add(&bar[XB_TOP], 1u);
      const unsigned tg = og / nx;
      if (og + 1u == (tg + 1u) * nx) xb_add(&bar[XB_TOPGEN], 1u);
      else XB_SPIN(xb_ld(&bar[XB_TOPGEN]) == tg, bar);
      __builtin_amdgcn_fence(__ATOMIC_ACQUIRE, "agent");
      xb_add(&bar[XB_XGEN(x)], 1u);
      asm volatile("s_waitcnt vmcnt(0)" ::: "memory");
    } else {
      XB_SPIN(xb_ld(&bar[XB_XGEN(x)]) == gen, bar);
      __builtin_amdgcn_fence(__ATOMIC_ACQUIRE, "agent");
      asm volatile("s_waitcnt vmcnt(0)" ::: "memory");
    }
  }
  __syncthreads();
}

__global__ void __launch_bounds__(256, 2) fwd_megakernel(Params P) {
  __shared__ __attribute__((aligned(16))) char smem[65536];
  cg::grid_group grid = cg::this_grid();
  unsigned* bar = (unsigned*)(P.ws + O_BAR);
  const unsigned xcc = xb_xcc_id();
  if (threadIdx.x == 0) (void)xb_add(&bar[XB_XCNT(xcc)], 1u);
  unsigned nloc = 1u, nx = 1u;
#define LND asm volatile("" : "+s"(l), "+s"(pass))
#define GSYNC xcd_barrier(bar, xcc, nloc, nx)
#pragma unroll 1
  for (int l = 0; l < 2; ++l) {
    phase_prep(P, l, smem);
    if (l == 0) {
      phase_xcopy(P);
      grid.sync();
      if (threadIdx.x == 0) xcd_census(bar, xcc, nloc, nx);
    } else {
      GSYNC;
    }
#pragma unroll 1
    for (int pass = 0; pass < 2; ++pass) {
      LND; phase_inproj(P, l, pass, smem); GSYNC;
      LND; phase2(P, l, pass, smem); GSYNC;
      LND; phase3(P, l, pass, smem); GSYNC;
      LND; phase4(P, l, pass, smem); GSYNC;
      LND; phase6(P, l, pass, smem); GSYNC;
      LND; phase7(P, l, pass, smem); GSYNC;
      LND; phase8(P, l, pass); GSYNC;
      LND; phase9(P, l, pass, smem); GSYNC;
      LND; phase11(P, l, pass, smem); if (!(l == 1 && pass == 1)) GSYNC;
    }
  }
}

extern "C" void kernel_launch(void* const* d_in, const int* in_sizes, int n_in, void* d_out, int out_size,
                              void* d_ws, size_t ws_size, hipStream_t stream) {
  static int grid_blocks = 0;
  if (!grid_blocks) {
    int dev = 0, cus = 0, per_cu = 0;
    hipGetDevice(&dev);
    hipDeviceGetAttribute(&cus, hipDeviceAttributeMultiprocessorCount, dev);
    hipOccupancyMaxActiveBlocksPerMultiprocessor(&per_cu, fwd_megakernel, 256, 0);
    if (per_cu > 2) per_cu = 2;
    if (per_cu < 1) per_cu = 1;
    grid_blocks = cus * per_cu;
  }
  if (ws_size < O_END) fprintf(stderr, "workspace too small: %zu < %zu\n", ws_size, (size_t)O_END);
  hipMemsetAsync((char*)d_ws + O_BAR, 0, 16384, stream);
  Params p{};
  for (int i = 0; i < 30; ++i) p.in[i] = (const float*)d_in[i];
  p.out = (float*)d_out;
  p.ws = (char*)d_ws;
  void* args[] = {&p};
  hipError_t e = hipLaunchCooperativeKernel((void*)fwd_megakernel, dim3(grid_blocks), dim3(256), args, 0, stream);
  if (e != hipSuccess) fprintf(stderr, "cooperative launch failed: %s (grid %d)\n", hipGetErrorString(e), grid_blocks);
}
```

```cpp
#include <hip/hip_runtime.h>
#include <hip/hip_bf16.h>
#include <hip/hip_cooperative_groups.h>
#include <cstdio>
namespace cg = cooperative_groups;

typedef unsigned short bfu;
using bf16x8 = __attribute__((ext_vector_type(8))) short;
using f32x4 = __attribute__((ext_vector_type(4))) float;
#define DEVI __device__ __forceinline__

constexpr float ALPHA = 1.41421356237f;
constexpr int NCOL = 12288;

constexpr size_t O_WIN = 0;
constexpr size_t O_WOA = O_WIN + 25165824;
constexpr size_t O_WOB = O_WOA + 2097152;
constexpr size_t O_WOC = O_WOB + 2097152;
constexpr size_t O_WO = O_WOC + 2097152;
constexpr size_t O_WQ = O_WO + 2097152;
constexpr size_t O_KEYS = O_WQ + 4194304;
constexpr size_t O_LRU = O_KEYS + 524288;
constexpr size_t O_UTB = O_LRU + 524288;
constexpr size_t O_VTB = O_UTB + 33554432;
constexpr size_t O_LBS = O_VTB + 33554432;
constexpr size_t O_XB = O_LBS + 8192;
constexpr size_t O_Z = O_XB + 34078720;
constexpr size_t O_UA = O_Z + 207618048;
constexpr size_t O_UB = O_UA + 17301504;
constexpr size_t O_UC = O_UB + 17301504;
constexpr size_t O_CB = O_UC + 17301504;
constexpr size_t O_AU = O_CB + 17301504;
constexpr size_t O_LSUM = O_AU + 69206016;
constexpr size_t O_US = O_LSUM + 540672;
constexpr size_t O_DEC = O_US + 33554432;
constexpr size_t O_BAR = O_DEC + 524288;
constexpr size_t O_END = O_BAR + 16384;
constexpr size_t O_PRE = O_Z;
constexpr size_t O_QP = O_Z + 34603008;
constexpr size_t O_SC = O_QP + 34603008;

constexpr long OUT_YS = 16777216;
constexpr long OUT_CAP = 17039360;
constexpr long OUT_CBP = 17055744;
constexpr long OUT_LRP = 17080320;
constexpr long OUT_HGP = 17088512;
constexpr long OUT_CAS = 18137088;
constexpr long OUT_CBS = 18169856;
constexpr long OUT_LRS = 18219008;
constexpr long OUT_HGS = 18235392;

struct Params {
  const float* in[30];
  float* out;
  char* ws;
};

DEVI bfu f2b(float f) {
  unsigned u = __float_as_uint(f);
  u += 0x7FFFu + ((u >> 16) & 1u);
  return (bfu)(u >> 16);
}
DEVI float b2f(bfu b) { return __uint_as_float(((unsigned)b) << 16); }
DEVI float sigmoidf_(float x) { return 1.f / (1.f + __expf(-x)); }
DEVI float siluf_(float x) { return x / (1.f + __expf(-x)); }
DEVI float geluf_(float x) { return 0.5f * x * (1.f + erff(x * 0.70710678118f)); }
DEVI float wave_sum(float v) {
#pragma unroll
  for (int o = 32; o; o >>= 1) v += __shfl_xor(v, o);
  return v;
}

DEVI char* wsp(const Params& P, size_t off) { asm volatile("" : "+s"(off)); return P.ws + off; }
DEVI int ltid() { int t = threadIdx.x; asm volatile("" : "+v"(t)); return t; }
struct TokInfo { int sample, seq, t; };
DEVI TokInfo tokinfo(int it) {
  TokInfo r;
  if (it < 8192) { r.sample = 0; r.seq = it >> 12; r.t = it & 4095; }
  else if (it < 8448) { int q = it - 8192; r.sample = 1; r.seq = q >> 5; r.t = q & 31; }
  else { int q = it - 8448; r.sample = 0; r.seq = 2 + (q >> 12); r.t = q & 4095; }
  return r;
}
DEVI float* xrow(const Params& P, int it) {
  TokInfo ti = tokinfo(it);
  return ti.sample ? P.out + OUT_YS + (long)(ti.seq * 32 + ti.t) * 1024
                   : P.out + (long)(ti.seq * 4096 + ti.t) * 1024;
}

DEVI void stage_tile(const bfu* __restrict__ g, int ld, int k0, char* lds, int tid) {
#pragma unroll
  for (int i = 0; i < 4; ++i) {
    int b = tid * 16 + i * 4096;
    int r = b >> 7, cp = (b >> 4) & 7, gc = cp ^ (r & 7);
    __builtin_amdgcn_global_load_lds((const unsigned*)(g + (long)r * ld + k0 + gc * 8),
                                     (unsigned*)(lds + b), 16, 0, 0);
  }
}
DEVI bf16x8 ldfrag(const char* tile, int r, int kc) {
  return *reinterpret_cast<const bf16x8*>(tile + r * 128 + ((kc ^ (r & 7)) << 4));
}
DEVI void stage_tile_gate(const bfu* __restrict__ Wa, const bfu* __restrict__ Wx, int k0, char* lds, int tid) {
#pragma unroll
  for (int i = 0; i < 4; ++i) {
    int b = tid * 16 + i * 4096;
    int r = b >> 7, cp = (b >> 4) & 7, gc = cp ^ (r & 7);
    const bfu* base = (r & 32) ? Wx : Wa;
    int c = (r >> 6) * 32 + (r & 31);
    __builtin_amdgcn_global_load_lds((const unsigned*)(base + (long)c * 128 + k0 + gc * 8),
                                     (unsigned*)(lds + b), 16, 0, 0);
  }
}
template <int GATE>
DEVI void gemm_core_t(f32x4 (&acc)[4][4], const bfu* __restrict__ A, int lda,
                    const bfu* __restrict__ B, int ldb, int K, char* smem, int tid, const bfu* __restrict__ B2 = nullptr) {
  const int wid = tid >> 6, lane = tid & 63;
  const int wr = wid >> 1, wc = wid & 1, fr = lane & 15, fq = lane >> 4;
  const int nt = K >> 6;
  __syncthreads();
  stage_tile(A, lda, 0, smem, tid);
  if (GATE) stage_tile_gate(B, B2, 0, smem + 16384, tid); else stage_tile(B, ldb, 0, smem + 16384, tid);
  for (int t = 0; t < nt; ++t) {
    asm volatile("s_waitcnt vmcnt(0)" ::: "memory");
    __syncthreads();
    char* cur = smem + (t & 1) * 32768;
    if (t + 1 < nt) {
      char* nx = smem + ((t + 1) & 1) * 32768;
      stage_tile(A, lda, (t + 1) * 64, nx, tid);
      if (GATE) stage_tile_gate(B, B2, (t + 1) * 64, nx + 16384, tid); else stage_tile(B, ldb, (t + 1) * 64, nx + 16384, tid);
    }
#pragma unroll
    for (int kk = 0; kk < 2; ++kk) {
      bf16x8 af[4], bfr[4];
#pragma unroll
      for (int m = 0; m < 4; ++m) af[m] = ldfrag(cur, wr * 64 + m * 16 + fr, kk * 4 + fq);
#pragma unroll
      for (int n = 0; n < 4; ++n) bfr[n] = ldfrag(cur + 16384, wc * 64 + n * 16 + fr, kk * 4 + fq);
#pragma unroll
      for (int m = 0; m < 4; ++m)
#pragma unroll
        for (int n = 0; n < 4; ++n)
          acc[m][n] = __builtin_amdgcn_mfma_f32_16x16x32_bf16(af[m], bfr[n], acc[m][n], 0, 0, 0);
    }
  }
}
DEVI void gemm_core(f32x4 (&acc)[4][4], const bfu* __restrict__ A, int lda,
                    const bfu* __restrict__ B, int ldb, int K, char* smem, int tid) {
  gemm_core_t<0>(acc, A, lda, B, ldb, K, smem, tid);
}
DEVI void tile_rc(int id, int nM, int nN, int& pm, int& pn) {
  const int x = id & 7, q = id >> 3;
  const int gfull = nM >> 3;
  const int g = q / nN;
  if (g < gfull) {
    int r = q - g * nN;
    pn = (r >> 3) * 8 + x;
    pm = g * 8 + (r & 7);
  } else {
    int gsz = nM - gfull * 8;
    int r = q - gfull * nN;
    pn = (r / gsz) * 8 + x;
    pm = gfull * 8 + (r % gsz);
  }
}
DEVI void tile_rc_m(int id, int nM, int nN, int& pm, int& pn) {
  const int gfull = nM >> 3;
  const int nfull = gfull * 8 * nN;
  if (id < nfull) {
    const int x = id & 7, q = id >> 3;
    const int g = q / nN;
    pn = q - g * nN;
    pm = g * 8 + x;
  } else {
    const int r = id - nfull;
    pm = gfull * 8 + r / nN;
    pn = r % nN;
  }
}
#define ZERO_ACC(a) _Pragma("unroll") for (int m_ = 0; m_ < 4; ++m_) _Pragma("unroll") for (int n_ = 0; n_ < 4; ++n_) a[m_][n_] = f32x4{0.f, 0.f, 0.f, 0.f}
#define EPI_LOOP \
  const int wid_ = tid >> 6, lane_ = tid & 63; \
  const int wr_ = wid_ >> 1, wc_ = wid_ & 1, fr_ = lane_ & 15, fq_ = lane_ >> 4; \
  _Pragma("unroll") for (int m = 0; m < 4; ++m) for (int sb_ = (__builtin_amdgcn_sched_barrier(0), 0); sb_ < 1; ++sb_) _Pragma("unroll") for (int n = 0; n < 4; ++n) _Pragma("unroll") for (int j = 0; j < 4; ++j)
#define EPI_ROW (wr_ * 64 + m * 16 + fq_ * 4 + j)
#define EPI_COL (wc_ * 64 + n * 16 + fr_)

DEVI void epi_stage_f32(const f32x4 (&acc)[4][4], char* smem, int tid) {
  const int wid = tid >> 6, lane = tid & 63, wr = wid >> 1, wc = wid & 1, fr = lane & 15, fq = lane >> 4;
  float* T = reinterpret_cast<float*>(smem);
  __syncthreads();
#pragma unroll
  for (int m = 0; m < 4; ++m)
#pragma unroll
    for (int n = 0; n < 4; ++n)
#pragma unroll
      for (int j = 0; j < 4; ++j)
        T[(wr * 64 + m * 16 + fq * 4 + j) * 128 + wc * 64 + n * 16 + fr] = acc[m][n][j];
  __syncthreads();
}
DEVI void epi_store_bf16(const f32x4 (&acc)[4][4], const float* colbias, bfu* dst, long ld, char* smem, int tid) {
  const int wid = tid >> 6, lane = tid & 63, wr = wid >> 1, wc = wid & 1, fr = lane & 15, fq = lane >> 4;
  bfu* T = reinterpret_cast<bfu*>(smem);
  __syncthreads();
#pragma unroll
  for (int n = 0; n < 4; ++n) {
    const int col = wc * 64 + n * 16 + fr;
    const float bias = colbias ? colbias[col] : 0.f;
#pragma unroll
    for (int m = 0; m < 4; ++m)
#pragma unroll
      for (int j = 0; j < 4; ++j)
        T[(wr * 64 + m * 16 + fq * 4 + j) * 136 + col] = f2b(acc[m][n][j] + bias);
  }
  __syncthreads();
#pragma unroll
  for (int q = 0; q < 8; ++q) {
    const int id = tid + 256 * q, row = id >> 4, c16 = id & 15;
    uint4 v = *reinterpret_cast<const uint4*>(T + row * 136 + c16 * 8);
    *reinterpret_cast<uint4*>(dst + (long)row * ld + c16 * 8) = v;
  }
}

DEVI void transpose_tile(const float* __restrict__ src, bfu* __restrict__ dst, int R, int C, int r0, int c0, float* tile, int tid) {
  __syncthreads();
  {
    int tx = tid & 15, ty = tid >> 4;
#pragma unroll
    for (int i = 0; i < 4; ++i) {
      int r = ty + i * 16;
      float4 v = *reinterpret_cast<const float4*>(src + (long)(r0 + r) * C + c0 + tx * 4);
      float* tp = tile + r * 65 + tx * 4;
      tp[0] = v.x; tp[1] = v.y; tp[2] = v.z; tp[3] = v.w;
    }
  }
  __syncthreads();
  {
    int c = tid >> 2, rs = (tid & 3) * 16;
    unsigned pk[8];
#pragma unroll
    for (int i = 0; i < 8; ++i) {
      unsigned lo = f2b(tile[(rs + 2 * i) * 65 + c]);
      unsigned hi = f2b(tile[(rs + 2 * i + 1) * 65 + c]);
      pk[i] = lo | (hi << 16);
    }
    uint4* dp = reinterpret_cast<uint4*>(dst + (long)(c0 + c) * R + r0 + rs);
    dp[0] = make_uint4(pk[0], pk[1], pk[2], pk[3]);
    dp[1] = make_uint4(pk[4], pk[5], pk[6], pk[7]);
  }
}
DEVI void convert_chunk(const float* __restrict__ src, bfu* __restrict__ dst, int tid) {
  int o = tid * 8;
  float4 a = *reinterpret_cast<const float4*>(src + o);
  float4 b = *reinterpret_cast<const float4*>(src + o + 4);
  uint4 r;
  r.x = f2b(a.x) | ((unsigned)f2b(a.y) << 16);
  r.y = f2b(a.z) | ((unsigned)f2b(a.w) << 16);
  r.z = f2b(b.x) | ((unsigned)f2b(b.y) << 16);
  r.w = f2b(b.z) | ((unsigned)f2b(b.w) << 16);
  *reinterpret_cast<uint4*>(dst + o) = r;
}

typedef float f32x2 __attribute__((ext_vector_type(2)));
constexpr float U_SCALE = 64.f, V_SCALE = 8.f;
DEVI void convert_chunk_fp8(const float* __restrict__ src, unsigned char* __restrict__ dst, float scale, int tid) {
  int o = tid * 16;
  uint4 r;
  unsigned rr[4];
#pragma unroll
  for (int q = 0; q < 4; ++q) {
    float4 a = *reinterpret_cast<const float4*>(src + o + q * 4);
    int p = __builtin_amdgcn_cvt_pk_fp8_f32(a.x * scale, a.y * scale, 0, false);
    p = __builtin_amdgcn_cvt_pk_fp8_f32(a.z * scale, a.w * scale, p, true);
    rr[q] = (unsigned)p;
  }
  r = make_uint4(rr[0], rr[1], rr[2], rr[3]);
  *reinterpret_cast<uint4*>(dst + o) = r;
}

DEVI void phase_prep(const Params& P, int l, char* smem) {
  const int tid = ltid();
  char* ws = wsp(P, 0);
  float* tile = reinterpret_cast<float*>(smem);
  const int NT_WIN = 3072, NT_SQ = 256, NT_WQ = 512, NT_LRU = 64;
  const int T0 = NT_WIN, T1 = T0 + 4 * NT_SQ, T2 = T1 + NT_WQ, T3 = T2 + NT_LRU;
  const int C0 = T3 + 128, C1 = C0 + 4096, C2 = C1 + 4096;
  const int X0 = C2;
  const int L0 = X0 + (l == 0 ? 8 : 0);
  for (int id = blockIdx.x; id < L0; id += gridDim.x) {
    if (id < T0) {
      int tr = id / 192, tc = id % 192;
      transpose_tile(P.in[6] + (long)l * 1024 * 12288, (bfu*)(ws + O_WIN), 1024, 12288, tr * 64, tc * 64, tile, tid);
    } else if (id < T1) {
      int q = id - T0, w = q >> 8, t = q & 255;
      const float* src = P.in[18 + w] + (long)l * 1048576;
      bfu* dst = (bfu*)(ws + (w == 0 ? O_WOA : w == 1 ? O_WOB : w == 2 ? O_WOC : O_WO));
      transpose_tile(src, dst, 1024, 1024, (t >> 4) * 64, (t & 15) * 64, tile, tid);
    } else if (id < T2) {
      int q = id - T1;
      transpose_tile(P.in[24] + (long)l * 2097152, (bfu*)(ws + O_WQ), 1024, 2048, (q >> 5) * 64, (q & 31) * 64, tile, tid);
    } else if (id < T3) {
      int q = id - T2, mtx = q >> 2, t = q & 3, g = mtx >> 3, nb = mtx & 7;
      const float* src = P.in[g == 0 ? 11 : 13] + (long)l * 131072 + nb * 16384;
      transpose_tile(src, (bfu*)(ws + O_LRU) + mtx * 16384, 128, 128, (t >> 1) * 64, (t & 1) * 64, tile, tid);
    } else if (id < C0) {
      int q = id - T3;
      convert_chunk(P.in[25] + (long)l * 262144 + (long)q * 2048, (bfu*)(ws + O_KEYS) + (long)q * 2048, tid);
    } else if (id < C1) {
      int q = id - C0;
      convert_chunk_fp8(P.in[26] + (long)l * 16777216 + (long)q * 4096, (unsigned char*)(ws + O_UTB) + (long)q * 4096, U_SCALE, tid);
    } else if (id < C2) {
      int q = id - C1;
      convert_chunk_fp8(P.in[27] + (long)l * 16777216 + (long)q * 4096, (unsigned char*)(ws + O_VTB) + (long)q * 4096, V_SCALE, tid);
    } else {
      int q = id - X0;
      int c = (q & 3) * 256 + tid, ll = q >> 2;
      float a0 = P.in[16][c], a1 = P.in[16][1024 + c];
      float mx = fmaxf(a0, a1);
      float e0 = __expf(a0 - mx), e1 = __expf(a1 - mx);
      float p1 = e1 / (e0 + e1);
      float* lbs = (float*)(ws + O_LBS);
      lbs[ll * 1024 + c] = (ll == 0) ? 0.f : p1;
    }
  }
}

DEVI void phase_xcopy(const Params& P) {
  const int tid = ltid();
  bfu* xb = (bfu*)wsp(P, O_XB);
  for (int it = blockIdx.x; it < 16640; it += gridDim.x) {
    TokInfo ti = tokinfo(it);
    const float* src = ti.sample ? P.in[1] + (long)(ti.seq * 32 + ti.t) * 1024 : P.in[0] + (long)(ti.seq * 4096 + ti.t) * 1024;
    float* dst = xrow(P, it);
    int c = tid * 4;
    float4 v = *reinterpret_cast<const float4*>(src + c);
    *reinterpret_cast<float4*>(dst + c) = v;
    uint2 r;
    r.x = f2b(v.x) | ((unsigned)f2b(v.y) << 16);
    r.y = f2b(v.z) | ((unsigned)f2b(v.w) << 16);
    *reinterpret_cast<uint2*>(xb + (long)it * 1024 + c) = r;
  }
}

DEVI void phase_inproj(const Params& P, int l, int pass, char* smem) {
  const int tid = ltid();
  const int ntok = pass ? 8192 : 8448, base = pass ? 8448 : 0;
  const int nM = ntok / 128, nN = 96;
  const bfu* xb = (const bfu*)wsp(P, O_XB) + (long)base * 1024;
  const bfu* wT = (const bfu*)wsp(P, O_WIN);
  bfu* z = (bfu*)wsp(P, O_Z);
  const float* bin = P.in[7] + l * NCOL;
  for (int id = blockIdx.x; id < nM * nN; id += gridDim.x) {
    int pm, pn; tile_rc(id, nM, nN, pm, pn);
    f32x4 acc[4][4]; ZERO_ACC(acc);
    gemm_core(acc, xb + (long)pm * 128 * 1024, 1024, wT + (long)pn * 128 * 1024, 1024, 1024, smem, tid);
    epi_store_bf16(acc, bin + pn * 128, z + (long)pm * 128 * NCOL + pn * 128, NCOL, smem, tid);
  }
}

DEVI void load4bf(const bfu* p, float (&o)[4]) {
  uint2 v = *reinterpret_cast<const uint2*>(p);
  o[0] = __uint_as_float(v.x << 16); o[1] = __uint_as_float(v.x & 0xFFFF0000u);
  o[2] = __uint_as_float(v.y << 16); o[3] = __uint_as_float(v.y & 0xFFFF0000u);
}
DEVI void store4bf(bfu* p, const float (&v)[4]) {
  uint2 r;
  r.x = f2b(v[0]) | ((unsigned)f2b(v[1]) << 16);
  r.y = f2b(v[2]) | ((unsigned)f2b(v[3]) << 16);
  *reinterpret_cast<uint2*>(p) = r;
}
DEVI void ld4f(const float* p, float (&o)[4]) {
  float4 v = *reinterpret_cast<const float4*>(p);
  o[0] = v.x; o[1] = v.y; o[2] = v.z; o[3] = v.w;
}
DEVI void mixab_row4(const Params& P, int l, int base, int lt0, int tid) {
  const int it0 = base + lt0;
  const TokInfo ti = tokinfo(it0);
  const int T = ti.sample ? 32 : 4096;
  const int t0 = ti.t;
  const bfu* z = (const bfu*)(P.ws + O_Z);
  const int c = tid * 4;
  {
    float pk[6][4], ab[4][4], wa[3][4];
#pragma unroll
    for (int k = 0; k < 6; ++k) {
      const int tt = t0 - 2 + k;
      if (tt >= 0) {
        const bfu* zr = z + (long)(lt0 - 2 + k) * NCOL;
        float ac[4], ax[4];
        load4bf(zr + 1024 + c, ac); load4bf(zr + 2048 + c, ax);
#pragma unroll
        for (int i = 0; i < 4; ++i) pk[k][i] = ac[i] * ax[i];
      } else if (ti.sample) {
        ld4f(P.in[2] + ((long)(l * 8 + ti.seq) * 2 + (tt + 2)) * 1024 + c, pk[k]);
      } else {
#pragma unroll
        for (int i = 0; i < 4; ++i) pk[k][i] = 0.f;
      }
    }
#pragma unroll
    for (int r = 0; r < 4; ++r) load4bf(z + (long)(lt0 + r) * NCOL + c, ab[r]);
#pragma unroll
    for (int k = 0; k < 3; ++k) ld4f(P.in[8] + (long)(l * 3 + k) * 1024 + c, wa[k]);
#pragma unroll
    for (int r = 0; r < 4; ++r) {
      float o[4];
#pragma unroll
      for (int i = 0; i < 4; ++i) o[i] = ab[r][i] * (wa[0][i] * pk[r][i] + wa[1][i] * pk[r + 1][i] + wa[2][i] * pk[r + 2][i]);
      store4bf((bfu*)(P.ws + O_UA) + (long)(lt0 + r) * 1024 + c, o);
    }
    if (t0 + 4 == T) {
      float* ca = ti.sample ? P.out + OUT_CAS + (long)(l * 8 + ti.seq) * 2 * 1024 + c : P.out + OUT_CAP + (long)(l * 4 + ti.seq) * 2 * 1024 + c;
#pragma unroll
      for (int r = 0; r < 2; ++r)
        *reinterpret_cast<float4*>(ca + r * 1024) = make_float4(pk[r + 4][0], pk[r + 4][1], pk[r + 4][2], pk[r + 4][3]);
    }
  }
  __builtin_amdgcn_sched_barrier(0);
  {
    float xk[7][4], wb[4][4], bb[4];
#pragma unroll
    for (int k = 0; k < 7; ++k) {
      const int tt = t0 - 3 + k;
      if (tt >= 0) {
        load4bf(z + (long)(lt0 - 3 + k) * NCOL + 3072 + c, xk[k]);
      } else if (ti.sample) {
        ld4f(P.in[3] + ((long)(l * 8 + ti.seq) * 3 + (tt + 3)) * 1024 + c, xk[k]);
      } else {
#pragma unroll
        for (int i = 0; i < 4; ++i) xk[k][i] = 0.f;
      }
    }
#pragma unroll
    for (int k = 0; k < 4; ++k) ld4f(P.in[9] + (long)(l * 4 + k) * 1024 + c, wb[k]);
    ld4f(P.in[10] + (long)l * 1024 + c, bb);
#pragma unroll
    for (int r = 0; r < 4; ++r) {
      float o2[4];
#pragma unroll
      for (int i = 0; i < 4; ++i)
        o2[i] = wb[0][i] * xk[r][i] + wb[1][i] * xk[r + 1][i] + wb[2][i] * xk[r + 2][i] + wb[3][i] * xk[r + 3][i] + bb[i];
      store4bf((bfu*)(P.ws + O_CB) + (long)(lt0 + r) * 1024 + c, o2);
    }
    if (t0 + 4 == T) {
      float* cbp = ti.sample ? P.out + OUT_CBS + (long)(l * 8 + ti.seq) * 3 * 1024 + c : P.out + OUT_CBP + (long)(l * 4 + ti.seq) * 3 * 1024 + c;
#pragma unroll
      for (int r = 0; r < 3; ++r)
        *reinterpret_cast<float4*>(cbp + r * 1024) = make_float4(xk[r + 4][0], xk[r + 4][1], xk[r + 4][2], xk[r + 4][3]);
    }
  }
}

struct ChunkInfo { int lt0, L, sample, seqi, c; };
DEVI ChunkInfo chunkinfo(int ck) {
  ChunkInfo r;
  if (ck < 128) { r.seqi = ck >> 6; r.c = ck & 63; r.lt0 = r.seqi * 4096 + r.c * 64; r.L = 64; r.sample = 0; }
  else { r.seqi = ck - 128; r.c = 0; r.lt0 = 8192 + r.seqi * 32; r.L = 32; r.sample = 1; }
  return r;
}

DEVI void h1_item(const Params& P, int l, int ck, int h, char* smem, int tid) {
  const ChunkInfo ci = chunkinfo(ck);
  const int lane = tid & 63, w = tid >> 6, fr = lane & 15, fq = lane >> 4;
  bfu* VT = (bfu*)smem;
  bfu* KT = VT + 128 * 72;
  bfu* FS = KT + 128 * 72;
  float* tots = (float*)(smem + 54272);
  float* decl = tots + 256;
  const int d = tid & 127, hf = tid >> 7, L = ci.L, Lh = L >> 1;
  const float lb = ((const float*)(P.ws + O_LBS))[l * 1024 + h * 128 + d];
  const bfu* Z = (const bfu*)(P.ws + O_Z);
  const bfu* zfb = Z + (long)ci.lt0 * NCOL + 6 * 1024 + h * 128;
  const bfu* zib = Z + (long)ci.lt0 * NCOL + 7 * 1024 + h * 128;
  __syncthreads();
#pragma unroll 1
  for (int q0 = 0; q0 < 4; q0 += 2) {
    uint4 vf[2], vi[2];
#pragma unroll
    for (int qq = 0; qq < 2; ++qq) {
      const int idx = tid + 256 * (q0 + qq);
      const int sr = (idx & 15) | (((idx >> 8) & 3) << 4), c16 = ((idx >> 4) & 3) | (((idx >> 6) & 3) << 2);
      if (sr < L) {
        vf[qq] = *reinterpret_cast<const uint4*>(zfb + (long)sr * NCOL + c16 * 8);
        vi[qq] = *reinterpret_cast<const uint4*>(zib + (long)sr * NCOL + c16 * 8);
      } else { vf[qq] = make_uint4(0, 0, 0, 0); vi[qq] = make_uint4(0, 0, 0, 0); }
    }
#pragma unroll
    for (int qq = 0; qq < 2; ++qq) {
      const int idx = tid + 256 * (q0 + qq);
      const int sr = (idx & 15) | (((idx >> 8) & 3) << 4), c16 = ((idx >> 4) & 3) | (((idx >> 6) & 3) << 2);
      *reinterpret_cast<uint4*>(FS + sr * 136 + c16 * 8) = vf[qq];
      const unsigned vv[4] = {vi[qq].x, vi[qq].y, vi[qq].z, vi[qq].w};
#pragma unroll
      for (int i = 0; i < 4; ++i) {
        VT[(c16 * 8 + 2 * i) * 72 + sr] = (bfu)(vv[i] & 0xFFFFu);
        VT[(c16 * 8 + 2 * i + 1) * 72 + sr] = (bfu)(vv[i] >> 16);
      }
    }
  }
  __syncthreads();
  float tot = 0.f;
#pragma unroll 8
  for (int i = 0; i < Lh; ++i) {
    float f = lb + (1.f - lb) * sigmoidf_(b2f(FS[(hf * Lh + i) * 136 + d]));
    tot += __logf(f);
  }
  tots[hf * 128 + d] = tot;
  __syncthreads();
  float run = hf ? 0.f : tots[128 + d];
#pragma unroll 8
  for (int i = Lh - 1; i >= 0; --i) {
    const int sr = hf * Lh + i;
    float f = lb + (1.f - lb) * sigmoidf_(b2f(FS[sr * 136 + d]));
    KT[d * 72 + sr] = f2b((1.f - f) * __expf(run));
    run += __logf(f);
  }
  if (L == 32) {
    for (int sr = 32 + hf * 16; sr < 48 + hf * 16; ++sr) KT[d * 72 + sr] = 0;
  }
  if (hf == 0) {
    float dc = __expf(tots[d] + tots[128 + d]);
    decl[d] = dc;
    if (!ci.sample) ((float*)(P.ws + O_DEC))[((ci.seqi * 8 + h) * 64 + ci.c) * 128 + d] = dc;
  }
  __syncthreads();
  f32x4 acc[2][8];
#pragma unroll
  for (int mi = 0; mi < 2; ++mi)
#pragma unroll
    for (int n = 0; n < 8; ++n) acc[mi][n] = f32x4{0.f, 0.f, 0.f, 0.f};
#pragma unroll
  for (int kk = 0; kk < 2; ++kk) {
    bf16x8 a[2];
#pragma unroll
    for (int mi = 0; mi < 2; ++mi) a[mi] = *reinterpret_cast<const bf16x8*>(VT + ((2 * w + mi) * 16 + fr) * 72 + kk * 32 + fq * 8);
#pragma unroll
    for (int n = 0; n < 8; ++n) {
      bf16x8 b = *reinterpret_cast<const bf16x8*>(KT + (n * 16 + fr) * 72 + kk * 32 + fq * 8);
#pragma unroll
      for (int mi = 0; mi < 2; ++mi) acc[mi][n] = __builtin_amdgcn_mfma_f32_16x16x32_bf16(a[mi], b, acc[mi][n], 0, 0, 0);
    }
  }
  if (!ci.sample) {
    bfu* US = (bfu*)(P.ws + O_US) + ((long)((ci.seqi * 8 + h) * 64 + ci.c) << 14);
#pragma unroll
    for (int mi = 0; mi < 2; ++mi) {
      __builtin_amdgcn_sched_barrier(0);
      bfu* bp = US + ((2 * w + mi) * 16 + fq * 4) * 128 + fr;
#pragma unroll
      for (int n = 0; n < 8; ++n)
#pragma unroll
        for (int j = 0; j < 4; ++j) bp[j * 128 + n * 16] = f2b(acc[mi][n][j]);
    }
  } else {
    long sb = ((long)((l * 8 + ci.seqi) * 8 + h)) << 14;
    const float* S0 = P.in[5] + sb;
    float* So = P.out + OUT_HGS + sb;
#pragma unroll
    for (int mi = 0; mi < 2; ++mi)
#pragma unroll
      for (int n = 0; n < 8; ++n) {
        __builtin_amdgcn_sched_barrier(0);
        int e0 = (2 * w + mi) * 16 + fq * 4, dd = n * 16 + fr;
        float4 s0 = *reinterpret_cast<const float4*>(S0 + dd * 128 + e0);
        float dcl = decl[dd];
        float4 r;
        r.x = dcl * s0.x + acc[mi][n][0]; r.y = dcl * s0.y + acc[mi][n][1];
        r.z = dcl * s0.z + acc[mi][n][2]; r.w = dcl * s0.w + acc[mi][n][3];
        *reinterpret_cast<float4*>(So + dd * 128 + e0) = r;
      }
  }
}

DEVI void phase2(const Params& P, int l, int pass, char* smem) {
  const int tid = ltid();
  const int ntok = pass ? 8192 : 8448, base = pass ? 8448 : 0;
  const int nck = pass ? 128 : 136;
  const int nH = nck * 8;
  const int total = nH + ntok / 4;
  for (int id = blockIdx.x; id < total; id += gridDim.x) {
    if (id < nH) h1_item(P, l, id >> 3, id & 7, smem, tid);
    else mixab_row4(P, l, base, (id - nH) * 4, tid);
  }
}

DEVI void gate_tile(const Params& P, int l, int pm, int q, char* smem, int tid) {
  const int nb = q >> 1, hb = q & 1;
  const bfu* cb = (const bfu*)wsp(P, O_CB);
  const bfu* A = cb + (long)pm * 128 * 1024 + nb * 128;
  const bfu* Wa = (const bfu*)wsp(P, O_LRU) + nb * 16384 + hb * 64 * 128;
  const bfu* Wx = Wa + 8 * 16384;
  float* au0 = (float*)wsp(P, O_AU);
  float* au1 = au0 + (long)8448 * 1024;
  const float* ba = P.in[12] + l * 1024;
  const float* bx = P.in[14] + l * 1024;
  const float* lam = P.in[15] + l * 1024;
  f32x4 acc[4][4]; ZERO_ACC(acc);
  gemm_core_t<1>(acc, A, 1024, Wa, 128, 128, smem, tid, Wx);
  epi_stage_f32(acc, smem, tid);
  const float* T = reinterpret_cast<const float*>(smem);
  float* Tw = reinterpret_cast<float*>(smem);
#pragma unroll 4
  for (int q = 0; q < 8; ++q) {
    const int id = tid + 256 * q, row = id >> 4, g4 = id & 15;
    const int cl = g4 * 4, wcc = cl >> 5, c32 = cl & 31;
    const long grow = (long)pm * 128 + row;
    const int col = nb * 128 + hb * 64 + cl;
    float4 rp = *reinterpret_cast<const float4*>(T + row * 128 + wcc * 64 + c32);
    float4 gp = *reinterpret_cast<const float4*>(T + row * 128 + wcc * 64 + 32 + c32);
    float xv[4], bav[4], bxv[4], lmv[4];
    load4bf(cb + grow * 1024 + col, xv);
    ld4f(ba + col, bav); ld4f(bx + col, bxv); ld4f(lam + col, lmv);
    const float rpa[4] = {rp.x, rp.y, rp.z, rp.w}, gpa[4] = {gp.x, gp.y, gp.z, gp.w};
    float av[4], uv[4];
#pragma unroll
    for (int i = 0; i < 4; ++i) {
      float r = sigmoidf_(rpa[i] + bav[i]);
      float gi = sigmoidf_(gpa[i] + bxv[i]);
      float a = __expf(-8.f * log1pf(__expf(-lmv[i])) * r);
      av[i] = a;
      uv[i] = sqrtf(fmaxf(1.f - a * a, 0.f)) * gi * xv[i];
    }
    *reinterpret_cast<float4*>(au0 + grow * 1024 + col) = make_float4(av[0], av[1], av[2], av[3]);
    *reinterpret_cast<float4*>(au1 + grow * 1024 + col) = make_float4(uv[0], uv[1], uv[2], uv[3]);
    *reinterpret_cast<float4*>(Tw + row * 128 + wcc * 64 + c32) = make_float4(av[0], av[1], av[2], av[3]);
    *reinterpret_cast<float4*>(Tw + row * 128 + wcc * 64 + 32 + c32) = make_float4(uv[0], uv[1], uv[2], uv[3]);
  }
  __syncthreads();
  if (tid < 64) {
    const int wcc = tid >> 5, c32 = tid & 31;
    const float* ta = T + wcc * 64 + c32;
    float Ap = 1.f, Hp = 0.f;
#pragma unroll 1
    for (int r0 = 0; r0 < 128; r0 += 16) {
      float av[16], uv[16];
#pragma unroll
      for (int i = 0; i < 16; ++i) { av[i] = ta[(r0 + i) * 128]; uv[i] = ta[(r0 + i) * 128 + 32]; }
#pragma unroll
      for (int i = 0; i < 16; ++i) { Hp = av[i] * Hp + uv[i]; Ap *= av[i]; }
    }
    float* ls = (float*)wsp(P, O_LSUM) + (long)pm * 2048 + nb * 128 + hb * 64 + tid;
    ls[0] = Ap; ls[1024] = Hp;
  }
}
DEVI void h2_item(const Params& P, int l, int pass, int item, int tid) {
  const int sh = item >> 6, blk = item & 63;
  const int idx = blk * 256 + tid, e = idx >> 7, d = idx & 127;
  bfu* US = (bfu*)wsp(P, O_US) + ((long)sh * 64 << 14) + idx;
  const float* dec = (const float*)wsp(P, O_DEC) + (long)sh * 64 * 128 + d;
  float S = 0.f;
  for (int c0 = 0; c0 < 64; c0 += 8) {
    float u[8], dc[8];
#pragma unroll
    for (int i = 0; i < 8; ++i) { u[i] = b2f(US[(long)(c0 + i) << 14]); dc[i] = dec[(c0 + i) * 128]; }
#pragma unroll
    for (int i = 0; i < 8; ++i) { US[(long)(c0 + i) << 14] = f2b(S); S = dc[i] * S + u[i]; }
  }
  const int sl = sh >> 3, h = sh & 7, b = pass * 2 + sl;
  P.out[OUT_HGP + (((long)((l * 4 + b) * 8 + h)) << 14) + d * 128 + e] = S;
}
DEVI void phase3(const Params& P, int l, int pass, char* smem) {
  const int tid = ltid();
  const int ntok = pass ? 8192 : 8448;
  const int nG = (ntok / 128) * 16, nH2 = 1024;
  for (int id = blockIdx.x; id < nG + nH2; id += gridDim.x) {
    if (id < nG) gate_tile(P, l, id >> 4, id & 15, smem, tid);
    else h2_item(P, l, pass, id - nG, tid);
  }
}

DEVI void lsum_item(const Params& P, int tile, int cg4, int tid) {
  const int w = tid >> 6, lane = tid & 63;
  const int ch = (cg4 * 4 + w) * 64 + lane;
  const float* a0 = (const float*)wsp(P, O_AU) + (long)tile * 128 * 1024 + ch;
  const float* u0 = a0 + (long)8448 * 1024;
  float A = 1.f, H = 0.f;
  for (int r0 = 0; r0 < 128; r0 += 16) {
    float av[16], uv[16];
#pragma unroll
    for (int i = 0; i < 16; ++i) { av[i] = a0[(long)(r0 + i) * 1024]; uv[i] = u0[(long)(r0 + i) * 1024]; }
#pragma unroll
    for (int i = 0; i < 16; ++i) { H = av[i] * H + uv[i]; A *= av[i]; }
  }
  float* ls = (float*)wsp(P, O_LSUM) + (long)tile * 2048;
  ls[ch] = A; ls[1024 + ch] = H;
}

DEVI void h3_item(const Params& P, int l, int ck, int h, char* smem, int tid) {
  const ChunkInfo ci = chunkinfo(ck);
  const int lane = tid & 63, w = tid >> 6, fr = lane & 15, fq = lane >> 4;
  bfu* QT = (bfu*)smem;
  bfu* KT = QT + 64 * 136;
  bfu* AT = KT + 64 * 136;
  bfu* BS = AT + 64 * 72;
  float* bmid = (float*)(BS + 128 * 72);
  const int d = tid & 127, hf = tid >> 7, L = ci.L, Lh = L >> 1;
  const float lb = ((const float*)(P.ws + O_LBS))[l * 1024 + h * 128 + d];
  const bfu* Z = (const bfu*)(P.ws + O_Z);
  const bfu* zqb = Z + (long)ci.lt0 * NCOL + 5 * 1024 + h * 128;
  __syncthreads();
  {
    uint4 vq[4], vf[4], vi[4];
#pragma unroll
    for (int q = 0; q < 4; ++q) {
      const int idx = tid + 256 * q;
      const int sr = (idx & 15) | (((idx >> 8) & 3) << 4), c16 = ((idx >> 4) & 3) | (((idx >> 6) & 3) << 2);
      if (sr < L) {
        const bfu* rp = zqb + (long)sr * NCOL + c16 * 8;
        vq[q] = *reinterpret_cast<const uint4*>(rp);
        vf[q] = *reinterpret_cast<const uint4*>(rp + 1024);
        vi[q] = *reinterpret_cast<const uint4*>(rp + 2048);
      } else { vq[q] = make_uint4(0, 0, 0, 0); vf[q] = vq[q]; vi[q] = vq[q]; }
    }
#pragma unroll
    for (int q = 0; q < 4; ++q) {
      const int idx = tid + 256 * q;
      const int sr = (idx & 15) | (((idx >> 8) & 3) << 4), c16 = ((idx >> 4) & 3) | (((idx >> 6) & 3) << 2);
      *reinterpret_cast<uint4*>(QT + sr * 136 + c16 * 8) = vq[q];
      *reinterpret_cast<uint4*>(KT + sr * 136 + c16 * 8) = vf[q];
      const unsigned vv[4] = {vi[q].x, vi[q].y, vi[q].z, vi[q].w};
#pragma unroll
      for (int i = 0; i < 4; ++i) {
        BS[(c16 * 8 + 2 * i) * 72 + sr] = (bfu)(vv[i] & 0xFFFFu);
        BS[(c16 * 8 + 2 * i + 1) * 72 + sr] = (bfu)(vv[i] >> 16);
      }
    }
  }
  __syncthreads();
  if (hf == 0) {
    float rel = 0.f;
#pragma unroll 8
    for (int t = Lh - 1; t >= 0; --t) {
      float f = lb + (1.f - lb) * sigmoidf_(b2f(KT[t * 136 + d]));
      float q = siluf_(b2f(QT[t * 136 + d]));
      QT[t * 136 + d] = f2b(q * __expf(fminf(rel, 80.f)));
      KT[t * 136 + d] = f2b((1.f - f) * __expf(-rel));
      rel -= __logf(f);
    }
    bmid[d] = -rel;
  } else {
    float rel = 0.f;
#pragma unroll 8
    for (int t = Lh; t < L; ++t) {
      float f = lb + (1.f - lb) * sigmoidf_(b2f(KT[t * 136 + d]));
      float q = siluf_(b2f(QT[t * 136 + d]));
      rel += __logf(f);
      QT[t * 136 + d] = f2b(q * __expf(rel));
      KT[t * 136 + d] = f2b((1.f - f) * __expf(fminf(-rel, 80.f)));
    }
  }
  if (L == 32) {
    for (int t = 32 + hf * 16; t < 48 + hf * 16; ++t) { QT[t * 136 + d] = 0; KT[t * 136 + d] = 0; }
  }
  uint4 vg[4];
#pragma unroll
  for (int q = 0; q < 4; ++q) {
    const int idx = tid + 256 * q;
    const int sr = (idx & 15) | (((idx >> 8) & 3) << 4), c16 = ((idx >> 4) & 3) | (((idx >> 6) & 3) << 2);
    vg[q] = (sr < L) ? *reinterpret_cast<const uint4*>(zqb + (long)sr * NCOL + 3072 + c16 * 8) : make_uint4(0, 0, 0, 0);
  }
  __syncthreads();
  bf16x8 aq[4];
#pragma unroll
  for (int kk = 0; kk < 4; ++kk) aq[kk] = *reinterpret_cast<const bf16x8*>(QT + (16 * w + fr) * 136 + kk * 32 + fq * 8);
  {
    f32x4 sa[4];
#pragma unroll
    for (int n = 0; n < 4; ++n) sa[n] = f32x4{0.f, 0.f, 0.f, 0.f};
#pragma unroll
    for (int kk = 0; kk < 4; ++kk)
#pragma unroll
      for (int n = 0; n < 4; ++n) {
        bf16x8 bk = *reinterpret_cast<const bf16x8*>(KT + (n * 16 + fr) * 136 + kk * 32 + fq * 8);
        sa[n] = __builtin_amdgcn_mfma_f32_16x16x32_bf16(aq[kk], bk, sa[n], 0, 0, 0);
      }
#pragma unroll
    for (int n = 0; n < 4; ++n)
#pragma unroll
      for (int j = 0; j < 4; ++j) {
        int t = 16 * w + fq * 4 + j, s = n * 16 + fr;
        AT[t * 72 + s] = (s <= t) ? f2b(sa[n][j]) : (bfu)0;
      }
  }
  __syncthreads();
#pragma unroll
  for (int q = 0; q < 4; ++q) {
    const int idx = tid + 256 * q;
    const int sr = (idx & 15) | (((idx >> 8) & 3) << 4), c16 = ((idx >> 4) & 3) | (((idx >> 6) & 3) << 2);
    *reinterpret_cast<uint4*>(QT + sr * 136 + c16 * 8) = vg[q];
  }
  f32x4 o[8];
#pragma unroll
  for (int n = 0; n < 8; ++n) o[n] = f32x4{0.f, 0.f, 0.f, 0.f};
#pragma unroll
  for (int kk = 0; kk < 2; ++kk) {
    bf16x8 a = *reinterpret_cast<const bf16x8*>(AT + (16 * w + fr) * 72 + kk * 32 + fq * 8);
#pragma unroll
    for (int n = 0; n < 8; ++n) {
      bf16x8 b = *reinterpret_cast<const bf16x8*>(BS + (n * 16 + fr) * 72 + kk * 32 + fq * 8);
      o[n] = __builtin_amdgcn_mfma_f32_16x16x32_bf16(a, b, o[n], 0, 0, 0);
    }
  }
#pragma unroll
  for (int sl = 0; sl < 2; ++sl) {
    __syncthreads();
    if (!ci.sample) {
      const bfu* src = (const bfu*)(P.ws + O_US) + ((long)((ci.seqi * 8 + h) * 64 + ci.c) << 14);
      int e2 = tid >> 1, dd0 = (tid & 1) * 32;
#pragma unroll
      for (int q4 = 0; q4 < 4; ++q4) {
        uint4 v = *reinterpret_cast<const uint4*>(src + e2 * 128 + sl * 64 + dd0 + q4 * 8);
        const float* bm = bmid + sl * 64 + dd0 + q4 * 8;
        unsigned vv[4] = {v.x, v.y, v.z, v.w};
        unsigned rr[4];
#pragma unroll
        for (int i = 0; i < 4; ++i) {
          float lo = __uint_as_float(vv[i] << 16) * __expf(bm[2 * i]);
          float hi = __uint_as_float(vv[i] & 0xFFFF0000u) * __expf(bm[2 * i + 1]);
          rr[i] = f2b(lo) | ((unsigned)f2b(hi) << 16);
        }
        *reinterpret_cast<uint4*>(BS + e2 * 72 + dd0 + q4 * 8) = make_uint4(rr[0], rr[1], rr[2], rr[3]);
      }
    } else {
      const float* S0 = P.in[5] + (((long)((l * 8 + ci.seqi) * 8 + h)) << 14);
#pragma unroll 4
      for (int dd = hf * 32; dd < hf * 32 + 32; ++dd)
        BS[d * 72 + dd] = f2b(S0[(sl * 64 + dd) * 128 + d] * __expf(bmid[sl * 64 + dd]));
    }
    __syncthreads();
#pragma unroll
    for (int kk = 0; kk < 2; ++kk) {
#pragma unroll
      for (int n = 0; n < 8; ++n) {
        bf16x8 b = *reinterpret_cast<const bf16x8*>(BS + (n * 16 + fr) * 72 + kk * 32 + fq * 8);
        o[n] = __builtin_amdgcn_mfma_f32_16x16x32_bf16(aq[sl * 2 + kk], b, o[n], 0, 0, 0);
      }
    }
  }
  float rinv[4];
#pragma unroll
  for (int j = 0; j < 4; ++j) {
    float ss = 0.f;
#pragma unroll
    for (int n = 0; n < 8; ++n) ss += o[n][j] * o[n][j];
    ss += __shfl_xor(ss, 1); ss += __shfl_xor(ss, 2); ss += __shfl_xor(ss, 4); ss += __shfl_xor(ss, 8);
    rinv[j] = rsqrtf(ss * (1.f / 128.f) + 1e-6f);
  }
  const float* ng = P.in[17] + l * 128;
  bfu* UC = (bfu*)(P.ws + O_UC);
#pragma unroll
  for (int n = 0; n < 8; ++n)
#pragma unroll
    for (int j = 0; j < 4; ++j) {
      int t = 16 * w + fq * 4 + j, e = n * 16 + fr;
      if (t < L) {
        float g = b2f(QT[t * 136 + e]);
        UC[(long)(ci.lt0 + t) * 1024 + h * 128 + e] = f2b(o[n][j] * rinv[j] * ng[e] * siluf_(g));
      }
    }
}
DEVI void apply_item(const Params& P, int l, int pass, int id, int tid) {
  const int base = pass ? 8448 : 0;
  const int w = tid >> 6, lane = tid & 63;
  const float* AU0 = (const float*)wsp(P, O_AU);
  const float* AU1 = AU0 + (long)8448 * 1024;
  const float* LS = (const float*)wsp(P, O_LSUM);
  const bfu* Z = (const bfu*)wsp(P, O_Z);
  bfu* UB = (bfu*)wsp(P, O_UB);
  const int tile = id >> 2, ch = ((id & 3) * 4 + w) * 64 + lane;
  const int lt0 = tile * 128;
  const TokInfo t0 = tokinfo(base + lt0);
  float hcur = 0.f;
  if (!t0.sample) {
    int jf = tile - (t0.t >> 7);
#pragma unroll 4
    for (int i = jf; i < tile; ++i) hcur = LS[(long)i * 2048 + ch] * hcur + LS[(long)i * 2048 + 1024 + ch];
  }
  for (int r0 = 0; r0 < 128; r0 += 8) {
    float av[8], uv[8], gv[8];
#pragma unroll
    for (int i = 0; i < 8; ++i) {
      long row = lt0 + r0 + i;
      av[i] = AU0[row * 1024 + ch]; uv[i] = AU1[row * 1024 + ch];
      gv[i] = b2f(Z[row * NCOL + 4 * 1024 + ch]);
    }
#pragma unroll
    for (int i = 0; i < 8; ++i) {
      int r = r0 + i;
      if (t0.sample && (r & 31) == 0) hcur = P.in[4][(long)(l * 8 + t0.seq + (r >> 5)) * 1024 + ch];
      hcur = av[i] * hcur + uv[i];
      UB[(long)(lt0 + r) * 1024 + ch] = f2b(geluf_(gv[i]) * hcur);
      if (t0.sample && (r & 31) == 31) P.out[OUT_LRS + (long)(l * 8 + t0.seq + (r >> 5)) * 1024 + ch] = hcur;
    }
  }
  if (!t0.sample && t0.t + 128 == 4096) P.out[OUT_LRP + (long)(l * 4 + t0.seq) * 1024 + ch] = hcur;
}
DEVI void phase4(const Params& P, int l, int pass, char* smem) {
  const int tid = ltid();
  const int ntok = pass ? 8192 : 8448;
  const int nck = pass ? 128 : 136;
  const int nH = nck * 8;
  const int nA = (ntok / 128) * 4;
  for (int id = blockIdx.x; id < nA + nH; id += gridDim.x) {
    if (id < nA) apply_item(P, l, pass, id, tid);
    else { int q = id - nA; h3_item(P, l, q >> 3, q & 7, smem, tid); }
  }
}

template <int BR>
DEVI void p6_branch(const Params& P, int pm, int pn, float* macc, char* smem, int tid) {
  asm volatile("" : "+s"(pm), "+s"(pn));
  const bfu* Z = (const bfu*)wsp(P, O_Z);
  bfu* M = (bfu*)wsp(P, O_CB);
  const bfu* A = (const bfu*)wsp(P, BR == 0 ? O_UA : BR == 1 ? O_UB : O_UC) + (long)pm * 128 * 1024;
  const bfu* B = (const bfu*)wsp(P, BR == 0 ? O_WOA : BR == 1 ? O_WOB : O_WOC) + (long)pn * 128 * 1024;
  f32x4 acc[4][4]; ZERO_ACC(acc);
  gemm_core(acc, A, 1024, B, 1024, 1024, smem, tid);
  epi_stage_f32(acc, smem, tid);
  const float* T = reinterpret_cast<const float*>(smem);
#pragma unroll 8
  for (int q = 0; q < 16; ++q) {
    const int id = tid + 256 * q, row = id >> 5, c4 = id & 31;
    const long grow = (long)pm * 128 + row;
    const int gcol = pn * 128 + c4 * 4;
    float4 a = *reinterpret_cast<const float4*>(T + row * 128 + c4 * 4);
    float g[4];
    load4bf(Z + grow * NCOL + (9 + BR) * 1024 + gcol, g);
    float v[4] = {sigmoidf_(g[0]) * a.x, sigmoidf_(g[1]) * a.y, sigmoidf_(g[2]) * a.z, sigmoidf_(g[3]) * a.w};
    if (BR > 0) {
      float4 mo = *reinterpret_cast<const float4*>(macc + grow * 1024 + gcol);
      v[0] += mo.x; v[1] += mo.y; v[2] += mo.z; v[3] += mo.w;
    }
    if (BR < 2) *reinterpret_cast<float4*>(macc + grow * 1024 + gcol) = make_float4(v[0], v[1], v[2], v[3]);
    else store4bf(M + grow * 1024 + gcol, v);
  }
}
DEVI void phase6(const Params& P, int l, int pass, char* smem) {
  const int tid = ltid();
  const int ntok = pass ? 8192 : 8448;
  const int nM = ntok / 128, nN = 8;
  const bfu* Z = (const bfu*)wsp(P, O_Z);
  bfu* M = (bfu*)wsp(P, O_CB);
  for (int id = blockIdx.x; id < nM * nN; id += gridDim.x) {
    int pm, pn; tile_rc_m(id, nM, nN, pm, pn);
    float* macc = (float*)wsp(P, O_AU);
    p6_branch<0>(P, pm, pn, macc, smem, tid);
    p6_branch<1>(P, pm, pn, macc, smem, tid);
    p6_branch<2>(P, pm, pn, macc, smem, tid);
  }
}

DEVI void phase7(const Params& P, int l, int pass, char* smem) {
  const int tid = ltid();
  const int ntok = pass ? 8192 : 8448, base = pass ? 8448 : 0;
  const int nM = ntok / 128, nN = 8;
  const bfu* M = (const bfu*)wsp(P, O_CB);
  const bfu* W = (const bfu*)wsp(P, O_WO);
  float* pre = (float*)wsp(P, O_PRE);
  for (int id = blockIdx.x; id < nM * nN; id += gridDim.x) {
    int pm, pn; tile_rc_m(id, nM, nN, pm, pn);
    f32x4 acc[4][4]; ZERO_ACC(acc);
    gemm_core(acc, M + (long)pm * 128 * 1024, 1024, W + (long)pn * 128 * 1024, 1024, 1024, smem, tid);
    epi_stage_f32(acc, smem, tid);
    {
      const float* T = reinterpret_cast<const float*>(smem);
#pragma unroll 8
      for (int q = 0; q < 16; ++q) {
        const int id = tid + 256 * q, row = id >> 5, c4 = id & 31;
        const int grow = pm * 128 + row, gcol = pn * 128 + c4 * 4;
        float4 a = *reinterpret_cast<const float4*>(T + row * 128 + c4 * 4);
        float4 xx = *reinterpret_cast<const float4*>(xrow(P, base + grow) + gcol);
        *reinterpret_cast<float4*>(pre + (long)grow * 1024 + gcol) =
            make_float4(ALPHA * xx.x + a.x, ALPHA * xx.y + a.y, ALPHA * xx.z + a.z, ALPHA * xx.w + a.w);
      }
    }
  }
}

DEVI void phase8(const Params& P, int l, int pass) {
  const int tid = ltid();
  const int ntok = pass ? 8192 : 8448, base = pass ? 8448 : 0;
  const int w = tid >> 6, lane = tid & 63;
  const float* pre = (const float*)wsp(P, O_PRE);
  const float* g = P.in[22] + l * 1024;
  const float* b = P.in[23] + l * 1024;
  bfu* xb = (bfu*)wsp(P, O_XB);
  for (int id = blockIdx.x; id < ntok / 4; id += gridDim.x) {
    int lt = id * 4 + w, it = base + lt;
    const float* src = pre + (long)lt * 1024;
    float v[16];
#pragma unroll
    for (int q = 0; q < 4; ++q) {
      float4 t = *reinterpret_cast<const float4*>(src + q * 256 + lane * 4);
      v[q * 4] = t.x; v[q * 4 + 1] = t.y; v[q * 4 + 2] = t.z; v[q * 4 + 3] = t.w;
    }
    float s = 0.f;
#pragma unroll
    for (int i = 0; i < 16; ++i) s += v[i];
    float mu = wave_sum(s) * (1.f / 1024.f);
    float ss = 0.f;
#pragma unroll
    for (int i = 0; i < 16; ++i) { float dlt = v[i] - mu; ss += dlt * dlt; }
    float rs = rsqrtf(wave_sum(ss) * (1.f / 1024.f) + 1e-5f);
    float* xr = xrow(P, it);
#pragma unroll
    for (int q = 0; q < 4; ++q) {
      int c = q * 256 + lane * 4;
      float o[4];
#pragma unroll
      for (int i = 0; i < 4; ++i) o[i] = (v[q * 4 + i] - mu) * rs * g[c + i] + b[c + i];
      *reinterpret_cast<float4*>(xr + c) = make_float4(o[0], o[1], o[2], o[3]);
      store4bf(xb + (long)it * 1024 + c, o);
    }
  }
}

DEVI void phase9(const Params& P, int l, int pass, char* smem) {
  const int tid = ltid();
  const int ntok = pass ? 8192 : 8448, base = pass ? 8448 : 0;
  const int nM = ntok / 128, nN = 16;
  const bfu* xb = (const bfu*)wsp(P, O_XB) + (long)base * 1024;
  const bfu* W = (const bfu*)wsp(P, O_WQ);
  bfu* qp = (bfu*)wsp(P, O_QP);
  const bfu* KB = (const bfu*)wsp(P, O_KEYS);
  float* sc = (float*)wsp(P, O_SC);
  for (int id = blockIdx.x; id < nM * nN; id += gridDim.x) {
    int pm, pn; tile_rc_m(id, nM, nN, pm, pn);
    {
      f32x4 acc[4][4]; ZERO_ACC(acc);
      gemm_core(acc, xb + (long)pm * 128 * 1024, 1024, W + (long)pn * 128 * 1024, 1024, 1024, smem, tid);
      epi_store_bf16(acc, nullptr, qp + (long)pm * 128 * 2048 + pn * 128, 2048, smem, tid);
    }
    asm volatile("s_waitcnt vmcnt(0)" ::: "memory");
    __builtin_amdgcn_fence(__ATOMIC_RELEASE, "workgroup");
    __syncthreads();
    __builtin_amdgcn_fence(__ATOMIC_ACQUIRE, "workgroup");
    asm volatile("" : "+s"(pm), "+s"(pn));
    {
      f32x4 acc[4][4]; ZERO_ACC(acc);
      gemm_core(acc, qp + (long)pm * 128 * 2048 + pn * 128, 2048, KB + (long)pn * 16384, 128, 128, smem, tid);
      epi_stage_f32(acc, smem, tid);
      const float* T = reinterpret_cast<const float*>(smem);
#pragma unroll 8
      for (int q = 0; q < 16; ++q) {
        const int id2 = tid + 256 * q, row = id2 >> 5, c4 = id2 & 31;
        *reinterpret_cast<float4*>(sc + (long)(pm * 128 + row) * 2048 + pn * 128 + c4 * 4) =
            *reinterpret_cast<const float4*>(T + row * 128 + c4 * 4);
      }
    }
  }
}

constexpr int KLOW = 12;
__constant__ unsigned char CAND_IJ[50] = {
  0x00,0x01,0x02,0x03,0x04,0x05,0x06,0x07,0x08,0x09,0x0A,0x0B,0x0C,0x0D,0x0E,0x0F,
  0x10,0x11,0x12,0x13,0x14,0x15,0x16,0x17,
  0x20,0x21,0x22,0x23,0x24,
  0x30,0x31,0x32,0x33,
  0x40,0x41,0x42,
  0x50,0x51, 0x60,0x61, 0x70,0x71,
  0x80,0x90,0xA0,0xB0,0xC0,0xD0,0xE0,0xF0};
DEVI unsigned fkey(float f) {
  unsigned u = __float_as_uint(f);
  return (u & 0x80000000u) ? ~u : (u | 0x80000000u);
}
DEVI void dec16(uint4 v, f32x2 (&o)[8]) {
  o[0] = __builtin_amdgcn_cvt_pk_f32_fp8((int)v.x, false); o[1] = __builtin_amdgcn_cvt_pk_f32_fp8((int)v.x, true);
  o[2] = __builtin_amdgcn_cvt_pk_f32_fp8((int)v.y, false); o[3] = __builtin_amdgcn_cvt_pk_f32_fp8((int)v.y, true);
  o[4] = __builtin_amdgcn_cvt_pk_f32_fp8((int)v.z, false); o[5] = __builtin_amdgcn_cvt_pk_f32_fp8((int)v.z, true);
  o[6] = __builtin_amdgcn_cvt_pk_f32_fp8((int)v.w, false); o[7] = __builtin_amdgcn_cvt_pk_f32_fp8((int)v.w, true);
}
DEVI void phase11(const Params& P, int l, int pass, char* smem) {
  const int ntok = pass ? 8192 : 8448, base = pass ? 8448 : 0;
  const int tid = ltid(); const int w = tid >> 6, lane = tid & 63;
  float* scl = (float*)smem;
  float* sv = scl + 2048;
  int* si = (int*)(sv + 256);
  float* tops = (float*)(si + 256);
  int* tope = (int*)(tops + 128);
  float* wgt = (float*)(tope + 128);
  float* svs = wgt + 128;
  int* sis = (int*)(svs + 256);
  float* red = (float*)(sis + 256);
  float* stat = red + 4096;
  const float* SC = (const float*)(P.ws + O_SC);
  const unsigned char* UT = (const unsigned char*)(P.ws + O_UTB);
  const unsigned char* VTb = (const unsigned char*)(P.ws + O_VTB);
  const float* g2 = P.in[28] + l * 1024;
  const float* b2 = P.in[29] + l * 1024;
  bfu* xb = (bfu*)(P.ws + O_XB);
  const unsigned long long ltmask = (1ull << lane) - 1ull;
  for (int lt = blockIdx.x; lt < ntok; lt += gridDim.x) {
    const int it = base + lt;
    float* xr = xrow(P, it);
    __syncthreads();
    {
      const float4* s4 = reinterpret_cast<const float4*>(SC + (long)lt * 2048);
      reinterpret_cast<float4*>(scl)[tid] = s4[tid];
      reinterpret_cast<float4*>(scl)[tid + 256] = s4[tid + 256];
    }
    __syncthreads();
    {
      float v0[4], v1[4]; unsigned k0[4], k1[4], T[4];
#pragma unroll
      for (int li = 0; li < 4; ++li) {
        const int Lx = w * 4 + li;
        v0[li] = scl[Lx * 128 + lane]; v1[li] = scl[Lx * 128 + 64 + lane];
        k0[li] = fkey(v0[li]); k1[li] = fkey(v1[li]); T[li] = 0;
      }
      for (int b = 31; b >= KLOW; --b) {
#pragma unroll
        for (int li = 0; li < 4; ++li) {
          unsigned cand = T[li] | (1u << b);
          int cnt = __popcll(__ballot(k0[li] >= cand)) + __popcll(__ballot(k1[li] >= cand));
          if (cnt >= 16) T[li] = cand;
        }
      }
#pragma unroll
      for (int li = 0; li < 4; ++li) {
        const int Lx = w * 4 + li;
        const unsigned T2 = T[li] + (1u << KLOW);
        bool g0 = k0[li] >= T2, g1 = k1[li] >= T2;
        bool q0 = (k0[li] >= T[li]) && !g0, q1 = (k1[li] >= T[li]) && !g1;
        unsigned long long mg0 = __ballot(g0), mg1 = __ballot(g1), mq0 = __ballot(q0), mq1 = __ballot(q1);
        int ng0 = __popcll(mg0), ng = ng0 + __popcll(mg1);
        int p0 = g0 ? __popcll(mg0 & ltmask) : ng + __popcll(mq0 & ltmask);
        int p1 = g1 ? ng0 + __popcll(mg1 & ltmask) : ng + __popcll(mq0) + __popcll(mq1 & ltmask);
        if ((g0 || q0) && p0 < 16) { sv[Lx * 16 + p0] = v0[li]; si[Lx * 16 + p0] = lane; }
        if ((g1 || q1) && p1 < 16) { sv[Lx * 16 + p1] = v1[li]; si[Lx * 16 + p1] = lane + 64; }
      }
    }
    __builtin_amdgcn_wave_barrier();
    {
      const int Lx = w * 4 + (lane >> 4), e = lane & 15;
      const float v = sv[Lx * 16 + e];
      const int id = si[Lx * 16 + e];
      int rank = 0;
#pragma unroll
      for (int q = 0; q < 4; ++q) {
        float4 o = *reinterpret_cast<const float4*>(sv + Lx * 16 + q * 4);
        rank += (o.x > v || (o.x == v && q * 4 + 0 < e)) ? 1 : 0;
        rank += (o.y > v || (o.y == v && q * 4 + 1 < e)) ? 1 : 0;
        rank += (o.z > v || (o.z == v && q * 4 + 2 < e)) ? 1 : 0;
        rank += (o.w > v || (o.w == v && q * 4 + 3 < e)) ? 1 : 0;
      }
      __builtin_amdgcn_wave_barrier();
      svs[Lx * 16 + rank] = v; sis[Lx * 16 + rank] = id;
    }
    __builtin_amdgcn_wave_barrier();
    {
      float cv[2]; unsigned ck[2], T[2]; int ce[2];
      const int cij = (lane < 50) ? (int)CAND_IJ[lane] : 0;
      const int ci = cij >> 4, cj = cij & 15;
#pragma unroll
      for (int hi = 0; hi < 2; ++hi) {
        const int h = w * 2 + hi;
        T[hi] = 0;
        cv[hi] = svs[(2 * h) * 16 + ci] + svs[(2 * h + 1) * 16 + cj];
        ce[hi] = sis[(2 * h) * 16 + ci] * 128 + sis[(2 * h + 1) * 16 + cj];
        ck[hi] = (lane < 50) ? fkey(cv[hi]) : 0u;
      }
      for (int b = 31; b >= KLOW; --b) {
#pragma unroll
        for (int hi = 0; hi < 2; ++hi) {
          unsigned cand = T[hi] | (1u << b);
          int cnt = __popcll(__ballot(ck[hi] >= cand));
          if (cnt >= 16) T[hi] = cand;
        }
      }
#pragma unroll
      for (int hi = 0; hi < 2; ++hi) {
        const int h = w * 2 + hi;
        const unsigned T2 = T[hi] + (1u << KLOW);
        bool g = ck[hi] >= T2, q = (ck[hi] >= T[hi]) && !g && (lane < 50);
        unsigned long long mg = __ballot(g), mq = __ballot(q);
        int p = g ? __popcll(mg & ltmask) : __popcll(mg) + __popcll(mq & ltmask);
        if ((g || q) && p < 16) { tops[h * 16 + p] = cv[hi]; tope[h * 16 + p] = ce[hi]; }
      }
    }
    __syncthreads();
    if (tid < 128) {
      float s = tops[tid];
      float mx = s;
      mx = fmaxf(mx, __shfl_xor(mx, 1)); mx = fmaxf(mx, __shfl_xor(mx, 2));
      mx = fmaxf(mx, __shfl_xor(mx, 4)); mx = fmaxf(mx, __shfl_xor(mx, 8));
      float e = __expf(s - mx);
      float sm = e;
      sm += __shfl_xor(sm, 1); sm += __shfl_xor(sm, 2); sm += __shfl_xor(sm, 4); sm += __shfl_xor(sm, 8);
      tops[tid] = e / sm;
    }
    __syncthreads();
    f32x2 xv[8];
    {
      const float4* xp = reinterpret_cast<const float4*>(xr + lane * 16);
#pragma unroll
      for (int q = 0; q < 4; ++q) {
        float4 a = xp[q];
        xv[2 * q] = f32x2{a.x, a.y}; xv[2 * q + 1] = f32x2{a.z, a.w};
      }
    }
    f32x2 oacc[8];
#pragma unroll
    for (int q = 0; q < 8; ++q) oacc[q] = f32x2{0.f, 0.f};
#pragma unroll 1
    for (int p0 = 0; p0 < 32; p0 += 8) {
      uint4 ru[8], rv[8];
#pragma unroll
      for (int i = 0; i < 8; ++i) {
        int e = tope[w * 32 + p0 + i];
        ru[i] = *reinterpret_cast<const uint4*>(UT + (long)e * 1024 + lane * 16);
        rv[i] = *reinterpret_cast<const uint4*>(VTb + (long)e * 1024 + lane * 16);
      }
      float dsum[8];
#pragma unroll
      for (int i = 0; i < 8; ++i) {
        f32x2 f[8];
        dec16(ru[i], f);
        f32x2 acc = f[0] * xv[0];
#pragma unroll
        for (int q = 1; q < 8; ++q) acc = __builtin_elementwise_fma(f[q], xv[q], acc);
        dsum[i] = acc.x + acc.y;
      }
      float e4[4], e2[2], e1;
      {
        const bool hi = (lane & 32) != 0;
#pragma unroll
        for (int i = 0; i < 4; ++i) {
          float snd = hi ? dsum[i] : dsum[i + 4];
          float kp = hi ? dsum[i + 4] : dsum[i];
          e4[i] = kp + __shfl_xor(snd, 32);
        }
        const bool hi2 = (lane & 16) != 0;
#pragma unroll
        for (int i = 0; i < 2; ++i) {
          float snd = hi2 ? e4[i] : e4[i + 2];
          float kp = hi2 ? e4[i + 2] : e4[i];
          e2[i] = kp + __shfl_xor(snd, 16);
        }
        const bool hi3 = (lane & 8) != 0;
        {
          float snd = hi3 ? e2[0] : e2[1];
          float kp = hi3 ? e2[1] : e2[0];
          e1 = kp + __shfl_xor(snd, 8);
        }
        e1 += __shfl_xor(e1, 4); e1 += __shfl_xor(e1, 2); e1 += __shfl_xor(e1, 1);
      }
      {
        int r = ((lane >> 5) & 1) * 4 + ((lane >> 4) & 1) * 2 + ((lane >> 3) & 1);
        float wv_ = tops[w * 32 + p0 + r] * geluf_(e1 * (1.f / U_SCALE)) * (1.f / V_SCALE);
        if ((lane & 7) == 0) wgt[w * 32 + p0 + r] = wv_;
      }
      __builtin_amdgcn_wave_barrier();
      float wg[8];
      {
        float4 wa = *reinterpret_cast<const float4*>(wgt + w * 32 + p0);
        float4 wb = *reinterpret_cast<const float4*>(wgt + w * 32 + p0 + 4);
        wg[0] = wa.x; wg[1] = wa.y; wg[2] = wa.z; wg[3] = wa.w; wg[4] = wb.x; wg[5] = wb.y; wg[6] = wb.z; wg[7] = wb.w;
      }
#pragma unroll
      for (int i = 0; i < 8; ++i) {
        f32x2 f[8];
        dec16(rv[i], f);
        f32x2 wv = f32x2{wg[i], wg[i]};
#pragma unroll
        for (int q = 0; q < 8; ++q) oacc[q] = __builtin_elementwise_fma(f[q], wv, oacc[q]);
      }
    }
    {
      float4* rwp = reinterpret_cast<float4*>(red + w * 1024 + lane * 16);
#pragma unroll
      for (int q = 0; q < 4; ++q) rwp[q] = make_float4(oacc[2 * q].x, oacc[2 * q].y, oacc[2 * q + 1].x, oacc[2 * q + 1].y);
    }
    __syncthreads();
    const int c = tid * 4;
    float y[4];
    {
      float4 xx = *reinterpret_cast<const float4*>(xr + c);
      float4 r0 = *reinterpret_cast<const float4*>(red + c);
      float4 r1 = *reinterpret_cast<const float4*>(red + 1024 + c);
      float4 r2 = *reinterpret_cast<const float4*>(red + 2048 + c);
      float4 r3 = *reinterpret_cast<const float4*>(red + 3072 + c);
      y[0] = ALPHA * xx.x + (r0.x + r1.x + r2.x + r3.x);
      y[1] = ALPHA * xx.y + (r0.y + r1.y + r2.y + r3.y);
      y[2] = ALPHA * xx.z + (r0.z + r1.z + r2.z + r3.z);
      y[3] = ALPHA * xx.w + (r0.w + r1.w + r2.w + r3.w);
    }
    float s = wave_sum(y[0] + y[1] + y[2] + y[3]);
    if (lane == 0) stat[w] = s;
    __syncthreads();
    float mu = (stat[0] + stat[1] + stat[2] + stat[3]) * (1.f / 1024.f);
    float ss = 0.f;
#pragma unroll
    for (int i = 0; i < 4; ++i) { float dl = y[i] - mu; ss += dl * dl; }
    ss = wave_sum(ss);
    if (lane == 0) stat[4 + w] = ss;
    __syncthreads();
    float rs = rsqrtf((stat[4] + stat[5] + stat[6] + stat[7]) * (1.f / 1024.f) + 1e-5f);
    float o[4];
#pragma unroll
    for (int i = 0; i < 4; ++i) o[i] = (y[i] - mu) * rs * g2[c + i] + b2[c + i];
    *reinterpret_cast<float4*>(xr + c) = make_float4(o[0], o[1], o[2], o[3]);
    store4bf(xb + (long)it * 1024 + c, o);
  }
}

#define XB_TMO      128
#define XB_XCNT(j)  (256  + 64 * (j))
#define XB_XSUB(j)  (1280 + 64 * (j))
#define XB_XGEN(j)  (2304 + 64 * (j))
#define XB_TOP      3328
#define XB_TOPGEN   3392
#define XCD_BAR_WORDS 3456
#define XB_SPIN_CAP (1u << 18)
DEVI unsigned xb_ld(unsigned* p) { return __hip_atomic_load(p, __ATOMIC_RELAXED, __HIP_MEMORY_SCOPE_AGENT); }
DEVI unsigned xb_add(unsigned* p, unsigned v) { return __hip_atomic_fetch_add(p, v, __ATOMIC_RELAXED, __HIP_MEMORY_SCOPE_AGENT); }
DEVI unsigned xb_xcc_id() { return (unsigned)__builtin_amdgcn_s_getreg((3 << 11) | 20) & 0xFu; }
#define XB_SPIN(cond, bar) do { unsigned _sp = 0; while (cond) { __builtin_amdgcn_s_sleep(1); \
    if ((++_sp & 255u) == 0u) { if (xb_ld(&(bar)[XB_TMO])) break; if (_sp > XB_SPIN_CAP) { atomicAdd(&(bar)[XB_TMO], 1u); break; } } } } while (0)
DEVI void xcd_census(unsigned* bar, unsigned x, unsigned& nloc, unsigned& nx) {
  const unsigned G = gridDim.x;
  unsigned sum, cnt, mine, sp = 0u;
  for (;;) {
    sum = 0u; cnt = 0u; mine = 0u;
#pragma unroll
    for (unsigned j = 0; j < 16; ++j) { const unsigned c = xb_ld(&bar[XB_XCNT(j)]); sum += c; cnt += (c > 0u) ? 1u : 0u; mine = (j == x) ? c : mine; }
    if (sum == G) break;
    __builtin_amdgcn_s_sleep(1);
    if ((++sp & 255u) == 0u) { if (xb_ld(&bar[XB_TMO])) break; if (sp > XB_SPIN_CAP) { atomicAdd(&bar[XB_TMO], 1u); break; } }
  }
  nloc = mine > 0u ? mine : 1u; nx = cnt > 0u ? cnt : 1u;
}
DEVI void xcd_barrier(unsigned* bar, unsigned x, unsigned nloc, unsigned nx) {
  asm volatile("s_waitcnt vmcnt(0)" ::: "memory");
  __syncthreads();
  if (threadIdx.x == 0) {
    __builtin_amdgcn_s_waitcnt(0);
    const unsigned old = xb_add(&bar[XB_XSUB(x)], 1u);
    const unsigned gen = old / nloc;
    if (old + 1u == (gen + 1u) * nloc) {
      __builtin_amdgcn_fence(__ATOMIC_RELEASE, "agent");
      asm volatile("s_waitcnt vmcnt(0)" ::: "memory");
      const unsigned og = xb_add(&bar[XB_TOP], 1u);
      const unsigned tg = og / nx;
      if (og + 1u == (tg + 1u) * nx) xb_add(&bar[XB_TOPGEN], 1u);
      else XB_SPIN(xb_ld(&bar[XB_TOPGEN]) == tg, bar);
      __builtin_amdgcn_fence(__ATOMIC_ACQUIRE, "agent");
      xb_add(&bar[XB_XGEN(x)], 1u);
      asm volatile("s_waitcnt vmcnt(0)" ::: "memory");
    } else {
      XB_SPIN(xb_ld(&bar[XB_XGEN(x)]) == gen, bar);
      __builtin_amdgcn_fence(__ATOMIC_ACQUIRE, "agent");
      asm volatile("s_waitcnt vmcnt(0)" ::: "memory");
    }
  }
  __syncthreads();
}

__global__ void __launch_bounds__(256, 2) fwd_megakernel(Params P) {
  __shared__ __attribute__((aligned(16))) char smem[65536];
  cg::grid_group grid = cg::this_grid();
  unsigned* bar = (unsigned*)(P.ws + O_BAR);
  const unsigned xcc = xb_xcc_id();
  if (threadIdx.x == 0) (void)xb_add(&bar[XB_XCNT(xcc)], 1u);
  unsigned nloc = 1u, nx = 1u;
#define LND asm volatile("" : "+s"(l), "+s"(pass))
#define GSYNC xcd_barrier(bar, xcc, nloc, nx)
#pragma unroll 1
  for (int l = 0; l < 2; ++l) {
    phase_prep(P, l, smem);
    if (l == 0) {
      phase_xcopy(P);
      grid.sync();
      if (threadIdx.x == 0) xcd_census(bar, xcc, nloc, nx);
    } else {
      GSYNC;
    }
#pragma unroll 1
    for (int pass = 0; pass < 2; ++pass) {
      LND; phase_inproj(P, l, pass, smem); GSYNC;
      LND; phase2(P, l, pass, smem); GSYNC;
      LND; phase3(P, l, pass, smem); GSYNC;
      LND; phase4(P, l, pass, smem); GSYNC;
      LND; phase6(P, l, pass, smem); GSYNC;
      LND; phase7(P, l, pass, smem); GSYNC;
      LND; phase8(P, l, pass); GSYNC;
      LND; phase9(P, l, pass, smem); GSYNC;
      LND; phase11(P, l, pass, smem); if (!(l == 1 && pass == 1)) GSYNC;
    }
  }
}

extern "C" void kernel_launch(void* const* d_in, const int* in_sizes, int n_in, void* d_out, int out_size,
                              void* d_ws, size_t ws_size, hipStream_t stream) {
  static int grid_blocks = 0;
  if (!grid_blocks) {
    int dev = 0, cus = 0, per_cu = 0;
    hipGetDevice(&dev);
    hipDeviceGetAttribute(&cus, hipDeviceAttributeMultiprocessorCount, dev);
    hipOccupancyMaxActiveBlocksPerMultiprocessor(&per_cu, fwd_megakernel, 256, 0);
    if (per_cu > 2) per_cu = 2;
    if (per_cu < 1) per_cu = 1;
    grid_blocks = cus * per_cu;
  }
  if (ws_size < O_END) fprintf(stderr, "workspace too small: %zu < %zu\n", ws_size, (size_t)O_END);
  hipMemsetAsync((char*)d_ws + O_BAR, 0, 16384, stream);
  Params p{};
  for (int i = 0; i < 30; ++i) p.in[i] = (const float*)d_in[i];
  p.out = (float*)d_out;
  p.ws = (char*)d_ws;
  void* args[] = {&p};
  hipError_t e = hipLaunchCooperativeKernel((void*)fwd_megakernel, dim3(grid_blocks), dim3(256), args, 0, stream);
  if (e != hipSuccess) fprintf(stderr, "cooperative launch failed: %s (grid %d)\n", hipGetErrorString(e), grid_blocks);
}
```

```cpp
#include <hip/hip_runtime.h>
#include <hip/hip_bf16.h>
#include <hip/hip_cooperative_groups.h>
#include <cstdio>
namespace cg = cooperative_groups;

typedef unsigned short bfu;
using bf16x8 = __attribute__((ext_vector_type(8))) short;
using f32x4 = __attribute__((ext_vector_type(4))) float;
#define DEVI __device__ __forceinline__

constexpr float ALPHA = 1.41421356237f;
constexpr int NCOL = 12288;

constexpr size_t O_WIN = 0;
constexpr size_t O_WOA = O_WIN + 25165824;
constexpr size_t O_WOB = O_WOA + 2097152;
constexpr size_t O_WOC = O_WOB + 2097152;
constexpr size_t O_WO = O_WOC + 2097152;
constexpr size_t O_WQ = O_WO + 2097152;
constexpr size_t O_KEYS = O_WQ + 4194304;
constexpr size_t O_LRU = O_KEYS + 524288;
constexpr size_t O_UTB = O_LRU + 524288;
constexpr size_t O_VTB = O_UTB + 33554432;
constexpr size_t O_LBS = O_VTB + 33554432;
constexpr size_t O_XB = O_LBS + 8192;
constexpr size_t O_Z = O_XB + 34078720;
constexpr size_t O_UA = O_Z + 207618048;
constexpr size_t O_UB = O_UA + 17301504;
constexpr size_t O_UC = O_UB + 17301504;
constexpr size_t O_CB = O_UC + 17301504;
constexpr size_t O_AU = O_CB + 17301504;
constexpr size_t O_LSUM = O_AU + 69206016;
constexpr size_t O_US = O_LSUM + 540672;
constexpr size_t O_DEC = O_US + 33554432;
constexpr size_t O_BAR = O_DEC + 524288;
constexpr size_t O_END = O_BAR + 16384;
constexpr size_t O_PRE = O_Z;
constexpr size_t O_QP = O_Z + 34603008;
constexpr size_t O_SC = O_QP + 34603008;

constexpr long OUT_YS = 16777216;
constexpr long OUT_CAP = 17039360;
constexpr long OUT_CBP = 17055744;
constexpr long OUT_LRP = 17080320;
constexpr long OUT_HGP = 17088512;
constexpr long OUT_CAS = 18137088;
constexpr long OUT_CBS = 18169856;
constexpr long OUT_LRS = 18219008;
constexpr long OUT_HGS = 18235392;

struct Params {
  const float* in[30];
  float* out;
  char* ws;
};

DEVI bfu f2b(float f) {
  unsigned u = __float_as_uint(f);
  u += 0x7FFFu + ((u >> 16) & 1u);
  return (bfu)(u >> 16);
}
DEVI float b2f(bfu b) { return __uint_as_float(((unsigned)b) << 16); }
DEVI float sigmoidf_(float x) { return 1.f / (1.f + __expf(-x)); }
DEVI float siluf_(float x) { return x / (1.f + __expf(-x)); }
DEVI float geluf_(float x) { return 0.5f * x * (1.f + erff(x * 0.70710678118f)); }
DEVI float wave_sum(float v) {
#pragma unroll
  for (int o = 32; o; o >>= 1) v += __shfl_xor(v, o);
  return v;
}

DEVI char* wsp(const Params& P, size_t off) { asm volatile("" : "+s"(off)); return P.ws + off; }
DEVI int ltid() { int t = threadIdx.x; asm volatile("" : "+v"(t)); return t; }
struct TokInfo { int sample, seq, t; };
DEVI TokInfo tokinfo(int it) {
  TokInfo r;
  if (it < 8192) { r.sample = 0; r.seq = it >> 12; r.t = it & 4095; }
  else if (it < 8448) { int q = it - 8192; r.sample = 1; r.seq = q >> 5; r.t = q & 31; }
  else { int q = it - 8448; r.sample = 0; r.seq = 2 + (q >> 12); r.t = q & 4095; }
  return r;
}
DEVI float* xrow(const Params& P, int it) {
  TokInfo ti = tokinfo(it);
  return ti.sample ? P.out + OUT_YS + (long)(ti.seq * 32 + ti.t) * 1024
                   : P.out + (long)(ti.seq * 4096 + ti.t) * 1024;
}

DEVI void stage_tile(const bfu* __restrict__ g, int ld, int k0, char* lds, int tid) {
#pragma unroll
  for (int i = 0; i < 4; ++i) {
    int b = tid * 16 + i * 4096;
    int r = b >> 7, cp = (b >> 4) & 7, gc = cp ^ (r & 7);
    __builtin_amdgcn_global_load_lds((const unsigned*)(g + (long)r * ld + k0 + gc * 8),
                                     (unsigned*)(lds + b), 16, 0, 0);
  }
}
DEVI bf16x8 ldfrag(const char* tile, int r, int kc) {
  return *reinterpret_cast<const bf16x8*>(tile + r * 128 + ((kc ^ (r & 7)) << 4));
}
DEVI void stage_tile_gate(const bfu* __restrict__ Wa, const bfu* __restrict__ Wx, int k0, char* lds, int tid) {
#pragma unroll
  for (int i = 0; i < 4; ++i) {
    int b = tid * 16 + i * 4096;
    int r = b >> 7, cp = (b >> 4) & 7, gc = cp ^ (r & 7);
    const bfu* base = (r & 32) ? Wx : Wa;
    int c = (r >> 6) * 32 + (r & 31);
    __builtin_amdgcn_global_load_lds((const unsigned*)(base + (long)c * 128 + k0 + gc * 8),
                                     (unsigned*)(lds + b), 16, 0, 0);
  }
}
template <int GATE>
DEVI void gemm_core_t(f32x4 (&acc)[4][4], const bfu* __restrict__ A, int lda,
                    const bfu* __restrict__ B, int ldb, int K, char* smem, int tid, const bfu* __restrict__ B2 = nullptr) {
  const int wid = tid >> 6, lane = tid & 63;
  const int wr = wid >> 1, wc = wid & 1, fr = lane & 15, fq = lane >> 4;
  const int nt = K >> 6;
  __syncthreads();
  stage_tile(A, lda, 0, smem, tid);
  if (GATE) stage_tile_gate(B, B2, 0, smem + 16384, tid); else stage_tile(B, ldb, 0, smem + 16384, tid);
  for (int t = 0; t < nt; ++t) {
    asm volatile("s_waitcnt vmcnt(0)" ::: "memory");
    __syncthreads();
    char* cur = smem + (t & 1) * 32768;
    if (t + 1 < nt) {
      char* nx = smem + ((t + 1) & 1) * 32768;
      stage_tile(A, lda, (t + 1) * 64, nx, tid);
      if (GATE) stage_tile_gate(B, B2, (t + 1) * 64, nx + 16384, tid); else stage_tile(B, ldb, (t + 1) * 64, nx + 16384, tid);
    }
#pragma unroll
    for (int kk = 0; kk < 2; ++kk) {
      bf16x8 af[4], bfr[4];
#pragma unroll
      for (int m = 0; m < 4; ++m) af[m] = ldfrag(cur, wr * 64 + m * 16 + fr, kk * 4 + fq);
#pragma unroll
      for (int n = 0; n < 4; ++n) bfr[n] = ldfrag(cur + 16384, wc * 64 + n * 16 + fr, kk * 4 + fq);
#pragma unroll
      for (int m = 0; m < 4; ++m)
#pragma unroll
        for (int n = 0; n < 4; ++n)
          acc[m][n] = __builtin_amdgcn_mfma_f32_16x16x32_bf16(af[m], bfr[n], acc[m][n], 0, 0, 0);
    }
  }
}
DEVI void gemm_core(f32x4 (&acc)[4][4], const bfu* __restrict__ A, int lda,
                    const bfu* __restrict__ B, int ldb, int K, char* smem, int tid) {
  gemm_core_t<0>(acc, A, lda, B, ldb, K, smem, tid);
}
DEVI void tile_rc(int id, int nM, int nN, int& pm, int& pn) {
  const int x = id & 7, q = id >> 3;
  const int gfull = nM >> 3;
  const int g = q / nN;
  if (g < gfull) {
    int r = q - g * nN;
    pn = (r >> 3) * 8 + x;
    pm = g * 8 + (r & 7);
  } else {
    int gsz = nM - gfull * 8;
    int r = q - gfull * nN;
    pn = (r / gsz) * 8 + x;
    pm = gfull * 8 + (r % gsz);
  }
}
DEVI void tile_rc_m(int id, int nM, int nN, int& pm, int& pn) {
  const int gfull = nM >> 3;
  const int nfull = gfull * 8 * nN;
  if (id < nfull) {
    const int x = id & 7, q = id >> 3;
    const int g = q / nN;
    pn = q - g * nN;
    pm = g * 8 + x;
  } else {
    const int r = id - nfull;
    pm = gfull * 8 + r / nN;
    pn = r % nN;
  }
}
#define ZERO_ACC(a) _Pragma("unroll") for (int m_ = 0; m_ < 4; ++m_) _Pragma("unroll") for (int n_ = 0; n_ < 4; ++n_) a[m_][n_] = f32x4{0.f, 0.f, 0.f, 0.f}
#define EPI_LOOP \
  const int wid_ = tid >> 6, lane_ = tid & 63; \
  const int wr_ = wid_ >> 1, wc_ = wid_ & 1, fr_ = lane_ & 15, fq_ = lane_ >> 4; \
  _Pragma("unroll") for (int m = 0; m < 4; ++m) for (int sb_ = (__builtin_amdgcn_sched_barrier(0), 0); sb_ < 1; ++sb_) _Pragma("unroll") for (int n = 0; n < 4; ++n) _Pragma("unroll") for (int j = 0; j < 4; ++j)
#define EPI_ROW (wr_ * 64 + m * 16 + fq_ * 4 + j)
#define EPI_COL (wc_ * 64 + n * 16 + fr_)

DEVI void epi_stage_f32(const f32x4 (&acc)[4][4], char* smem, int tid) {
  const int wid = tid >> 6, lane = tid & 63, wr = wid >> 1, wc = wid & 1, fr = lane & 15, fq = lane >> 4;
  float* T = reinterpret_cast<float*>(smem);
  __syncthreads();
#pragma unroll
  for (int m = 0; m < 4; ++m)
#pragma unroll
    for (int n = 0; n < 4; ++n)
#pragma unroll
      for (int j = 0; j < 4; ++j)
        T[(wr * 64 + m * 16 + fq * 4 + j) * 128 + wc * 64 + n * 16 + fr] = acc[m][n][j];
  __syncthreads();
}
DEVI void epi_store_bf16(const f32x4 (&acc)[4][4], const float* colbias, bfu* dst, long ld, char* smem, int tid) {
  const int wid = tid >> 6, lane = tid & 63, wr = wid >> 1, wc = wid & 1, fr = lane & 15, fq = lane >> 4;
  bfu* T = reinterpret_cast<bfu*>(smem);
  __syncthreads();
#pragma unroll
  for (int n = 0; n < 4; ++n) {
    const int col = wc * 64 + n * 16 + fr;
    const float bias = colbias ? colbias[col] : 0.f;
#pragma unroll
    for (int m = 0; m < 4; ++m)
#pragma unroll
      for (int j = 0; j < 4; ++j)
        T[(wr * 64 + m * 16 + fq * 4 + j) * 136 + col] = f2b(acc[m][n][j] + bias);
  }
  __syncthreads();
#pragma unroll
  for (int q = 0; q < 8; ++q) {
    const int id = tid + 256 * q, row = id >> 4, c16 = id & 15;
    uint4 v = *reinterpret_cast<const uint4*>(T + row * 136 + c16 * 8);
    *reinterpret_cast<uint4*>(dst + (long)row * ld + c16 * 8) = v;
  }
}

DEVI void transpose_tile(const float* __restrict__ src, bfu* __restrict__ dst, int R, int C, int r0, int c0, float* tile, int tid) {
  __syncthreads();
  {
    int tx = tid & 15, ty = tid >> 4;
#pragma unroll
    for (int i = 0; i < 4; ++i) {
      int r = ty + i * 16;
      float4 v = *reinterpret_cast<const float4*>(src + (long)(r0 + r) * C + c0 + tx * 4);
      float* tp = tile + r * 65 + tx * 4;
      tp[0] = v.x; tp[1] = v.y; tp[2] = v.z; tp[3] = v.w;
    }
  }
  __syncthreads();
  {
    int c = tid >> 2, rs = (tid & 3) * 16;
    unsigned pk[8];
#pragma unroll
    for (int i = 0; i < 8; ++i) {
      unsigned lo = f2b(tile[(rs + 2 * i) * 65 + c]);
      unsigned hi = f2b(tile[(rs + 2 * i + 1) * 65 + c]);
      pk[i] = lo | (hi << 16);
    }
    uint4* dp = reinterpret_cast<uint4*>(dst + (long)(c0 + c) * R + r0 + rs);
    dp[0] = make_uint4(pk[0], pk[1], pk[2], pk[3]);
    dp[1] = make_uint4(pk[4], pk[5], pk[6], pk[7]);
  }
}
DEVI void convert_chunk(const float* __restrict__ src, bfu* __restrict__ dst, int tid) {
  int o = tid * 8;
  float4 a = *reinterpret_cast<const float4*>(src + o);
  float4 b = *reinterpret_cast<const float4*>(src + o + 4);
  uint4 r;
  r.x = f2b(a.x) | ((unsigned)f2b(a.y) << 16);
  r.y = f2b(a.z) | ((unsigned)f2b(a.w) << 16);
  r.z = f2b(b.x) | ((unsigned)f2b(b.y) << 16);
  r.w = f2b(b.z) | ((unsigned)f2b(b.w) << 16);
  *reinterpret_cast<uint4*>(dst + o) = r;
}

typedef float f32x2 __attribute__((ext_vector_type(2)));
constexpr float U_SCALE = 64.f, V_SCALE = 8.f;
DEVI void convert_chunk_fp8(const float* __restrict__ src, unsigned char* __restrict__ dst, float scale, int tid) {
  int o = tid * 16;
  uint4 r;
  unsigned rr[4];
#pragma unroll
  for (int q = 0; q < 4; ++q) {
    float4 a = *reinterpret_cast<const float4*>(src + o + q * 4);
    int p = __builtin_amdgcn_cvt_pk_fp8_f32(a.x * scale, a.y * scale, 0, false);
    p = __builtin_amdgcn_cvt_pk_fp8_f32(a.z * scale, a.w * scale, p, true);
    rr[q] = (unsigned)p;
  }
  r = make_uint4(rr[0], rr[1], rr[2], rr[3]);
  *reinterpret_cast<uint4*>(dst + o) = r;
}

DEVI void phase_prep(const Params& P, int l, char* smem) {
  const int tid = ltid();
  char* ws = wsp(P, 0);
  float* tile = reinterpret_cast<float*>(smem);
  const int NT_WIN = 3072, NT_SQ = 256, NT_WQ = 512, NT_LRU = 64;
  const int T0 = NT_WIN, T1 = T0 + 4 * NT_SQ, T2 = T1 + NT_WQ, T3 = T2 + NT_LRU;
  const int C0 = T3 + 128, C1 = C0 + 4096, C2 = C1 + 4096;
  const int X0 = C2;
  const int L0 = X0 + (l == 0 ? 8 : 0);
  for (int id = blockIdx.x; id < L0; id += gridDim.x) {
    if (id < T0) {
      int tr = id / 192, tc = id % 192;
      transpose_tile(P.in[6] + (long)l * 1024 * 12288, (bfu*)(ws + O_WIN), 1024, 12288, tr * 64, tc * 64, tile, tid);
    } else if (id < T1) {
      int q = id - T0, w = q >> 8, t = q & 255;
      const float* src = P.in[18 + w] + (long)l * 1048576;
      bfu* dst = (bfu*)(ws + (w == 0 ? O_WOA : w == 1 ? O_WOB : w == 2 ? O_WOC : O_WO));
      transpose_tile(src, dst, 1024, 1024, (t >> 4) * 64, (t & 15) * 64, tile, tid);
    } else if (id < T2) {
      int q = id - T1;
      transpose_tile(P.in[24] + (long)l * 2097152, (bfu*)(ws + O_WQ), 1024, 2048, (q >> 5) * 64, (q & 31) * 64, tile, tid);
    } else if (id < T3) {
      int q = id - T2, mtx = q >> 2, t = q & 3, g = mtx >> 3, nb = mtx & 7;
      const float* src = P.in[g == 0 ? 11 : 13] + (long)l * 131072 + nb * 16384;
      transpose_tile(src, (bfu*)(ws + O_LRU) + mtx * 16384, 128, 128, (t >> 1) * 64, (t & 1) * 64, tile, tid);
    } else if (id < C0) {
      int q = id - T3;
      convert_chunk(P.in[25] + (long)l * 262144 + (long)q * 2048, (bfu*)(ws + O_KEYS) + (long)q * 2048, tid);
    } else if (id < C1) {
      int q = id - C0;
      convert_chunk_fp8(P.in[26] + (long)l * 16777216 + (long)q * 4096, (unsigned char*)(ws + O_UTB) + (long)q * 4096, U_SCALE, tid);
    } else if (id < C2) {
      int q = id - C1;
      convert_chunk_fp8(P.in[27] + (long)l * 16777216 + (long)q * 4096, (unsigned char*)(ws + O_VTB) + (long)q * 4096, V_SCALE, tid);
    } else {
      int q = id - X0;
      int c = (q & 3) * 256 + tid, ll = q >> 2;
      float a0 = P.in[16][c], a1 = P.in[16][1024 + c];
      float mx = fmaxf(a0, a1);
      float e0 = __expf(a0 - mx), e1 = __expf(a1 - mx);
      float p1 = e1 / (e0 + e1);
      float* lbs = (float*)(ws + O_LBS);
      lbs[ll * 1024 + c] = (ll == 0) ? 0.f : p1;
    }
  }
}

DEVI void phase_xcopy(const Params& P) {
  const int tid = ltid();
  bfu* xb = (bfu*)wsp(P, O_XB);
  for (int it = blockIdx.x; it < 16640; it += gridDim.x) {
    TokInfo ti = tokinfo(it);
    const float* src = ti.sample ? P.in[1] + (long)(ti.seq * 32 + ti.t) * 1024 : P.in[0] + (long)(ti.seq * 4096 + ti.t) * 1024;
    float* dst = xrow(P, it);
    int c = tid * 4;
    float4 v = *reinterpret_cast<const float4*>(src + c);
    *reinterpret_cast<float4*>(dst + c) = v;
    uint2 r;
    r.x = f2b(v.x) | ((unsigned)f2b(v.y) << 16);
    r.y = f2b(v.z) | ((unsigned)f2b(v.w) << 16);
    *reinterpret_cast<uint2*>(xb + (long)it * 1024 + c) = r;
  }
}

DEVI void phase_inproj(const Params& P, int l, int pass, char* smem) {
  const int tid = ltid();
  const int ntok = pass ? 8192 : 8448, base = pass ? 8448 : 0;
  const int nM = ntok / 128, nN = 96;
  const bfu* xb = (const bfu*)wsp(P, O_XB) + (long)base * 1024;
  const bfu* wT = (const bfu*)wsp(P, O_WIN);
  bfu* z = (bfu*)wsp(P, O_Z);
  const float* bin = P.in[7] + l * NCOL;
  for (int id = blockIdx.x; id < nM * nN; id += gridDim.x) {
    int pm, pn; tile_rc(id, nM, nN, pm, pn);
    f32x4 acc[4][4]; ZERO_ACC(acc);
    gemm_core(acc, xb + (long)pm * 128 * 1024, 1024, wT + (long)pn * 128 * 1024, 1024, 1024, smem, tid);
    epi_store_bf16(acc, bin + pn * 128, z + (long)pm * 128 * NCOL + pn * 128, NCOL, smem, tid);
  }
}

DEVI void load4bf(const bfu* p, float (&o)[4]) {
  uint2 v = *reinterpret_cast<const uint2*>(p);
  o[0] = __uint_as_float(v.x << 16); o[1] = __uint_as_float(v.x & 0xFFFF0000u);
  o[2] = __uint_as_float(v.y << 16); o[3] = __uint_as_float(v.y & 0xFFFF0000u);
}
DEVI void store4bf(bfu* p, const float (&v)[4]) {
  uint2 r;
  r.x = f2b(v[0]) | ((unsigned)f2b(v[1]) << 16);
  r.y = f2b(v[2]) | ((unsigned)f2b(v[3]) << 16);
  *reinterpret_cast<uint2*>(p) = r;
}
DEVI void ld4f(const float* p, float (&o)[4]) {
  float4 v = *reinterpret_cast<const float4*>(p);
  o[0] = v.x; o[1] = v.y; o[2] = v.z; o[3] = v.w;
}
DEVI void mixab_row4(const Params& P, int l, int base, int lt0, int tid) {
  const int it0 = base + lt0;
  const TokInfo ti = tokinfo(it0);
  const int T = ti.sample ? 32 : 4096;
  const int t0 = ti.t;
  const bfu* z = (const bfu*)(P.ws + O_Z);
  const int c = tid * 4;
  {
    float pk[6][4], ab[4][4], wa[3][4];
#pragma unroll
    for (int k = 0; k < 6; ++k) {
      const int tt = t0 - 2 + k;
      if (tt >= 0) {
        const bfu* zr = z + (long)(lt0 - 2 + k) * NCOL;
        float ac[4], ax[4];
        load4bf(zr + 1024 + c, ac); load4bf(zr + 2048 + c, ax);
#pragma unroll
        for (int i = 0; i < 4; ++i) pk[k][i] = ac[i] * ax[i];
      } else if (ti.sample) {
        ld4f(P.in[2] + ((long)(l * 8 + ti.seq) * 2 + (tt + 2)) * 1024 + c, pk[k]);
      } else {
#pragma unroll
        for (int i = 0; i < 4; ++i) pk[k][i] = 0.f;
      }
    }
#pragma unroll
    for (int r = 0; r < 4; ++r) load4bf(z + (long)(lt0 + r) * NCOL + c, ab[r]);
#pragma unroll
    for (int k = 0; k < 3; ++k) ld4f(P.in[8] + (long)(l * 3 + k) * 1024 + c, wa[k]);
#pragma unroll
    for (int r = 0; r < 4; ++r) {
      float o[4];
#pragma unroll
      for (int i = 0; i < 4; ++i) o[i] = ab[r][i] * (wa[0][i] * pk[r][i] + wa[1][i] * pk[r + 1][i] + wa[2][i] * pk[r + 2][i]);
      store4bf((bfu*)(P.ws + O_UA) + (long)(lt0 + r) * 1024 + c, o);
    }
    if (t0 + 4 == T) {
      float* ca = ti.sample ? P.out + OUT_CAS + (long)(l * 8 + ti.seq) * 2 * 1024 + c : P.out + OUT_CAP + (long)(l * 4 + ti.seq) * 2 * 1024 + c;
#pragma unroll
      for (int r = 0; r < 2; ++r)
        *reinterpret_cast<float4*>(ca + r * 1024) = make_float4(pk[r + 4][0], pk[r + 4][1], pk[r + 4][2], pk[r + 4][3]);
    }
  }
  __builtin_amdgcn_sched_barrier(0);
  {
    float xk[7][4], wb[4][4], bb[4];
#pragma unroll
    for (int k = 0; k < 7; ++k) {
      const int tt = t0 - 3 + k;
      if (tt >= 0) {
        load4bf(z + (long)(lt0 - 3 + k) * NCOL + 3072 + c, xk[k]);
      } else if (ti.sample) {
        ld4f(P.in[3] + ((long)(l * 8 + ti.seq) * 3 + (tt + 3)) * 1024 + c, xk[k]);
      } else {
#pragma unroll
        for (int i = 0; i < 4; ++i) xk[k][i] = 0.f;
      }
    }
#pragma unroll
    for (int k = 0; k < 4; ++k) ld4f(P.in[9] + (long)(l * 4 + k) * 1024 + c, wb[k]);
    ld4f(P.in[10] + (long)l * 1024 + c, bb);
#pragma unroll
    for (int r = 0; r < 4; ++r) {
      float o2[4];
#pragma unroll
      for (int i = 0; i < 4; ++i)
        o2[i] = wb[0][i] * xk[r][i] + wb[1][i] * xk[r + 1][i] + wb[2][i] * xk[r + 2][i] + wb[3][i] * xk[r + 3][i] + bb[i];
      store4bf((bfu*)(P.ws + O_CB) + (long)(lt0 + r) * 1024 + c, o2);
    }
    if (t0 + 4 == T) {
      float* cbp = ti.sample ? P.out + OUT_CBS + (long)(l * 8 + ti.seq) * 3 * 1024 + c : P.out + OUT_CBP + (long)(l * 4 + ti.seq) * 3 * 1024 + c;
#pragma unroll
      for (int r = 0; r < 3; ++r)
        *reinterpret_cast<float4*>(cbp + r * 1024) = make_float4(xk[r + 4][0], xk[r + 4][1], xk[r + 4][2], xk[r + 4][3]);
    }
  }
}

struct ChunkInfo { int lt0, L, sample, seqi, c; };
DEVI ChunkInfo chunkinfo(int ck) {
  ChunkInfo r;
  if (ck < 128) { r.seqi = ck >> 6; r.c = ck & 63; r.lt0 = r.seqi * 4096 + r.c * 64; r.L = 64; r.sample = 0; }
  else { r.seqi = ck - 128; r.c = 0; r.lt0 = 8192 + r.seqi * 32; r.L = 32; r.sample = 1; }
  return r;
}

DEVI void h1_item(const Params& P, int l, int ck, int h, char* smem, int tid) {
  const ChunkInfo ci = chunkinfo(ck);
  const int lane = tid & 63, w = tid >> 6, fr = lane & 15, fq = lane >> 4;
  bfu* VT = (bfu*)smem;
  bfu* KT = VT + 128 * 72;
  bfu* FS = KT + 128 * 72;
  float* tots = (float*)(smem + 54272);
  float* decl = tots + 256;
  const int d = tid & 127, hf = tid >> 7, L = ci.L, Lh = L >> 1;
  const float lb = ((const float*)(P.ws + O_LBS))[l * 1024 + h * 128 + d];
  const bfu* Z = (const bfu*)(P.ws + O_Z);
  const bfu* zfb = Z + (long)ci.lt0 * NCOL + 6 * 1024 + h * 128;
  const bfu* zib = Z + (long)ci.lt0 * NCOL + 7 * 1024 + h * 128;
  __syncthreads();
#pragma unroll 1
  for (int q0 = 0; q0 < 4; q0 += 2) {
    uint4 vf[2], vi[2];
#pragma unroll
    for (int qq = 0; qq < 2; ++qq) {
      const int idx = tid + 256 * (q0 + qq);
      const int sr = (idx & 15) | (((idx >> 8) & 3) << 4), c16 = ((idx >> 4) & 3) | (((idx >> 6) & 3) << 2);
      if (sr < L) {
        vf[qq] = *reinterpret_cast<const uint4*>(zfb + (long)sr * NCOL + c16 * 8);
        vi[qq] = *reinterpret_cast<const uint4*>(zib + (long)sr * NCOL + c16 * 8);
      } else { vf[qq] = make_uint4(0, 0, 0, 0); vi[qq] = make_uint4(0, 0, 0, 0); }
    }
#pragma unroll
    for (int qq = 0; qq < 2; ++qq) {
      const int idx = tid + 256 * (q0 + qq);
      const int sr = (idx & 15) | (((idx >> 8) & 3) << 4), c16 = ((idx >> 4) & 3) | (((idx >> 6) & 3) << 2);
      *reinterpret_cast<uint4*>(FS + sr * 136 + c16 * 8) = vf[qq];
      const unsigned vv[4] = {vi[qq].x, vi[qq].y, vi[qq].z, vi[qq].w};
#pragma unroll
      for (int i = 0; i < 4; ++i) {
        VT[(c16 * 8 + 2 * i) * 72 + sr] = (bfu)(vv[i] & 0xFFFFu);
        VT[(c16 * 8 + 2 * i + 1) * 72 + sr] = (bfu)(vv[i] >> 16);
      }
    }
  }
  __syncthreads();
  float tot = 0.f;
#pragma unroll 8
  for (int i = 0; i < Lh; ++i) {
    float f = lb + (1.f - lb) * sigmoidf_(b2f(FS[(hf * Lh + i) * 136 + d]));
    tot += __logf(f);
  }
  tots[hf * 128 + d] = tot;
  __syncthreads();
  float run = hf ? 0.f : tots[128 + d];
#pragma unroll 8
  for (int i = Lh - 1; i >= 0; --i) {
    const int sr = hf * Lh + i;
    float f = lb + (1.f - lb) * sigmoidf_(b2f(FS[sr * 136 + d]));
    KT[d * 72 + sr] = f2b((1.f - f) * __expf(run));
    run += __logf(f);
  }
  if (L == 32) {
    for (int sr = 32 + hf * 16; sr < 48 + hf * 16; ++sr) KT[d * 72 + sr] = 0;
  }
  if (hf == 0) {
    float dc = __expf(tots[d] + tots[128 + d]);
    decl[d] = dc;
    if (!ci.sample) ((float*)(P.ws + O_DEC))[((ci.seqi * 8 + h) * 64 + ci.c) * 128 + d] = dc;
  }
  __syncthreads();
  f32x4 acc[2][8];
#pragma unroll
  for (int mi = 0; mi < 2; ++mi)
#pragma unroll
    for (int n = 0; n < 8; ++n) acc[mi][n] = f32x4{0.f, 0.f, 0.f, 0.f};
#pragma unroll
  for (int kk = 0; kk < 2; ++kk) {
    bf16x8 a[2];
#pragma unroll
    for (int mi = 0; mi < 2; ++mi) a[mi] = *reinterpret_cast<const bf16x8*>(VT + ((2 * w + mi) * 16 + fr) * 72 + kk * 32 + fq * 8);
#pragma unroll
    for (int n = 0; n < 8; ++n) {
      bf16x8 b = *reinterpret_cast<const bf16x8*>(KT + (n * 16 + fr) * 72 + kk * 32 + fq * 8);
#pragma unroll
      for (int mi = 0; mi < 2; ++mi) acc[mi][n] = __builtin_amdgcn_mfma_f32_16x16x32_bf16(a[mi], b, acc[mi][n], 0, 0, 0);
    }
  }
  if (!ci.sample) {
    bfu* US = (bfu*)(P.ws + O_US) + ((long)((ci.seqi * 8 + h) * 64 + ci.c) << 14);
#pragma unroll
    for (int mi = 0; mi < 2; ++mi) {
      __builtin_amdgcn_sched_barrier(0);
      bfu* bp = US + ((2 * w + mi) * 16 + fq * 4) * 128 + fr;
#pragma unroll
      for (int n = 0; n < 8; ++n)
#pragma unroll
        for (int j = 0; j < 4; ++j) bp[j * 128 + n * 16] = f2b(acc[mi][n][j]);
    }
  } else {
    long sb = ((long)((l * 8 + ci.seqi) * 8 + h)) << 14;
    const float* S0 = P.in[5] + sb;
    float* So = P.out + OUT_HGS + sb;
#pragma unroll
    for (int mi = 0; mi < 2; ++mi)
#pragma unroll
      for (int n = 0; n < 8; ++n) {
        __builtin_amdgcn_sched_barrier(0);
        int e0 = (2 * w + mi) * 16 + fq * 4, dd = n * 16 + fr;
        float4 s0 = *reinterpret_cast<const float4*>(S0 + dd * 128 + e0);
        float dcl = decl[dd];
        float4 r;
        r.x = dcl * s0.x + acc[mi][n][0]; r.y = dcl * s0.y + acc[mi][n][1];
        r.z = dcl * s0.z + acc[mi][n][2]; r.w = dcl * s0.w + acc[mi][n][3];
        *reinterpret_cast<float4*>(So + dd * 128 + e0) = r;
      }
  }
}

DEVI void phase2(const Params& P, int l, int pass, char* smem) {
  const int tid = ltid();
  const int ntok = pass ? 8192 : 8448, base = pass ? 8448 : 0;
  const int nck = pass ? 128 : 136;
  const int nH = nck * 8;
  const int total = nH + ntok / 4;
  for (int id = blockIdx.x; id < total; id += gridDim.x) {
    if (id < nH) h1_item(P, l, id >> 3, id & 7, smem, tid);
    else mixab_row4(P, l, base, (id - nH) * 4, tid);
  }
}

DEVI void gate_tile(const Params& P, int l, int pm, int q, char* smem, int tid) {
  const int nb = q >> 1, hb = q & 1;
  const bfu* cb = (const bfu*)wsp(P, O_CB);
  const bfu* A = cb + (long)pm * 128 * 1024 + nb * 128;
  const bfu* Wa = (const bfu*)wsp(P, O_LRU) + nb * 16384 + hb * 64 * 128;
  const bfu* Wx = Wa + 8 * 16384;
  float* au0 = (float*)wsp(P, O_AU);
  float* au1 = au0 + (long)8448 * 1024;
  const float* ba = P.in[12] + l * 1024;
  const float* bx = P.in[14] + l * 1024;
  const float* lam = P.in[15] + l * 1024;
  f32x4 acc[4][4]; ZERO_ACC(acc);
  gemm_core_t<1>(acc, A, 1024, Wa, 128, 128, smem, tid, Wx);
  epi_stage_f32(acc, smem, tid);
  const float* T = reinterpret_cast<const float*>(smem);
  float* Tw = reinterpret_cast<float*>(smem);
#pragma unroll 4
  for (int q = 0; q < 8; ++q) {
    const int id = tid + 256 * q, row = id >> 4, g4 = id & 15;
    const int cl = g4 * 4, wcc = cl >> 5, c32 = cl & 31;
    const long grow = (long)pm * 128 + row;
    const int col = nb * 128 + hb * 64 + cl;
    float4 rp = *reinterpret_cast<const float4*>(T + row * 128 + wcc * 64 + c32);
    float4 gp = *reinterpret_cast<const float4*>(T + row * 128 + wcc * 64 + 32 + c32);
    float xv[4], bav[4], bxv[4], lmv[4];
    load4bf(cb + grow * 1024 + col, xv);
    ld4f(ba + col, bav); ld4f(bx + col, bxv); ld4f(lam + col, lmv);
    const float rpa[4] = {rp.x, rp.y, rp.z, rp.w}, gpa[4] = {gp.x, gp.y, gp.z, gp.w};
    float av[4], uv[4];
#pragma unroll
    for (int i = 0; i < 4; ++i) {
      float r = sigmoidf_(rpa[i] + bav[i]);
      float gi = sigmoidf_(gpa[i] + bxv[i]);
      float a = __expf(-8.f * log1pf(__expf(-lmv[i])) * r);
      av[i] = a;
      uv[i] = sqrtf(fmaxf(1.f - a * a, 0.f)) * gi * xv[i];
    }
    *reinterpret_cast<float4*>(au0 + grow * 1024 + col) = make_float4(av[0], av[1], av[2], av[3]);
    *reinterpret_cast<float4*>(au1 + grow * 1024 + col) = make_float4(uv[0], uv[1], uv[2], uv[3]);
    *reinterpret_cast<float4*>(Tw + row * 128 + wcc * 64 + c32) = make_float4(av[0], av[1], av[2], av[3]);
    *reinterpret_cast<float4*>(Tw + row * 128 + wcc * 64 + 32 + c32) = make_float4(uv[0], uv[1], uv[2], uv[3]);
  }
  __syncthreads();
  if (tid < 64) {
    const int wcc = tid >> 5, c32 = tid & 31;
    const float* ta = T + wcc * 64 + c32;
    float Ap = 1.f, Hp = 0.f;
#pragma unroll 1
    for (int r0 = 0; r0 < 128; r0 += 16) {
      float av[16], uv[16];
#pragma unroll
      for (int i = 0; i < 16; ++i) { av[i] = ta[(r0 + i) * 128]; uv[i] = ta[(r0 + i) * 128 + 32]; }
#pragma unroll
      for (int i = 0; i < 16; ++i) { Hp = av[i] * Hp + uv[i]; Ap *= av[i]; }
    }
    float* ls = (float*)wsp(P, O_LSUM) + (long)pm * 2048 + nb * 128 + hb * 64 + tid;
    ls[0] = Ap; ls[1024] = Hp;
  }
}
DEVI void h2_item(const Params& P, int l, int pass, int item, int tid) {
  const int sh = item >> 6, blk = item & 63;
  const int idx = blk * 256 + tid, e = idx >> 7, d = idx & 127;
  bfu* US = (bfu*)wsp(P, O_US) + ((long)sh * 64 << 14) + idx;
  const float* dec = (const float*)wsp(P, O_DEC) + (long)sh * 64 * 128 + d;
  float S = 0.f;
  for (int c0 = 0; c0 < 64; c0 += 8) {
    float u[8], dc[8];
#pragma unroll
    for (int i = 0; i < 8; ++i) { u[i] = b2f(US[(long)(c0 + i) << 14]); dc[i] = dec[(c0 + i) * 128]; }
#pragma unroll
    for (int i = 0; i < 8; ++i) { US[(long)(c0 + i) << 14] = f2b(S); S = dc[i] * S + u[i]; }
  }
  const int sl = sh >> 3, h = sh & 7, b = pass * 2 + sl;
  P.out[OUT_HGP + (((long)((l * 4 + b) * 8 + h)) << 14) + d * 128 + e] = S;
}
DEVI void phase3(const Params& P, int l, int pass, char* smem) {
  const int tid = ltid();
  const int ntok = pass ? 8192 : 8448;
  const int nG = (ntok / 128) * 16, nH2 = 1024;
  for (int id = blockIdx.x; id < nG + nH2; id += gridDim.x) {
    if (id < nG) gate_tile(P, l, id >> 4, id & 15, smem, tid);
    else h2_item(P, l, pass, id - nG, tid);
  }
}

DEVI void lsum_item(const Params& P, int tile, int cg4, int tid) {
  const int w = tid >> 6, lane = tid & 63;
  const int ch = (cg4 * 4 + w) * 64 + lane;
  const float* a0 = (const float*)wsp(P, O_AU) + (long)tile * 128 * 1024 + ch;
  const float* u0 = a0 + (long)8448 * 1024;
  float A = 1.f, H = 0.f;
  for (int r0 = 0; r0 < 128; r0 += 16) {
    float av[16], uv[16];
#pragma unroll
    for (int i = 0; i < 16; ++i) { av[i] = a0[(long)(r0 + i) * 1024]; uv[i] = u0[(long)(r0 + i) * 1024]; }
#pragma unroll
    for (int i = 0; i < 16; ++i) { H = av[i] * H + uv[i]; A *= av[i]; }
  }
  float* ls = (float*)wsp(P, O_LSUM) + (long)tile * 2048;
  ls[ch] = A; ls[1024 + ch] = H;
}

DEVI void h3_item(const Params& P, int l, int ck, int h, char* smem, int tid) {
  const ChunkInfo ci = chunkinfo(ck);
  const int lane = tid & 63, w = tid >> 6, fr = lane & 15, fq = lane >> 4;
  bfu* QT = (bfu*)smem;
  bfu* KT = QT + 64 * 136;
  bfu* AT = KT + 64 * 136;
  bfu* BS = AT + 64 * 72;
  float* bmid = (float*)(BS + 128 * 72);
  const int d = tid & 127, hf = tid >> 7, L = ci.L, Lh = L >> 1;
  const float lb = ((const float*)(P.ws + O_LBS))[l * 1024 + h * 128 + d];
  const bfu* Z = (const bfu*)(P.ws + O_Z);
  const bfu* zqb = Z + (long)ci.lt0 * NCOL + 5 * 1024 + h * 128;
  __syncthreads();
  {
    uint4 vq[4], vf[4], vi[4];
#pragma unroll
    for (int q = 0; q < 4; ++q) {
      const int idx = tid + 256 * q;
      const int sr = (idx & 15) | (((idx >> 8) & 3) << 4), c16 = ((idx >> 4) & 3) | (((idx >> 6) & 3) << 2);
      if (sr < L) {
        const bfu* rp = zqb + (long)sr * NCOL + c16 * 8;
        vq[q] = *reinterpret_cast<const uint4*>(rp);
        vf[q] = *reinterpret_cast<const uint4*>(rp + 1024);
        vi[q] = *reinterpret_cast<const uint4*>(rp + 2048);
      } else { vq[q] = make_uint4(0, 0, 0, 0); vf[q] = vq[q]; vi[q] = vq[q]; }
    }
#pragma unroll
    for (int q = 0; q < 4; ++q) {
      const int idx = tid + 256 * q;
      const int sr = (idx & 15) | (((idx >> 8) & 3) << 4), c16 = ((idx >> 4) & 3) | (((idx >> 6) & 3) << 2);
      *reinterpret_cast<uint4*>(QT + sr * 136 + c16 * 8) = vq[q];
      *reinterpret_cast<uint4*>(KT + sr * 136 + c16 * 8) = vf[q];
      const unsigned vv[4] = {vi[q].x, vi[q].y, vi[q].z, vi[q].w};
#pragma unroll
      for (int i = 0; i < 4; ++i) {
        BS[(c16 * 8 + 2 * i) * 72 + sr] = (bfu)(vv[i] & 0xFFFFu);
        BS[(c16 * 8 + 2 * i + 1) * 72 + sr] = (bfu)(vv[i] >> 16);
      }
    }
  }
  __syncthreads();
  if (hf == 0) {
    float rel = 0.f;
#pragma unroll 8
    for (int t = Lh - 1; t >= 0; --t) {
      float f = lb + (1.f - lb) * sigmoidf_(b2f(KT[t * 136 + d]));
      float q = siluf_(b2f(QT[t * 136 + d]));
      QT[t * 136 + d] = f2b(q * __expf(fminf(rel, 80.f)));
      KT[t * 136 + d] = f2b((1.f - f) * __expf(-rel));
      rel -= __logf(f);
    }
    bmid[d] = -rel;
  } else {
    float rel = 0.f;
#pragma unroll 8
    for (int t = Lh; t < L; ++t) {
      float f = lb + (1.f - lb) * sigmoidf_(b2f(KT[t * 136 + d]));
      float q = siluf_(b2f(QT[t * 136 + d]));
      rel += __logf(f);
      QT[t * 136 + d] = f2b(q * __expf(rel));
      KT[t * 136 + d] = f2b((1.f - f) * __expf(fminf(-rel, 80.f)));
    }
  }
  if (L == 32) {
    for (int t = 32 + hf * 16; t < 48 + hf * 16; ++t) { QT[t * 136 + d] = 0; KT[t * 136 + d] = 0; }
  }
  uint4 vg[4];
#pragma unroll
  for (int q = 0; q < 4; ++q) {
    const int idx = tid + 256 * q;
    const int sr = (idx & 15) | (((idx >> 8) & 3) << 4), c16 = ((idx >> 4) & 3) | (((idx >> 6) & 3) << 2);
    vg[q] = (sr < L) ? *reinterpret_cast<const uint4*>(zqb + (long)sr * NCOL + 3072 + c16 * 8) : make_uint4(0, 0, 0, 0);
  }
  __syncthreads();
  bf16x8 aq[4];
#pragma unroll
  for (int kk = 0; kk < 4; ++kk) aq[kk] = *reinterpret_cast<const bf16x8*>(QT + (16 * w + fr) * 136 + kk * 32 + fq * 8);
  {
    f32x4 sa[4];
#pragma unroll
    for (int n = 0; n < 4; ++n) sa[n] = f32x4{0.f, 0.f, 0.f, 0.f};
#pragma unroll
    for (int kk = 0; kk < 4; ++kk)
#pragma unroll
      for (int n = 0; n < 4; ++n) {
        bf16x8 bk = *reinterpret_cast<const bf16x8*>(KT + (n * 16 + fr) * 136 + kk * 32 + fq * 8);
        sa[n] = __builtin_amdgcn_mfma_f32_16x16x32_bf16(aq[kk], bk, sa[n], 0, 0, 0);
      }
#pragma unroll
    for (int n = 0; n < 4; ++n)
#pragma unroll
      for (int j = 0; j < 4; ++j) {
        int t = 16 * w + fq * 4 + j, s = n * 16 + fr;
        AT[t * 72 + s] = (s <= t) ? f2b(sa[n][j]) : (bfu)0;
      }
  }
  __syncthreads();
#pragma unroll
  for (int q = 0; q < 4; ++q) {
    const int idx = tid + 256 * q;
    const int sr = (idx & 15) | (((idx >> 8) & 3) << 4), c16 = ((idx >> 4) & 3) | (((idx >> 6) & 3) << 2);
    *reinterpret_cast<uint4*>(QT + sr * 136 + c16 * 8) = vg[q];
  }
  f32x4 o[8];
#pragma unroll
  for (int n = 0; n < 8; ++n) o[n] = f32x4{0.f, 0.f, 0.f, 0.f};
#pragma unroll
  for (int kk = 0; kk < 2; ++kk) {
    bf16x8 a = *reinterpret_cast<const bf16x8*>(AT + (16 * w + fr) * 72 + kk * 32 + fq * 8);
#pragma unroll
    for (int n = 0; n < 8; ++n) {
      bf16x8 b = *reinterpret_cast<const bf16x8*>(BS + (n * 16 + fr) * 72 + kk * 32 + fq * 8);
      o[n] = __builtin_amdgcn_mfma_f32_16x16x32_bf16(a, b, o[n], 0, 0, 0);
    }
  }
#pragma unroll
  for (int sl = 0; sl < 2; ++sl) {
    __syncthreads();
    if (!ci.sample) {
      const bfu* src = (const bfu*)(P.ws + O_US) + ((long)((ci.seqi * 8 + h) * 64 + ci.c) << 14);
      int e2 = tid >> 1, dd0 = (tid & 1) * 32;
#pragma unroll
      for (int q4 = 0; q4 < 4; ++q4) {
        uint4 v = *reinterpret_cast<const uint4*>(src + e2 * 128 + sl * 64 + dd0 + q4 * 8);
        const float* bm = bmid + sl * 64 + dd0 + q4 * 8;
        unsigned vv[4] = {v.x, v.y, v.z, v.w};
        unsigned rr[4];
#pragma unroll
        for (int i = 0; i < 4; ++i) {
          float lo = __uint_as_float(vv[i] << 16) * __expf(bm[2 * i]);
          float hi = __uint_as_float(vv[i] & 0xFFFF0000u) * __expf(bm[2 * i + 1]);
          rr[i] = f2b(lo) | ((unsigned)f2b(hi) << 16);
        }
        *reinterpret_cast<uint4*>(BS + e2 * 72 + dd0 + q4 * 8) = make_uint4(rr[0], rr[1], rr[2], rr[3]);
      }
    } else {
      const float* S0 = P.in[5] + (((long)((l * 8 + ci.seqi) * 8 + h)) << 14);
#pragma unroll 4
      for (int dd = hf * 32; dd < hf * 32 + 32; ++dd)
        BS[d * 72 + dd] = f2b(S0[(sl * 64 + dd) * 128 + d] * __expf(bmid[sl * 64 + dd]));
    }
    __syncthreads();
#pragma unroll
    for (int kk = 0; kk < 2; ++kk) {
#pragma unroll
      for (int n = 0; n < 8; ++n) {
        bf16x8 b = *reinterpret_cast<const bf16x8*>(BS + (n * 16 + fr) * 72 + kk * 32 + fq * 8);
        o[n] = __builtin_amdgcn_mfma_f32_16x16x32_bf16(aq[sl * 2 + kk], b, o[n], 0, 0, 0);
      }
    }
  }
  float rinv[4];
#pragma unroll
  for (int j = 0; j < 4; ++j) {
    float ss = 0.f;
#pragma unroll
    for (int n = 0; n < 8; ++n) ss += o[n][j] * o[n][j];
    ss += __shfl_xor(ss, 1); ss += __shfl_xor(ss, 2); ss += __shfl_xor(ss, 4); ss += __shfl_xor(ss, 8);
    rinv[j] = rsqrtf(ss * (1.f / 128.f) + 1e-6f);
  }
  const float* ng = P.in[17] + l * 128;
  bfu* UC = (bfu*)(P.ws + O_UC);
#pragma unroll
  for (int n = 0; n < 8; ++n)
#pragma unroll
    for (int j = 0; j < 4; ++j) {
      int t = 16 * w + fq * 4 + j, e = n * 16 + fr;
      if (t < L) {
        float g = b2f(QT[t * 136 + e]);
        UC[(long)(ci.lt0 + t) * 1024 + h * 128 + e] = f2b(o[n][j] * rinv[j] * ng[e] * siluf_(g));
      }
    }
}
DEVI void apply_item(const Params& P, int l, int pass, int id, int tid) {
  const int base = pass ? 8448 : 0;
  const int w = tid >> 6, lane = tid & 63;
  const float* AU0 = (const float*)wsp(P, O_AU);
  const float* AU1 = AU0 + (long)8448 * 1024;
  const float* LS = (const float*)wsp(P, O_LSUM);
  const bfu* Z = (const bfu*)wsp(P, O_Z);
  bfu* UB = (bfu*)wsp(P, O_UB);
  const int tile = id >> 2, ch = ((id & 3) * 4 + w) * 64 + lane;
  const int lt0 = tile * 128;
  const TokInfo t0 = tokinfo(base + lt0);
  float hcur = 0.f;
  if (!t0.sample) {
    int jf = tile - (t0.t >> 7);
#pragma unroll 4
    for (int i = jf; i < tile; ++i) hcur = LS[(long)i * 2048 + ch] * hcur + LS[(long)i * 2048 + 1024 + ch];
  }
  for (int r0 = 0; r0 < 128; r0 += 8) {
    float av[8], uv[8], gv[8];
#pragma unroll
    for (int i = 0; i < 8; ++i) {
      long row = lt0 + r0 + i;
      av[i] = AU0[row * 1024 + ch]; uv[i] = AU1[row * 1024 + ch];
      gv[i] = b2f(Z[row * NCOL + 4 * 1024 + ch]);
    }
#pragma unroll
    for (int i = 0; i < 8; ++i) {
      int r = r0 + i;
      if (t0.sample && (r & 31) == 0) hcur = P.in[4][(long)(l * 8 + t0.seq + (r >> 5)) * 1024 + ch];
      hcur = av[i] * hcur + uv[i];
      UB[(long)(lt0 + r) * 1024 + ch] = f2b(geluf_(gv[i]) * hcur);
      if (t0.sample && (r & 31) == 31) P.out[OUT_LRS + (long)(l * 8 + t0.seq + (r >> 5)) * 1024 + ch] = hcur;
    }
  }
  if (!t0.sample && t0.t + 128 == 4096) P.out[OUT_LRP + (long)(l * 4 + t0.seq) * 1024 + ch] = hcur;
}
template <int BR, int IN, int OUT>
DEVI void p6_branch(const Params& P, int pm, int pn, float* macc, char* smem, int tid) {
  asm volatile("" : "+s"(pm), "+s"(pn));
  const bfu* Z = (const bfu*)wsp(P, O_Z);
  bfu* M = (bfu*)wsp(P, O_CB);
  const bfu* A = (const bfu*)wsp(P, BR == 0 ? O_UA : BR == 1 ? O_UB : O_UC) + (long)pm * 128 * 1024;
  const bfu* B = (const bfu*)wsp(P, BR == 0 ? O_WOA : BR == 1 ? O_WOB : O_WOC) + (long)pn * 128 * 1024;
  f32x4 acc[4][4]; ZERO_ACC(acc);
  gemm_core(acc, A, 1024, B, 1024, 1024, smem, tid);
  epi_stage_f32(acc, smem, tid);
  const float* T = reinterpret_cast<const float*>(smem);
#pragma unroll 8
  for (int q = 0; q < 16; ++q) {
    const int id = tid + 256 * q, row = id >> 5, c4 = id & 31;
    const long grow = (long)pm * 128 + row;
    const int gcol = pn * 128 + c4 * 4;
    float4 a = *reinterpret_cast<const float4*>(T + row * 128 + c4 * 4);
    float g[4];
    load4bf(Z + grow * NCOL + (9 + BR) * 1024 + gcol, g);
    float v[4] = {sigmoidf_(g[0]) * a.x, sigmoidf_(g[1]) * a.y, sigmoidf_(g[2]) * a.z, sigmoidf_(g[3]) * a.w};
    if (IN == 1) {
      float mo[4]; load4bf(M + grow * 1024 + gcol, mo);
      v[0] += mo[0]; v[1] += mo[1]; v[2] += mo[2]; v[3] += mo[3];
    }
    if (IN == 2) {
      float4 mo = *reinterpret_cast<const float4*>(macc + grow * 1024 + gcol);
      v[0] += mo.x; v[1] += mo.y; v[2] += mo.z; v[3] += mo.w;
    }
    if (OUT == 1) *reinterpret_cast<float4*>(macc + grow * 1024 + gcol) = make_float4(v[0], v[1], v[2], v[3]);
    else store4bf(M + grow * 1024 + gcol, v);
  }
}
DEVI void phase4(const Params& P, int l, int pass, char* smem) {
  const int tid = ltid();
  const int ntok = pass ? 8192 : 8448;
  const int nck = pass ? 128 : 136;
  const int nH = nck * 8;
  const int nA = (ntok / 128) * 4;
  const int nM = ntok / 128, nT = nM * 8;
  for (int id = blockIdx.x; id < nA + nH + nT; id += gridDim.x) {
    if (id < nA) apply_item(P, l, pass, id, tid);
    else if (id < nA + nH) { int q = id - nA; h3_item(P, l, q >> 3, q & 7, smem, tid); }
    else { int pm, pn; tile_rc_m(id - nA - nH, nM, 8, pm, pn); p6_branch<0, 0, 0>(P, pm, pn, nullptr, smem, tid); }
  }
}

DEVI void phase6(const Params& P, int l, int pass, char* smem) {
  const int tid = ltid();
  const int ntok = pass ? 8192 : 8448;
  const int nM = ntok / 128, nN = 8;
  const bfu* Z = (const bfu*)wsp(P, O_Z);
  bfu* M = (bfu*)wsp(P, O_CB);
  for (int id = blockIdx.x; id < nM * nN; id += gridDim.x) {
    int pm, pn; tile_rc_m(id, nM, nN, pm, pn);
    float* macc = (float*)wsp(P, O_AU);
    p6_branch<2, 1, 1>(P, pm, pn, macc, smem, tid);
    p6_branch<1, 2, 0>(P, pm, pn, macc, smem, tid);
  }
}

DEVI void phase7(const Params& P, int l, int pass, char* smem) {
  const int tid = ltid();
  const int ntok = pass ? 8192 : 8448, base = pass ? 8448 : 0;
  const int nM = ntok / 128, nN = 8;
  const bfu* M = (const bfu*)wsp(P, O_CB);
  const bfu* W = (const bfu*)wsp(P, O_WO);
  float* pre = (float*)wsp(P, O_PRE);
  for (int id = blockIdx.x; id < nM * nN; id += gridDim.x) {
    int pm, pn; tile_rc_m(id, nM, nN, pm, pn);
    f32x4 acc[4][4]; ZERO_ACC(acc);
    gemm_core(acc, M + (long)pm * 128 * 1024, 1024, W + (long)pn * 128 * 1024, 1024, 1024, smem, tid);
    epi_stage_f32(acc, smem, tid);
    {
      const float* T = reinterpret_cast<const float*>(smem);
#pragma unroll 8
      for (int q = 0; q < 16; ++q) {
        const int id = tid + 256 * q, row = id >> 5, c4 = id & 31;
        const int grow = pm * 128 + row, gcol = pn * 128 + c4 * 4;
        float4 a = *reinterpret_cast<const float4*>(T + row * 128 + c4 * 4);
        float4 xx = *reinterpret_cast<const float4*>(xrow(P, base + grow) + gcol);
        *reinterpret_cast<float4*>(pre + (long)grow * 1024 + gcol) =
            make_float4(ALPHA * xx.x + a.x, ALPHA * xx.y + a.y, ALPHA * xx.z + a.z, ALPHA * xx.w + a.w);
      }
    }
  }
}

DEVI void phase8(const Params& P, int l, int pass) {
  const int tid = ltid();
  const int ntok = pass ? 8192 : 8448, base = pass ? 8448 : 0;
  const int w = tid >> 6, lane = tid & 63;
  const float* pre = (const float*)wsp(P, O_PRE);
  const float* g = P.in[22] + l * 1024;
  const float* b = P.in[23] + l * 1024;
  bfu* xb = (bfu*)wsp(P, O_XB);
  for (int id = blockIdx.x; id < ntok / 4; id += gridDim.x) {
    int lt = id * 4 + w, it = base + lt;
    const float* src = pre + (long)lt * 1024;
    float v[16];
#pragma unroll
    for (int q = 0; q < 4; ++q) {
      float4 t = *reinterpret_cast<const float4*>(src + q * 256 + lane * 4);
      v[q * 4] = t.x; v[q * 4 + 1] = t.y; v[q * 4 + 2] = t.z; v[q * 4 + 3] = t.w;
    }
    float s = 0.f;
#pragma unroll
    for (int i = 0; i < 16; ++i) s += v[i];
    float mu = wave_sum(s) * (1.f / 1024.f);
    float ss = 0.f;
#pragma unroll
    for (int i = 0; i < 16; ++i) { float dlt = v[i] - mu; ss += dlt * dlt; }
    float rs = rsqrtf(wave_sum(ss) * (1.f / 1024.f) + 1e-5f);
    float* xr = xrow(P, it);
#pragma unroll
    for (int q = 0; q < 4; ++q) {
      int c = q * 256 + lane * 4;
      float o[4];
#pragma unroll
      for (int i = 0; i < 4; ++i) o[i] = (v[q * 4 + i] - mu) * rs * g[c + i] + b[c + i];
      *reinterpret_cast<float4*>(xr + c) = make_float4(o[0], o[1], o[2], o[3]);
      store4bf(xb + (long)it * 1024 + c, o);
    }
  }
}

DEVI void phase9(const Params& P, int l, int pass, char* smem) {
  const int tid = ltid();
  const int ntok = pass ? 8192 : 8448, base = pass ? 8448 : 0;
  const int nM = ntok / 128, nN = 16;
  const bfu* xb = (const bfu*)wsp(P, O_XB) + (long)base * 1024;
  const bfu* W = (const bfu*)wsp(P, O_WQ);
  bfu* qp = (bfu*)wsp(P, O_QP);
  const bfu* KB = (const bfu*)wsp(P, O_KEYS);
  float* sc = (float*)wsp(P, O_SC);
  for (int id = blockIdx.x; id < nM * nN; id += gridDim.x) {
    int pm, pn; tile_rc_m(id, nM, nN, pm, pn);
    {
      f32x4 acc[4][4]; ZERO_ACC(acc);
      gemm_core(acc, xb + (long)pm * 128 * 1024, 1024, W + (long)pn * 128 * 1024, 1024, 1024, smem, tid);
      epi_store_bf16(acc, nullptr, qp + (long)pm * 128 * 2048 + pn * 128, 2048, smem, tid);
    }
    asm volatile("s_waitcnt vmcnt(0)" ::: "memory");
    __builtin_amdgcn_fence(__ATOMIC_RELEASE, "workgroup");
    __syncthreads();
    __builtin_amdgcn_fence(__ATOMIC_ACQUIRE, "workgroup");
    asm volatile("" : "+s"(pm), "+s"(pn));
    {
      f32x4 acc[4][4]; ZERO_ACC(acc);
      gemm_core(acc, qp + (long)pm * 128 * 2048 + pn * 128, 2048, KB + (long)pn * 16384, 128, 128, smem, tid);
      epi_stage_f32(acc, smem, tid);
      const float* T = reinterpret_cast<const float*>(smem);
#pragma unroll 8
      for (int q = 0; q < 16; ++q) {
        const int id2 = tid + 256 * q, row = id2 >> 5, c4 = id2 & 31;
        *reinterpret_cast<float4*>(sc + (long)(pm * 128 + row) * 2048 + pn * 128 + c4 * 4) =
            *reinterpret_cast<const float4*>(T + row * 128 + c4 * 4);
      }
    }
  }
}

constexpr int KLOW = 12;
__constant__ unsigned char CAND_IJ[50] = {
  0x00,0x01,0x02,0x03,0x04,0x05,0x06,0x07,0x08,0x09,0x0A,0x0B,0x0C,0x0D,0x0E,0x0F,
  0x10,0x11,0x12,0x13,0x14,0x15,0x16,0x17,
  0x20,0x21,0x22,0x23,0x24,
  0x30,0x31,0x32,0x33,
  0x40,0x41,0x42,
  0x50,0x51, 0x60,0x61, 0x70,0x71,
  0x80,0x90,0xA0,0xB0,0xC0,0xD0,0xE0,0xF0};
DEVI unsigned fkey(float f) {
  unsigned u = __float_as_uint(f);
  return (u & 0x80000000u) ? ~u : (u | 0x80000000u);
}
DEVI void dec16(uint4 v, f32x2 (&o)[8]) {
  o[0] = __builtin_amdgcn_cvt_pk_f32_fp8((int)v.x, false); o[1] = __builtin_amdgcn_cvt_pk_f32_fp8((int)v.x, true);
  o[2] = __builtin_amdgcn_cvt_pk_f32_fp8((int)v.y, false); o[3] = __builtin_amdgcn_cvt_pk_f32_fp8((int)v.y, true);
  o[4] = __builtin_amdgcn_cvt_pk_f32_fp8((int)v.z, false); o[5] = __builtin_amdgcn_cvt_pk_f32_fp8((int)v.z, true);
  o[6] = __builtin_amdgcn_cvt_pk_f32_fp8((int)v.w, false); o[7] = __builtin_amdgcn_cvt_pk_f32_fp8((int)v.w, true);
}
DEVI void phase11(const Params& P, int l, int pass, char* smem) {
  const int ntok = pass ? 8192 : 8448, base = pass ? 8448 : 0;
  const int tid = ltid(); const int w = tid >> 6, lane = tid & 63;
  float* scl = (float*)smem;
  float* sv = scl + 2048;
  int* si = (int*)(sv + 256);
  float* tops = (float*)(si + 256);
  int* tope = (int*)(tops + 128);
  float* wgt = (float*)(tope + 128);
  float* svs = wgt + 128;
  int* sis = (int*)(svs + 256);
  float* red = (float*)(sis + 256);
  float* stat = red + 4096;
  const float* SC = (const float*)(P.ws + O_SC);
  const unsigned char* UT = (const unsigned char*)(P.ws + O_UTB);
  const unsigned char* VTb = (const unsigned char*)(P.ws + O_VTB);
  const float* g2 = P.in[28] + l * 1024;
  const float* b2 = P.in[29] + l * 1024;
  bfu* xb = (bfu*)(P.ws + O_XB);
  const unsigned long long ltmask = (1ull << lane) - 1ull;
  for (int lt = blockIdx.x; lt < ntok; lt += gridDim.x) {
    const int it = base + lt;
    float* xr = xrow(P, it);
    __syncthreads();
    {
      const float4* s4 = reinterpret_cast<const float4*>(SC + (long)lt * 2048);
      reinterpret_cast<float4*>(scl)[tid] = s4[tid];
      reinterpret_cast<float4*>(scl)[tid + 256] = s4[tid + 256];
    }
    __syncthreads();
    {
      float v0[4], v1[4]; unsigned k0[4], k1[4], T[4];
#pragma unroll
      for (int li = 0; li < 4; ++li) {
        const int Lx = w * 4 + li;
        v0[li] = scl[Lx * 128 + lane]; v1[li] = scl[Lx * 128 + 64 + lane];
        k0[li] = fkey(v0[li]); k1[li] = fkey(v1[li]); T[li] = 0;
      }
      for (int b = 31; b >= KLOW; --b) {
#pragma unroll
        for (int li = 0; li < 4; ++li) {
          unsigned cand = T[li] | (1u << b);
          int cnt = __popcll(__ballot(k0[li] >= cand)) + __popcll(__ballot(k1[li] >= cand));
          if (cnt >= 16) T[li] = cand;
        }
      }
#pragma unroll
      for (int li = 0; li < 4; ++li) {
        const int Lx = w * 4 + li;
        const unsigned T2 = T[li] + (1u << KLOW);
        bool g0 = k0[li] >= T2, g1 = k1[li] >= T2;
        bool q0 = (k0[li] >= T[li]) && !g0, q1 = (k1[li] >= T[li]) && !g1;
        unsigned long long mg0 = __ballot(g0), mg1 = __ballot(g1), mq0 = __ballot(q0), mq1 = __ballot(q1);
        int ng0 = __popcll(mg0), ng = ng0 + __popcll(mg1);
        int p0 = g0 ? __popcll(mg0 & ltmask) : ng + __popcll(mq0 & ltmask);
        int p1 = g1 ? ng0 + __popcll(mg1 & ltmask) : ng + __popcll(mq0) + __popcll(mq1 & ltmask);
        if ((g0 || q0) && p0 < 16) { sv[Lx * 16 + p0] = v0[li]; si[Lx * 16 + p0] = lane; }
        if ((g1 || q1) && p1 < 16) { sv[Lx * 16 + p1] = v1[li]; si[Lx * 16 + p1] = lane + 64; }
      }
    }
    __builtin_amdgcn_wave_barrier();
    {
      const int Lx = w * 4 + (lane >> 4), e = lane & 15;
      const float v = sv[Lx * 16 + e];
      const int id = si[Lx * 16 + e];
      int rank = 0;
#pragma unroll
      for (int q = 0; q < 4; ++q) {
        float4 o = *reinterpret_cast<const float4*>(sv + Lx * 16 + q * 4);
        rank += (o.x > v || (o.x == v && q * 4 + 0 < e)) ? 1 : 0;
        rank += (o.y > v || (o.y == v && q * 4 + 1 < e)) ? 1 : 0;
        rank += (o.z > v || (o.z == v && q * 4 + 2 < e)) ? 1 : 0;
        rank += (o.w > v || (o.w == v && q * 4 + 3 < e)) ? 1 : 0;
      }
      __builtin_amdgcn_wave_barrier();
      svs[Lx * 16 + rank] = v; sis[Lx * 16 + rank] = id;
    }
    __builtin_amdgcn_wave_barrier();
    {
      float cv[2]; unsigned ck[2], T[2]; int ce[2];
      const int cij = (lane < 50) ? (int)CAND_IJ[lane] : 0;
      const int ci = cij >> 4, cj = cij & 15;
#pragma unroll
      for (int hi = 0; hi < 2; ++hi) {
        const int h = w * 2 + hi;
        T[hi] = 0;
        cv[hi] = svs[(2 * h) * 16 + ci] + svs[(2 * h + 1) * 16 + cj];
        ce[hi] = sis[(2 * h) * 16 + ci] * 128 + sis[(2 * h + 1) * 16 + cj];
        ck[hi] = (lane < 50) ? fkey(cv[hi]) : 0u;
      }
      for (int b = 31; b >= KLOW; --b) {
#pragma unroll
        for (int hi = 0; hi < 2; ++hi) {
          unsigned cand = T[hi] | (1u << b);
          int cnt = __popcll(__ballot(ck[hi] >= cand));
          if (cnt >= 16) T[hi] = cand;
        }
      }
#pragma unroll
      for (int hi = 0; hi < 2; ++hi) {
        const int h = w * 2 + hi;
        const unsigned T2 = T[hi] + (1u << KLOW);
        bool g = ck[hi] >= T2, q = (ck[hi] >= T[hi]) && !g && (lane < 50);
        unsigned long long mg = __ballot(g), mq = __ballot(q);
        int p = g ? __popcll(mg & ltmask) : __popcll(mg) + __popcll(mq & ltmask);
        if ((g || q) && p < 16) { tops[h * 16 + p] = cv[hi]; tope[h * 16 + p] = ce[hi]; }
      }
    }
    __syncthreads();
    if (tid < 128) {
      float s = tops[tid];
      float mx = s;
      mx = fmaxf(mx, __shfl_xor(mx, 1)); mx = fmaxf(mx, __shfl_xor(mx, 2));
      mx = fmaxf(mx, __shfl_xor(mx, 4)); mx = fmaxf(mx, __shfl_xor(mx, 8));
      float e = __expf(s - mx);
      float sm = e;
      sm += __shfl_xor(sm, 1); sm += __shfl_xor(sm, 2); sm += __shfl_xor(sm, 4); sm += __shfl_xor(sm, 8);
      tops[tid] = e / sm;
    }
    __syncthreads();
    f32x2 xv[8];
    {
      const float4* xp = reinterpret_cast<const float4*>(xr + lane * 16);
#pragma unroll
      for (int q = 0; q < 4; ++q) {
        float4 a = xp[q];
        xv[2 * q] = f32x2{a.x, a.y}; xv[2 * q + 1] = f32x2{a.z, a.w};
      }
    }
    f32x2 oacc[8];
#pragma unroll
    for (int q = 0; q < 8; ++q) oacc[q] = f32x2{0.f, 0.f};
#pragma unroll 1
    for (int p0 = 0; p0 < 32; p0 += 8) {
      uint4 ru[8], rv[8];
#pragma unroll
      for (int i = 0; i < 8; ++i) {
        int e = tope[w * 32 + p0 + i];
        ru[i] = *reinterpret_cast<const uint4*>(UT + (long)e * 1024 + lane * 16);
        rv[i] = *reinterpret_cast<const uint4*>(VTb + (long)e * 1024 + lane * 16);
      }
      float dsum[8];
#pragma unroll
      for (int i = 0; i < 8; ++i) {
        f32x2 f[8];
        dec16(ru[i], f);
        f32x2 acc = f[0] * xv[0];
#pragma unroll
        for (int q = 1; q < 8; ++q) acc = __builtin_elementwise_fma(f[q], xv[q], acc);
        dsum[i] = acc.x + acc.y;
      }
      float e4[4], e2[2], e1;
      {
        const bool hi = (lane & 32) != 0;
#pragma unroll
        for (int i = 0; i < 4; ++i) {
          float snd = hi ? dsum[i] : dsum[i + 4];
          float kp = hi ? dsum[i + 4] : dsum[i];
          e4[i] = kp + __shfl_xor(snd, 32);
        }
        const bool hi2 = (lane & 16) != 0;
#pragma unroll
        for (int i = 0; i < 2; ++i) {
          float snd = hi2 ? e4[i] : e4[i + 2];
          float kp = hi2 ? e4[i + 2] : e4[i];
          e2[i] = kp + __shfl_xor(snd, 16);
        }
        const bool hi3 = (lane & 8) != 0;
        {
          float snd = hi3 ? e2[0] : e2[1];
          float kp = hi3 ? e2[1] : e2[0];
          e1 = kp + __shfl_xor(snd, 8);
        }
        e1 += __shfl_xor(e1, 4); e1 += __shfl_xor(e1, 2); e1 += __shfl_xor(e1, 1);
      }
      {
        int r = ((lane >> 5) & 1) * 4 + ((lane >> 4) & 1) * 2 + ((lane >> 3) & 1);
        float wv_ = tops[w * 32 + p0 + r] * geluf_(e1 * (1.f / U_SCALE)) * (1.f / V_SCALE);
        if ((lane & 7) == 0) wgt[w * 32 + p0 + r] = wv_;
      }
      __builtin_amdgcn_wave_barrier();
      float wg[8];
      {
        float4 wa = *reinterpret_cast<const float4*>(wgt + w * 32 + p0);
        float4 wb = *reinterpret_cast<const float4*>(wgt + w * 32 + p0 + 4);
        wg[0] = wa.x; wg[1] = wa.y; wg[2] = wa.z; wg[3] = wa.w; wg[4] = wb.x; wg[5] = wb.y; wg[6] = wb.z; wg[7] = wb.w;
      }
#pragma unroll
      for (int i = 0; i < 8; ++i) {
        f32x2 f[8];
        dec16(rv[i], f);
        f32x2 wv = f32x2{wg[i], wg[i]};
#pragma unroll
        for (int q = 0; q < 8; ++q) oacc[q] = __builtin_elementwise_fma(f[q], wv, oacc[q]);
      }
    }
    {
      float4* rwp = reinterpret_cast<float4*>(red + w * 1024 + lane * 16);
#pragma unroll
      for (int q = 0; q < 4; ++q) rwp[q] = make_float4(oacc[2 * q].x, oacc[2 * q].y, oacc[2 * q + 1].x, oacc[2 * q + 1].y);
    }
    __syncthreads();
    const int c = tid * 4;
    float y[4];
    {
      float4 xx = *reinterpret_cast<const float4*>(xr + c);
      float4 r0 = *reinterpret_cast<const float4*>(red + c);
      float4 r1 = *reinterpret_cast<const float4*>(red + 1024 + c);
      float4 r2 = *reinterpret_cast<const float4*>(red + 2048 + c);
      float4 r3 = *reinterpret_cast<const float4*>(red + 3072 + c);
      y[0] = ALPHA * xx.x + (r0.x + r1.x + r2.x + r3.x);
      y[1] = ALPHA * xx.y + (r0.y + r1.y + r2.y + r3.y);
      y[2] = ALPHA * xx.z + (r0.z + r1.z + r2.z + r3.z);
      y[3] = ALPHA * xx.w + (r0.w + r1.w + r2.w + r3.w);
    }
    float s = wave_sum(y[0] + y[1] + y[2] + y[3]);
    if (lane == 0) stat[w] = s;
    __syncthreads();
    float mu = (stat[0] + stat[1] + stat[2] + stat[3]) * (1.f / 1024.f);
    float ss = 0.f;
#pragma unroll
    for (int i = 0; i < 4; ++i) { float dl = y[i] - mu; ss += dl * dl; }
    ss = wave_sum(ss);
    if (lane == 0) stat[4 + w] = ss;
    __syncthreads();
    float rs = rsqrtf((stat[4] + stat[5] + stat[6] + stat[7]) * (1.f / 1024.f) + 1e-5f);
    float o[4];
#pragma unroll
    for (int i = 0; i < 4; ++i) o[i] = (y[i] - mu) * rs * g2[c + i] + b2[c + i];
    *reinterpret_cast<float4*>(xr + c) = make_float4(o[0], o[1], o[2], o[3]);
    store4bf(xb + (long)it * 1024 + c, o);
  }
}

#define XB_TMO      128
#define XB_XCNT(j)  (256  + 64 * (j))
#define XB_XSUB(j)  (1280 + 64 * (j))
#define XB_XGEN(j)  (2304 + 64 * (j))
#define XB_TOP      3328
#define XB_TOPGEN   3392
#define XCD_BAR_WORDS 3456
#define XB_SPIN_CAP (1u << 18)
DEVI unsigned xb_ld(unsigned* p) { return __hip_atomic_load(p, __ATOMIC_RELAXED, __HIP_MEMORY_SCOPE_AGENT); }
DEVI unsigned xb_add(unsigned* p, unsigned v) { return __hip_atomic_fetch_add(p, v, __ATOMIC_RELAXED, __HIP_MEMORY_SCOPE_AGENT); }
DEVI unsigned xb_xcc_id() { return (unsigned)__builtin_amdgcn_s_getreg((3 << 11) | 20) & 0xFu; }
#define XB_SPIN(cond, bar) do { unsigned _sp = 0; while (cond) { __builtin_amdgcn_s_sleep(1); \
    if ((++_sp & 255u) == 0u) { if (xb_ld(&(bar)[XB_TMO])) break; if (_sp > XB_SPIN_CAP) { atomicAdd(&(bar)[XB_TMO], 1u); break; } } } } while (0)
DEVI void xcd_census(unsigned* bar, unsigned x, unsigned& nloc, unsigned& nx) {
  const unsigned G = gridDim.x;
  unsigned sum, cnt, mine, sp = 0u;
  for (;;) {
    sum = 0u; cnt = 0u; mine = 0u;
#pragma unroll
    for (unsigned j = 0; j < 16; ++j) { const unsigned c = xb_ld(&bar[XB_XCNT(j)]); sum += c; cnt += (c > 0u) ? 1u : 0u; mine = (j == x) ? c : mine; }
    if (sum == G) break;
    __builtin_amdgcn_s_sleep(1);
    if ((++sp & 255u) == 0u) { if (xb_ld(&bar[XB_TMO])) break; if (sp > XB_SPIN_CAP) { atomicAdd(&bar[XB_TMO], 1u); break; } }
  }
  nloc = mine > 0u ? mine : 1u; nx = cnt > 0u ? cnt : 1u;
}
DEVI void xcd_barrier(unsigned* bar, unsigned x, unsigned nloc, unsigned nx) {
  asm volatile("s_waitcnt vmcnt(0)" ::: "memory");
  __syncthreads();
  if (threadIdx.x == 0) {
    __builtin_amdgcn_s_waitcnt(0);
    const unsigned old = xb_add(&bar[XB_XSUB(x)], 1u);
    const unsigned gen = old / nloc;
    if (old + 1u == (gen + 1u) * nloc) {
      __builtin_amdgcn_fence(__ATOMIC_RELEASE, "agent");
      asm volatile("s_waitcnt vmcnt(0)" ::: "memory");
      const unsigned og = xb_add(&bar[XB_TOP], 1u);
      const unsigned tg = og / nx;
      if (og + 1u == (tg + 1u) * nx) xb_add(&bar[XB_TOPGEN], 1u);
      else XB_SPIN(xb_ld(&bar[XB_TOPGEN]) == tg, bar);
      __builtin_amdgcn_fence(__ATOMIC_ACQUIRE, "agent");
      xb_add(&bar[XB_XGEN(x)], 1u);
      asm volatile("s_waitcnt vmcnt(0)" ::: "memory");
    } else {
      XB_SPIN(xb_ld(&bar[XB_XGEN(x)]) == gen, bar);
      __builtin_amdgcn_fence(__ATOMIC_ACQUIRE, "agent");
      asm volatile("s_waitcnt vmcnt(0)" ::: "memory");
    }
  }
  __syncthreads();
}

__global__ void __launch_bounds__(256, 2) fwd_megakernel(Params P) {
  __shared__ __attribute__((aligned(16))) char smem[65536];
  cg::grid_group grid = cg::this_grid();
  unsigned* bar = (unsigned*)(P.ws + O_BAR);
  const unsigned xcc = xb_xcc_id();
  if (threadIdx.x == 0) (void)xb_add(&bar[XB_XCNT(xcc)], 1u);
  unsigned nloc = 1u, nx = 1u;
#define LND asm volatile("" : "+s"(l), "+s"(pass))
#define GSYNC xcd_barrier(bar, xcc, nloc, nx)
#pragma unroll 1
  for (int l = 0; l < 2; ++l) {
    phase_prep(P, l, smem);
    if (l == 0) {
      phase_xcopy(P);
      grid.sync();
      if (threadIdx.x == 0) xcd_census(bar, xcc, nloc, nx);
    } else {
      GSYNC;
    }
#pragma unroll 1
    for (int pass = 0; pass < 2; ++pass) {
      LND; phase_inproj(P, l, pass, smem); GSYNC;
      LND; phase2(P, l, pass, smem); GSYNC;
      LND; phase3(P, l, pass, smem); GSYNC;
      LND; phase4(P, l, pass, smem); GSYNC;
      LND; phase6(P, l, pass, smem); GSYNC;
      LND; phase7(P, l, pass, smem); GSYNC;
      LND; phase8(P, l, pass); GSYNC;
      LND; phase9(P, l, pass, smem); GSYNC;
      LND; phase11(P, l, pass, smem); if (!(l == 1 && pass == 1)) GSYNC;
    }
  }
}

extern "C" void kernel_launch(void* const* d_in, const int* in_sizes, int n_in, void* d_out, int out_size,
                              void* d_ws, size_t ws_size, hipStream_t stream) {
  static int grid_blocks = 0;
  if (!grid_blocks) {
    int dev = 0, cus = 0, per_cu = 0;
    hipGetDevice(&dev);
    hipDeviceGetAttribute(&cus, hipDeviceAttributeMultiprocessorCount, dev);
    hipOccupancyMaxActiveBlocksPerMultiprocessor(&per_cu, fwd_megakernel, 256, 0);
    if (per_cu > 2) per_cu = 2;
    if (per_cu < 1) per_cu = 1;
    grid_blocks = cus * per_cu;
  }
  if (ws_size < O_END) fprintf(stderr, "workspace too small: %zu < %zu\n", ws_size, (size_t)O_END);
  hipMemsetAsync((char*)d_ws + O_BAR, 0, 16384, stream);
  Params p{};
  for (int i = 0; i < 30; ++i) p.in[i] = (const float*)d_in[i];
  p.out = (float*)d_out;
  p.ws = (char*)d_ws;
  void* args[] = {&p};
  hipError_t e = hipLaunchCooperativeKernel((void*)fwd_megakernel, dim3(grid_blocks), dim3(256), args, 0, stream);
  if (e != hipSuccess) fprintf(stderr, "cooperative launch failed: %s (grid %d)\n", hipGetErrorString(e), grid_blocks);
}
```
